# Optimizing an MI355X kernel written in HIP

```python
import math
import jax, jax.numpy as jnp
from jax import lax
import numpy as np

D_MODEL = 1024
BATCH = 32
SEQ = 256
DEPTH = 4
DEC_BATCH = 8
DEC_SEQ = 4096
PAST_LEN = 256

GRID_W = 64
N_HEADS = 8
N_KV_HEADS = 2
HEAD_DIM = 64
ATTN_W = N_HEADS * HEAD_DIM
KV_W = N_KV_HEADS * HEAD_DIM
HYENA_W = 256
CONV_W = 256
MIX_W = ATTN_W + HYENA_W + CONV_W
WINDOW = 128
BLOCK = 128
HYENA_ORDER = 2
FILTER_EMB = 33
FILTER_HIDDEN = 64
HYENA_TARGET = 1e-2
FAST_DECAY_PCT = 0.3
SLOW_DECAY_PCT = 1.5
ROPE_BASE = 10000.0
RMS_EPS = 1e-6
NEG_INF = -1e30
IN_COLS = ATTN_W + 2 * KV_W + ATTN_W + 3 * HYENA_W + HYENA_W + 3 * CONV_W + CONV_W
SPLITS = (ATTN_W,
          ATTN_W + KV_W,
          ATTN_W + 2 * KV_W,
          2 * ATTN_W + 2 * KV_W,
          2 * ATTN_W + 2 * KV_W + 3 * HYENA_W,
          2 * ATTN_W + 2 * KV_W + 4 * HYENA_W,
          2 * ATTN_W + 2 * KV_W + 4 * HYENA_W + 3 * CONV_W)

kernel_name = 'hybrid_diffusion_parallel_heads_step'


def rms_norm(x, g):
    xf = x.astype(jnp.float32)
    y = xf * lax.rsqrt(jnp.mean(xf * xf, axis=-1, keepdims=True) + RMS_EPS)
    return (y * g.astype(jnp.float32)).astype(x.dtype)


def dwconv3(u, w):
    L = u.shape[1]
    up = jnp.pad(u, ((0, 0), (1, 1), (0, 0)))
    return up[:, :L] * w[0] + up[:, 1:L + 1] * w[1] + up[:, 2:] * w[2]


def axial_rope(L, dtype):
    t = jnp.arange(L)
    n_freq = HEAD_DIM // 4
    inv = ROPE_BASE ** (-jnp.arange(n_freq, dtype=jnp.float32) / n_freq)
    row = (t // GRID_W).astype(jnp.float32)[:, None] * inv
    col = (t % GRID_W).astype(jnp.float32)[:, None] * inv
    ang = jnp.stack([row, col], axis=1)
    return jnp.cos(ang).astype(dtype), jnp.sin(ang).astype(dtype)


def apply_rope(x, cos, sin):
    xs = x.reshape(x.shape[:-1] + (2, 2, HEAD_DIM // 4))
    xa, xb = xs[..., 0, :], xs[..., 1, :]
    c = cos[:, None]
    s = sin[:, None]
    out = jnp.stack([xa * c - xb * s, xb * c + xa * s], axis=-2)
    return out.reshape(x.shape)


def context_attention(q, k, v, sink):
    B, Lc = q.shape[:2]
    G = N_HEADS // N_KV_HEADS
    nb = Lc // BLOCK
    scale = HEAD_DIM ** -0.5
    sink_logit = sink.astype(jnp.float32).reshape(1, N_KV_HEADS, G, 1, 1)

    def block(n):
        qb = lax.dynamic_slice_in_dim(q, n * BLOCK, BLOCK, 1).reshape(B, BLOCK, N_KV_HEADS, G, HEAD_DIM)
        s = jnp.einsum('bqhgd,bkhd->bhgqk', qb, k).astype(jnp.float32) * scale
        s_snk = jnp.broadcast_to(sink_logit, s.shape[:-1] + (1,))
        p = jax.nn.softmax(jnp.concatenate([s, s_snk], axis=-1), axis=-1)[..., :Lc].astype(v.dtype)
        o = jnp.einsum('bhgqk,bkhd->bqhgd', p, v)
        return o.reshape(B, BLOCK, ATTN_W)

    out = lax.map(block, jnp.arange(nb))
    return jnp.moveaxis(out, 0, 1).reshape(B, Lc, ATTN_W)


def latent_attention(q_rot, q_raw, k_rot, v, ck, cv, sink):
    B, L = q_rot.shape[:2]
    Lc = ck.shape[1]
    G = N_HEADS // N_KV_HEADS
    nb = L // BLOCK
    scale = HEAD_DIM ** -0.5
    pad = ((0, 0), (BLOCK, BLOCK), (0, 0), (0, 0))
    kp = jnp.pad(k_rot, pad)
    vp = jnp.pad(v, pad)
    qi = jnp.arange(BLOCK)[:, None]
    kj = jnp.arange(3 * BLOCK)[None, :]
    in_window = jnp.abs(kj - BLOCK - qi) <= WINDOW
    sink_logit = sink.astype(jnp.float32).reshape(1, N_KV_HEADS, G, 1, 1)

    def block(n):
        start = n * BLOCK
        qb = lax.dynamic_slice_in_dim(q_rot, start, BLOCK, 1).reshape(B, BLOCK, N_KV_HEADS, G, HEAD_DIM)
        q0 = lax.dynamic_slice_in_dim(q_raw, start, BLOCK, 1).reshape(B, BLOCK, N_KV_HEADS, G, HEAD_DIM)
        kb = lax.dynamic_slice_in_dim(kp, start, 3 * BLOCK, 1)
        vb = lax.dynamic_slice_in_dim(vp, start, 3 * BLOCK, 1)
        kpos = start - BLOCK + kj
        mask = in_window & (kpos >= 0) & (kpos < L)
        s_loc = jnp.einsum('bqhgd,bkhd->bhgqk', qb, kb).astype(jnp.float32) * scale
        s_loc = jnp.where(mask, s_loc, NEG_INF)
        s_ctx = jnp.einsum('bqhgd,bchd->bhgqc', q0, ck).astype(jnp.float32) * scale
        s_snk = jnp.broadcast_to(sink_logit, s_loc.shape[:-1] + (1,))
        p = jax.nn.softmax(jnp.concatenate([s_loc, s_ctx, s_snk], axis=-1), axis=-1).astype(v.dtype)
        o = (jnp.einsum('bhgqk,bkhd->bqhgd', p[..., :3 * BLOCK], vb)
             + jnp.einsum('bhgqc,bchd->bqhgd', p[..., 3 * BLOCK:3 * BLOCK + Lc], cv))
        return o.reshape(B, BLOCK, ATTN_W)

    out = lax.map(block, jnp.arange(nb))
    return jnp.moveaxis(out, 0, 1).reshape(B, L, ATTN_W)


def hyena_filters(L, w1, b1, w2, b2, w3, freq):
    f32 = jnp.float32
    t = jnp.linspace(0.0, 1.0, L, dtype=f32)[:, None]
    bands = (FILTER_EMB - 1) // 2
    ang = (2.0 * math.pi / L) * jnp.arange(L, dtype=f32)[:, None]
    fr = jnp.linspace(1e-4, bands - 1, bands, dtype=f32)[None, :]
    feats = jnp.concatenate([t, jnp.cos(fr * ang), -jnp.sin(fr * ang)], axis=-1)
    fq = freq.astype(f32)
    h = jnp.sin(fq * (feats @ w1.astype(f32) + b1.astype(f32)))
    h = jnp.sin(fq * (h @ w2.astype(f32) + b2.astype(f32)))
    h = (h @ w3.astype(f32)).reshape(L, 2, HYENA_ORDER, HYENA_W)
    max_decay = math.log(HYENA_TARGET) / FAST_DECAY_PCT
    min_decay = math.log(HYENA_TARGET) / SLOW_DECAY_PCT
    deltas = jnp.abs(jnp.linspace(min_decay, max_decay, HYENA_W, dtype=f32))
    h = h * jnp.exp(-t * deltas)[:, None, None, :]
    fwd, bwd = h[:, 0], h[:, 1]
    k = jnp.concatenate([fwd, jnp.zeros_like(fwd[:1]), jnp.flip(bwd[1:], axis=0)], axis=0)
    k = k / jnp.sum(jnp.abs(k), axis=0, keepdims=True)
    return jnp.fft.rfft(k, axis=0)


def long_conv(u, kf, d):
    L = u.shape[1]
    uf32 = u.astype(jnp.float32)
    uf = jnp.fft.rfft(uf32, n=2 * L, axis=1)
    y = jnp.fft.irfft(uf * kf[None], n=2 * L, axis=1)[:, :L]
    return (y + uf32 * d.astype(jnp.float32)).astype(u.dtype)


def trunk_layer(x, mod, ck, cv, norm_g, w_in, attn_sink, hy_conv_w, hy_filt_w1, hy_filt_b1,
                hy_filt_w2, hy_filt_b2, hy_filt_w3, hy_filt_freq, hy_d, sc_conv_w, w_out):
    B, L = x.shape[:2]
    shift, scale, gate = jnp.split(mod, 3, axis=-1)
    h = rms_norm(x, norm_g) * (1.0 + scale[:, None]) + shift[:, None]
    proj = h @ w_in
    q, k, v, g_a, hy, g_h, sc, g_c = jnp.split(proj, SPLITS, axis=-1)
    q = q.reshape(B, L, N_HEADS, HEAD_DIM)
    k = k.reshape(B, L, N_KV_HEADS, HEAD_DIM)
    v = v.reshape(B, L, N_KV_HEADS, HEAD_DIM)
    if ck is None:
        attn = context_attention(q, k, v, attn_sink)
    else:
        cos, sin = axial_rope(L, q.dtype)
        attn = latent_attention(apply_rope(q, cos, sin), q, apply_rope(k, cos, sin), v, ck, cv, attn_sink)
    hy = dwconv3(hy, hy_conv_w)
    hv, hx1, hx2 = jnp.split(hy, 3, axis=-1)
    kf = hyena_filters(L, hy_filt_w1, hy_filt_b1, hy_filt_w2, hy_filt_b2, hy_filt_w3, hy_filt_freq)
    z = hx1 * long_conv(hv, kf[:, 0], hy_d[0])
    z = hx2 * long_conv(z, kf[:, 1], hy_d[1])
    sb, scg, sx = jnp.split(sc, 3, axis=-1)
    sc_out = sb * dwconv3(scg * sx, sc_conv_w)
    mixed = jnp.concatenate([attn * jax.nn.silu(g_a), z * jax.nn.silu(g_h), sc_out * jax.nn.silu(g_c)], axis=-1)
    return x + gate[:, None] * (mixed @ w_out), k, v


def setup_inputs(seed: int = 0) -> dict:
    key = jax.random.key(seed)
    ks = jax.random.split(key, 22)
    f32 = jnp.float32

    def nrm(k, shape, s):
        return jax.random.normal(k, shape, f32) * s

    cache_shape = (DEC_BATCH, DEPTH, PAST_LEN, N_KV_HEADS, HEAD_DIM)
    return {
        'x_prompt': nrm(ks[0], (BATCH, SEQ, D_MODEL), 1.0),
        'x_sample': nrm(ks[1], (DEC_BATCH, DEC_SEQ, D_MODEL), 1.0),
        'cache_k': nrm(ks[2], cache_shape, 1.0),
        'cache_v': nrm(ks[3], cache_shape, 1.0),
        'c': nrm(ks[4], (DEC_BATCH, D_MODEL), 1.0),
        'c_ctx': nrm(ks[5], (D_MODEL,), 1.0),
        'norm_g': 1.0 + nrm(ks[6], (DEPTH, D_MODEL), 0.1),
        'mod_w': nrm(ks[7], (DEPTH, D_MODEL, 3 * D_MODEL), D_MODEL ** -0.5),
        'mod_b': nrm(ks[8], (DEPTH, 3 * D_MODEL), 0.02),
        'w_in': nrm(ks[9], (DEPTH, D_MODEL, IN_COLS), D_MODEL ** -0.5),
        'attn_sink': nrm(ks[10], (DEPTH, N_HEADS), 0.5),
        'hy_conv_w': nrm(ks[11], (DEPTH, 3, 3 * HYENA_W), 3 ** -0.5),
        'hy_filt_w1': nrm(ks[12], (DEPTH, FILTER_EMB, FILTER_HIDDEN), FILTER_EMB ** -0.5),
        'hy_filt_b1': nrm(ks[13], (DEPTH, FILTER_HIDDEN), 0.02),
        'hy_filt_w2': nrm(ks[14], (DEPTH, FILTER_HIDDEN, FILTER_HIDDEN), FILTER_HIDDEN ** -0.5),
        'hy_filt_b2': nrm(ks[15], (DEPTH, FILTER_HIDDEN), 0.02),
        'hy_filt_w3': nrm(ks[16], (DEPTH, FILTER_HIDDEN, 2 * HYENA_ORDER * HYENA_W), FILTER_HIDDEN ** -0.5),
        'hy_filt_freq': 1.0 + nrm(ks[17], (DEPTH, FILTER_HIDDEN), 0.1),
        'hy_d': nrm(ks[18], (DEPTH, HYENA_ORDER, HYENA_W), 0.5),
        'sc_conv_w': nrm(ks[19], (DEPTH, 3, CONV_W), 3 ** -0.5),
        'w_out': nrm(ks[20], (DEPTH, MIX_W, D_MODEL), MIX_W ** -0.5),
        'final_g': 1.0 + nrm(ks[21], (D_MODEL,), 0.1),
    }


def reference(x_prompt, x_sample, cache_k, cache_v, c, c_ctx, norm_g, mod_w, mod_b, w_in, attn_sink,
              hy_conv_w, hy_filt_w1, hy_filt_b1, hy_filt_w2, hy_filt_b2, hy_filt_w3, hy_filt_freq, hy_d,
              sc_conv_w, w_out, final_g):
    cond_ctx = jax.nn.silu(c_ctx)[None, :]
    cond_lat = jax.nn.silu(c)
    xp, xs = x_prompt, x_sample
    ks_new, vs_new = [], []
    for l in range(DEPTH):
        lw = (norm_g[l], w_in[l], attn_sink[l], hy_conv_w[l], hy_filt_w1[l], hy_filt_b1[l], hy_filt_w2[l],
              hy_filt_b2[l], hy_filt_w3[l], hy_filt_freq[l], hy_d[l], sc_conv_w[l], w_out[l])
        mod_p = cond_ctx @ mod_w[l] + mod_b[l]
        mod_s = cond_lat @ mod_w[l] + mod_b[l]
        xp, k_l, v_l = trunk_layer(xp, mod_p, None, None, *lw)
        xs, _, _ = trunk_layer(xs, mod_s, cache_k[:, l], cache_v[:, l], *lw)
        ks_new.append(k_l)
        vs_new.append(v_l)
    new_cache_k = jnp.stack(ks_new, axis=1)
    new_cache_v = jnp.stack(vs_new, axis=1)
    y_prompt = rms_norm(xp, final_g)
    y_sample = rms_norm(xs, final_g)
    return (y_prompt, y_sample, new_cache_k, new_cache_v)
```

```cpp
#ifdef EMU
#include "emu.h"
#define GRID_SYNC() emu_grid_sync()
#define MFMA32(a, b, c) emu_mfma32((a), (b), (c))
#else
#include <hip/hip_runtime.h>
#include <hip/hip_cooperative_groups.h>
#include <cstdio>
#include <cstdint>
typedef short bf16x8 __attribute__((ext_vector_type(8)));
typedef float f32x16 __attribute__((ext_vector_type(16)));
typedef float f32x4 __attribute__((ext_vector_type(4)));
#define GRID_SYNC() cooperative_groups::this_grid().sync()
#define MFMA32(a, b, c) __builtin_amdgcn_mfma_f32_32x32x16_bf16((a), (b), (c), 0, 0, 0)
#endif
typedef unsigned u32x4 __attribute__((ext_vector_type(4)));
typedef unsigned u32x2 __attribute__((ext_vector_type(2)));
typedef float f32x2 __attribute__((ext_vector_type(2)));
typedef unsigned short bf16;
#define DI __device__ __forceinline__

#ifdef CFG_SMALL
constexpr int D_MODEL = 128, BATCH = 2, SEQ = 256, DEPTH = 2, DEC_BATCH = 2, DEC_SEQ = 4096, PAST_LEN = 256, HYENA_W = 128, CONV_W = 128;
#else
constexpr int D_MODEL = 1024, BATCH = 32, SEQ = 256, DEPTH = 4, DEC_BATCH = 8, DEC_SEQ = 4096, PAST_LEN = 256, HYENA_W = 256, CONV_W = 256;
#endif
constexpr int GRID_W = 64, N_HEADS = 8, N_KV = 2, HD = 64, ATTN_W = 512, KV_W = 128;
constexpr int MIX_W = ATTN_W + HYENA_W + CONV_W;
constexpr int C_Q = 0, C_K = ATTN_W, C_V = C_K + KV_W, C_GA = C_V + KV_W, C_HV = C_GA + ATTN_W, C_GH = C_HV + 3 * HYENA_W,
              C_SB = C_GH + HYENA_W, C_GC = C_SB + 3 * CONV_W, IN_COLS = C_GC + CONV_W;
constexpr int TC = BATCH * SEQ, TL = DEC_BATCH * DEC_SEQ, T = TC + TL;
constexpr int NR = 1 + DEC_BATCH;
constexpr int FH = 64, FE = 33;
constexpr int NTHR = 512;
static_assert(T % 256 == 0 && TC % 256 == 0 && IN_COLS % 128 == 0 && D_MODEL % 128 == 0, "tiling");
static_assert(SEQ == 256 && DEC_SEQ == 4096 && PAST_LEN == 256, "fft sizes");

constexpr size_t al256(size_t x) { return (x + 255) & ~(size_t)255; }
constexpr size_t WS_BAR = 0;
constexpr size_t WS_WINT = 65536;
constexpr size_t WS_WOUTT = WS_WINT + al256((size_t)DEPTH * IN_COLS * D_MODEL * 2);
constexpr size_t WS_MOD = WS_WOUTT + al256((size_t)DEPTH * D_MODEL * MIX_W * 2);
constexpr size_t WS_ROPE = WS_MOD + al256((size_t)DEPTH * NR * 3 * D_MODEL * 4);
constexpr size_t WS_HID2 = WS_ROPE + al256((size_t)DEC_SEQ * 32 * 8);
constexpr size_t WS_CKB = WS_HID2 + al256((size_t)DEPTH * (SEQ + DEC_SEQ) * FH * 4);
constexpr size_t WS_CVTB = WS_CKB + al256((size_t)DEC_BATCH * DEPTH * PAST_LEN * KV_W * 2);
constexpr size_t WS_KFL = WS_CVTB + al256((size_t)DEC_BATCH * DEPTH * PAST_LEN * KV_W * 2);
constexpr size_t WS_KFC = WS_KFL + al256((size_t)2 * HYENA_W * 8192 * 8);
constexpr size_t WS_XN = WS_KFC + al256((size_t)2 * HYENA_W * 512 * 8);
constexpr size_t WS_Q = WS_XN + al256((size_t)T * (D_MODEL > MIX_W ? D_MODEL : MIX_W) * 2);
constexpr size_t WS_KB = WS_Q + al256((size_t)T * ATTN_W * 2);
constexpr size_t WS_VT = WS_KB + al256((size_t)T * KV_W * 2);
constexpr size_t WS_GA = WS_VT + al256((size_t)T * KV_W * 2);
constexpr size_t WS_HYT = WS_GA + al256((size_t)T * ATTN_W * 2);
constexpr size_t WS_SC = WS_HYT + al256((size_t)4 * HYENA_W * T * 2);
constexpr size_t WS_END = WS_SC + al256((size_t)T * 4 * CONV_W * 2);

constexpr size_t OUT_YS = (size_t)TC * D_MODEL, OUT_NK = (size_t)T * D_MODEL, OUT_NV = OUT_NK + (size_t)BATCH * DEPTH * SEQ * KV_W,
                 OUT_TOTAL = OUT_NV + (size_t)BATCH * DEPTH * SEQ * KV_W;

constexpr int LDS_BYTES = 149504;

struct Params {
    const float* in[22];
    float* out;
    unsigned char* ws;
};
enum { I_XP = 0, I_XS, I_CK, I_CV, I_C, I_CCTX, I_NORMG, I_MODW, I_MODB, I_WIN, I_SINK, I_HYCW, I_FW1, I_FB1, I_FW2, I_FB2, I_FW3, I_FFREQ, I_HYD, I_SCW, I_WOUT, I_FINALG };

DI bf16 f2bf(float f) { unsigned u = __float_as_uint(f); u += 0x7fffu + ((u >> 16) & 1u); return (bf16)(u >> 16); }
DI float bf2f(bf16 h) { return __uint_as_float(((unsigned)h) << 16); }
DI unsigned pack2(float a, float b) { return (unsigned)f2bf(a) | ((unsigned)f2bf(b) << 16); }
DI float silu_f(float x) { return x / (1.f + __expf(-x)); }
struct cpx { float x, y; };
DI cpx cmul(cpx a, cpx b) { return cpx{a.x * b.x - a.y * b.y, a.x * b.y + a.y * b.x}; }
DI cpx cadd(cpx a, cpx b) { return cpx{a.x + b.x, a.y + b.y}; }
DI cpx csub(cpx a, cpx b) { return cpx{a.x - b.x, a.y - b.y}; }
#ifdef EMU
DI Params launder(const Params& p) { return p; }
#else
DI Params launder(const Params& p) { Params q = p; asm volatile("" : "+s"(q.ws), "+s"(q.out)); return q; }
#endif
DI int mod_row(int m) { return m < TC ? 0 : 1 + (m - TC) / DEC_SEQ; }

DI void p0_transpose_item(const float* W, int K, int N, bf16* WT, int item, char* smem) {
    float* scr = (float*)smem;
    const int tid = threadIdx.x, nblk = N / 64, k0 = (item / nblk) * 64, n0 = (item % nblk) * 64;
#pragma unroll
    for (int i = 0; i < 8; ++i) { const int kk = (tid >> 6) + 8 * i, nn = tid & 63; scr[kk * 65 + nn] = W[(size_t)(k0 + kk) * N + n0 + nn]; }
    __syncthreads();
    const int n = tid >> 3, c = tid & 7;
    const float* s = scr + (8 * c) * 65 + n;
    u32x4 o; o.x = pack2(s[0], s[65]); o.y = pack2(s[2 * 65], s[3 * 65]); o.z = pack2(s[4 * 65], s[5 * 65]); o.w = pack2(s[6 * 65], s[7 * 65]);
    *(u32x4*)(WT + (size_t)(n0 + n) * K + k0 + 8 * c) = o;
    __syncthreads();
}
DI void p0_mod_item(const Params& p, int item, char* smem) {
    constexpr int NCH = (3 * D_MODEL + 511) / 512;
    float* tab = (float*)smem;
    const int tid = threadIdx.x, l = item / NCH, col = (item % NCH) * 512 + tid;
    for (int e = tid; e < NR * D_MODEL; e += NTHR) { const int r = e / D_MODEL, k = e % D_MODEL; const float cv = r == 0 ? p.in[I_CCTX][k] : p.in[I_C][(size_t)(r - 1) * D_MODEL + k]; tab[e] = silu_f(cv); }
    __syncthreads();
    if (col < 3 * D_MODEL) {
        float acc[NR];
#pragma unroll
        for (int r = 0; r < NR; ++r) acc[r] = 0.f;
        const float* w = p.in[I_MODW] + (size_t)l * D_MODEL * 3 * D_MODEL + col;
        for (int k = 0; k < D_MODEL; ++k) { const float wv = w[(size_t)k * 3 * D_MODEL];
#pragma unroll
            for (int r = 0; r < NR; ++r) acc[r] += tab[r * D_MODEL + k] * wv; }
        const float bv = p.in[I_MODB][(size_t)l * 3 * D_MODEL + col];
        float* mod = (float*)(p.ws + WS_MOD);
#pragma unroll
        for (int r = 0; r < NR; ++r) mod[((size_t)l * NR + r) * 3 * D_MODEL + col] = acc[r] + bv;
    }
    __syncthreads();
}
DI void p0_rope_item(const Params& p, int item) {
    const int e = item * NTHR + threadIdx.x;
    if (e < DEC_SEQ * 32) {
        const int t = e >> 5, a = (e >> 4) & 1, f = e & 15;
        const float pos = (float)(a ? (t % GRID_W) : (t / GRID_W));
        const float inv = exp2f(-(float)f * (13.287712379549449f / 16.f));
        const float ang = pos * inv;
        f32x2 v; v.x = cosf(ang); v.y = sinf(ang);
        ((f32x2*)(p.ws + WS_ROPE))[e] = v;
    }
}
DI void p0_hid2_item(const Params& p, int item) {
    const int lane = threadIdx.x & 63, w = threadIdx.x >> 6;
    const int rr = item * 8 + w;
    if (rr >= DEPTH * (SEQ + DEC_SEQ)) return;
    const int l = rr / (SEQ + DEC_SEQ), q = rr % (SEQ + DEC_SEQ);
    const int L = q < SEQ ? SEQ : DEC_SEQ, t = q < SEQ ? q : q - SEQ;
    float feat = 0.f;
    if (lane == 0) feat = (float)t / (float)(L - 1);
    else if (lane < FE) {
        const int b = (lane - 1) & 15;
        const float fr = 1e-4f + (float)b * ((15.f - 1e-4f) / 15.f);
        const float ang = (6.283185307179586f / (float)L) * (float)t;
        feat = lane <= 16 ? cosf(fr * ang) : -sinf(fr * ang);
    }
    const float* w1 = p.in[I_FW1] + (size_t)l * FE * FH; const float* w2 = p.in[I_FW2] + (size_t)l * FH * FH;
    const float fq = p.in[I_FFREQ][l * FH + lane];
    float a1 = p.in[I_FB1][l * FH + lane];
    for (int i = 0; i < FE; ++i) a1 += __shfl(feat, i) * w1[i * FH + lane];
    const float h1 = sinf(fq * a1);
    float a2 = p.in[I_FB2][l * FH + lane];
    for (int i = 0; i < FH; ++i) a2 += __shfl(h1, i) * w2[i * FH + lane];
    const float h2 = sinf(fq * a2);
    ((float*)(p.ws + WS_HID2))[(size_t)rr * FH + lane] = h2;
}
DI void p0_cache_item(const Params& p, int item) {
    constexpr int NCHUNK = DEC_BATCH * DEPTH * PAST_LEN * KV_W / 8;
    int e = item * NTHR + threadIdx.x;
    if (e < NCHUNK) {
        const int c8 = e & 7, j = (e >> 3) % PAST_LEN, kvh = (e >> 3) / PAST_LEN % N_KV, bl = (e >> 3) / PAST_LEN / N_KV;
        const float* src = p.in[I_CK] + ((size_t)(bl * PAST_LEN + j) * N_KV + kvh) * HD + c8 * 8;
        u32x4 o; o.x = pack2(src[0], src[1]); o.y = pack2(src[2], src[3]); o.z = pack2(src[4], src[5]); o.w = pack2(src[6], src[7]);
        *(u32x4*)((bf16*)(p.ws + WS_CKB) + (size_t)e * 8) = o;
    } else if (e < 2 * NCHUNK) {
        e -= NCHUNK;
        const int j8 = e % (PAST_LEN / 8), d = (e / (PAST_LEN / 8)) % HD, kvh = (e / (PAST_LEN / 8)) / HD % N_KV, bl = (e / (PAST_LEN / 8)) / HD / N_KV;
        const float* src = p.in[I_CV] + ((size_t)(bl * PAST_LEN + j8 * 8) * N_KV + kvh) * HD + d;
        constexpr int S = N_KV * HD;
        u32x4 o; o.x = pack2(src[0], src[S]); o.y = pack2(src[2 * S], src[3 * S]); o.z = pack2(src[4 * S], src[5 * S]); o.w = pack2(src[6 * S], src[7 * S]);
        *(u32x4*)((bf16*)(p.ws + WS_CVTB) + (size_t)e * 8) = o;
    }
}

DI const float* x_row_src(const Params& p, int l, int m) {
    if (l == 0) return m < TC ? p.in[I_XP] + (size_t)m * D_MODEL : p.in[I_XS] + (size_t)(m - TC) * D_MODEL;
    return p.out + (size_t)m * D_MODEL;
}
DI void norm_item(const Params& p, int l, int item) {
    const int lane = threadIdx.x & 63, w = threadIdx.x >> 6, m = item * 8 + w;
    if (m >= T) return;
    const float* xr = x_row_src(p, l, m);
    float ss = 0.f;
    for (int c4 = lane; c4 < D_MODEL / 4; c4 += 64) { const f32x4 v = *(const f32x4*)(xr + 4 * c4); ss += v.x * v.x + v.y * v.y + v.z * v.z + v.w * v.w; }
#pragma unroll
    for (int o = 1; o < 64; o <<= 1) ss += __shfl_xor(ss, o);
    const float rstd = rsqrtf(ss * (1.f / D_MODEL) + 1e-6f);
    if (l < DEPTH) {
        const float* g = p.in[I_NORMG] + (size_t)l * D_MODEL;
        const float* mod = (const float*)(p.ws + WS_MOD) + ((size_t)l * NR + mod_row(m)) * 3 * D_MODEL;
        bf16* xn = (bf16*)(p.ws + WS_XN) + (size_t)m * D_MODEL;
        for (int c4 = lane; c4 < D_MODEL / 4; c4 += 64) {
            const f32x4 v = *(const f32x4*)(xr + 4 * c4), gv = *(const f32x4*)(g + 4 * c4), sh = *(const f32x4*)(mod + 4 * c4), sc = *(const f32x4*)(mod + D_MODEL + 4 * c4);
            u32x2 o; o.x = pack2(v.x * rstd * gv.x * (1.f + sc.x) + sh.x, v.y * rstd * gv.y * (1.f + sc.y) + sh.y);
            o.y = pack2(v.z * rstd * gv.z * (1.f + sc.z) + sh.z, v.w * rstd * gv.w * (1.f + sc.w) + sh.w);
            *(u32x2*)(xn + 4 * c4) = o;
        }
    } else {
        const float* g = p.in[I_FINALG];
        float* yo = p.out + (size_t)m * D_MODEL;
        for (int c4 = lane; c4 < D_MODEL / 4; c4 += 64) {
            const f32x4 v = *(const f32x4*)(xr + 4 * c4), gv = *(const f32x4*)(g + 4 * c4);
            f32x4 o; o.x = v.x * rstd * gv.x; o.y = v.y * rstd * gv.y; o.z = v.z * rstd * gv.z; o.w = v.w * rstd * gv.w;
            *(f32x4*)(yo + 4 * c4) = o;
        }
    }
}

DI int swz128(int row, int c) { return row * 128 + ((c ^ ((row >> 1) & 7)) << 4); }
template <bool SWAP, class Epi>
DI void gemm_tile(const bf16* A, const bf16* Bt, int K, int m0, int n0, char* smem, const Epi& epi) {
    const int tid = threadIdx.x, lane = tid & 63, w = tid >> 6, wm = w >> 1, wn = w & 1, r = lane & 31, h = lane >> 5;
    f32x16 acc[2][2];
#pragma unroll
    for (int i = 0; i < 2; ++i)
#pragma unroll
        for (int j = 0; j < 2; ++j)
#pragma unroll
            for (int e = 0; e < 16; ++e) acc[i][j][e] = 0.f;
    const int nk = K / 64;
    u32x4 ra[4], rb[2];
    const bf16* Ag = A + (size_t)(m0 + (tid >> 3)) * K + (tid & 7) * 8;
    const bf16* Bg = Bt + (size_t)(n0 + (tid >> 3)) * K + (tid & 7) * 8;
#pragma unroll
    for (int i = 0; i < 4; ++i) ra[i] = *(const u32x4*)(Ag + (size_t)(64 * i) * K);
#pragma unroll
    for (int i = 0; i < 2; ++i) rb[i] = *(const u32x4*)(Bg + (size_t)(64 * i) * K);
    {
        char* As = smem; char* Bs = smem + 32768;
#pragma unroll
        for (int i = 0; i < 4; ++i) *(u32x4*)(As + swz128((tid >> 3) + 64 * i, tid & 7)) = ra[i];
#pragma unroll
        for (int i = 0; i < 2; ++i) *(u32x4*)(Bs + swz128((tid >> 3) + 64 * i, tid & 7)) = rb[i];
    }
    __syncthreads();
    for (int kt = 0; kt < nk; ++kt) {
        if (kt + 1 < nk) {
#pragma unroll
            for (int i = 0; i < 4; ++i) ra[i] = *(const u32x4*)(Ag + (size_t)(64 * i) * K + (kt + 1) * 64);
#pragma unroll
            for (int i = 0; i < 2; ++i) rb[i] = *(const u32x4*)(Bg + (size_t)(64 * i) * K + (kt + 1) * 64);
        }
        const char* As = smem + (kt & 1) * 49152; const char* Bs = As + 32768;
#pragma unroll
        for (int s = 0; s < 4; ++s) {
            bf16x8 a[2], b[2];
#pragma unroll
            for (int i = 0; i < 2; ++i) a[i] = *(const bf16x8*)(As + swz128(wm * 64 + i * 32 + r, 2 * s + h));
#pragma unroll
            for (int j = 0; j < 2; ++j) b[j] = *(const bf16x8*)(Bs + swz128(wn * 64 + j * 32 + r, 2 * s + h));
#pragma unroll
            for (int i = 0; i < 2; ++i)
#pragma unroll
                for (int j = 0; j < 2; ++j) acc[i][j] = SWAP ? MFMA32(b[j], a[i], acc[i][j]) : MFMA32(a[i], b[j], acc[i][j]);
        }
        if (kt + 1 < nk) {
            char* As2 = smem + ((kt + 1) & 1) * 49152; char* Bs2 = As2 + 32768;
#pragma unroll
            for (int i = 0; i < 4; ++i) *(u32x4*)(As2 + swz128((tid >> 3) + 64 * i, tid & 7)) = ra[i];
#pragma unroll
            for (int i = 0; i < 2; ++i) *(u32x4*)(Bs2 + swz128((tid >> 3) + 64 * i, tid & 7)) = rb[i];
        }
        __syncthreads();
    }
    epi.template run<SWAP>(acc, m0 + wm * 64, n0 + wn * 64, lane);
}

struct InProjEpi {
    const Params& p; int l; int n0;
    template <bool swap> DI void run(const f32x16 (&acc)[2][2], int mb, int nb, int lane) const {
        const int r = lane & 31, h = lane >> 5;
        const bool ctx = mb < TC;
        bf16* Qb = (bf16*)(p.ws + WS_Q); bf16* Kb = (bf16*)(p.ws + WS_KB); bf16* VTb = (bf16*)(p.ws + WS_VT); bf16* GAb = (bf16*)(p.ws + WS_GA);
        bf16* HYT = (bf16*)(p.ws + WS_HYT); bf16* SCb = (bf16*)(p.ws + WS_SC);
        if (!swap) {
#pragma unroll
            for (int i = 0; i < 2; ++i)
#pragma unroll
                for (int j = 0; j < 2; ++j) {
                    const int n = nb + 32 * j + r;
#pragma unroll
                    for (int reg = 0; reg < 16; ++reg) {
                        const int m = mb + 32 * i + (reg & 3) + 8 * (reg >> 2) + 4 * h;
                        const float v = acc[i][j][reg];
                        if (n0 < C_K) Qb[(size_t)m * ATTN_W + n] = f2bf(v);
                        else if (n0 < C_V) {
                            const int nn = n - C_K;
                            if (ctx) {
                                Kb[(size_t)m * KV_W + nn] = f2bf(v);
                                const int b = m / SEQ, s = m % SEQ;
                                p.out[OUT_NK + ((size_t)(b * DEPTH + l) * SEQ + s) * KV_W + nn] = v;
                            } else {
                                const int pos = (m - TC) % DEC_SEQ, a = (nn >> 5) & 1, pp = (lane >> 4) & 1, f = lane & 15;
                                const f32x2 cs = ((const f32x2*)(p.ws + WS_ROPE))[(pos * 2 + a) * 16 + f];
                                const float oth = __shfl_xor(v, 16);
                                const float o = pp ? v * cs.x + oth * cs.y : v * cs.x - oth * cs.y;
                                Kb[(size_t)m * KV_W + nn] = f2bf(o);
                            }
                        } else if (n0 < C_HV) GAb[(size_t)m * ATTN_W + (n - C_GA)] = f2bf(silu_f(v));
                        else { const int col = n - C_SB; SCb[(size_t)m * (4 * CONV_W) + col] = f2bf(col >= 3 * CONV_W ? silu_f(v) : v); }
                    }
                }
        } else {
#pragma unroll
            for (int i = 0; i < 2; ++i)
#pragma unroll
                for (int j = 0; j < 2; ++j) {
                    const int m = mb + 32 * i + r;
#pragma unroll
                    for (int reg = 0; reg < 16; ++reg) {
                        const int n = nb + 32 * j + (reg & 3) + 8 * (reg >> 2) + 4 * h;
                        const float v = acc[i][j][reg];
                        if (n0 < C_GA) {
                            const int nn = n - C_V;
                            VTb[(size_t)nn * T + m] = f2bf(v);
                            if (ctx) { const int b = m / SEQ, s = m % SEQ; p.out[OUT_NV + ((size_t)(b * DEPTH + l) * SEQ + s) * KV_W + nn] = v; }
                        } else { const int nn = n - C_HV; HYT[(size_t)nn * T + m] = f2bf(nn >= 3 * HYENA_W ? silu_f(v) : v); }
                    }
                }
        }
    }
};
struct OutProjEpi {
    const Params& p; int l;
    template <bool swap> DI void run(const f32x16 (&acc)[2][2], int mb, int nb, int lane) const {
        const int r = lane & 31, h = lane >> 5;
        const float* gate = (const float*)(p.ws + WS_MOD) + ((size_t)l * NR + mod_row(mb)) * 3 * D_MODEL + 2 * D_MODEL;
#pragma unroll
        for (int i = 0; i < 2; ++i)
#pragma unroll
            for (int j = 0; j < 2; ++j) {
                const int n = nb + 32 * j + r; const float g = gate[n];
#pragma unroll
                for (int reg = 0; reg < 16; ++reg) {
                    const int m = mb + 32 * i + (reg & 3) + 8 * (reg >> 2) + 4 * h;
                    const float xv = x_row_src(p, l, m)[n];
                    p.out[(size_t)m * D_MODEL + n] = xv + g * acc[i][j][reg];
                }
            }
    }
};

DI int PADX(int i) { return i + (i >> 4); }
template <int SIGN> DI void dft4(cpx& a0, cpx& a1, cpx& a2, cpx& a3) {
    const cpx t0 = cadd(a0, a2), t1 = csub(a0, a2), t2 = cadd(a1, a3), t3 = csub(a1, a3);
    const cpx t3r = SIGN < 0 ? cpx{t3.y, -t3.x} : cpx{-t3.y, t3.x};
    a0 = cadd(t0, t2); a1 = cadd(t1, t3r); a2 = csub(t0, t2); a3 = csub(t1, t3r);
}
template <int SIGN> DI void dft16(cpx (&v)[16]) {
#pragma unroll
    for (int n2 = 0; n2 < 4; ++n2) dft4<SIGN>(v[n2], v[4 + n2], v[8 + n2], v[12 + n2]);
    constexpr float C1 = 0.92387953251128674f, S1 = 0.38268343236508977f, R = 0.70710678118654752f, SG = (float)SIGN;
    v[5] = cmul(v[5], cpx{C1, SG * S1});  v[6] = cmul(v[6], cpx{R, SG * R});     v[7] = cmul(v[7], cpx{S1, SG * C1});
    v[9] = cmul(v[9], cpx{R, SG * R});    v[10] = cmul(v[10], cpx{0.f, SG});     v[11] = cmul(v[11], cpx{-R, SG * R});
    v[13] = cmul(v[13], cpx{S1, SG * C1}); v[14] = cmul(v[14], cpx{-R, SG * R}); v[15] = cmul(v[15], cpx{-C1, -SG * S1});
#pragma unroll
    for (int k1 = 0; k1 < 4; ++k1) dft4<SIGN>(v[4 * k1], v[4 * k1 + 1], v[4 * k1 + 2], v[4 * k1 + 3]);
}
template <int SIGN> DI void fft_pass16(cpx* fb, int j, int Ns, int N16) {
    cpx v[16];
#pragma unroll
    for (int r = 0; r < 16; ++r) v[r] = fb[PADX(j + N16 * r)];
    const int k = j & (Ns - 1);
    if (Ns > 1) {
        float sn, cs; sincospif((float)(SIGN * 2 * k) / (float)(16 * Ns), &sn, &cs);
        const cpx w{cs, sn}; cpx wr = w;
        v[1] = cmul(v[1], wr);
#pragma unroll
        for (int r = 2; r < 16; ++r) { wr = cmul(wr, w); v[r] = cmul(v[r], wr); }
    }
    dft16<SIGN>(v);
    __syncthreads();
    const int base = (j - k) * 16 + k;
#pragma unroll
    for (int kk = 0; kk < 16; ++kk) fb[PADX(base + kk * Ns)] = v[4 * (kk & 3) + (kk >> 2)];
    __syncthreads();
}
template <int SIGN> DI void fft_passes(cpx* fb, int j, int Ns0, int np16, int N16) {
#pragma unroll 1
    for (int ps = 0, Ns = Ns0; ps < np16; ++ps, Ns <<= 4) fft_pass16<SIGN>(fb, j, Ns, N16);
}
DI void fftconv(cpx* fb, int j, const cpx* kf, bool active, int np16, int N16) {
    fft_passes<-1>(fb, j, 2, np16, N16);
    if (active) {
#pragma unroll 4
        for (int i = 0; i < 16; ++i) { const int f = j + N16 * i; fb[PADX(f)] = cmul(fb[PADX(f)], kf[f]); }
    }
    __syncthreads();
    fft_passes<1>(fb, j, 1, np16, N16);
}
DI cpx conv_out(const cpx* fb, int t, int L) {
    const cpx a = fb[PADX(t)], b = fb[PADX(t + L)];
    float sn, cs; sincospif((float)t / (float)L, &sn, &cs);
    const cpx wb = cmul(cpx{cs, sn}, b);
    const float rn = 0.5f / (float)L;
    return cpx{(a.x + wb.x) * rn, (a.y + wb.y) * rn};
}
DI float conv3(const bf16* ptr, int t, int L, float w0, float w1, float w2) {
    const float a = t > 0 ? bf2f(ptr[t - 1]) : 0.f, b = bf2f(ptr[t]), c = t < L - 1 ? bf2f(ptr[t + 1]) : 0.f;
    return a * w0 + b * w1 + c * w2;
}

DI void filter_item(const Params& p, int l, int item, char* smem, bool lat) {
    const int np16 = lat ? 3 : 2, N16 = lat ? 512 : 32, N = 16 * N16, L = N / 2;
    const int NSUB = NTHR / N16;
    const int tid = threadIdx.x, sub = tid / N16, j = tid % N16;
    const int o = item / (HYENA_W / NSUB), c = (item % (HYENA_W / NSUB)) * NSUB + sub;
    cpx* fb = (cpx*)smem + sub * (N + N / 16);
    float* red = (float*)(smem + 8704 * 8);
    const float* hid = (const float*)(p.ws + WS_HID2) + ((size_t)l * (SEQ + DEC_SEQ) + (lat ? SEQ : 0)) * FH;
    const float* w3 = p.in[I_FW3] + (size_t)l * FH * 4 * HYENA_W;
    const int colf = o * HYENA_W + c, colb = 2 * HYENA_W + o * HYENA_W + c;
    const float min_decay = -4.605170185988091f / 1.5f, max_decay = -4.605170185988091f / 0.3f;
    const float delta = fabsf(min_decay + (max_decay - min_decay) * (float)c / (float)(HYENA_W - 1));
    float asum = 0.f;
#pragma unroll 1
    for (int i = 0; i < 8; ++i) {
        const int t = j + N16 * i;
        const float* hr = hid + (size_t)t * FH;
        float f = 0.f, b = 0.f;
        for (int q = 0; q < FH; ++q) { const float hv = hr[q]; f += hv * w3[(size_t)q * 4 * HYENA_W + colf]; b += hv * w3[(size_t)q * 4 * HYENA_W + colb]; }
        const float dec = __expf(-((float)t / (float)(L - 1)) * delta);
        f *= dec; b *= dec;
        fb[PADX(t)] = cpx{f, 0.f};
        if (t == 0) fb[PADX(L)] = cpx{0.f, 0.f}; else fb[PADX(N - t)] = cpx{b, 0.f};
        asum += fabsf(f) + (t == 0 ? 0.f : fabsf(b));
    }
#pragma unroll
    for (int s = 1; s < 32; s <<= 1) asum += __shfl_xor(asum, s);
    if (lat) {
        asum += __shfl_xor(asum, 32);
        if ((tid & 63) == 0) red[tid >> 6] = asum;
    }
    __syncthreads();
    if (lat) { asum = 0.f;
#pragma unroll
        for (int q = 0; q < 8; ++q) asum += red[q]; }
    const float rn = 1.f / asum;
    {
        cpx a[8], b[8];
#pragma unroll
        for (int i = 0; i < 8; ++i) { const int t = j + N16 * i; a[i] = fb[PADX(t)]; b[i] = fb[PADX(t + L)]; }
        __syncthreads();
#pragma unroll
        for (int i = 0; i < 8; ++i) { const int t = j + N16 * i; fb[PADX(2 * t)] = cadd(a[i], b[i]); fb[PADX(2 * t + 1)] = csub(a[i], b[i]); }
        __syncthreads();
    }
    fft_passes<-1>(fb, j, 2, np16, N16);
    cpx* kf = (cpx*)(p.ws + (lat ? WS_KFL : WS_KFC)) + (size_t)(o * HYENA_W + c) * N;
#pragma unroll 4
    for (int i = 0; i < 16; ++i) { const int f = j + N16 * i; const cpx v = fb[PADX(f)]; kf[f] = cpx{v.x * rn, v.y * rn}; }
    __syncthreads();
}

DI void hyena_item(const Params& p, int l, int item, char* smem, bool lat) {
    const int np16 = lat ? 3 : 2, N16 = lat ? 512 : 32, N = 16 * N16, L = N / 2;
    const int NSUB = NTHR / N16;
    const int NPAIR = lat ? DEC_BATCH / 2 : BATCH / 2;
    const int tid = threadIdx.x, sub = tid / N16, j = tid % N16;
    int c, pr; bool active = true;
    if (lat) { c = item / NPAIR; pr = item % NPAIR; }
    else { constexpr int GPC = (BATCH / 2 + 15) / 16; c = item / GPC; pr = (item % GPC) * NSUB + sub; active = pr < NPAIR; }
    const int tok0 = (lat ? TC : 0) + (active ? 2 * pr : 0) * L, tok1 = tok0 + L;
    cpx* fb = (cpx*)smem + sub * (N + N / 16);
    const bf16* HYT = (const bf16*)(p.ws + WS_HYT);
    const float* cw = p.in[I_HYCW] + (size_t)l * 3 * 3 * HYENA_W;
    const bf16* hv = HYT + (size_t)c * T; const bf16* gh = HYT + (size_t)(3 * HYENA_W + c) * T;
    const cpx* kfbase = (const cpx*)(p.ws + (lat ? WS_KFL : WS_KFC));
    f32x2* ub = (f32x2*)(smem + 8704 * 8 + 256) + sub * L;
    {
        const float w0 = cw[c], w1 = cw[3 * HYENA_W + c], w2 = cw[6 * HYENA_W + c];
#pragma unroll 2
        for (int i = 0; i < 8; ++i) {
            const int t = j + N16 * i;
            f32x2 u; u.x = active ? conv3(hv + tok0, t, L, w0, w1, w2) : 0.f; u.y = active ? conv3(hv + tok1, t, L, w0, w1, w2) : 0.f;
            ub[t] = u;
            fb[PADX(2 * t)] = cpx{u.x, u.y}; fb[PADX(2 * t + 1)] = cpx{u.x, u.y};
        }
    }
    __syncthreads();
    bf16* mixed = (bf16*)(p.ws + WS_XN);
#pragma unroll 1
    for (int o = 0; o < 2; ++o) {
        fftconv(fb, j, kfbase + (size_t)(o * HYENA_W + c) * N, active, np16, N16);
        const bf16* hx = HYT + (size_t)((1 + o) * HYENA_W + c) * T;
        const float w0 = cw[(1 + o) * HYENA_W + c], w1 = cw[3 * HYENA_W + (1 + o) * HYENA_W + c], w2 = cw[6 * HYENA_W + (1 + o) * HYENA_W + c];
        const float dd = p.in[I_HYD][(size_t)l * 2 * HYENA_W + o * HYENA_W + c];
#pragma unroll 2
        for (int i = 0; i < 8; ++i) {
            const int t = j + N16 * i;
            const cpx y = conv_out(fb, t, L);
            const f32x2 u = ub[t];
            const float x0 = active ? conv3(hx + tok0, t, L, w0, w1, w2) : 0.f, x1 = active ? conv3(hx + tok1, t, L, w0, w1, w2) : 0.f;
            f32x2 z; z.x = x0 * (y.x + dd * u.x); z.y = x1 * (y.y + dd * u.y);
            if (o == 0) ub[t] = z;
            else if (active) {
                mixed[(size_t)(tok0 + t) * MIX_W + ATTN_W + c] = f2bf(z.x * bf2f(gh[tok0 + t]));
                mixed[(size_t)(tok1 + t) * MIX_W + ATTN_W + c] = f2bf(z.y * bf2f(gh[tok1 + t]));
            }
        }
        __syncthreads();
        if (o == 0) {
#pragma unroll 2
            for (int i = 0; i < 8; ++i) { const int t = j + N16 * i; const f32x2 z = ub[t]; fb[PADX(2 * t)] = cpx{z.x, z.y}; fb[PADX(2 * t + 1)] = cpx{z.x, z.y}; }
            __syncthreads();
        }
    }
}

DI void shortconv_item(const Params& p, int l, int item) {
    const bf16* SCb = (const bf16*)(p.ws + WS_SC);
    bf16* mixed = (bf16*)(p.ws + WS_XN);
    const float* cw = p.in[I_SCW] + (size_t)l * 3 * CONV_W;
    for (int e = threadIdx.x; e < 64 * CONV_W; e += NTHR) {
        const int m = item * 64 + e / CONV_W, c = e % CONV_W;
        const int L = m < TC ? SEQ : DEC_SEQ, t = m < TC ? m % SEQ : (m - TC) % DEC_SEQ;
        const bf16* row = SCb + (size_t)m * 4 * CONV_W;
        const float pc = bf2f(row[CONV_W + c]) * bf2f(row[2 * CONV_W + c]);
        const float pm = t > 0 ? bf2f(row[-4 * CONV_W + CONV_W + c]) * bf2f(row[-4 * CONV_W + 2 * CONV_W + c]) : 0.f;
        const float pn = t < L - 1 ? bf2f(row[4 * CONV_W + CONV_W + c]) * bf2f(row[4 * CONV_W + 2 * CONV_W + c]) : 0.f;
        const float o = bf2f(row[c]) * (pm * cw[c] + pc * cw[CONV_W + c] + pn * cw[2 * CONV_W + c]) * bf2f(row[3 * CONV_W + c]);
        mixed[(size_t)m * MIX_W + ATTN_W + HYENA_W + c] = f2bf(o);
    }
}

constexpr int AT_NKL = 320, AT_VLS = 648, AT_VCS = 520;
constexpr int AT_KL = 0, AT_VL = AT_KL + AT_NKL * 128, AT_KC = AT_VL + 64 * AT_VLS, AT_VC = AT_KC + 256 * 128, AT_END = AT_VC + 64 * AT_VCS;
static_assert(AT_END <= LDS_BYTES, "lds");
DI void softmax_pv(f32x16& S, f32x16 (&O)[2], float& m_run, float& l_run, const char* vrow0, int vstride, int h) {
    float tmax = S[0];
#pragma unroll
    for (int e = 1; e < 16; ++e) tmax = fmaxf(tmax, S[e]);
    tmax = fmaxf(tmax, __shfl_xor(tmax, 32));
    const float mnew = fmaxf(m_run, tmax), alpha = exp2f(m_run - mnew);
    m_run = mnew; l_run *= alpha;
#pragma unroll
    for (int e = 0; e < 16; ++e) { O[0][e] *= alpha; O[1][e] *= alpha; }
    float ps = 0.f; unsigned pk[8];
#pragma unroll
    for (int e = 0; e < 8; ++e) { const float p0 = exp2f(S[2 * e] - mnew), p1 = exp2f(S[2 * e + 1] - mnew); ps += p0 + p1; pk[e] = pack2(p0, p1); }
    l_run += ps;
    u32x4 q0; q0.x = pk[0]; q0.y = pk[1]; q0.z = pk[2]; q0.w = pk[3];
    u32x4 q1; q1.x = pk[4]; q1.y = pk[5]; q1.z = pk[6]; q1.w = pk[7];
    const bf16x8 pb0 = __builtin_bit_cast(bf16x8, q0), pb1 = __builtin_bit_cast(bf16x8, q1);
#pragma unroll
    for (int dt = 0; dt < 2; ++dt)
#pragma unroll
        for (int s = 0; s < 2; ++s) {
            const char* vp = vrow0 + dt * 32 * vstride + (16 * s + 4 * h) * 2;
            const u32x2 lo = *(const u32x2*)vp, hi = *(const u32x2*)(vp + 16);
            u32x4 vv; vv.x = lo.x; vv.y = lo.y; vv.z = hi.x; vv.w = hi.y;
            O[dt] = MFMA32(__builtin_bit_cast(bf16x8, vv), s ? pb1 : pb0, O[dt]);
        }
}
DI void attn_item(const Params& p, int l, int item, char* smem, bool LAT) {
    const int tid = threadIdx.x, lane = tid & 63, w = tid >> 6, r = lane & 31, h = lane >> 5;
    const int SL = LAT ? DEC_SEQ : SEQ, NQB = SL / 64;
    const int b = item / (N_KV * NQB), kvh = (item / NQB) % N_KV, q0 = (item % NQB) * 64;
    const int tokbase = (LAT ? TC : 0) + b * SL;
    const bf16* Qb = (const bf16*)(p.ws + WS_Q); const bf16* Kb = (const bf16*)(p.ws + WS_KB); const bf16* VTb = (const bf16*)(p.ws + WS_VT);
    const bf16* GAb = (const bf16*)(p.ws + WS_GA); bf16* mixed = (bf16*)(p.ws + WS_XN);
    char* KL = smem + AT_KL; char* VL = smem + AT_VL; char* KC = smem + AT_KC; char* VC = smem + AT_VC;
    const u32x4 zero4 = {0u, 0u, 0u, 0u};
    if (LAT) {
        for (int id = tid; id < AT_NKL * 8; id += NTHR) {
            const int row = id >> 3, c = id & 7, kp = q0 - 128 + row;
            u32x4 v = zero4;
            if (kp >= 0 && kp < SL) v = *(const u32x4*)(Kb + (size_t)(tokbase + kp) * KV_W + kvh * HD + c * 8);
            *(u32x4*)(KL + swz128(row, c)) = v;
        }
        for (int id = tid; id < 64 * (AT_NKL / 8); id += NTHR) {
            const int d = id / (AT_NKL / 8), c = id % (AT_NKL / 8), kp = q0 - 128 + c * 8;
            u32x4 v = zero4;
            if (kp >= 0 && kp < SL) v = *(const u32x4*)(VTb + (size_t)(kvh * HD + d) * T + tokbase + kp);
            char* dst = VL + d * AT_VLS + c * 16;
            u32x2 a; a.x = v.x; a.y = v.y; u32x2 bb; bb.x = v.z; bb.y = v.w;
            *(u32x2*)dst = a; *(u32x2*)(dst + 8) = bb;
        }
    }
    {
        const bf16* ksrc; const bf16* vsrc; size_t kstride, vstride;
        if (LAT) { const size_t o = (size_t)((b * DEPTH + l) * N_KV + kvh) * PAST_LEN * HD; ksrc = (const bf16*)(p.ws + WS_CKB) + o; kstride = HD; vsrc = (const bf16*)(p.ws + WS_CVTB) + o; vstride = PAST_LEN; }
        else { ksrc = Kb + (size_t)tokbase * KV_W + kvh * HD; kstride = KV_W; vsrc = VTb + (size_t)(kvh * HD) * T + tokbase; vstride = T; }
        for (int id = tid; id < 256 * 8; id += NTHR) { const int row = id >> 3, c = id & 7; *(u32x4*)(KC + swz128(row, c)) = *(const u32x4*)(ksrc + (size_t)row * kstride + c * 8); }
        for (int id = tid; id < 64 * 32; id += NTHR) {
            const int d = id >> 5, c = id & 31;
            const u32x4 v = *(const u32x4*)(vsrc + (size_t)d * vstride + c * 8);
            char* dst = VC + d * AT_VCS + c * 16;
            u32x2 a; a.x = v.x; a.y = v.y; u32x2 bb; bb.x = v.z; bb.y = v.w;
            *(u32x2*)dst = a; *(u32x2*)(dst + 8) = bb;
        }
    }
    __syncthreads();
    {
        const int g = w >> 1, qt = w & 1, head = kvh * 4 + g;
        const int qpos = q0 + 32 * qt + r;
        const size_t qtok = (size_t)tokbase + qpos;
        bf16x8 qraw[4], qrot[4];
#pragma unroll
        for (int s = 0; s < 4; ++s) { qraw[s] = *(const bf16x8*)(Qb + qtok * ATTN_W + head * HD + 16 * s + 8 * h); qrot[s] = qraw[s]; }
        if (LAT) {
            const f32x2* rope = (const f32x2*)(p.ws + WS_ROPE);
#pragma unroll
            for (int a = 0; a < 2; ++a)
#pragma unroll
                for (int jj = 0; jj < 8; ++jj) {
                    const f32x2 cs = rope[(qpos * 2 + a) * 16 + 8 * h + jj];
                    const float xa = bf2f((bf16)qraw[2 * a][jj]), xb = bf2f((bf16)qraw[2 * a + 1][jj]);
                    qrot[2 * a][jj] = (short)f2bf(xa * cs.x - xb * cs.y);
                    qrot[2 * a + 1][jj] = (short)f2bf(xb * cs.x + xa * cs.y);
                }
        }
        const float c1 = 0.125f * 1.4426950408889634f;
        float m_run = p.in[I_SINK][l * N_HEADS + head] * 1.4426950408889634f, l_run = h == 0 ? 1.f : 0.f;
        f32x16 O[2];
#pragma unroll
        for (int e = 0; e < 16; ++e) { O[0][e] = 0.f; O[1][e] = 0.f; }
        if (LAT) {
            for (int jt = qt; jt < qt + 9; ++jt) {
                f32x16 S;
#pragma unroll
                for (int e = 0; e < 16; ++e) S[e] = 0.f;
                const int krow = 32 * jt + r;
#pragma unroll
                for (int s = 0; s < 4; ++s) S = MFMA32(*(const bf16x8*)(KL + swz128(krow, 2 * s + h)), qrot[s], S);
#pragma unroll
                for (int e = 0; e < 16; ++e) {
                    const int kp = q0 - 128 + 32 * jt + (e & 3) + 8 * (e >> 2) + 4 * h, dd = kp - qpos;
                    const bool ok = dd <= 128 && dd >= -128 && kp >= 0 && kp < SL;
                    S[e] = ok ? S[e] * c1 : -1e30f;
                }
                softmax_pv(S, O, m_run, l_run, VL + r * AT_VLS + 32 * jt * 2, AT_VLS, h);
            }
        }
        for (int jt = 0; jt < 8; ++jt) {
            f32x16 S;
#pragma unroll
            for (int e = 0; e < 16; ++e) S[e] = 0.f;
            const int krow = 32 * jt + r;
#pragma unroll
            for (int s = 0; s < 4; ++s) S = MFMA32(*(const bf16x8*)(KC + swz128(krow, 2 * s + h)), qraw[s], S);
#pragma unroll
            for (int e = 0; e < 16; ++e) S[e] *= c1;
            softmax_pv(S, O, m_run, l_run, VC + r * AT_VCS + 32 * jt * 2, AT_VCS, h);
        }
        const float inv = 1.f / (l_run + __shfl_xor(l_run, 32));
#pragma unroll
        for (int dt = 0; dt < 2; ++dt)
#pragma unroll
            for (int rg = 0; rg < 4; ++rg) {
                const int d0 = dt * 32 + 8 * rg + 4 * h;
                const u32x2 gv = *(const u32x2*)(GAb + qtok * ATTN_W + head * HD + d0);
                const float g0 = bf2f((bf16)(gv.x & 0xffffu)), g1 = bf2f((bf16)(gv.x >> 16)), g2 = bf2f((bf16)(gv.y & 0xffffu)), g3 = bf2f((bf16)(gv.y >> 16));
                u32x2 o; o.x = pack2(O[dt][4 * rg] * inv * g0, O[dt][4 * rg + 1] * inv * g1); o.y = pack2(O[dt][4 * rg + 2] * inv * g2, O[dt][4 * rg + 3] * inv * g3);
                *(u32x2*)(mixed + qtok * MIX_W + head * HD + d0) = o;
            }
    }
    __syncthreads();
}

DI void phase_p0(const Params& p_, char* smem) {
    constexpr int I_T1 = DEPTH * (D_MODEL / 64) * (IN_COLS / 64), I_T2 = DEPTH * (MIX_W / 64) * (D_MODEL / 64);
    constexpr int I_MOD = DEPTH * ((3 * D_MODEL + 511) / 512), I_ROPE = DEC_SEQ * 32 / NTHR, I_HID = (DEPTH * (SEQ + DEC_SEQ) + 7) / 8;
    constexpr int I_CACHE = (2 * DEC_BATCH * DEPTH * PAST_LEN * KV_W / 8 + NTHR - 1) / NTHR;
    constexpr int TOTAL = I_T1 + I_T2 + I_MOD + I_ROPE + I_HID + I_CACHE;
    for (int it = blockIdx.x; it < TOTAL; it += gridDim.x) {
        const Params p = launder(p_);
        int q = it;
        if (q < I_T1) { constexpr int per = (D_MODEL / 64) * (IN_COLS / 64); const int l = q / per;
            p0_transpose_item(p.in[I_WIN] + (size_t)l * D_MODEL * IN_COLS, D_MODEL, IN_COLS, (bf16*)(p.ws + WS_WINT) + (size_t)l * IN_COLS * D_MODEL, q % per, smem); continue; }
        q -= I_T1;
        if (q < I_T2) { constexpr int per = (MIX_W / 64) * (D_MODEL / 64); const int l = q / per;
            p0_transpose_item(p.in[I_WOUT] + (size_t)l * MIX_W * D_MODEL, MIX_W, D_MODEL, (bf16*)(p.ws + WS_WOUTT) + (size_t)l * D_MODEL * MIX_W, q % per, smem); continue; }
        q -= I_T2;
        if (q < I_MOD) { p0_mod_item(p, q, smem); continue; }
        q -= I_MOD;
        if (q < I_ROPE) { p0_rope_item(p, q); continue; }
        q -= I_ROPE;
        if (q < I_HID) { p0_hid2_item(p, q); continue; }
        q -= I_HID;
        p0_cache_item(p, q);
    }
}
DI void phase_norm(const Params& p, int l) {
    for (int it = blockIdx.x; it < T / 8; it += gridDim.x) norm_item(p, l, it);
}
DI void phase_a(const Params& p_, int l, char* smem) {
    constexpr int I_FL = 2 * HYENA_W, I_FC = 2 * HYENA_W / 16, NTN = IN_COLS / 128, I_G = (T / 256) * NTN;
    for (int it = blockIdx.x; it < I_FL + I_FC + I_G; it += gridDim.x) {
        const Params p = launder(p_);
        const bf16* A = (const bf16*)(p.ws + WS_XN);
        const bf16* Bt = (const bf16*)(p.ws + WS_WINT) + (size_t)l * IN_COLS * D_MODEL;
        int q = it;
        if (q < I_FL + I_FC) { const bool lat = q < I_FL; filter_item(p, l, lat ? q : q - I_FL, smem, lat); continue; }
        q -= I_FL + I_FC;
        const int m0 = (q / NTN) * 256, n0 = (q % NTN) * 128;
        const InProjEpi epi{p, l, n0};
        const bool swap = (n0 >= C_V && n0 < C_GA) || (n0 >= C_HV && n0 < C_SB);
        if (swap) gemm_tile<true>(A, Bt, D_MODEL, m0, n0, smem, epi); else gemm_tile<false>(A, Bt, D_MODEL, m0, n0, smem, epi);
    }
}
DI void phase_b(const Params& p_, int l, char* smem) {
    constexpr int I_HL = HYENA_W * (DEC_BATCH / 2), I_AL = DEC_BATCH * N_KV * (DEC_SEQ / 64), I_AC = BATCH * N_KV * (SEQ / 64);
    constexpr int I_HC = HYENA_W * ((BATCH / 2 + 15) / 16), I_SC = T / 64;
    for (int it = blockIdx.x; it < I_HL + I_AL + I_AC + I_HC + I_SC; it += gridDim.x) {
        const Params p = launder(p_);
        int q = it;
        if (q < I_HL + I_HC) { const bool lat = q < I_HL; hyena_item(p, l, lat ? q : q - I_HL, smem, lat); continue; }
        q -= I_HL + I_HC;
        if (q < I_AL + I_AC) { const bool lat = q < I_AL; attn_item(p, l, lat ? q : q - I_AL, smem, lat); continue; }
        q -= I_AL + I_AC;
        shortconv_item(p, l, q);
    }
}
DI void phase_c(const Params& p, int l, char* smem) {
    constexpr int NTN = D_MODEL / 128, I_G = (T / 256) * NTN;
    const bf16* A = (const bf16*)(p.ws + WS_XN);
    const bf16* Bt = (const bf16*)(p.ws + WS_WOUTT) + (size_t)l * D_MODEL * MIX_W;
    const OutProjEpi epi{p, l};
    for (int it = blockIdx.x; it < I_G; it += gridDim.x) gemm_tile<false>(A, Bt, MIX_W, (it / NTN) * 256, (it % NTN) * 128, smem, epi);
}

#ifndef PH_STOP
#define PH_STOP 1000
#endif
__global__ void __launch_bounds__(NTHR) fwd_kernel(Params p) {
#ifdef EMU
    char* smem = emu_smem();
#else
    extern __shared__ __attribute__((aligned(16))) char smem[];
#endif
    int ph = 0;
    phase_p0(p, smem);
    GRID_SYNC(); if (++ph >= PH_STOP) return;
    phase_norm(p, 0);
    GRID_SYNC(); if (++ph >= PH_STOP) return;
    for (int l = 0; l < DEPTH; ++l) {
        phase_a(p, l, smem);
        GRID_SYNC(); if (++ph >= PH_STOP) return;
        phase_b(p, l, smem);
        GRID_SYNC(); if (++ph >= PH_STOP) return;
        phase_c(p, l, smem);
        GRID_SYNC(); if (++ph >= PH_STOP) return;
        phase_norm(p, l + 1);
        if (l + 1 < DEPTH) { GRID_SYNC(); if (++ph >= PH_STOP) return; }
    }
}

#ifndef EMU
extern "C" void kernel_launch(void* const* d_in, const int* in_sizes, int n_in, void* d_out, int out_size, void* d_ws, size_t ws_size, hipStream_t stream) {
    static int grid = 0;
    if (grid == 0) {
        if (n_in != 22 || (size_t)out_size != OUT_TOTAL || ws_size < WS_END) { fprintf(stderr, "kernel_launch: unexpected sizes n_in %d out %d ws %zu (need %zu)\n", n_in, out_size, ws_size, (size_t)WS_END); grid = -1; return; }
        int dev = 0, cus = 0, per_cu = 0;
        hipGetDevice(&dev); hipDeviceGetAttribute(&cus, hipDeviceAttributeMultiprocessorCount, dev);
        if (hipFuncSetAttribute((const void*)fwd_kernel, hipFuncAttributeMaxDynamicSharedMemorySize, LDS_BYTES) != hipSuccess) { fprintf(stderr, "hipFuncSetAttribute failed\n"); grid = -1; return; }
        hipOccupancyMaxActiveBlocksPerMultiprocessor(&per_cu, (const void*)fwd_kernel, NTHR, LDS_BYTES);
        if (per_cu < 1) { fprintf(stderr, "occupancy query says %d\n", per_cu); grid = -1; return; }
        grid = cus;
    }
    if (grid < 0) return;
    Params p{};
    for (int i = 0; i < 22; ++i) p.in[i] = (const float*)d_in[i];
    p.out = (float*)d_out; p.ws = (unsigned char*)d_ws;
    void* args[] = {&p};
    hipError_t e = hipLaunchCooperativeKernel((const void*)fwd_kernel, dim3(grid), dim3(NTHR), args, LDS_BYTES, stream);
    if (e != hipSuccess) fprintf(stderr, "cooperative launch failed: %s (grid %d)\n", hipGetErrorString(e), grid);
}
#endif
```

```cpp
#ifdef EMU
#include "emu.h"
#define GRID_SYNC() emu_grid_sync()
#define MFMA32(a, b, c) emu_mfma32((a), (b), (c))
#else
#include <hip/hip_runtime.h>
#include <cstdio>
#include <cstdint>
typedef short bf16x8 __attribute__((ext_vector_type(8)));
typedef float f32x16 __attribute__((ext_vector_type(16)));
typedef float f32x4 __attribute__((ext_vector_type(4)));
#define GRID_SYNC() xcd_barrier(xbar)
#define MFMA32(a, b, c) __builtin_amdgcn_mfma_f32_32x32x16_bf16((a), (b), (c), 0, 0, 0)
#endif
typedef unsigned u32x4 __attribute__((ext_vector_type(4)));
typedef unsigned u32x2 __attribute__((ext_vector_type(2)));
typedef float f32x2 __attribute__((ext_vector_type(2)));
typedef unsigned short bf16;
#define DI __device__ __forceinline__

#ifdef CFG_SMALL
constexpr int D_MODEL = 128, BATCH = 2, SEQ = 256, DEPTH = 2, DEC_BATCH = 2, DEC_SEQ = 4096, PAST_LEN = 256, HYENA_W = 128, CONV_W = 128;
#else
constexpr int D_MODEL = 1024, BATCH = 32, SEQ = 256, DEPTH = 4, DEC_BATCH = 8, DEC_SEQ = 4096, PAST_LEN = 256, HYENA_W = 256, CONV_W = 256;
#endif
constexpr int GRID_W = 64, N_HEADS = 8, N_KV = 2, HD = 64, ATTN_W = 512, KV_W = 128;
constexpr int MIX_W = ATTN_W + HYENA_W + CONV_W;
constexpr int C_Q = 0, C_K = ATTN_W, C_V = C_K + KV_W, C_GA = C_V + KV_W, C_HV = C_GA + ATTN_W, C_GH = C_HV + 3 * HYENA_W,
              C_SB = C_GH + HYENA_W, C_GC = C_SB + 3 * CONV_W, IN_COLS = C_GC + CONV_W;
constexpr int TC = BATCH * SEQ, TL = DEC_BATCH * DEC_SEQ, T = TC + TL;
constexpr int NR = 1 + DEC_BATCH;
constexpr int FH = 64, FE = 33;
constexpr int NTHR = 512;
static_assert(T % 256 == 0 && TC % 256 == 0 && IN_COLS % 128 == 0 && D_MODEL % 128 == 0, "tiling");
static_assert(SEQ == 256 && DEC_SEQ == 4096 && PAST_LEN == 256, "fft sizes");

constexpr size_t al256(size_t x) { return (x + 255) & ~(size_t)255; }
constexpr size_t WS_BAR = 0;
constexpr size_t WS_WINT = 65536;
constexpr size_t WS_WOUTT = WS_WINT + al256((size_t)DEPTH * IN_COLS * D_MODEL * 2);
constexpr size_t WS_MOD = WS_WOUTT + al256((size_t)DEPTH * D_MODEL * MIX_W * 2);
constexpr size_t WS_ROPE = WS_MOD + al256((size_t)DEPTH * NR * 3 * D_MODEL * 4);
constexpr size_t WS_HID2 = WS_ROPE + al256((size_t)DEC_SEQ * 32 * 8);
constexpr size_t WS_CKB = WS_HID2 + al256((size_t)DEPTH * (SEQ + DEC_SEQ) * FH * 4);
constexpr size_t WS_CVTB = WS_CKB + al256((size_t)DEC_BATCH * DEPTH * PAST_LEN * KV_W * 2);
constexpr size_t WS_KFL = WS_CVTB + al256((size_t)DEC_BATCH * DEPTH * PAST_LEN * KV_W * 2);
constexpr size_t WS_KFC = WS_KFL + al256((size_t)2 * HYENA_W * 8192 * 8);
constexpr size_t WS_XN = WS_KFC + al256((size_t)2 * HYENA_W * 512 * 8);
constexpr size_t WS_Q = WS_XN + al256((size_t)T * (D_MODEL > MIX_W ? D_MODEL : MIX_W) * 2);
constexpr size_t WS_KB = WS_Q + al256((size_t)T * ATTN_W * 2);
constexpr size_t WS_VT = WS_KB + al256((size_t)T * KV_W * 2);
constexpr size_t WS_GA = WS_VT + al256((size_t)T * KV_W * 2);
constexpr size_t WS_HYT = WS_GA + al256((size_t)T * ATTN_W * 2);
constexpr size_t WS_SC = WS_HYT + al256((size_t)4 * HYENA_W * T * 2);
constexpr size_t WS_END = WS_SC + al256((size_t)T * 4 * CONV_W * 2);

constexpr size_t OUT_YS = (size_t)TC * D_MODEL, OUT_NK = (size_t)T * D_MODEL, OUT_NV = OUT_NK + (size_t)BATCH * DEPTH * SEQ * KV_W,
                 OUT_TOTAL = OUT_NV + (size_t)BATCH * DEPTH * SEQ * KV_W;

constexpr int LDS_BYTES = 149504;

struct Params {
    const float* in[22];
    float* out;
    unsigned char* ws;
};
enum { I_XP = 0, I_XS, I_CK, I_CV, I_C, I_CCTX, I_NORMG, I_MODW, I_MODB, I_WIN, I_SINK, I_HYCW, I_FW1, I_FB1, I_FW2, I_FB2, I_FW3, I_FFREQ, I_HYD, I_SCW, I_WOUT, I_FINALG };

DI bf16 f2bf(float f) { unsigned u = __float_as_uint(f); u += 0x7fffu + ((u >> 16) & 1u); return (bf16)(u >> 16); }
DI float bf2f(bf16 h) { return __uint_as_float(((unsigned)h) << 16); }
DI unsigned pack2(float a, float b) { return (unsigned)f2bf(a) | ((unsigned)f2bf(b) << 16); }
DI float silu_f(float x) { return x / (1.f + __expf(-x)); }
struct cpx { float x, y; };
DI cpx cmul(cpx a, cpx b) { return cpx{a.x * b.x - a.y * b.y, a.x * b.y + a.y * b.x}; }
DI cpx cadd(cpx a, cpx b) { return cpx{a.x + b.x, a.y + b.y}; }
DI cpx csub(cpx a, cpx b) { return cpx{a.x - b.x, a.y - b.y}; }
#ifdef EMU
DI Params launder(const Params& p) { return p; }
#else
DI Params launder(const Params& p) { Params q = p; asm volatile("" : "+s"(q.ws), "+s"(q.out)); return q; }
#endif
DI int mod_row(int m) { return m < TC ? 0 : 1 + (m - TC) / DEC_SEQ; }


#ifndef EMU
#define XB_TMO      128
#define XB_XCNT(j)  (256  + 64 * (j))
#define XB_XSUB(j)  (1280 + 64 * (j))
#define XB_XGEN(j)  (2304 + 64 * (j))
#define XB_TOP      3328
#define XB_TOPGEN   3392
#define XCD_BAR_WORDS 3456
#define XB_SPIN_CAP (1u << 22)
#define LAS __attribute__((address_space(3)))
DI unsigned xb_ld(unsigned* p) { return __hip_atomic_load(p, __ATOMIC_RELAXED, __HIP_MEMORY_SCOPE_AGENT); }
DI unsigned xb_add(unsigned* p, unsigned v) { return __hip_atomic_fetch_add(p, v, __ATOMIC_RELAXED, __HIP_MEMORY_SCOPE_AGENT); }
DI unsigned xb_xcc_id() { return (unsigned)__builtin_amdgcn_s_getreg((3 << 11) | 20) & 0xFu; }
#define XB_SPIN(cond, bar) do { unsigned _sp = 0; while (cond) { __builtin_amdgcn_s_sleep(1); \
    if ((++_sp & 255u) == 0u) { if (xb_ld(&(bar)[XB_TMO])) break; if (_sp > XB_SPIN_CAP) { atomicAdd(&(bar)[XB_TMO], 1u); break; } } } } while (0)
struct XcdBarrier { unsigned* bar; unsigned x; volatile LAS unsigned* st; };
DI XcdBarrier xcd_barrier_post(unsigned* bar, volatile LAS unsigned* st) {
    XcdBarrier b; b.bar = bar; b.x = xb_xcc_id(); b.st = st;
    if (threadIdx.x == 0) (void)xb_add(&bar[XB_XCNT(b.x)], 1u);
    return b;
}
DI void xcd_barrier_complete(unsigned* bar, unsigned x, unsigned& nloc, unsigned& nx) {
    const unsigned G = gridDim.x * gridDim.y * gridDim.z;
    unsigned sum, cnt, mine, sp = 0u;
    for (;;) {
        sum = 0u; cnt = 0u; mine = 0u;
#pragma unroll
        for (unsigned j = 0; j < 16; ++j) { const unsigned c = xb_ld(&bar[XB_XCNT(j)]); sum += c; cnt += (c > 0u) ? 1u : 0u; mine = (j == x) ? c : mine; }
        if (sum == G) break;
        __builtin_amdgcn_s_sleep(1);
        if ((++sp & 255u) == 0u) { if (xb_ld(&bar[XB_TMO])) break; if (sp > XB_SPIN_CAP) { atomicAdd(&bar[XB_TMO], 1u); break; } }
    }
    nloc = mine > 0u ? mine : 1u; nx = cnt > 0u ? cnt : 1u;
}
DI void xcd_barrier(const XcdBarrier& b) {
    asm volatile("s_waitcnt vmcnt(0)" ::: "memory");
    __syncthreads();
    if (threadIdx.x == 0) {
        unsigned* bar = b.bar;
        __builtin_amdgcn_s_waitcnt(0);
        unsigned nloc = b.st[0], nx = b.st[1];
        if (nloc == 0u) { xcd_barrier_complete(bar, b.x, nloc, nx); b.st[0] = nloc; b.st[1] = nx; }
        const unsigned old = xb_add(&bar[XB_XSUB(b.x)], 1u);
        const unsigned gen = old / nloc;
        if (old + 1u == (gen + 1u) * nloc) {
            __builtin_amdgcn_fence(__ATOMIC_RELEASE, "agent");
            asm volatile("s_waitcnt vmcnt(0)" ::: "memory");
            const unsigned og = xb_add(&bar[XB_TOP], 1u);
            const unsigned tg = og / nx;
            if (og + 1u == (tg + 1u) * nx) xb_add(&bar[XB_TOPGEN], 1u);
            else XB_SPIN(xb_ld(&bar[XB_TOPGEN]) == tg, bar);
            __builtin_amdgcn_fence(__ATOMIC_ACQUIRE, "agent");
            xb_add(&bar[XB_XGEN(b.x)], 1u);
            asm volatile("s_waitcnt vmcnt(0)" ::: "memory");
        } else {
            XB_SPIN(xb_ld(&bar[XB_XGEN(b.x)]) == gen, bar);
            __builtin_amdgcn_fence(__ATOMIC_ACQUIRE, "agent");
            asm volatile("s_waitcnt vmcnt(0)" ::: "memory");
        }
    }
    __syncthreads();
}
#endif

DI void p0_transpose_item(const float* W, int K, int N, bf16* WT, int item, char* smem) {
    float* scr = (float*)smem;
    const int tid = threadIdx.x, nblk = N / 64, k0 = (item / nblk) * 64, n0 = (item % nblk) * 64;
#pragma unroll
    for (int i = 0; i < 8; ++i) { const int kk = (tid >> 6) + 8 * i, nn = tid & 63; scr[kk * 65 + nn] = W[(size_t)(k0 + kk) * N + n0 + nn]; }
    __syncthreads();
    const int n = tid >> 3, c = tid & 7;
    const float* s = scr + (8 * c) * 65 + n;
    u32x4 o; o.x = pack2(s[0], s[65]); o.y = pack2(s[2 * 65], s[3 * 65]); o.z = pack2(s[4 * 65], s[5 * 65]); o.w = pack2(s[6 * 65], s[7 * 65]);
    *(u32x4*)(WT + (size_t)(n0 + n) * K + k0 + 8 * c) = o;
    __syncthreads();
}
DI void p0_mod_item(const Params& p, int item, char* smem) {
    constexpr int NCH = (3 * D_MODEL + 511) / 512;
    float* tab = (float*)smem;
    const int tid = threadIdx.x, l = item / NCH, col = (item % NCH) * 512 + tid;
    for (int e = tid; e < NR * D_MODEL; e += NTHR) { const int r = e / D_MODEL, k = e % D_MODEL; const float cv = r == 0 ? p.in[I_CCTX][k] : p.in[I_C][(size_t)(r - 1) * D_MODEL + k]; tab[e] = silu_f(cv); }
    __syncthreads();
    if (col < 3 * D_MODEL) {
        float acc[NR];
#pragma unroll
        for (int r = 0; r < NR; ++r) acc[r] = 0.f;
        const float* w = p.in[I_MODW] + (size_t)l * D_MODEL * 3 * D_MODEL + col;
        for (int k = 0; k < D_MODEL; ++k) { const float wv = w[(size_t)k * 3 * D_MODEL];
#pragma unroll
            for (int r = 0; r < NR; ++r) acc[r] += tab[r * D_MODEL + k] * wv; }
        const float bv = p.in[I_MODB][(size_t)l * 3 * D_MODEL + col];
        float* mod = (float*)(p.ws + WS_MOD);
#pragma unroll
        for (int r = 0; r < NR; ++r) mod[((size_t)l * NR + r) * 3 * D_MODEL + col] = acc[r] + bv;
    }
    __syncthreads();
}
DI void p0_rope_item(const Params& p, int item) {
    const int e = item * NTHR + threadIdx.x;
    if (e < DEC_SEQ * 32) {
        const int t = e >> 5, a = (e >> 4) & 1, f = e & 15;
        const float pos = (float)(a ? (t % GRID_W) : (t / GRID_W));
        const float inv = exp2f(-(float)f * (13.287712379549449f / 16.f));
        const float ang = pos * inv;
        f32x2 v; v.x = cosf(ang); v.y = sinf(ang);
        ((f32x2*)(p.ws + WS_ROPE))[e] = v;
    }
}
DI void p0_hid2_item(const Params& p, int item) {
    const int lane = threadIdx.x & 63, w = threadIdx.x >> 6;
    const int rr = item * 8 + w;
    if (rr >= DEPTH * (SEQ + DEC_SEQ)) return;
    const int l = rr / (SEQ + DEC_SEQ), q = rr % (SEQ + DEC_SEQ);
    const int L = q < SEQ ? SEQ : DEC_SEQ, t = q < SEQ ? q : q - SEQ;
    float feat = 0.f;
    if (lane == 0) feat = (float)t / (float)(L - 1);
    else if (lane < FE) {
        const int b = (lane - 1) & 15;
        const float fr = 1e-4f + (float)b * ((15.f - 1e-4f) / 15.f);
        const float ang = (6.283185307179586f / (float)L) * (float)t;
        feat = lane <= 16 ? cosf(fr * ang) : -sinf(fr * ang);
    }
    const float* w1 = p.in[I_FW1] + (size_t)l * FE * FH; const float* w2 = p.in[I_FW2] + (size_t)l * FH * FH;
    const float fq = p.in[I_FFREQ][l * FH + lane];
    float a1 = p.in[I_FB1][l * FH + lane];
    for (int i = 0; i < FE; ++i) a1 += __shfl(feat, i) * w1[i * FH + lane];
    const float h1 = sinf(fq * a1);
    float a2 = p.in[I_FB2][l * FH + lane];
    for (int i = 0; i < FH; ++i) a2 += __shfl(h1, i) * w2[i * FH + lane];
    const float h2 = sinf(fq * a2);
    ((float*)(p.ws + WS_HID2))[(size_t)rr * FH + lane] = h2;
}
DI void p0_cache_item(const Params& p, int item) {
    constexpr int NCHUNK = DEC_BATCH * DEPTH * PAST_LEN * KV_W / 8;
    int e = item * NTHR + threadIdx.x;
    if (e < NCHUNK) {
        const int c8 = e & 7, j = (e >> 3) % PAST_LEN, kvh = (e >> 3) / PAST_LEN % N_KV, bl = (e >> 3) / PAST_LEN / N_KV;
        const float* src = p.in[I_CK] + ((size_t)(bl * PAST_LEN + j) * N_KV + kvh) * HD + c8 * 8;
        u32x4 o; o.x = pack2(src[0], src[1]); o.y = pack2(src[2], src[3]); o.z = pack2(src[4], src[5]); o.w = pack2(src[6], src[7]);
        *(u32x4*)((bf16*)(p.ws + WS_CKB) + (size_t)e * 8) = o;
    } else if (e < 2 * NCHUNK) {
        e -= NCHUNK;
        const int j8 = e % (PAST_LEN / 8), d = (e / (PAST_LEN / 8)) % HD, kvh = (e / (PAST_LEN / 8)) / HD % N_KV, bl = (e / (PAST_LEN / 8)) / HD / N_KV;
        const float* src = p.in[I_CV] + ((size_t)(bl * PAST_LEN + j8 * 8) * N_KV + kvh) * HD + d;
        constexpr int S = N_KV * HD;
        u32x4 o; o.x = pack2(src[0], src[S]); o.y = pack2(src[2 * S], src[3 * S]); o.z = pack2(src[4 * S], src[5 * S]); o.w = pack2(src[6 * S], src[7 * S]);
        *(u32x4*)((bf16*)(p.ws + WS_CVTB) + (size_t)e * 8) = o;
    }
}

DI const float* x_row_src(const Params& p, int l, int m) {
    if (l == 0) return m < TC ? p.in[I_XP] + (size_t)m * D_MODEL : p.in[I_XS] + (size_t)(m - TC) * D_MODEL;
    return p.out + (size_t)m * D_MODEL;
}
DI void norm_item(const Params& p, int l, int item) {
    const int lane = threadIdx.x & 63, w = threadIdx.x >> 6, m = item * 8 + w;
    if (m >= T) return;
    const float* xr = x_row_src(p, l, m);
    float ss = 0.f;
    for (int c4 = lane; c4 < D_MODEL / 4; c4 += 64) { const f32x4 v = *(const f32x4*)(xr + 4 * c4); ss += v.x * v.x + v.y * v.y + v.z * v.z + v.w * v.w; }
#pragma unroll
    for (int o = 1; o < 64; o <<= 1) ss += __shfl_xor(ss, o);
    const float rstd = rsqrtf(ss * (1.f / D_MODEL) + 1e-6f);
    if (l < DEPTH) {
        const float* g = p.in[I_NORMG] + (size_t)l * D_MODEL;
        const float* mod = (const float*)(p.ws + WS_MOD) + ((size_t)l * NR + mod_row(m)) * 3 * D_MODEL;
        bf16* xn = (bf16*)(p.ws + WS_XN) + (size_t)m * D_MODEL;
        for (int c4 = lane; c4 < D_MODEL / 4; c4 += 64) {
            const f32x4 v = *(const f32x4*)(xr + 4 * c4), gv = *(const f32x4*)(g + 4 * c4), sh = *(const f32x4*)(mod + 4 * c4), sc = *(const f32x4*)(mod + D_MODEL + 4 * c4);
            u32x2 o; o.x = pack2(v.x * rstd * gv.x * (1.f + sc.x) + sh.x, v.y * rstd * gv.y * (1.f + sc.y) + sh.y);
            o.y = pack2(v.z * rstd * gv.z * (1.f + sc.z) + sh.z, v.w * rstd * gv.w * (1.f + sc.w) + sh.w);
            *(u32x2*)(xn + 4 * c4) = o;
        }
    } else {
        const float* g = p.in[I_FINALG];
        float* yo = p.out + (size_t)m * D_MODEL;
        for (int c4 = lane; c4 < D_MODEL / 4; c4 += 64) {
            const f32x4 v = *(const f32x4*)(xr + 4 * c4), gv = *(const f32x4*)(g + 4 * c4);
            f32x4 o; o.x = v.x * rstd * gv.x; o.y = v.y * rstd * gv.y; o.z = v.z * rstd * gv.z; o.w = v.w * rstd * gv.w;
            *(f32x4*)(yo + 4 * c4) = o;
        }
    }
}

DI int swz128(int row, int c) { return row * 128 + ((c ^ ((row >> 1) & 7)) << 4); }
template <bool SWAP, class Epi>
DI void gemm_tile(const bf16* A, const bf16* Bt, int K, int m0, int n0, char* smem, const Epi& epi) {
    const int tid = threadIdx.x, lane = tid & 63, w = tid >> 6, wm = w >> 1, wn = w & 1, r = lane & 31, h = lane >> 5;
    f32x16 acc[2][2];
#pragma unroll
    for (int i = 0; i < 2; ++i)
#pragma unroll
        for (int j = 0; j < 2; ++j)
#pragma unroll
            for (int e = 0; e < 16; ++e) acc[i][j][e] = 0.f;
    const int nk = K / 64;
    u32x4 ra[4], rb[2];
    const bf16* Ag = A + (size_t)(m0 + (tid >> 3)) * K + (tid & 7) * 8;
    const bf16* Bg = Bt + (size_t)(n0 + (tid >> 3)) * K + (tid & 7) * 8;
#pragma unroll
    for (int i = 0; i < 4; ++i) ra[i] = *(const u32x4*)(Ag + (size_t)(64 * i) * K);
#pragma unroll
    for (int i = 0; i < 2; ++i) rb[i] = *(const u32x4*)(Bg + (size_t)(64 * i) * K);
    {
        char* As = smem; char* Bs = smem + 32768;
#pragma unroll
        for (int i = 0; i < 4; ++i) *(u32x4*)(As + swz128((tid >> 3) + 64 * i, tid & 7)) = ra[i];
#pragma unroll
        for (int i = 0; i < 2; ++i) *(u32x4*)(Bs + swz128((tid >> 3) + 64 * i, tid & 7)) = rb[i];
    }
    __syncthreads();
    for (int kt = 0; kt < nk; ++kt) {
        if (kt + 1 < nk) {
#pragma unroll
            for (int i = 0; i < 4; ++i) ra[i] = *(const u32x4*)(Ag + (size_t)(64 * i) * K + (kt + 1) * 64);
#pragma unroll
            for (int i = 0; i < 2; ++i) rb[i] = *(const u32x4*)(Bg + (size_t)(64 * i) * K + (kt + 1) * 64);
        }
        const char* As = smem + (kt & 1) * 49152; const char* Bs = As + 32768;
#pragma unroll
        for (int s = 0; s < 4; ++s) {
            bf16x8 a[2], b[2];
#pragma unroll
            for (int i = 0; i < 2; ++i) a[i] = *(const bf16x8*)(As + swz128(wm * 64 + i * 32 + r, 2 * s + h));
#pragma unroll
            for (int j = 0; j < 2; ++j) b[j] = *(const bf16x8*)(Bs + swz128(wn * 64 + j * 32 + r, 2 * s + h));
#pragma unroll
            for (int i = 0; i < 2; ++i)
#pragma unroll
                for (int j = 0; j < 2; ++j) acc[i][j] = SWAP ? MFMA32(b[j], a[i], acc[i][j]) : MFMA32(a[i], b[j], acc[i][j]);
        }
        if (kt + 1 < nk) {
            char* As2 = smem + ((kt + 1) & 1) * 49152; char* Bs2 = As2 + 32768;
#pragma unroll
            for (int i = 0; i < 4; ++i) *(u32x4*)(As2 + swz128((tid >> 3) + 64 * i, tid & 7)) = ra[i];
#pragma unroll
            for (int i = 0; i < 2; ++i) *(u32x4*)(Bs2 + swz128((tid >> 3) + 64 * i, tid & 7)) = rb[i];
        }
        __syncthreads();
    }
    epi.template run<SWAP>(acc, m0 + wm * 64, n0 + wn * 64, lane);
}

struct InProjEpi {
    const Params& p; int l; int n0;
    template <bool swap> DI void run(const f32x16 (&acc)[2][2], int mb, int nb, int lane) const {
        const int r = lane & 31, h = lane >> 5;
        const bool ctx = mb < TC;
        bf16* Qb = (bf16*)(p.ws + WS_Q); bf16* Kb = (bf16*)(p.ws + WS_KB); bf16* VTb = (bf16*)(p.ws + WS_VT); bf16* GAb = (bf16*)(p.ws + WS_GA);
        bf16* HYT = (bf16*)(p.ws + WS_HYT); bf16* SCb = (bf16*)(p.ws + WS_SC);
        if (!swap) {
#pragma unroll
            for (int i = 0; i < 2; ++i)
#pragma unroll
                for (int j = 0; j < 2; ++j) {
                    const int n = nb + 32 * j + r;
#pragma unroll
                    for (int reg = 0; reg < 16; ++reg) {
                        const int m = mb + 32 * i + (reg & 3) + 8 * (reg >> 2) + 4 * h;
                        const float v = acc[i][j][reg];
                        if (n0 < C_K) Qb[(size_t)m * ATTN_W + n] = f2bf(v);
                        else if (n0 < C_V) {
                            const int nn = n - C_K;
                            if (ctx) {
                                Kb[(size_t)m * KV_W + nn] = f2bf(v);
                                const int b = m / SEQ, s = m % SEQ;
                                p.out[OUT_NK + ((size_t)(b * DEPTH + l) * SEQ + s) * KV_W + nn] = v;
                            } else {
                                const int pos = (m - TC) % DEC_SEQ, a = (nn >> 5) & 1, pp = (lane >> 4) & 1, f = lane & 15;
                                const f32x2 cs = ((const f32x2*)(p.ws + WS_ROPE))[(pos * 2 + a) * 16 + f];
                                const float oth = __shfl_xor(v, 16);
                                const float o = pp ? v * cs.x + oth * cs.y : v * cs.x - oth * cs.y;
                                Kb[(size_t)m * KV_W + nn] = f2bf(o);
                            }
                        } else if (n0 < C_HV) GAb[(size_t)m * ATTN_W + (n - C_GA)] = f2bf(silu_f(v));
                        else { const int col = n - C_SB; SCb[(size_t)m * (4 * CONV_W) + col] = f2bf(col >= 3 * CONV_W ? silu_f(v) : v); }
                    }
                }
        } else {
#pragma unroll
            for (int i = 0; i < 2; ++i)
#pragma unroll
                for (int j = 0; j < 2; ++j) {
                    const int m = mb + 32 * i + r;
#pragma unroll
                    for (int reg = 0; reg < 16; ++reg) {
                        const int n = nb + 32 * j + (reg & 3) + 8 * (reg >> 2) + 4 * h;
                        const float v = acc[i][j][reg];
                        if (n0 < C_GA) {
                            const int nn = n - C_V;
                            VTb[(size_t)nn * T + m] = f2bf(v);
                            if (ctx) { const int b = m / SEQ, s = m % SEQ; p.out[OUT_NV + ((size_t)(b * DEPTH + l) * SEQ + s) * KV_W + nn] = v; }
                        } else { const int nn = n - C_HV; HYT[(size_t)nn * T + m] = f2bf(nn >= 3 * HYENA_W ? silu_f(v) : v); }
                    }
                }
        }
    }
};
struct OutProjEpi {
    const Params& p; int l;
    template <bool swap> DI void run(const f32x16 (&acc)[2][2], int mb, int nb, int lane) const {
        const int r = lane & 31, h = lane >> 5;
        const float* gate = (const float*)(p.ws + WS_MOD) + ((size_t)l * NR + mod_row(mb)) * 3 * D_MODEL + 2 * D_MODEL;
#pragma unroll
        for (int i = 0; i < 2; ++i)
#pragma unroll
            for (int j = 0; j < 2; ++j) {
                const int n = nb + 32 * j + r; const float g = gate[n];
#pragma unroll
                for (int reg = 0; reg < 16; ++reg) {
                    const int m = mb + 32 * i + (reg & 3) + 8 * (reg >> 2) + 4 * h;
                    const float xv = x_row_src(p, l, m)[n];
                    p.out[(size_t)m * D_MODEL + n] = xv + g * acc[i][j][reg];
                }
            }
    }
};

DI int PADX(int i) { return i + (i >> 4); }
template <int SIGN> DI void dft4(cpx& a0, cpx& a1, cpx& a2, cpx& a3) {
    const cpx t0 = cadd(a0, a2), t1 = csub(a0, a2), t2 = cadd(a1, a3), t3 = csub(a1, a3);
    const cpx t3r = SIGN < 0 ? cpx{t3.y, -t3.x} : cpx{-t3.y, t3.x};
    a0 = cadd(t0, t2); a1 = cadd(t1, t3r); a2 = csub(t0, t2); a3 = csub(t1, t3r);
}
template <int SIGN> DI void dft16(cpx (&v)[16]) {
#pragma unroll
    for (int n2 = 0; n2 < 4; ++n2) dft4<SIGN>(v[n2], v[4 + n2], v[8 + n2], v[12 + n2]);
    constexpr float C1 = 0.92387953251128674f, S1 = 0.38268343236508977f, R = 0.70710678118654752f, SG = (float)SIGN;
    v[5] = cmul(v[5], cpx{C1, SG * S1});  v[6] = cmul(v[6], cpx{R, SG * R});     v[7] = cmul(v[7], cpx{S1, SG * C1});
    v[9] = cmul(v[9], cpx{R, SG * R});    v[10] = cmul(v[10], cpx{0.f, SG});     v[11] = cmul(v[11], cpx{-R, SG * R});
    v[13] = cmul(v[13], cpx{S1, SG * C1}); v[14] = cmul(v[14], cpx{-R, SG * R}); v[15] = cmul(v[15], cpx{-C1, -SG * S1});
#pragma unroll
    for (int k1 = 0; k1 < 4; ++k1) dft4<SIGN>(v[4 * k1], v[4 * k1 + 1], v[4 * k1 + 2], v[4 * k1 + 3]);
}
template <int SIGN> DI void fft_pass16(cpx* fb, int j, int Ns, int N16) {
    cpx v[16];
#pragma unroll
    for (int r = 0; r < 16; ++r) v[r] = fb[PADX(j + N16 * r)];
    const int k = j & (Ns - 1);
    if (Ns > 1) {
        float sn, cs; sincospif((float)(SIGN * 2 * k) / (float)(16 * Ns), &sn, &cs);
        const cpx w{cs, sn}; cpx wr = w;
        v[1] = cmul(v[1], wr);
#pragma unroll
        for (int r = 2; r < 16; ++r) { wr = cmul(wr, w); v[r] = cmul(v[r], wr); }
    }
    dft16<SIGN>(v);
    __syncthreads();
    const int base = (j - k) * 16 + k;
#pragma unroll
    for (int kk = 0; kk < 16; ++kk) fb[PADX(base + kk * Ns)] = v[4 * (kk & 3) + (kk >> 2)];
    __syncthreads();
}
template <int SIGN> DI void fft_passes(cpx* fb, int j, int Ns0, int np16, int N16) {
#pragma unroll 1
    for (int ps = 0, Ns = Ns0; ps < np16; ++ps, Ns <<= 4) fft_pass16<SIGN>(fb, j, Ns, N16);
}
DI void fftconv(cpx* fb, int j, const cpx* kf, bool active, int np16, int N16) {
    fft_passes<-1>(fb, j, 2, np16, N16);
    if (active) {
#pragma unroll 4
        for (int i = 0; i < 16; ++i) { const int f = j + N16 * i; fb[PADX(f)] = cmul(fb[PADX(f)], kf[f]); }
    }
    __syncthreads();
    fft_passes<1>(fb, j, 1, np16, N16);
}
DI cpx conv_out(const cpx* fb, int t, int L) {
    const cpx a = fb[PADX(t)], b = fb[PADX(t + L)];
    float sn, cs; sincospif((float)t / (float)L, &sn, &cs);
    const cpx wb = cmul(cpx{cs, sn}, b);
    const float rn = 0.5f / (float)L;
    return cpx{(a.x + wb.x) * rn, (a.y + wb.y) * rn};
}
DI float conv3(const bf16* ptr, int t, int L, float w0, float w1, float w2) {
    const float a = t > 0 ? bf2f(ptr[t - 1]) : 0.f, b = bf2f(ptr[t]), c = t < L - 1 ? bf2f(ptr[t + 1]) : 0.f;
    return a * w0 + b * w1 + c * w2;
}

DI void filter_item(const Params& p, int l, int item, char* smem, bool lat) {
    const int np16 = lat ? 3 : 2, N16 = lat ? 512 : 32, N = 16 * N16, L = N / 2;
    const int NSUB = NTHR / N16;
    const int tid = threadIdx.x, sub = tid / N16, j = tid % N16;
    const int o = item / (HYENA_W / NSUB), c = (item % (HYENA_W / NSUB)) * NSUB + sub;
    cpx* fb = (cpx*)smem + sub * (N + N / 16);
    float* red = (float*)(smem + 8704 * 8);
    const float* hid = (const float*)(p.ws + WS_HID2) + ((size_t)l * (SEQ + DEC_SEQ) + (lat ? SEQ : 0)) * FH;
    const float* w3 = p.in[I_FW3] + (size_t)l * FH * 4 * HYENA_W;
    const int colf = o * HYENA_W + c, colb = 2 * HYENA_W + o * HYENA_W + c;
    const float min_decay = -4.605170185988091f / 1.5f, max_decay = -4.605170185988091f / 0.3f;
    const float delta = fabsf(min_decay + (max_decay - min_decay) * (float)c / (float)(HYENA_W - 1));
    float asum = 0.f;
#pragma unroll 1
    for (int i = 0; i < 8; ++i) {
        const int t = j + N16 * i;
        const float* hr = hid + (size_t)t * FH;
        float f = 0.f, b = 0.f;
        for (int q = 0; q < FH; ++q) { const float hv = hr[q]; f += hv * w3[(size_t)q * 4 * HYENA_W + colf]; b += hv * w3[(size_t)q * 4 * HYENA_W + colb]; }
        const float dec = __expf(-((float)t / (float)(L - 1)) * delta);
        f *= dec; b *= dec;
        fb[PADX(t)] = cpx{f, 0.f};
        if (t == 0) fb[PADX(L)] = cpx{0.f, 0.f}; else fb[PADX(N - t)] = cpx{b, 0.f};
        asum += fabsf(f) + (t == 0 ? 0.f : fabsf(b));
    }
#pragma unroll
    for (int s = 1; s < 32; s <<= 1) asum += __shfl_xor(asum, s);
    if (lat) {
        asum += __shfl_xor(asum, 32);
        if ((tid & 63) == 0) red[tid >> 6] = asum;
    }
    __syncthreads();
    if (lat) { asum = 0.f;
#pragma unroll
        for (int q = 0; q < 8; ++q) asum += red[q]; }
    const float rn = 1.f / asum;
    {
        cpx a[8], b[8];
#pragma unroll
        for (int i = 0; i < 8; ++i) { const int t = j + N16 * i; a[i] = fb[PADX(t)]; b[i] = fb[PADX(t + L)]; }
        __syncthreads();
#pragma unroll
        for (int i = 0; i < 8; ++i) { const int t = j + N16 * i; fb[PADX(2 * t)] = cadd(a[i], b[i]); fb[PADX(2 * t + 1)] = csub(a[i], b[i]); }
        __syncthreads();
    }
    fft_passes<-1>(fb, j, 2, np16, N16);
    cpx* kf = (cpx*)(p.ws + (lat ? WS_KFL : WS_KFC)) + (size_t)(o * HYENA_W + c) * N;
#pragma unroll 4
    for (int i = 0; i < 16; ++i) { const int f = j + N16 * i; const cpx v = fb[PADX(f)]; kf[f] = cpx{v.x * rn, v.y * rn}; }
    __syncthreads();
}

DI void hyena_item(const Params& p, int l, int item, char* smem, bool lat) {
    const int np16 = lat ? 3 : 2, N16 = lat ? 512 : 32, N = 16 * N16, L = N / 2;
    const int NSUB = NTHR / N16;
    const int NPAIR = lat ? DEC_BATCH / 2 : BATCH / 2;
    const int tid = threadIdx.x, sub = tid / N16, j = tid % N16;
    int c, pr; bool active = true;
    if (lat) { c = item / NPAIR; pr = item % NPAIR; }
    else { constexpr int GPC = (BATCH / 2 + 15) / 16; c = item / GPC; pr = (item % GPC) * NSUB + sub; active = pr < NPAIR; }
    const int tok0 = (lat ? TC : 0) + (active ? 2 * pr : 0) * L, tok1 = tok0 + L;
    cpx* fb = (cpx*)smem + sub * (N + N / 16);
    const bf16* HYT = (const bf16*)(p.ws + WS_HYT);
    const float* cw = p.in[I_HYCW] + (size_t)l * 3 * 3 * HYENA_W;
    const bf16* hv = HYT + (size_t)c * T; const bf16* gh = HYT + (size_t)(3 * HYENA_W + c) * T;
    const cpx* kfbase = (const cpx*)(p.ws + (lat ? WS_KFL : WS_KFC));
    f32x2* ub = (f32x2*)(smem + 8704 * 8 + 256) + sub * L;
    {
        const float w0 = cw[c], w1 = cw[3 * HYENA_W + c], w2 = cw[6 * HYENA_W + c];
#pragma unroll 2
        for (int i = 0; i < 8; ++i) {
            const int t = j + N16 * i;
            f32x2 u; u.x = active ? conv3(hv + tok0, t, L, w0, w1, w2) : 0.f; u.y = active ? conv3(hv + tok1, t, L, w0, w1, w2) : 0.f;
            ub[t] = u;
            fb[PADX(2 * t)] = cpx{u.x, u.y}; fb[PADX(2 * t + 1)] = cpx{u.x, u.y};
        }
    }
    __syncthreads();
    bf16* mixed = (bf16*)(p.ws + WS_XN);
#pragma unroll 1
    for (int o = 0; o < 2; ++o) {
        fftconv(fb, j, kfbase + (size_t)(o * HYENA_W + c) * N, active, np16, N16);
        const bf16* hx = HYT + (size_t)((1 + o) * HYENA_W + c) * T;
        const float w0 = cw[(1 + o) * HYENA_W + c], w1 = cw[3 * HYENA_W + (1 + o) * HYENA_W + c], w2 = cw[6 * HYENA_W + (1 + o) * HYENA_W + c];
        const float dd = p.in[I_HYD][(size_t)l * 2 * HYENA_W + o * HYENA_W + c];
#pragma unroll 2
        for (int i = 0; i < 8; ++i) {
            const int t = j + N16 * i;
            const cpx y = conv_out(fb, t, L);
            const f32x2 u = ub[t];
            const float x0 = active ? conv3(hx + tok0, t, L, w0, w1, w2) : 0.f, x1 = active ? conv3(hx + tok1, t, L, w0, w1, w2) : 0.f;
            f32x2 z; z.x = x0 * (y.x + dd * u.x); z.y = x1 * (y.y + dd * u.y);
            if (o == 0) ub[t] = z;
            else if (active) {
                mixed[(size_t)(tok0 + t) * MIX_W + ATTN_W + c] = f2bf(z.x * bf2f(gh[tok0 + t]));
                mixed[(size_t)(tok1 + t) * MIX_W + ATTN_W + c] = f2bf(z.y * bf2f(gh[tok1 + t]));
            }
        }
        __syncthreads();
        if (o == 0) {
#pragma unroll 2
            for (int i = 0; i < 8; ++i) { const int t = j + N16 * i; const f32x2 z = ub[t]; fb[PADX(2 * t)] = cpx{z.x, z.y}; fb[PADX(2 * t + 1)] = cpx{z.x, z.y}; }
            __syncthreads();
        }
    }
}

DI void shortconv_item(const Params& p, int l, int item) {
    const bf16* SCb = (const bf16*)(p.ws + WS_SC);
    bf16* mixed = (bf16*)(p.ws + WS_XN);
    const float* cw = p.in[I_SCW] + (size_t)l * 3 * CONV_W;
    for (int e = threadIdx.x; e < 64 * CONV_W; e += NTHR) {
        const int m = item * 64 + e / CONV_W, c = e % CONV_W;
        const int L = m < TC ? SEQ : DEC_SEQ, t = m < TC ? m % SEQ : (m - TC) % DEC_SEQ;
        const bf16* row = SCb + (size_t)m * 4 * CONV_W;
        const float pc = bf2f(row[CONV_W + c]) * bf2f(row[2 * CONV_W + c]);
        const float pm = t > 0 ? bf2f(row[-4 * CONV_W + CONV_W + c]) * bf2f(row[-4 * CONV_W + 2 * CONV_W + c]) : 0.f;
        const float pn = t < L - 1 ? bf2f(row[4 * CONV_W + CONV_W + c]) * bf2f(row[4 * CONV_W + 2 * CONV_W + c]) : 0.f;
        const float o = bf2f(row[c]) * (pm * cw[c] + pc * cw[CONV_W + c] + pn * cw[2 * CONV_W + c]) * bf2f(row[3 * CONV_W + c]);
        mixed[(size_t)m * MIX_W + ATTN_W + HYENA_W + c] = f2bf(o);
    }
}

constexpr int AT_NKL = 320, AT_VLS = 648, AT_VCS = 520;
constexpr int AT_KL = 0, AT_VL = AT_KL + AT_NKL * 128, AT_KC = AT_VL + 64 * AT_VLS, AT_VC = AT_KC + 256 * 128, AT_END = AT_VC + 64 * AT_VCS;
static_assert(AT_END <= LDS_BYTES, "lds");
DI void softmax_pv(f32x16& S, f32x16 (&O)[2], float& m_run, float& l_run, const char* vrow0, int vstride, int h) {
    float tmax = S[0];
#pragma unroll
    for (int e = 1; e < 16; ++e) tmax = fmaxf(tmax, S[e]);
    tmax = fmaxf(tmax, __shfl_xor(tmax, 32));
    const float mnew = fmaxf(m_run, tmax), alpha = exp2f(m_run - mnew);
    m_run = mnew; l_run *= alpha;
#pragma unroll
    for (int e = 0; e < 16; ++e) { O[0][e] *= alpha; O[1][e] *= alpha; }
    float ps = 0.f; unsigned pk[8];
#pragma unroll
    for (int e = 0; e < 8; ++e) { const float p0 = exp2f(S[2 * e] - mnew), p1 = exp2f(S[2 * e + 1] - mnew); ps += p0 + p1; pk[e] = pack2(p0, p1); }
    l_run += ps;
    u32x4 q0; q0.x = pk[0]; q0.y = pk[1]; q0.z = pk[2]; q0.w = pk[3];
    u32x4 q1; q1.x = pk[4]; q1.y = pk[5]; q1.z = pk[6]; q1.w = pk[7];
    const bf16x8 pb0 = __builtin_bit_cast(bf16x8, q0), pb1 = __builtin_bit_cast(bf16x8, q1);
#pragma unroll
    for (int dt = 0; dt < 2; ++dt)
#pragma unroll
        for (int s = 0; s < 2; ++s) {
            const char* vp = vrow0 + dt * 32 * vstride + (16 * s + 4 * h) * 2;
            const u32x2 lo = *(const u32x2*)vp, hi = *(const u32x2*)(vp + 16);
            u32x4 vv; vv.x = lo.x; vv.y = lo.y; vv.z = hi.x; vv.w = hi.y;
            O[dt] = MFMA32(__builtin_bit_cast(bf16x8, vv), s ? pb1 : pb0, O[dt]);
        }
}
DI void attn_item(const Params& p, int l, int item, char* smem, bool LAT) {
    const int tid = threadIdx.x, lane = tid & 63, w = tid >> 6, r = lane & 31, h = lane >> 5;
    const int SL = LAT ? DEC_SEQ : SEQ, NQB = SL / 64;
    const int b = item / (N_KV * NQB), kvh = (item / NQB) % N_KV, q0 = (item % NQB) * 64;
    const int tokbase = (LAT ? TC : 0) + b * SL;
    const bf16* Qb = (const bf16*)(p.ws + WS_Q); const bf16* Kb = (const bf16*)(p.ws + WS_KB); const bf16* VTb = (const bf16*)(p.ws + WS_VT);
    const bf16* GAb = (const bf16*)(p.ws + WS_GA); bf16* mixed = (bf16*)(p.ws + WS_XN);
    char* KL = smem + AT_KL; char* VL = smem + AT_VL; char* KC = smem + AT_KC; char* VC = smem + AT_VC;
    const u32x4 zero4 = {0u, 0u, 0u, 0u};
    if (LAT) {
        for (int id = tid; id < AT_NKL * 8; id += NTHR) {
            const int row = id >> 3, c = id & 7, kp = q0 - 128 + row;
            u32x4 v = zero4;
            if (kp >= 0 && kp < SL) v = *(const u32x4*)(Kb + (size_t)(tokbase + kp) * KV_W + kvh * HD + c * 8);
            *(u32x4*)(KL + swz128(row, c)) = v;
        }
        for (int id = tid; id < 64 * (AT_NKL / 8); id += NTHR) {
            const int d = id / (AT_NKL / 8), c = id % (AT_NKL / 8), kp = q0 - 128 + c * 8;
            u32x4 v = zero4;
            if (kp >= 0 && kp < SL) v = *(const u32x4*)(VTb + (size_t)(kvh * HD + d) * T + tokbase + kp);
            char* dst = VL + d * AT_VLS + c * 16;
            u32x2 a; a.x = v.x; a.y = v.y; u32x2 bb; bb.x = v.z; bb.y = v.w;
            *(u32x2*)dst = a; *(u32x2*)(dst + 8) = bb;
        }
    }
    {
        const bf16* ksrc; const bf16* vsrc; size_t kstride, vstride;
        if (LAT) { const size_t o = (size_t)((b * DEPTH + l) * N_KV + kvh) * PAST_LEN * HD; ksrc = (const bf16*)(p.ws + WS_CKB) + o; kstride = HD; vsrc = (const bf16*)(p.ws + WS_CVTB) + o; vstride = PAST_LEN; }
        else { ksrc = Kb + (size_t)tokbase * KV_W + kvh * HD; kstride = KV_W; vsrc = VTb + (size_t)(kvh * HD) * T + tokbase; vstride = T; }
        for (int id = tid; id < 256 * 8; id += NTHR) { const int row = id >> 3, c = id & 7; *(u32x4*)(KC + swz128(row, c)) = *(const u32x4*)(ksrc + (size_t)row * kstride + c * 8); }
        for (int id = tid; id < 64 * 32; id += NTHR) {
            const int d = id >> 5, c = id & 31;
            const u32x4 v = *(const u32x4*)(vsrc + (size_t)d * vstride + c * 8);
            char* dst = VC + d * AT_VCS + c * 16;
            u32x2 a; a.x = v.x; a.y = v.y; u32x2 bb; bb.x = v.z; bb.y = v.w;
            *(u32x2*)dst = a; *(u32x2*)(dst + 8) = bb;
        }
    }
    __syncthreads();
    {
        const int g = w >> 1, qt = w & 1, head = kvh * 4 + g;
        const int qpos = q0 + 32 * qt + r;
        const size_t qtok = (size_t)tokbase + qpos;
        bf16x8 qraw[4], qrot[4];
#pragma unroll
        for (int s = 0; s < 4; ++s) { qraw[s] = *(const bf16x8*)(Qb + qtok * ATTN_W + head * HD + 16 * s + 8 * h); qrot[s] = qraw[s]; }
        if (LAT) {
            const f32x2* rope = (const f32x2*)(p.ws + WS_ROPE);
#pragma unroll
            for (int a = 0; a < 2; ++a)
#pragma unroll
                for (int jj = 0; jj < 8; ++jj) {
                    const f32x2 cs = rope[(qpos * 2 + a) * 16 + 8 * h + jj];
                    const float xa = bf2f((bf16)qraw[2 * a][jj]), xb = bf2f((bf16)qraw[2 * a + 1][jj]);
                    qrot[2 * a][jj] = (short)f2bf(xa * cs.x - xb * cs.y);
                    qrot[2 * a + 1][jj] = (short)f2bf(xb * cs.x + xa * cs.y);
                }
        }
        const float c1 = 0.125f * 1.4426950408889634f;
        float m_run = p.in[I_SINK][l * N_HEADS + head] * 1.4426950408889634f, l_run = h == 0 ? 1.f : 0.f;
        f32x16 O[2];
#pragma unroll
        for (int e = 0; e < 16; ++e) { O[0][e] = 0.f; O[1][e] = 0.f; }
        if (LAT) {
            for (int jt = qt; jt < qt + 9; ++jt) {
                f32x16 S;
#pragma unroll
                for (int e = 0; e < 16; ++e) S[e] = 0.f;
                const int krow = 32 * jt + r;
#pragma unroll
                for (int s = 0; s < 4; ++s) S = MFMA32(*(const bf16x8*)(KL + swz128(krow, 2 * s + h)), qrot[s], S);
#pragma unroll
                for (int e = 0; e < 16; ++e) {
                    const int kp = q0 - 128 + 32 * jt + (e & 3) + 8 * (e >> 2) + 4 * h, dd = kp - qpos;
                    const bool ok = dd <= 128 && dd >= -128 && kp >= 0 && kp < SL;
                    S[e] = ok ? S[e] * c1 : -1e30f;
                }
                softmax_pv(S, O, m_run, l_run, VL + r * AT_VLS + 32 * jt * 2, AT_VLS, h);
            }
        }
        for (int jt = 0; jt < 8; ++jt) {
            f32x16 S;
#pragma unroll
            for (int e = 0; e < 16; ++e) S[e] = 0.f;
            const int krow = 32 * jt + r;
#pragma unroll
            for (int s = 0; s < 4; ++s) S = MFMA32(*(const bf16x8*)(KC + swz128(krow, 2 * s + h)), qraw[s], S);
#pragma unroll
            for (int e = 0; e < 16; ++e) S[e] *= c1;
            softmax_pv(S, O, m_run, l_run, VC + r * AT_VCS + 32 * jt * 2, AT_VCS, h);
        }
        const float inv = 1.f / (l_run + __shfl_xor(l_run, 32));
#pragma unroll
        for (int dt = 0; dt < 2; ++dt)
#pragma unroll
            for (int rg = 0; rg < 4; ++rg) {
                const int d0 = dt * 32 + 8 * rg + 4 * h;
                const u32x2 gv = *(const u32x2*)(GAb + qtok * ATTN_W + head * HD + d0);
                const float g0 = bf2f((bf16)(gv.x & 0xffffu)), g1 = bf2f((bf16)(gv.x >> 16)), g2 = bf2f((bf16)(gv.y & 0xffffu)), g3 = bf2f((bf16)(gv.y >> 16));
                u32x2 o; o.x = pack2(O[dt][4 * rg] * inv * g0, O[dt][4 * rg + 1] * inv * g1); o.y = pack2(O[dt][4 * rg + 2] * inv * g2, O[dt][4 * rg + 3] * inv * g3);
                *(u32x2*)(mixed + qtok * MIX_W + head * HD + d0) = o;
            }
    }
    __syncthreads();
}

DI void phase_p0(const Params& p_, char* smem) {
    constexpr int I_T1 = DEPTH * (D_MODEL / 64) * (IN_COLS / 64), I_T2 = DEPTH * (MIX_W / 64) * (D_MODEL / 64);
    constexpr int I_MOD = DEPTH * ((3 * D_MODEL + 511) / 512), I_ROPE = DEC_SEQ * 32 / NTHR, I_HID = (DEPTH * (SEQ + DEC_SEQ) + 7) / 8;
    constexpr int I_CACHE = (2 * DEC_BATCH * DEPTH * PAST_LEN * KV_W / 8 + NTHR - 1) / NTHR;
    constexpr int TOTAL = I_T1 + I_T2 + I_MOD + I_ROPE + I_HID + I_CACHE;
    for (int it = blockIdx.x; it < TOTAL; it += gridDim.x) {
        const Params p = launder(p_);
        int q = it;
        if (q < I_T1) { constexpr int per = (D_MODEL / 64) * (IN_COLS / 64); const int l = q / per;
            p0_transpose_item(p.in[I_WIN] + (size_t)l * D_MODEL * IN_COLS, D_MODEL, IN_COLS, (bf16*)(p.ws + WS_WINT) + (size_t)l * IN_COLS * D_MODEL, q % per, smem); continue; }
        q -= I_T1;
        if (q < I_T2) { constexpr int per = (MIX_W / 64) * (D_MODEL / 64); const int l = q / per;
            p0_transpose_item(p.in[I_WOUT] + (size_t)l * MIX_W * D_MODEL, MIX_W, D_MODEL, (bf16*)(p.ws + WS_WOUTT) + (size_t)l * D_MODEL * MIX_W, q % per, smem); continue; }
        q -= I_T2;
        if (q < I_MOD) { p0_mod_item(p, q, smem); continue; }
        q -= I_MOD;
        if (q < I_ROPE) { p0_rope_item(p, q); continue; }
        q -= I_ROPE;
        if (q < I_HID) { p0_hid2_item(p, q); continue; }
        q -= I_HID;
        p0_cache_item(p, q);
    }
}
DI void phase_norm(const Params& p, int l) {
    for (int it = blockIdx.x; it < T / 8; it += gridDim.x) norm_item(p, l, it);
}
DI void phase_a(const Params& p_, int l, char* smem) {
    constexpr int I_FL = 2 * HYENA_W, I_FC = 2 * HYENA_W / 16, NTN = IN_COLS / 128, I_G = (T / 256) * NTN;
    for (int it = blockIdx.x; it < I_FL + I_FC + I_G; it += gridDim.x) {
        const Params p = launder(p_);
        const bf16* A = (const bf16*)(p.ws + WS_XN);
        const bf16* Bt = (const bf16*)(p.ws + WS_WINT) + (size_t)l * IN_COLS * D_MODEL;
        int q = it;
        if (q < I_FL + I_FC) { const bool lat = q < I_FL; filter_item(p, l, lat ? q : q - I_FL, smem, lat); continue; }
        q -= I_FL + I_FC;
        const int m0 = (q / NTN) * 256, n0 = (q % NTN) * 128;
        const InProjEpi epi{p, l, n0};
        const bool swap = (n0 >= C_V && n0 < C_GA) || (n0 >= C_HV && n0 < C_SB);
        if (swap) gemm_tile<true>(A, Bt, D_MODEL, m0, n0, smem, epi); else gemm_tile<false>(A, Bt, D_MODEL, m0, n0, smem, epi);
    }
}
DI void phase_b(const Params& p_, int l, char* smem) {
    constexpr int I_HL = HYENA_W * (DEC_BATCH / 2), I_AL = DEC_BATCH * N_KV * (DEC_SEQ / 64), I_AC = BATCH * N_KV * (SEQ / 64);
    constexpr int I_HC = HYENA_W * ((BATCH / 2 + 15) / 16), I_SC = T / 64;
    for (int it = blockIdx.x; it < I_HL + I_AL + I_AC + I_HC + I_SC; it += gridDim.x) {
        const Params p = launder(p_);
        int q = it;
        if (q < I_HL + I_HC) { const bool lat = q < I_HL; hyena_item(p, l, lat ? q : q - I_HL, smem, lat); continue; }
        q -= I_HL + I_HC;
        if (q < I_AL + I_AC) { const bool lat = q < I_AL; attn_item(p, l, lat ? q : q - I_AL, smem, lat); continue; }
        q -= I_AL + I_AC;
        shortconv_item(p, l, q);
    }
}
DI void phase_c(const Params& p, int l, char* smem) {
    constexpr int NTN = D_MODEL / 128, I_G = (T / 256) * NTN;
    const bf16* A = (const bf16*)(p.ws + WS_XN);
    const bf16* Bt = (const bf16*)(p.ws + WS_WOUTT) + (size_t)l * D_MODEL * MIX_W;
    const OutProjEpi epi{p, l};
    for (int it = blockIdx.x; it < I_G; it += gridDim.x) gemm_tile<false>(A, Bt, MIX_W, (it / NTN) * 256, (it % NTN) * 128, smem, epi);
}

#ifndef PH_STOP
#define PH_STOP 1000
#endif
__global__ void __launch_bounds__(NTHR) fwd_kernel(Params p) {
#ifdef EMU
    char* smem = emu_smem();
#else
    extern __shared__ __attribute__((aligned(16))) char smem[];
    volatile LAS unsigned* xst = (volatile LAS unsigned*)(smem + LDS_BYTES - 16);
    if (threadIdx.x == 0) { xst[0] = 0u; xst[1] = 0u; }
    __syncthreads();
    const XcdBarrier xbar = xcd_barrier_post((unsigned*)(p.ws + WS_BAR), xst);
#endif
    int ph = 0;
    phase_p0(p, smem);
    GRID_SYNC(); if (++ph >= PH_STOP) return;
    phase_norm(p, 0);
    GRID_SYNC(); if (++ph >= PH_STOP) return;
    for (int l = 0; l < DEPTH; ++l) {
        phase_a(p, l, smem);
        GRID_SYNC(); if (++ph >= PH_STOP) return;
        phase_b(p, l, smem);
        GRID_SYNC(); if (++ph >= PH_STOP) return;
        phase_c(p, l, smem);
        GRID_SYNC(); if (++ph >= PH_STOP) return;
        phase_norm(p, l + 1);
        if (l + 1 < DEPTH) { GRID_SYNC(); if (++ph >= PH_STOP) return; }
    }
}

#ifndef EMU
extern "C" void kernel_launch(void* const* d_in, const int* in_sizes, int n_in, void* d_out, int out_size, void* d_ws, size_t ws_size, hipStream_t stream) {
    static int grid = 0;
    if (grid == 0) {
        if (n_in != 22 || (size_t)out_size != OUT_TOTAL || ws_size < WS_END) { fprintf(stderr, "kernel_launch: unexpected sizes n_in %d out %d ws %zu (need %zu)\n", n_in, out_size, ws_size, (size_t)WS_END); grid = -1; return; }
        int dev = 0, cus = 0, per_cu = 0;
        hipGetDevice(&dev); hipDeviceGetAttribute(&cus, hipDeviceAttributeMultiprocessorCount, dev);
        if (hipFuncSetAttribute((const void*)fwd_kernel, hipFuncAttributeMaxDynamicSharedMemorySize, LDS_BYTES) != hipSuccess) { fprintf(stderr, "hipFuncSetAttribute failed\n"); grid = -1; return; }
        hipOccupancyMaxActiveBlocksPerMultiprocessor(&per_cu, (const void*)fwd_kernel, NTHR, LDS_BYTES);
        if (per_cu < 1) { fprintf(stderr, "occupancy query says %d\n", per_cu); grid = -1; return; }
        grid = cus;
    }
    if (grid < 0) return;
    Params p{};
    for (int i = 0; i < 22; ++i) p.in[i] = (const float*)d_in[i];
    p.out = (float*)d_out; p.ws = (unsigned char*)d_ws;
    if (hipMemsetAsync((char*)d_ws + WS_BAR, 0, XCD_BAR_WORDS * 4, stream) != hipSuccess) { fprintf(stderr, "memset failed\n"); return; }
    hipLaunchKernelGGL(fwd_kernel, dim3(grid), dim3(NTHR), LDS_BYTES, stream, p);
    const hipError_t e = hipPeekAtLastError();
    if (e != hipSuccess) fprintf(stderr, "launch failed: %s (grid %d)\n", hipGetErrorString(e), grid);
}
#endif
```

```cpp
#ifdef EMU
#include "emu.h"
#define GRID_SYNC() emu_grid_sync()
#define MFMA32(a, b, c) emu_mfma32((a), (b), (c))
#else
#include <hip/hip_runtime.h>
#include <cstdio>
#include <cstdint>
typedef short bf16x8 __attribute__((ext_vector_type(8)));
typedef float f32x16 __attribute__((ext_vector_type(16)));
typedef float f32x4 __attribute__((ext_vector_type(4)));
#define GRID_SYNC() xcd_barrier(xbar)
#define MFMA32(a, b, c) __builtin_amdgcn_mfma_f32_32x32x16_bf16((a), (b), (c), 0, 0, 0)
#endif
typedef unsigned u32x4 __attribute__((ext_vector_type(4)));
typedef unsigned u32x2 __attribute__((ext_vector_type(2)));
typedef float f32x2 __attribute__((ext_vector_type(2)));
typedef unsigned short bf16;
#define DI __device__ __forceinline__

#ifdef CFG_SMALL
constexpr int D_MODEL = 128, BATCH = 2, SEQ = 256, DEPTH = 2, DEC_BATCH = 2, DEC_SEQ = 4096, PAST_LEN = 256, HYENA_W = 128, CONV_W = 128;
#else
constexpr int D_MODEL = 1024, BATCH = 32, SEQ = 256, DEPTH = 4, DEC_BATCH = 8, DEC_SEQ = 4096, PAST_LEN = 256, HYENA_W = 256, CONV_W = 256;
#endif
constexpr int GRID_W = 64, N_HEADS = 8, N_KV = 2, HD = 64, ATTN_W = 512, KV_W = 128;
constexpr int MIX_W = ATTN_W + HYENA_W + CONV_W;
constexpr int C_Q = 0, C_K = ATTN_W, C_V = C_K + KV_W, C_GA = C_V + KV_W, C_HV = C_GA + ATTN_W, C_GH = C_HV + 3 * HYENA_W,
              C_SB = C_GH + HYENA_W, C_GC = C_SB + 3 * CONV_W, IN_COLS = C_GC + CONV_W;
constexpr int TC = BATCH * SEQ, TL = DEC_BATCH * DEC_SEQ, T = TC + TL;
constexpr int NR = 1 + DEC_BATCH;
constexpr int FH = 64, FE = 33;
constexpr int NTHR = 512;
static_assert(T % 256 == 0 && TC % 256 == 0 && IN_COLS % 128 == 0 && D_MODEL % 128 == 0, "tiling");
static_assert(SEQ == 256 && DEC_SEQ == 4096 && PAST_LEN == 256, "fft sizes");

constexpr size_t al256(size_t x) { return (x + 255) & ~(size_t)255; }
constexpr size_t WS_BAR = 0;
constexpr size_t WS_WINT = 65536;
constexpr size_t WS_WOUTT = WS_WINT + al256((size_t)DEPTH * IN_COLS * D_MODEL * 2);
constexpr size_t WS_MOD = WS_WOUTT + al256((size_t)DEPTH * D_MODEL * MIX_W * 2);
constexpr size_t WS_ROPE = WS_MOD + al256((size_t)DEPTH * NR * 3 * D_MODEL * 4);
constexpr size_t WS_HID2 = WS_ROPE + al256((size_t)DEC_SEQ * 32 * 8);
constexpr size_t WS_CKB = WS_HID2 + al256((size_t)DEPTH * (SEQ + DEC_SEQ) * FH * 4);
constexpr size_t WS_CVTB = WS_CKB + al256((size_t)DEC_BATCH * DEPTH * PAST_LEN * KV_W * 2);
constexpr size_t WS_KFL = WS_CVTB + al256((size_t)DEC_BATCH * DEPTH * PAST_LEN * KV_W * 2);
constexpr size_t WS_KFC = WS_KFL + al256((size_t)2 * HYENA_W * 8192 * 8);
constexpr size_t WS_XN = WS_KFC + al256((size_t)2 * HYENA_W * 512 * 8);
constexpr size_t WS_Q = WS_XN + al256((size_t)T * (D_MODEL > MIX_W ? D_MODEL : MIX_W) * 2);
constexpr size_t WS_KB = WS_Q + al256((size_t)T * ATTN_W * 2);
constexpr size_t WS_VT = WS_KB + al256((size_t)T * KV_W * 2);
constexpr size_t WS_GA = WS_VT + al256((size_t)T * KV_W * 2);
constexpr size_t WS_HYT = WS_GA + al256((size_t)T * ATTN_W * 2);
constexpr size_t WS_SC = WS_HYT + al256((size_t)4 * HYENA_W * T * 2);
constexpr size_t WS_END = WS_SC + al256((size_t)T * 4 * CONV_W * 2);

constexpr size_t OUT_YS = (size_t)TC * D_MODEL, OUT_NK = (size_t)T * D_MODEL, OUT_NV = OUT_NK + (size_t)BATCH * DEPTH * SEQ * KV_W,
                 OUT_TOTAL = OUT_NV + (size_t)BATCH * DEPTH * SEQ * KV_W;

constexpr int LDS_BYTES = 149504;

struct Params {
    const float* in[22];
    float* out;
    unsigned char* ws;
};
enum { I_XP = 0, I_XS, I_CK, I_CV, I_C, I_CCTX, I_NORMG, I_MODW, I_MODB, I_WIN, I_SINK, I_HYCW, I_FW1, I_FB1, I_FW2, I_FB2, I_FW3, I_FFREQ, I_HYD, I_SCW, I_WOUT, I_FINALG };

DI bf16 f2bf(float f) { unsigned u = __float_as_uint(f); u += 0x7fffu + ((u >> 16) & 1u); return (bf16)(u >> 16); }
DI float bf2f(bf16 h) { return __uint_as_float(((unsigned)h) << 16); }
DI unsigned pack2(float a, float b) { return (unsigned)f2bf(a) | ((unsigned)f2bf(b) << 16); }
DI float silu_f(float x) { return x / (1.f + __expf(-x)); }
struct cpx { float x, y; };
DI cpx cmul(cpx a, cpx b) { return cpx{a.x * b.x - a.y * b.y, a.x * b.y + a.y * b.x}; }
DI cpx cadd(cpx a, cpx b) { return cpx{a.x + b.x, a.y + b.y}; }
DI cpx csub(cpx a, cpx b) { return cpx{a.x - b.x, a.y - b.y}; }
#ifdef EMU
DI Params launder(const Params& p) { return p; }
#else
DI Params launder(const Params& p) { Params q = p; asm volatile("" : "+s"(q.ws), "+s"(q.out)); return q; }
#endif
DI int mod_row(int m) { return m < TC ? 0 : 1 + (m - TC) / DEC_SEQ; }


#ifndef EMU
#define XB_TMO      128
#define XB_XCNT(j)  (256  + 64 * (j))
#define XB_XSUB(j)  (1280 + 64 * (j))
#define XB_XGEN(j)  (2304 + 64 * (j))
#define XB_TOP      3328
#define XB_TOPGEN   3392
#define XCD_BAR_WORDS 3456
#define XB_SPIN_CAP (1u << 22)
#define LAS __attribute__((address_space(3)))
DI unsigned xb_ld(unsigned* p) { return __hip_atomic_load(p, __ATOMIC_RELAXED, __HIP_MEMORY_SCOPE_AGENT); }
DI unsigned xb_add(unsigned* p, unsigned v) { return __hip_atomic_fetch_add(p, v, __ATOMIC_RELAXED, __HIP_MEMORY_SCOPE_AGENT); }
DI unsigned xb_xcc_id() { return (unsigned)__builtin_amdgcn_s_getreg((3 << 11) | 20) & 0xFu; }
#define XB_SPIN(cond, bar) do { unsigned _sp = 0; while (cond) { __builtin_amdgcn_s_sleep(1); \
    if ((++_sp & 255u) == 0u) { if (xb_ld(&(bar)[XB_TMO])) break; if (_sp > XB_SPIN_CAP) { atomicAdd(&(bar)[XB_TMO], 1u); break; } } } } while (0)
struct XcdBarrier { unsigned* bar; unsigned x; volatile LAS unsigned* st; };
DI XcdBarrier xcd_barrier_post(unsigned* bar, volatile LAS unsigned* st) {
    XcdBarrier b; b.bar = bar; b.x = xb_xcc_id(); b.st = st;
    if (threadIdx.x == 0) (void)xb_add(&bar[XB_XCNT(b.x)], 1u);
    return b;
}
DI void xcd_barrier_complete(unsigned* bar, unsigned x, unsigned& nloc, unsigned& nx) {
    const unsigned G = gridDim.x * gridDim.y * gridDim.z;
    unsigned sum, cnt, mine, sp = 0u;
    for (;;) {
        sum = 0u; cnt = 0u; mine = 0u;
#pragma unroll
        for (unsigned j = 0; j < 16; ++j) { const unsigned c = xb_ld(&bar[XB_XCNT(j)]); sum += c; cnt += (c > 0u) ? 1u : 0u; mine = (j == x) ? c : mine; }
        if (sum == G) break;
        __builtin_amdgcn_s_sleep(1);
        if ((++sp & 255u) == 0u) { if (xb_ld(&bar[XB_TMO])) break; if (sp > XB_SPIN_CAP) { atomicAdd(&bar[XB_TMO], 1u); break; } }
    }
    nloc = mine > 0u ? mine : 1u; nx = cnt > 0u ? cnt : 1u;
}
DI void xcd_barrier(const XcdBarrier& b) {
    asm volatile("s_waitcnt vmcnt(0)" ::: "memory");
    __syncthreads();
    if (threadIdx.x == 0) {
        unsigned* bar = b.bar;
        __builtin_amdgcn_s_waitcnt(0);
        unsigned nloc = b.st[0], nx = b.st[1];
        if (nloc == 0u) { xcd_barrier_complete(bar, b.x, nloc, nx); b.st[0] = nloc; b.st[1] = nx; }
        const unsigned old = xb_add(&bar[XB_XSUB(b.x)], 1u);
        const unsigned gen = old / nloc;
        if (old + 1u == (gen + 1u) * nloc) {
            __builtin_amdgcn_fence(__ATOMIC_RELEASE, "agent");
            asm volatile("s_waitcnt vmcnt(0)" ::: "memory");
            const unsigned og = xb_add(&bar[XB_TOP], 1u);
            const unsigned tg = og / nx;
            if (og + 1u == (tg + 1u) * nx) xb_add(&bar[XB_TOPGEN], 1u);
            else XB_SPIN(xb_ld(&bar[XB_TOPGEN]) == tg, bar);
            __builtin_amdgcn_fence(__ATOMIC_ACQUIRE, "agent");
            xb_add(&bar[XB_XGEN(b.x)], 1u);
            asm volatile("s_waitcnt vmcnt(0)" ::: "memory");
        } else {
            XB_SPIN(xb_ld(&bar[XB_XGEN(b.x)]) == gen, bar);
            __builtin_amdgcn_fence(__ATOMIC_ACQUIRE, "agent");
            asm volatile("s_waitcnt vmcnt(0)" ::: "memory");
        }
    }
    __syncthreads();
}
#endif

DI void p0_transpose_item(const float* W, int K, int N, bf16* WT, int item, char* smem) {
    float* scr = (float*)smem;
    const int tid = threadIdx.x, nblk = N / 64, k0 = (item / nblk) * 64, n0 = (item % nblk) * 64;
#pragma unroll
    for (int i = 0; i < 8; ++i) { const int kk = (tid >> 6) + 8 * i, nn = tid & 63; scr[kk * 65 + nn] = W[(size_t)(k0 + kk) * N + n0 + nn]; }
    __syncthreads();
    const int n = tid >> 3, c = tid & 7;
    const float* s = scr + (8 * c) * 65 + n;
    u32x4 o; o.x = pack2(s[0], s[65]); o.y = pack2(s[2 * 65], s[3 * 65]); o.z = pack2(s[4 * 65], s[5 * 65]); o.w = pack2(s[6 * 65], s[7 * 65]);
    *(u32x4*)(WT + (size_t)(n0 + n) * K + k0 + 8 * c) = o;
    __syncthreads();
}
DI void p0_mod_item(const Params& p, int item, char* smem) {
    constexpr int NCH = (3 * D_MODEL + 511) / 512;
    float* tab = (float*)smem;
    const int tid = threadIdx.x, l = item / NCH, col = (item % NCH) * 512 + tid;
    for (int e = tid; e < NR * D_MODEL; e += NTHR) { const int r = e / D_MODEL, k = e % D_MODEL; const float cv = r == 0 ? p.in[I_CCTX][k] : p.in[I_C][(size_t)(r - 1) * D_MODEL + k]; tab[e] = silu_f(cv); }
    __syncthreads();
    if (col < 3 * D_MODEL) {
        float acc[NR];
#pragma unroll
        for (int r = 0; r < NR; ++r) acc[r] = 0.f;
        const float* w = p.in[I_MODW] + (size_t)l * D_MODEL * 3 * D_MODEL + col;
        for (int k = 0; k < D_MODEL; ++k) { const float wv = w[(size_t)k * 3 * D_MODEL];
#pragma unroll
            for (int r = 0; r < NR; ++r) acc[r] += tab[r * D_MODEL + k] * wv; }
        const float bv = p.in[I_MODB][(size_t)l * 3 * D_MODEL + col];
        float* mod = (float*)(p.ws + WS_MOD);
#pragma unroll
        for (int r = 0; r < NR; ++r) mod[((size_t)l * NR + r) * 3 * D_MODEL + col] = acc[r] + bv;
    }
    __syncthreads();
}
DI void p0_rope_item(const Params& p, int item) {
    const int e = item * NTHR + threadIdx.x;
    if (e < DEC_SEQ * 32) {
        const int t = e >> 5, a = (e >> 4) & 1, f = e & 15;
        const float pos = (float)(a ? (t % GRID_W) : (t / GRID_W));
        const float inv = exp2f(-(float)f * (13.287712379549449f / 16.f));
        const float ang = pos * inv;
        f32x2 v; v.x = cosf(ang); v.y = sinf(ang);
        ((f32x2*)(p.ws + WS_ROPE))[e] = v;
    }
}
DI void p0_hid2_item(const Params& p, int item) {
    const int lane = threadIdx.x & 63, w = threadIdx.x >> 6;
    const int rr = item * 8 + w;
    if (rr >= DEPTH * (SEQ + DEC_SEQ)) return;
    const int l = rr / (SEQ + DEC_SEQ), q = rr % (SEQ + DEC_SEQ);
    const int L = q < SEQ ? SEQ : DEC_SEQ, t = q < SEQ ? q : q - SEQ;
    float feat = 0.f;
    if (lane == 0) feat = (float)t / (float)(L - 1);
    else if (lane < FE) {
        const int b = (lane - 1) & 15;
        const float fr = 1e-4f + (float)b * ((15.f - 1e-4f) / 15.f);
        const float ang = (6.283185307179586f / (float)L) * (float)t;
        feat = lane <= 16 ? cosf(fr * ang) : -sinf(fr * ang);
    }
    const float* w1 = p.in[I_FW1] + (size_t)l * FE * FH; const float* w2 = p.in[I_FW2] + (size_t)l * FH * FH;
    const float fq = p.in[I_FFREQ][l * FH + lane];
    float a1 = p.in[I_FB1][l * FH + lane];
    for (int i = 0; i < FE; ++i) a1 += __shfl(feat, i) * w1[i * FH + lane];
    const float h1 = sinf(fq * a1);
    float a2 = p.in[I_FB2][l * FH + lane];
    for (int i = 0; i < FH; ++i) a2 += __shfl(h1, i) * w2[i * FH + lane];
    const float h2 = sinf(fq * a2);
    ((float*)(p.ws + WS_HID2))[(size_t)l * (SEQ + DEC_SEQ) * FH + (q < SEQ ? 0 : (size_t)SEQ * FH) + (size_t)lane * L + t] = h2;
}
DI void p0_cache_item(const Params& p, int item) {
    constexpr int NCHUNK = DEC_BATCH * DEPTH * PAST_LEN * KV_W / 8;
    int e = item * NTHR + threadIdx.x;
    if (e < NCHUNK) {
        const int c8 = e & 7, j = (e >> 3) % PAST_LEN, kvh = (e >> 3) / PAST_LEN % N_KV, bl = (e >> 3) / PAST_LEN / N_KV;
        const float* src = p.in[I_CK] + ((size_t)(bl * PAST_LEN + j) * N_KV + kvh) * HD + c8 * 8;
        u32x4 o; o.x = pack2(src[0], src[1]); o.y = pack2(src[2], src[3]); o.z = pack2(src[4], src[5]); o.w = pack2(src[6], src[7]);
        *(u32x4*)((bf16*)(p.ws + WS_CKB) + (size_t)e * 8) = o;
    } else if (e < 2 * NCHUNK) {
        e -= NCHUNK;
        const int j8 = e % (PAST_LEN / 8), d = (e / (PAST_LEN / 8)) % HD, kvh = (e / (PAST_LEN / 8)) / HD % N_KV, bl = (e / (PAST_LEN / 8)) / HD / N_KV;
        const float* src = p.in[I_CV] + ((size_t)(bl * PAST_LEN + j8 * 8) * N_KV + kvh) * HD + d;
        constexpr int S = N_KV * HD;
        u32x4 o; o.x = pack2(src[0], src[S]); o.y = pack2(src[2 * S], src[3 * S]); o.z = pack2(src[4 * S], src[5 * S]); o.w = pack2(src[6 * S], src[7 * S]);
        *(u32x4*)((bf16*)(p.ws + WS_CVTB) + (size_t)e * 8) = o;
    }
}

DI const float* x_row_src(const Params& p, int l, int m) {
    if (l == 0) return m < TC ? p.in[I_XP] + (size_t)m * D_MODEL : p.in[I_XS] + (size_t)(m - TC) * D_MODEL;
    return p.out + (size_t)m * D_MODEL;
}
DI void norm_item(const Params& p, int l, int item) {
    const int lane = threadIdx.x & 63, w = threadIdx.x >> 6, m = item * 8 + w;
    if (m >= T) return;
    const float* xr = x_row_src(p, l, m);
    float ss = 0.f;
    for (int c4 = lane; c4 < D_MODEL / 4; c4 += 64) { const f32x4 v = *(const f32x4*)(xr + 4 * c4); ss += v.x * v.x + v.y * v.y + v.z * v.z + v.w * v.w; }
#pragma unroll
    for (int o = 1; o < 64; o <<= 1) ss += __shfl_xor(ss, o);
    const float rstd = rsqrtf(ss * (1.f / D_MODEL) + 1e-6f);
    if (l < DEPTH) {
        const float* g = p.in[I_NORMG] + (size_t)l * D_MODEL;
        const float* mod = (const float*)(p.ws + WS_MOD) + ((size_t)l * NR + mod_row(m)) * 3 * D_MODEL;
        bf16* xn = (bf16*)(p.ws + WS_XN) + (size_t)m * D_MODEL;
        for (int c4 = lane; c4 < D_MODEL / 4; c4 += 64) {
            const f32x4 v = *(const f32x4*)(xr + 4 * c4), gv = *(const f32x4*)(g + 4 * c4), sh = *(const f32x4*)(mod + 4 * c4), sc = *(const f32x4*)(mod + D_MODEL + 4 * c4);
            u32x2 o; o.x = pack2(v.x * rstd * gv.x * (1.f + sc.x) + sh.x, v.y * rstd * gv.y * (1.f + sc.y) + sh.y);
            o.y = pack2(v.z * rstd * gv.z * (1.f + sc.z) + sh.z, v.w * rstd * gv.w * (1.f + sc.w) + sh.w);
            *(u32x2*)(xn + 4 * c4) = o;
        }
    } else {
        const float* g = p.in[I_FINALG];
        float* yo = p.out + (size_t)m * D_MODEL;
        for (int c4 = lane; c4 < D_MODEL / 4; c4 += 64) {
            const f32x4 v = *(const f32x4*)(xr + 4 * c4), gv = *(const f32x4*)(g + 4 * c4);
            f32x4 o; o.x = v.x * rstd * gv.x; o.y = v.y * rstd * gv.y; o.z = v.z * rstd * gv.z; o.w = v.w * rstd * gv.w;
            *(f32x4*)(yo + 4 * c4) = o;
        }
    }
}

DI int swz128(int row, int c) { return row * 128 + ((c ^ ((row >> 1) & 7)) << 4); }
template <bool SWAP, class Epi>
DI void gemm_tile(const bf16* A, const bf16* Bt, int K, int m0, int n0, char* smem, const Epi& epi) {
    const int tid = threadIdx.x, lane = tid & 63, w = tid >> 6, wm = w >> 1, wn = w & 1, r = lane & 31, h = lane >> 5;
    f32x16 acc[2][2];
#pragma unroll
    for (int i = 0; i < 2; ++i)
#pragma unroll
        for (int j = 0; j < 2; ++j)
#pragma unroll
            for (int e = 0; e < 16; ++e) acc[i][j][e] = 0.f;
    const int nk = K / 64;
    u32x4 ra[4], rb[2];
    const bf16* Ag = A + (size_t)(m0 + (tid >> 3)) * K + (tid & 7) * 8;
    const bf16* Bg = Bt + (size_t)(n0 + (tid >> 3)) * K + (tid & 7) * 8;
#pragma unroll
    for (int i = 0; i < 4; ++i) ra[i] = *(const u32x4*)(Ag + (size_t)(64 * i) * K);
#pragma unroll
    for (int i = 0; i < 2; ++i) rb[i] = *(const u32x4*)(Bg + (size_t)(64 * i) * K);
    {
        char* As = smem; char* Bs = smem + 32768;
#pragma unroll
        for (int i = 0; i < 4; ++i) *(u32x4*)(As + swz128((tid >> 3) + 64 * i, tid & 7)) = ra[i];
#pragma unroll
        for (int i = 0; i < 2; ++i) *(u32x4*)(Bs + swz128((tid >> 3) + 64 * i, tid & 7)) = rb[i];
    }
    __syncthreads();
    for (int kt = 0; kt < nk; ++kt) {
        if (kt + 1 < nk) {
#pragma unroll
            for (int i = 0; i < 4; ++i) ra[i] = *(const u32x4*)(Ag + (size_t)(64 * i) * K + (kt + 1) * 64);
#pragma unroll
            for (int i = 0; i < 2; ++i) rb[i] = *(const u32x4*)(Bg + (size_t)(64 * i) * K + (kt + 1) * 64);
        }
        const char* As = smem + (kt & 1) * 49152; const char* Bs = As + 32768;
#pragma unroll
        for (int s = 0; s < 4; ++s) {
            bf16x8 a[2], b[2];
#pragma unroll
            for (int i = 0; i < 2; ++i) a[i] = *(const bf16x8*)(As + swz128(wm * 64 + i * 32 + r, 2 * s + h));
#pragma unroll
            for (int j = 0; j < 2; ++j) b[j] = *(const bf16x8*)(Bs + swz128(wn * 64 + j * 32 + r, 2 * s + h));
#pragma unroll
            for (int i = 0; i < 2; ++i)
#pragma unroll
                for (int j = 0; j < 2; ++j) acc[i][j] = SWAP ? MFMA32(b[j], a[i], acc[i][j]) : MFMA32(a[i], b[j], acc[i][j]);
        }
        if (kt + 1 < nk) {
            char* As2 = smem + ((kt + 1) & 1) * 49152; char* Bs2 = As2 + 32768;
#pragma unroll
            for (int i = 0; i < 4; ++i) *(u32x4*)(As2 + swz128((tid >> 3) + 64 * i, tid & 7)) = ra[i];
#pragma unroll
            for (int i = 0; i < 2; ++i) *(u32x4*)(Bs2 + swz128((tid >> 3) + 64 * i, tid & 7)) = rb[i];
        }
        __syncthreads();
    }
    epi.template run<SWAP>(acc, m0 + wm * 64, n0 + wn * 64, lane);
}

struct InProjEpi {
    const Params& p; int l; int n0;
    template <bool swap> DI void run(const f32x16 (&acc)[2][2], int mb, int nb, int lane) const {
        const int r = lane & 31, h = lane >> 5;
        const bool ctx = mb < TC;
        bf16* Qb = (bf16*)(p.ws + WS_Q); bf16* Kb = (bf16*)(p.ws + WS_KB); bf16* VTb = (bf16*)(p.ws + WS_VT); bf16* GAb = (bf16*)(p.ws + WS_GA);
        bf16* HYT = (bf16*)(p.ws + WS_HYT); bf16* SCb = (bf16*)(p.ws + WS_SC);
        if (!swap) {
#pragma unroll
            for (int i = 0; i < 2; ++i)
#pragma unroll
                for (int j = 0; j < 2; ++j) {
                    const int n = nb + 32 * j + r;
#pragma unroll
                    for (int reg = 0; reg < 16; ++reg) {
                        const int m = mb + 32 * i + (reg & 3) + 8 * (reg >> 2) + 4 * h;
                        const float v = acc[i][j][reg];
                        if (n0 < C_K) Qb[(size_t)m * ATTN_W + n] = f2bf(v);
                        else if (n0 < C_V) {
                            const int nn = n - C_K;
                            if (ctx) {
                                Kb[(size_t)m * KV_W + nn] = f2bf(v);
                                const int b = m / SEQ, s = m % SEQ;
                                p.out[OUT_NK + ((size_t)(b * DEPTH + l) * SEQ + s) * KV_W + nn] = v;
                            } else {
                                const int pos = (m - TC) % DEC_SEQ, a = (nn >> 5) & 1, pp = (lane >> 4) & 1, f = lane & 15;
                                const f32x2 cs = ((const f32x2*)(p.ws + WS_ROPE))[(pos * 2 + a) * 16 + f];
                                const float oth = __shfl_xor(v, 16);
                                const float o = pp ? v * cs.x + oth * cs.y : v * cs.x - oth * cs.y;
                                Kb[(size_t)m * KV_W + nn] = f2bf(o);
                            }
                        } else if (n0 < C_HV) GAb[(size_t)m * ATTN_W + (n - C_GA)] = f2bf(silu_f(v));
                        else { const int col = n - C_SB; SCb[(size_t)m * (4 * CONV_W) + col] = f2bf(col >= 3 * CONV_W ? silu_f(v) : v); }
                    }
                }
        } else {
#pragma unroll
            for (int i = 0; i < 2; ++i)
#pragma unroll
                for (int j = 0; j < 2; ++j) {
                    const int m = mb + 32 * i + r;
#pragma unroll
                    for (int reg = 0; reg < 16; ++reg) {
                        const int n = nb + 32 * j + (reg & 3) + 8 * (reg >> 2) + 4 * h;
                        const float v = acc[i][j][reg];
                        if (n0 < C_GA) {
                            const int nn = n - C_V;
                            VTb[(size_t)nn * T + m] = f2bf(v);
                            if (ctx) { const int b = m / SEQ, s = m % SEQ; p.out[OUT_NV + ((size_t)(b * DEPTH + l) * SEQ + s) * KV_W + nn] = v; }
                        } else { const int nn = n - C_HV; HYT[(size_t)nn * T + m] = f2bf(nn >= 3 * HYENA_W ? silu_f(v) : v); }
                    }
                }
        }
    }
};
struct OutProjEpi {
    const Params& p; int l;
    template <bool swap> DI void run(const f32x16 (&acc)[2][2], int mb, int nb, int lane) const {
        const int r = lane & 31, h = lane >> 5;
        const float* gate = (const float*)(p.ws + WS_MOD) + ((size_t)l * NR + mod_row(mb)) * 3 * D_MODEL + 2 * D_MODEL;
#pragma unroll
        for (int i = 0; i < 2; ++i)
#pragma unroll
            for (int j = 0; j < 2; ++j) {
                const int n = nb + 32 * j + r; const float g = gate[n];
#pragma unroll
                for (int reg = 0; reg < 16; ++reg) {
                    const int m = mb + 32 * i + (reg & 3) + 8 * (reg >> 2) + 4 * h;
                    const float xv = x_row_src(p, l, m)[n];
                    p.out[(size_t)m * D_MODEL + n] = xv + g * acc[i][j][reg];
                }
            }
    }
};

DI int PADX(int i) { return i + (i >> 4); }
template <int SIGN> DI void dft4(cpx& a0, cpx& a1, cpx& a2, cpx& a3) {
    const cpx t0 = cadd(a0, a2), t1 = csub(a0, a2), t2 = cadd(a1, a3), t3 = csub(a1, a3);
    const cpx t3r = SIGN < 0 ? cpx{t3.y, -t3.x} : cpx{-t3.y, t3.x};
    a0 = cadd(t0, t2); a1 = cadd(t1, t3r); a2 = csub(t0, t2); a3 = csub(t1, t3r);
}
template <int SIGN> DI void dft16(cpx (&v)[16]) {
#pragma unroll
    for (int n2 = 0; n2 < 4; ++n2) dft4<SIGN>(v[n2], v[4 + n2], v[8 + n2], v[12 + n2]);
    constexpr float C1 = 0.92387953251128674f, S1 = 0.38268343236508977f, R = 0.70710678118654752f, SG = (float)SIGN;
    v[5] = cmul(v[5], cpx{C1, SG * S1});  v[6] = cmul(v[6], cpx{R, SG * R});     v[7] = cmul(v[7], cpx{S1, SG * C1});
    v[9] = cmul(v[9], cpx{R, SG * R});    v[10] = cmul(v[10], cpx{0.f, SG});     v[11] = cmul(v[11], cpx{-R, SG * R});
    v[13] = cmul(v[13], cpx{S1, SG * C1}); v[14] = cmul(v[14], cpx{-R, SG * R}); v[15] = cmul(v[15], cpx{-C1, -SG * S1});
#pragma unroll
    for (int k1 = 0; k1 < 4; ++k1) dft4<SIGN>(v[4 * k1], v[4 * k1 + 1], v[4 * k1 + 2], v[4 * k1 + 3]);
}
template <int SIGN> DI void fft_pass16(cpx* fb, int j, int Ns, int N16) {
    cpx v[16];
#pragma unroll
    for (int r = 0; r < 16; ++r) v[r] = fb[PADX(j + N16 * r)];
    const int k = j & (Ns - 1);
    if (Ns > 1) {
        float sn, cs; sincospif((float)(SIGN * 2 * k) / (float)(16 * Ns), &sn, &cs);
        const cpx w{cs, sn}; cpx wr = w;
        v[1] = cmul(v[1], wr);
#pragma unroll
        for (int r = 2; r < 16; ++r) { wr = cmul(wr, w); v[r] = cmul(v[r], wr); }
    }
    dft16<SIGN>(v);
    __syncthreads();
    const int base = (j - k) * 16 + k;
#pragma unroll
    for (int kk = 0; kk < 16; ++kk) fb[PADX(base + kk * Ns)] = v[4 * (kk & 3) + (kk >> 2)];
    __syncthreads();
}
template <int SIGN> DI void fft_passes(cpx* fb, int j, int Ns0, int np16, int N16) {
#pragma unroll 1
    for (int ps = 0, Ns = Ns0; ps < np16; ++ps, Ns <<= 4) fft_pass16<SIGN>(fb, j, Ns, N16);
}
DI void fftconv(cpx* fb, int j, const cpx* kf, bool active, int np16, int N16) {
    fft_passes<-1>(fb, j, 2, np16, N16);
    if (active) {
#pragma unroll 4
        for (int i = 0; i < 16; ++i) { const int f = j + N16 * i; fb[PADX(f)] = cmul(fb[PADX(f)], kf[f]); }
    }
    __syncthreads();
    fft_passes<1>(fb, j, 1, np16, N16);
}
DI cpx conv_out(const cpx* fb, int t, int L) {
    const cpx a = fb[PADX(t)], b = fb[PADX(t + L)];
    float sn, cs; sincospif((float)t / (float)L, &sn, &cs);
    const cpx wb = cmul(cpx{cs, sn}, b);
    const float rn = 0.5f / (float)L;
    return cpx{(a.x + wb.x) * rn, (a.y + wb.y) * rn};
}
DI float conv3(const bf16* ptr, int t, int L, float w0, float w1, float w2) {
    const float a = t > 0 ? bf2f(ptr[t - 1]) : 0.f, b = bf2f(ptr[t]), c = t < L - 1 ? bf2f(ptr[t + 1]) : 0.f;
    return a * w0 + b * w1 + c * w2;
}

DI void filter_item(const Params& p, int l, int item, char* smem, bool lat) {
    const int np16 = lat ? 3 : 2, N16 = lat ? 512 : 32, N = 16 * N16, L = N / 2;
    const int NSUB = NTHR / N16;
    const int tid = threadIdx.x, sub = tid / N16, j = tid % N16;
    const int o = item / (HYENA_W / NSUB), c = (item % (HYENA_W / NSUB)) * NSUB + sub;
    cpx* fb = (cpx*)smem + sub * (N + N / 16);
    float* red = (float*)(smem + 8704 * 8);
    const float* hid = (const float*)(p.ws + WS_HID2) + ((size_t)l * (SEQ + DEC_SEQ) + (lat ? SEQ : 0)) * FH;
    const float* w3 = p.in[I_FW3] + (size_t)l * FH * 4 * HYENA_W;
    const int colf = o * HYENA_W + c, colb = 2 * HYENA_W + o * HYENA_W + c;
    const float min_decay = -4.605170185988091f / 1.5f, max_decay = -4.605170185988091f / 0.3f;
    const float delta = fabsf(min_decay + (max_decay - min_decay) * (float)c / (float)(HYENA_W - 1));
    float asum = 0.f;
#pragma unroll 1
    for (int i = 0; i < 8; ++i) {
        const int t = j + N16 * i;
        const float* hr = hid + t;
        float f = 0.f, b = 0.f;
#pragma unroll 8
        for (int q = 0; q < FH; ++q) { const float hv = hr[(size_t)q * L]; f += hv * w3[(size_t)q * 4 * HYENA_W + colf]; b += hv * w3[(size_t)q * 4 * HYENA_W + colb]; }
        const float dec = __expf(-((float)t / (float)(L - 1)) * delta);
        f *= dec; b *= dec;
        fb[PADX(t)] = cpx{f, 0.f};
        if (t == 0) fb[PADX(L)] = cpx{0.f, 0.f}; else fb[PADX(N - t)] = cpx{b, 0.f};
        asum += fabsf(f) + (t == 0 ? 0.f : fabsf(b));
    }
#pragma unroll
    for (int s = 1; s < 32; s <<= 1) asum += __shfl_xor(asum, s);
    if (lat) {
        asum += __shfl_xor(asum, 32);
        if ((tid & 63) == 0) red[tid >> 6] = asum;
    }
    __syncthreads();
    if (lat) { asum = 0.f;
#pragma unroll
        for (int q = 0; q < 8; ++q) asum += red[q]; }
    const float rn = 1.f / asum;
    {
        cpx a[8], b[8];
#pragma unroll
        for (int i = 0; i < 8; ++i) { const int t = j + N16 * i; a[i] = fb[PADX(t)]; b[i] = fb[PADX(t + L)]; }
        __syncthreads();
#pragma unroll
        for (int i = 0; i < 8; ++i) { const int t = j + N16 * i; fb[PADX(2 * t)] = cadd(a[i], b[i]); fb[PADX(2 * t + 1)] = csub(a[i], b[i]); }
        __syncthreads();
    }
    fft_passes<-1>(fb, j, 2, np16, N16);
    cpx* kf = (cpx*)(p.ws + (lat ? WS_KFL : WS_KFC)) + (size_t)(o * HYENA_W + c) * N;
#pragma unroll 4
    for (int i = 0; i < 16; ++i) { const int f = j + N16 * i; const cpx v = fb[PADX(f)]; kf[f] = cpx{v.x * rn, v.y * rn}; }
    __syncthreads();
}

DI void hyena_item(const Params& p, int l, int item, char* smem, bool lat) {
    const int np16 = lat ? 3 : 2, N16 = lat ? 512 : 32, N = 16 * N16, L = N / 2;
    const int NSUB = NTHR / N16;
    const int NPAIR = lat ? DEC_BATCH / 2 : BATCH / 2;
    const int tid = threadIdx.x, sub = tid / N16, j = tid % N16;
    int c, pr; bool active = true;
    if (lat) { c = item / NPAIR; pr = item % NPAIR; }
    else { constexpr int GPC = (BATCH / 2 + 15) / 16; c = item / GPC; pr = (item % GPC) * NSUB + sub; active = pr < NPAIR; }
    const int tok0 = (lat ? TC : 0) + (active ? 2 * pr : 0) * L, tok1 = tok0 + L;
    cpx* fb = (cpx*)smem + sub * (N + N / 16);
    const bf16* HYT = (const bf16*)(p.ws + WS_HYT);
    const float* cw = p.in[I_HYCW] + (size_t)l * 3 * 3 * HYENA_W;
    const bf16* hv = HYT + (size_t)c * T; const bf16* gh = HYT + (size_t)(3 * HYENA_W + c) * T;
    const cpx* kfbase = (const cpx*)(p.ws + (lat ? WS_KFL : WS_KFC));
    f32x2* ub = (f32x2*)(smem + 8704 * 8 + 256) + sub * L;
    {
        const float w0 = cw[c], w1 = cw[3 * HYENA_W + c], w2 = cw[6 * HYENA_W + c];
#pragma unroll 2
        for (int i = 0; i < 8; ++i) {
            const int t = j + N16 * i;
            f32x2 u; u.x = active ? conv3(hv + tok0, t, L, w0, w1, w2) : 0.f; u.y = active ? conv3(hv + tok1, t, L, w0, w1, w2) : 0.f;
            ub[t] = u;
            fb[PADX(2 * t)] = cpx{u.x, u.y}; fb[PADX(2 * t + 1)] = cpx{u.x, u.y};
        }
    }
    __syncthreads();
    bf16* mixed = (bf16*)(p.ws + WS_XN);
#pragma unroll 1
    for (int o = 0; o < 2; ++o) {
        fftconv(fb, j, kfbase + (size_t)(o * HYENA_W + c) * N, active, np16, N16);
        const bf16* hx = HYT + (size_t)((1 + o) * HYENA_W + c) * T;
        const float w0 = cw[(1 + o) * HYENA_W + c], w1 = cw[3 * HYENA_W + (1 + o) * HYENA_W + c], w2 = cw[6 * HYENA_W + (1 + o) * HYENA_W + c];
        const float dd = p.in[I_HYD][(size_t)l * 2 * HYENA_W + o * HYENA_W + c];
#pragma unroll 2
        for (int i = 0; i < 8; ++i) {
            const int t = j + N16 * i;
            const cpx y = conv_out(fb, t, L);
            const f32x2 u = ub[t];
            const float x0 = active ? conv3(hx + tok0, t, L, w0, w1, w2) : 0.f, x1 = active ? conv3(hx + tok1, t, L, w0, w1, w2) : 0.f;
            f32x2 z; z.x = x0 * (y.x + dd * u.x); z.y = x1 * (y.y + dd * u.y);
            if (o == 0) ub[t] = z;
            else if (active) {
                mixed[(size_t)(tok0 + t) * MIX_W + ATTN_W + c] = f2bf(z.x * bf2f(gh[tok0 + t]));
                mixed[(size_t)(tok1 + t) * MIX_W + ATTN_W + c] = f2bf(z.y * bf2f(gh[tok1 + t]));
            }
        }
        __syncthreads();
        if (o == 0) {
#pragma unroll 2
            for (int i = 0; i < 8; ++i) { const int t = j + N16 * i; const f32x2 z = ub[t]; fb[PADX(2 * t)] = cpx{z.x, z.y}; fb[PADX(2 * t + 1)] = cpx{z.x, z.y}; }
            __syncthreads();
        }
    }
}

DI void unpack8(const u32x4 v, float (&f)[8]) {
    f[0] = __uint_as_float(v.x << 16); f[1] = __uint_as_float(v.x & 0xffff0000u); f[2] = __uint_as_float(v.y << 16); f[3] = __uint_as_float(v.y & 0xffff0000u);
    f[4] = __uint_as_float(v.z << 16); f[5] = __uint_as_float(v.z & 0xffff0000u); f[6] = __uint_as_float(v.w << 16); f[7] = __uint_as_float(v.w & 0xffff0000u);
}
DI void shortconv_item(const Params& p, int l, int item) {
    const bf16* SCb = (const bf16*)(p.ws + WS_SC);
    bf16* mixed = (bf16*)(p.ws + WS_XN);
    const float* cw = p.in[I_SCW] + (size_t)l * 3 * CONV_W;
    constexpr int C8 = CONV_W / 8;
    const u32x4 zero4 = {0u, 0u, 0u, 0u};
    for (int e = threadIdx.x; e < 64 * C8; e += NTHR) {
        const int m = item * 64 + e / C8, c = (e % C8) * 8;
        const int L = m < TC ? SEQ : DEC_SEQ, t = m < TC ? m % SEQ : (m - TC) % DEC_SEQ;
        const bf16* row = SCb + (size_t)m * 4 * CONV_W + c;
        float sb[8], g0[8], x0[8], gm[8], xm[8], gn[8], xn[8], gc[8], w0[8], w1[8], w2[8];
        unpack8(*(const u32x4*)row, sb); unpack8(*(const u32x4*)(row + CONV_W), g0); unpack8(*(const u32x4*)(row + 2 * CONV_W), x0); unpack8(*(const u32x4*)(row + 3 * CONV_W), gc);
        unpack8(t > 0 ? *(const u32x4*)(row - 4 * CONV_W + CONV_W) : zero4, gm); unpack8(t > 0 ? *(const u32x4*)(row - 4 * CONV_W + 2 * CONV_W) : zero4, xm);
        unpack8(t < L - 1 ? *(const u32x4*)(row + 4 * CONV_W + CONV_W) : zero4, gn); unpack8(t < L - 1 ? *(const u32x4*)(row + 4 * CONV_W + 2 * CONV_W) : zero4, xn);
#pragma unroll
        for (int i = 0; i < 2; ++i) {
            const f32x4 a = *(const f32x4*)(cw + c + 4 * i), b = *(const f32x4*)(cw + CONV_W + c + 4 * i), d = *(const f32x4*)(cw + 2 * CONV_W + c + 4 * i);
            w0[4 * i] = a.x; w0[4 * i + 1] = a.y; w0[4 * i + 2] = a.z; w0[4 * i + 3] = a.w;
            w1[4 * i] = b.x; w1[4 * i + 1] = b.y; w1[4 * i + 2] = b.z; w1[4 * i + 3] = b.w;
            w2[4 * i] = d.x; w2[4 * i + 1] = d.y; w2[4 * i + 2] = d.z; w2[4 * i + 3] = d.w;
        }
        float o[8];
#pragma unroll
        for (int i = 0; i < 8; ++i) o[i] = sb[i] * (gm[i] * xm[i] * w0[i] + g0[i] * x0[i] * w1[i] + gn[i] * xn[i] * w2[i]) * gc[i];
        u32x4 ov; ov.x = pack2(o[0], o[1]); ov.y = pack2(o[2], o[3]); ov.z = pack2(o[4], o[5]); ov.w = pack2(o[6], o[7]);
        *(u32x4*)(mixed + (size_t)m * MIX_W + ATTN_W + HYENA_W + c) = ov;
    }
}

constexpr int AT_NKL = 320, AT_VLS = 648, AT_VCS = 520;
constexpr int AT_KL = 0, AT_VL = AT_KL + AT_NKL * 128, AT_KC = AT_VL + 64 * AT_VLS, AT_VC = AT_KC + 256 * 128, AT_END = AT_VC + 64 * AT_VCS;
static_assert(AT_END <= LDS_BYTES, "lds");
DI void softmax_pv(f32x16& S, f32x16 (&O)[2], float& m_run, float& l_run, const char* vrow0, int vstride, int h) {
    float tmax = S[0];
#pragma unroll
    for (int e = 1; e < 16; ++e) tmax = fmaxf(tmax, S[e]);
    tmax = fmaxf(tmax, __shfl_xor(tmax, 32));
    const float mnew = fmaxf(m_run, tmax), alpha = exp2f(m_run - mnew);
    m_run = mnew; l_run *= alpha;
#pragma unroll
    for (int e = 0; e < 16; ++e) { O[0][e] *= alpha; O[1][e] *= alpha; }
    float ps = 0.f; unsigned pk[8];
#pragma unroll
    for (int e = 0; e < 8; ++e) { const float p0 = exp2f(S[2 * e] - mnew), p1 = exp2f(S[2 * e + 1] - mnew); ps += p0 + p1; pk[e] = pack2(p0, p1); }
    l_run += ps;
    u32x4 q0; q0.x = pk[0]; q0.y = pk[1]; q0.z = pk[2]; q0.w = pk[3];
    u32x4 q1; q1.x = pk[4]; q1.y = pk[5]; q1.z = pk[6]; q1.w = pk[7];
    const bf16x8 pb0 = __builtin_bit_cast(bf16x8, q0), pb1 = __builtin_bit_cast(bf16x8, q1);
#pragma unroll
    for (int dt = 0; dt < 2; ++dt)
#pragma unroll
        for (int s = 0; s < 2; ++s) {
            const char* vp = vrow0 + dt * 32 * vstride + (16 * s + 4 * h) * 2;
            const u32x2 lo = *(const u32x2*)vp, hi = *(const u32x2*)(vp + 16);
            u32x4 vv; vv.x = lo.x; vv.y = lo.y; vv.z = hi.x; vv.w = hi.y;
            O[dt] = MFMA32(__builtin_bit_cast(bf16x8, vv), s ? pb1 : pb0, O[dt]);
        }
}
DI void attn_item(const Params& p, int l, int item, char* smem, bool LAT) {
    const int tid = threadIdx.x, lane = tid & 63, w = tid >> 6, r = lane & 31, h = lane >> 5;
    const int SL = LAT ? DEC_SEQ : SEQ, NQB = SL / 64;
    const int b = item / (N_KV * NQB), kvh = (item / NQB) % N_KV, q0 = (item % NQB) * 64;
    const int tokbase = (LAT ? TC : 0) + b * SL;
    const bf16* Qb = (const bf16*)(p.ws + WS_Q); const bf16* Kb = (const bf16*)(p.ws + WS_KB); const bf16* VTb = (const bf16*)(p.ws + WS_VT);
    const bf16* GAb = (const bf16*)(p.ws + WS_GA); bf16* mixed = (bf16*)(p.ws + WS_XN);
    char* KL = smem + AT_KL; char* VL = smem + AT_VL; char* KC = smem + AT_KC; char* VC = smem + AT_VC;
    const u32x4 zero4 = {0u, 0u, 0u, 0u};
    if (LAT) {
        for (int id = tid; id < AT_NKL * 8; id += NTHR) {
            const int row = id >> 3, c = id & 7, kp = q0 - 128 + row;
            u32x4 v = zero4;
            if (kp >= 0 && kp < SL) v = *(const u32x4*)(Kb + (size_t)(tokbase + kp) * KV_W + kvh * HD + c * 8);
            *(u32x4*)(KL + swz128(row, c)) = v;
        }
        for (int id = tid; id < 64 * (AT_NKL / 8); id += NTHR) {
            const int d = id / (AT_NKL / 8), c = id % (AT_NKL / 8), kp = q0 - 128 + c * 8;
            u32x4 v = zero4;
            if (kp >= 0 && kp < SL) v = *(const u32x4*)(VTb + (size_t)(kvh * HD + d) * T + tokbase + kp);
            char* dst = VL + d * AT_VLS + c * 16;
            u32x2 a; a.x = v.x; a.y = v.y; u32x2 bb; bb.x = v.z; bb.y = v.w;
            *(u32x2*)dst = a; *(u32x2*)(dst + 8) = bb;
        }
    }
    {
        const bf16* ksrc; const bf16* vsrc; size_t kstride, vstride;
        if (LAT) { const size_t o = (size_t)((b * DEPTH + l) * N_KV + kvh) * PAST_LEN * HD; ksrc = (const bf16*)(p.ws + WS_CKB) + o; kstride = HD; vsrc = (const bf16*)(p.ws + WS_CVTB) + o; vstride = PAST_LEN; }
        else { ksrc = Kb + (size_t)tokbase * KV_W + kvh * HD; kstride = KV_W; vsrc = VTb + (size_t)(kvh * HD) * T + tokbase; vstride = T; }
        for (int id = tid; id < 256 * 8; id += NTHR) { const int row = id >> 3, c = id & 7; *(u32x4*)(KC + swz128(row, c)) = *(const u32x4*)(ksrc + (size_t)row * kstride + c * 8); }
        for (int id = tid; id < 64 * 32; id += NTHR) {
            const int d = id >> 5, c = id & 31;
            const u32x4 v = *(const u32x4*)(vsrc + (size_t)d * vstride + c * 8);
            char* dst = VC + d * AT_VCS + c * 16;
            u32x2 a; a.x = v.x; a.y = v.y; u32x2 bb; bb.x = v.z; bb.y = v.w;
            *(u32x2*)dst = a; *(u32x2*)(dst + 8) = bb;
        }
    }
    __syncthreads();
    {
        const int g = w >> 1, qt = w & 1, head = kvh * 4 + g;
        const int qpos = q0 + 32 * qt + r;
        const size_t qtok = (size_t)tokbase + qpos;
        bf16x8 qraw[4], qrot[4];
#pragma unroll
        for (int s = 0; s < 4; ++s) { qraw[s] = *(const bf16x8*)(Qb + qtok * ATTN_W + head * HD + 16 * s + 8 * h); qrot[s] = qraw[s]; }
        if (LAT) {
            const f32x2* rope = (const f32x2*)(p.ws + WS_ROPE);
#pragma unroll
            for (int a = 0; a < 2; ++a)
#pragma unroll
                for (int jj = 0; jj < 8; ++jj) {
                    const f32x2 cs = rope[(qpos * 2 + a) * 16 + 8 * h + jj];
                    const float xa = bf2f((bf16)qraw[2 * a][jj]), xb = bf2f((bf16)qraw[2 * a + 1][jj]);
                    qrot[2 * a][jj] = (short)f2bf(xa * cs.x - xb * cs.y);
                    qrot[2 * a + 1][jj] = (short)f2bf(xb * cs.x + xa * cs.y);
                }
        }
        const float c1 = 0.125f * 1.4426950408889634f;
        float m_run = p.in[I_SINK][l * N_HEADS + head] * 1.4426950408889634f, l_run = h == 0 ? 1.f : 0.f;
        f32x16 O[2];
#pragma unroll
        for (int e = 0; e < 16; ++e) { O[0][e] = 0.f; O[1][e] = 0.f; }
        if (LAT) {
            for (int jt = qt; jt < qt + 9; ++jt) {
                f32x16 S;
#pragma unroll
                for (int e = 0; e < 16; ++e) S[e] = 0.f;
                const int krow = 32 * jt + r;
#pragma unroll
                for (int s = 0; s < 4; ++s) S = MFMA32(*(const bf16x8*)(KL + swz128(krow, 2 * s + h)), qrot[s], S);
#pragma unroll
                for (int e = 0; e < 16; ++e) {
                    const int kp = q0 - 128 + 32 * jt + (e & 3) + 8 * (e >> 2) + 4 * h, dd = kp - qpos;
                    const bool ok = dd <= 128 && dd >= -128 && kp >= 0 && kp < SL;
                    S[e] = ok ? S[e] * c1 : -1e30f;
                }
                softmax_pv(S, O, m_run, l_run, VL + r * AT_VLS + 32 * jt * 2, AT_VLS, h);
            }
        }
        for (int jt = 0; jt < 8; ++jt) {
            f32x16 S;
#pragma unroll
            for (int e = 0; e < 16; ++e) S[e] = 0.f;
            const int krow = 32 * jt + r;
#pragma unroll
            for (int s = 0; s < 4; ++s) S = MFMA32(*(const bf16x8*)(KC + swz128(krow, 2 * s + h)), qraw[s], S);
#pragma unroll
            for (int e = 0; e < 16; ++e) S[e] *= c1;
            softmax_pv(S, O, m_run, l_run, VC + r * AT_VCS + 32 * jt * 2, AT_VCS, h);
        }
        const float inv = 1.f / (l_run + __shfl_xor(l_run, 32));
#pragma unroll
        for (int dt = 0; dt < 2; ++dt)
#pragma unroll
            for (int rg = 0; rg < 4; ++rg) {
                const int d0 = dt * 32 + 8 * rg + 4 * h;
                const u32x2 gv = *(const u32x2*)(GAb + qtok * ATTN_W + head * HD + d0);
                const float g0 = bf2f((bf16)(gv.x & 0xffffu)), g1 = bf2f((bf16)(gv.x >> 16)), g2 = bf2f((bf16)(gv.y & 0xffffu)), g3 = bf2f((bf16)(gv.y >> 16));
                u32x2 o; o.x = pack2(O[dt][4 * rg] * inv * g0, O[dt][4 * rg + 1] * inv * g1); o.y = pack2(O[dt][4 * rg + 2] * inv * g2, O[dt][4 * rg + 3] * inv * g3);
                *(u32x2*)(mixed + qtok * MIX_W + head * HD + d0) = o;
            }
    }
    __syncthreads();
}

DI void phase_p0(const Params& p_, char* smem) {
    constexpr int I_T1 = DEPTH * (D_MODEL / 64) * (IN_COLS / 64), I_T2 = DEPTH * (MIX_W / 64) * (D_MODEL / 64);
    constexpr int I_MOD = DEPTH * ((3 * D_MODEL + 511) / 512), I_ROPE = DEC_SEQ * 32 / NTHR, I_HID = (DEPTH * (SEQ + DEC_SEQ) + 7) / 8;
    constexpr int I_CACHE = (2 * DEC_BATCH * DEPTH * PAST_LEN * KV_W / 8 + NTHR - 1) / NTHR;
    constexpr int TOTAL = I_T1 + I_T2 + I_MOD + I_ROPE + I_HID + I_CACHE;
    for (int it = blockIdx.x; it < TOTAL; it += gridDim.x) {
        const Params p = launder(p_);
        int q = it;
        if (q < I_T1) { constexpr int per = (D_MODEL / 64) * (IN_COLS / 64); const int l = q / per;
            p0_transpose_item(p.in[I_WIN] + (size_t)l * D_MODEL * IN_COLS, D_MODEL, IN_COLS, (bf16*)(p.ws + WS_WINT) + (size_t)l * IN_COLS * D_MODEL, q % per, smem); continue; }
        q -= I_T1;
        if (q < I_T2) { constexpr int per = (MIX_W / 64) * (D_MODEL / 64); const int l = q / per;
            p0_transpose_item(p.in[I_WOUT] + (size_t)l * MIX_W * D_MODEL, MIX_W, D_MODEL, (bf16*)(p.ws + WS_WOUTT) + (size_t)l * D_MODEL * MIX_W, q % per, smem); continue; }
        q -= I_T2;
        if (q < I_MOD) { p0_mod_item(p, q, smem); continue; }
        q -= I_MOD;
        if (q < I_ROPE) { p0_rope_item(p, q); continue; }
        q -= I_ROPE;
        if (q < I_HID) { p0_hid2_item(p, q); continue; }
        q -= I_HID;
        p0_cache_item(p, q);
    }
}
DI void phase_norm(const Params& p, int l) {
    for (int it = blockIdx.x; it < T / 8; it += gridDim.x) norm_item(p, l, it);
}
DI void phase_a(const Params& p_, int l, char* smem, int mask = 3) {
    constexpr int I_FL = 2 * HYENA_W, I_FC = 2 * HYENA_W / 16, NTN = IN_COLS / 128, I_G = (T / 256) * NTN;
    for (int it = blockIdx.x; it < I_FL + I_FC + I_G; it += gridDim.x) {
        const Params p = launder(p_);
        const bf16* A = (const bf16*)(p.ws + WS_XN);
        const bf16* Bt = (const bf16*)(p.ws + WS_WINT) + (size_t)l * IN_COLS * D_MODEL;
        int q = it;
        if (q < I_FL + I_FC) { const bool lat = q < I_FL; if (mask & 1) filter_item(p, l, lat ? q : q - I_FL, smem, lat); continue; }
        if (!(mask & 2)) continue;
        q -= I_FL + I_FC;
        const int m0 = (q / NTN) * 256, n0 = (q % NTN) * 128;
        const InProjEpi epi{p, l, n0};
        const bool swap = (n0 >= C_V && n0 < C_GA) || (n0 >= C_HV && n0 < C_SB);
        if (swap) gemm_tile<true>(A, Bt, D_MODEL, m0, n0, smem, epi); else gemm_tile<false>(A, Bt, D_MODEL, m0, n0, smem, epi);
    }
}
DI void phase_b(const Params& p_, int l, char* smem, int mask = 31) {
    constexpr int I_HL = HYENA_W * (DEC_BATCH / 2), I_AL = DEC_BATCH * N_KV * (DEC_SEQ / 64), I_AC = BATCH * N_KV * (SEQ / 64);
    constexpr int I_HC = HYENA_W * ((BATCH / 2 + 15) / 16), I_SC = T / 64;
    for (int it = blockIdx.x; it < I_HL + I_AL + I_AC + I_HC + I_SC; it += gridDim.x) {
        const Params p = launder(p_);
        int q = it;
        if (q < I_HL + I_HC) { const bool lat = q < I_HL; if (mask & (lat ? 1 : 2)) hyena_item(p, l, lat ? q : q - I_HL, smem, lat); continue; }
        q -= I_HL + I_HC;
        if (q < I_AL + I_AC) { const bool lat = q < I_AL; if (mask & (lat ? 4 : 8)) attn_item(p, l, lat ? q : q - I_AL, smem, lat); continue; }
        q -= I_AL + I_AC;
        if (mask & 16) shortconv_item(p, l, q);
    }
}
DI void phase_c(const Params& p, int l, char* smem) {
    constexpr int NTN = D_MODEL / 128, I_G = (T / 256) * NTN;
    const bf16* A = (const bf16*)(p.ws + WS_XN);
    const bf16* Bt = (const bf16*)(p.ws + WS_WOUTT) + (size_t)l * D_MODEL * MIX_W;
    const OutProjEpi epi{p, l};
    for (int it = blockIdx.x; it < I_G; it += gridDim.x) gemm_tile<false>(A, Bt, MIX_W, (it / NTN) * 256, (it % NTN) * 128, smem, epi);
}

#ifndef PH_STOP
#define PH_STOP 1000
#endif
#ifndef DUP
#define DUP 0
#endif
#ifndef DMASK
#define DMASK 31
#endif
__global__ void __launch_bounds__(NTHR) fwd_kernel(Params p) {
#ifdef EMU
    char* smem = emu_smem();
#else
    extern __shared__ __attribute__((aligned(16))) char smem[];
    volatile LAS unsigned* xst = (volatile LAS unsigned*)(smem + LDS_BYTES - 16);
    if (threadIdx.x == 0) { xst[0] = 0u; xst[1] = 0u; }
    __syncthreads();
    const XcdBarrier xbar = xcd_barrier_post((unsigned*)(p.ws + WS_BAR), xst);
#endif
    int ph = 0;
#pragma unroll 1
    for (int rep = 0; rep < (DUP == 1 ? 2 : 1); ++rep) phase_p0(p, smem);
    GRID_SYNC(); if (++ph >= PH_STOP) return;
#pragma unroll 1
    for (int rep = 0; rep < (DUP == 2 ? 2 : 1); ++rep) phase_norm(p, 0);
    GRID_SYNC(); if (++ph >= PH_STOP) return;
    for (int l = 0; l < DEPTH; ++l) {
#pragma unroll 1
        for (int rep = 0; rep < ((DUP == 3 && l == 0) ? 2 : 1); ++rep) phase_a(p, l, smem, rep ? DMASK : 3);
        GRID_SYNC(); if (++ph >= PH_STOP) return;
#pragma unroll 1
        for (int rep = 0; rep < ((DUP == 4 && l == 0) ? 2 : 1); ++rep) phase_b(p, l, smem, rep ? DMASK : 31);
        GRID_SYNC(); if (++ph >= PH_STOP) return;
#pragma unroll 1
        for (int rep = 0; rep < ((DUP == 5 && l == 0) ? 2 : 1); ++rep) phase_c(p, l, smem);
        if (DUP == 6 && l == 0) { GRID_SYNC(); GRID_SYNC(); GRID_SYNC(); GRID_SYNC(); GRID_SYNC(); GRID_SYNC(); GRID_SYNC(); GRID_SYNC(); GRID_SYNC(); GRID_SYNC(); }
        GRID_SYNC(); if (++ph >= PH_STOP) return;
        phase_norm(p, l + 1);
        if (l + 1 < DEPTH) { GRID_SYNC(); if (++ph >= PH_STOP) return; }
    }
}

#ifndef EMU
extern "C" void kernel_launch(void* const* d_in, const int* in_sizes, int n_in, void* d_out, int out_size, void* d_ws, size_t ws_size, hipStream_t stream) {
    static int grid = 0;
    if (grid == 0) {
        if (n_in != 22 || (size_t)out_size != OUT_TOTAL || ws_size < WS_END) { fprintf(stderr, "kernel_launch: unexpected sizes n_in %d out %d ws %zu (need %zu)\n", n_in, out_size, ws_size, (size_t)WS_END); grid = -1; return; }
        int dev = 0, cus = 0, per_cu = 0;
        hipGetDevice(&dev); hipDeviceGetAttribute(&cus, hipDeviceAttributeMultiprocessorCount, dev);
        if (hipFuncSetAttribute((const void*)fwd_kernel, hipFuncAttributeMaxDynamicSharedMemorySize, LDS_BYTES) != hipSuccess) { fprintf(stderr, "hipFuncSetAttribute failed\n"); grid = -1; return; }
        hipOccupancyMaxActiveBlocksPerMultiprocessor(&per_cu, (const void*)fwd_kernel, NTHR, LDS_BYTES);
        if (per_cu < 1) { fprintf(stderr, "occupancy query says %d\n", per_cu); grid = -1; return; }
        grid = cus;
    }
    if (grid < 0) return;
    Params p{};
    for (int i = 0; i < 22; ++i) p.in[i] = (const float*)d_in[i];
    p.out = (float*)d_out; p.ws = (unsigned char*)d_ws;
    if (hipMemsetAsync((char*)d_ws + WS_BAR, 0, XCD_BAR_WORDS * 4, stream) != hipSuccess) { fprintf(stderr, "memset failed\n"); return; }
    hipLaunchKernelGGL(fwd_kernel, dim3(grid), dim3(NTHR), LDS_BYTES, stream, p);
    const hipError_t e = hipPeekAtLastError();
    if (e != hipSuccess) fprintf(stderr, "launch failed: %s (grid %d)\n", hipGetErrorString(e), grid);
}
#endif
```

```cpp
#ifdef EMU
#include "emu.h"
#define GRID_SYNC() emu_grid_sync()
#define MFMA32(a, b, c) emu_mfma32((a), (b), (c))
#define MFMA16(a, b, c) emu_mfma16((a), (b), (c))
#define LAS
#define GLDS16(g, l) emu_glds16((const void*)(g), (void*)(l))
#define S_BARRIER() __syncthreads()
#define WAIT_V(n)
#define WAIT_L(n)
#define SCHED_BAR()
#define SETPRIO(x)
#define RFL(x) (x)
#define CBAR()
#define OPQ(x) (x)
#define TIDX() ((int)threadIdx.x)
#define BIDX() ((int)blockIdx.x)
#else
#include <hip/hip_runtime.h>
#include <cstdio>
#include <cstdint>
typedef short bf16x8 __attribute__((ext_vector_type(8)));
typedef float f32x16 __attribute__((ext_vector_type(16)));
typedef float f32x4 __attribute__((ext_vector_type(4)));
#define GRID_SYNC() xcd_barrier(xbar)
#define MFMA32(a, b, c) __builtin_amdgcn_mfma_f32_32x32x16_bf16((a), (b), (c), 0, 0, 0)
#define MFMA16(a, b, c) __builtin_amdgcn_mfma_f32_16x16x32_bf16((a), (b), (c), 0, 0, 0)
#define LAS __attribute__((address_space(3)))
#define GLDS16(g, l) __builtin_amdgcn_global_load_lds((const unsigned*)(g), (LAS unsigned*)(l), 16, 0, 0)
#define S_BARRIER() __builtin_amdgcn_s_barrier()
#define WAIT_V(n) asm volatile("s_waitcnt vmcnt(" #n ")" ::: "memory")
#define WAIT_L(n) asm volatile("s_waitcnt lgkmcnt(" #n ")" ::: "memory")
#define SCHED_BAR() __builtin_amdgcn_sched_barrier(0)
#define SETPRIO(x) __builtin_amdgcn_s_setprio(x)
#define RFL(x) __builtin_amdgcn_readfirstlane(x)
#define CBAR() asm volatile("" ::: "memory")
__device__ __forceinline__ int opq_(int x) { asm volatile("" : "+v"(x)); return x; }
#define OPQ(x) opq_(x)
__device__ __forceinline__ int tidx_() { int t = threadIdx.x; asm volatile("" : "+v"(t)); return t; }
__device__ __forceinline__ int bidx_() { int t = blockIdx.x; asm volatile("" : "+s"(t)); return t; }
#define TIDX() tidx_()
#define BIDX() bidx_()
#endif
typedef unsigned u32x4 __attribute__((ext_vector_type(4)));
typedef unsigned u32x2 __attribute__((ext_vector_type(2)));
typedef float f32x2 __attribute__((ext_vector_type(2)));
typedef unsigned short bf16;
#define DI __device__ __forceinline__

#ifdef CFG_SMALL
constexpr int D_MODEL = 256, BATCH = 2, SEQ = 256, DEPTH = 2, DEC_BATCH = 2, DEC_SEQ = 4096, PAST_LEN = 256, HYENA_W = 128, CONV_W = 128;
#else
constexpr int D_MODEL = 1024, BATCH = 32, SEQ = 256, DEPTH = 4, DEC_BATCH = 8, DEC_SEQ = 4096, PAST_LEN = 256, HYENA_W = 256, CONV_W = 256;
#endif
constexpr int GRID_W = 64, N_HEADS = 8, N_KV = 2, HD = 64, ATTN_W = 512, KV_W = 128;
constexpr int MIX_W = ATTN_W + HYENA_W + CONV_W;
constexpr int C_Q = 0, C_K = ATTN_W, C_V = C_K + KV_W, C_GA = C_V + KV_W, C_HV = C_GA + ATTN_W, C_GH = C_HV + 3 * HYENA_W,
              C_SB = C_GH + HYENA_W, C_GC = C_SB + 3 * CONV_W, IN_COLS = C_GC + CONV_W;
constexpr int TC = BATCH * SEQ, TL = DEC_BATCH * DEC_SEQ, T = TC + TL;
constexpr int NR = 1 + DEC_BATCH;
constexpr int FH = 64, FE = 33;
constexpr int NTHR = 512;
static_assert(T % 256 == 0 && TC % 256 == 0 && C_HV % 256 == 0 && C_SB % 256 == 0 && IN_COLS % 256 == 0 && D_MODEL % 256 == 0 && MIX_W % 128 == 0 && (4 * HYENA_W) % 256 == 0, "tiling");
static_assert(SEQ == 256 && DEC_SEQ == 4096 && PAST_LEN == 256, "fft sizes");

constexpr size_t al256(size_t x) { return (x + 255) & ~(size_t)255; }
constexpr size_t WS_BAR = 0;
constexpr size_t WS_WINT = 65536;
constexpr size_t WS_WOUTT = WS_WINT + al256((size_t)DEPTH * IN_COLS * D_MODEL * 2);
constexpr size_t WS_MOD = WS_WOUTT + al256((size_t)DEPTH * D_MODEL * MIX_W * 2);
constexpr size_t WS_ROPE = WS_MOD + al256((size_t)DEPTH * NR * 3 * D_MODEL * 4);
constexpr size_t WS_HID2 = WS_ROPE + al256((size_t)DEC_SEQ * 32 * 8);
constexpr size_t WS_CKB = WS_HID2 + al256((size_t)DEPTH * (SEQ + DEC_SEQ) * FH * 4);
constexpr size_t WS_CVTB = WS_CKB + al256((size_t)DEC_BATCH * DEPTH * PAST_LEN * KV_W * 2);
constexpr size_t WS_KFL = WS_CVTB + al256((size_t)DEC_BATCH * DEPTH * PAST_LEN * KV_W * 2);
constexpr size_t KFL_BYTES = al256((size_t)2 * HYENA_W * 8192 * 8), KFC_BYTES = al256((size_t)2 * HYENA_W * 512 * 8);
constexpr size_t WS_KFC = WS_KFL + 2 * KFL_BYTES;
constexpr size_t WS_XN = WS_KFC + 2 * KFC_BYTES;
constexpr size_t WS_Q = WS_XN + al256((size_t)T * (D_MODEL > MIX_W ? D_MODEL : MIX_W) * 2);
constexpr size_t WS_KB = WS_Q + al256((size_t)T * ATTN_W * 2);
constexpr size_t WS_VB = WS_KB + al256((size_t)T * KV_W * 2);
constexpr size_t WS_GA = WS_VB + al256((size_t)T * KV_W * 2);
constexpr size_t WS_HYT = WS_GA + al256((size_t)T * ATTN_W * 2);
constexpr size_t WS_SC = WS_HYT + al256((size_t)4 * HYENA_W * T * 2);
constexpr size_t WS_END = WS_SC + al256((size_t)T * 4 * CONV_W * 2);

constexpr size_t OUT_YS = (size_t)TC * D_MODEL, OUT_NK = (size_t)T * D_MODEL, OUT_NV = OUT_NK + (size_t)BATCH * DEPTH * SEQ * KV_W,
                 OUT_TOTAL = OUT_NV + (size_t)BATCH * DEPTH * SEQ * KV_W;

constexpr int LDS_BYTES = 149504;

struct Params {
    const float* in[22];
    float* out;
    unsigned char* ws;
};
enum { I_XP = 0, I_XS, I_CK, I_CV, I_C, I_CCTX, I_NORMG, I_MODW, I_MODB, I_WIN, I_SINK, I_HYCW, I_FW1, I_FB1, I_FW2, I_FB2, I_FW3, I_FFREQ, I_HYD, I_SCW, I_WOUT, I_FINALG };

DI bf16 f2bf(float f) { unsigned u = __float_as_uint(f); u += 0x7fffu + ((u >> 16) & 1u); return (bf16)(u >> 16); }
DI float bf2f(bf16 h) { return __uint_as_float(((unsigned)h) << 16); }
DI unsigned pack2(float a, float b) { return (unsigned)f2bf(a) | ((unsigned)f2bf(b) << 16); }
DI float silu_f(float x) { return x / (1.f + __expf(-x)); }
struct cpx { float x, y; };
DI cpx cmul(cpx a, cpx b) { return cpx{a.x * b.x - a.y * b.y, a.x * b.y + a.y * b.x}; }
DI cpx cadd(cpx a, cpx b) { return cpx{a.x + b.x, a.y + b.y}; }
DI cpx csub(cpx a, cpx b) { return cpx{a.x - b.x, a.y - b.y}; }
#ifdef EMU
DI Params launder(const Params& p) { return p; }
#else
DI Params launder(const Params& p) { Params q = p; asm volatile("" : "+s"(q.ws), "+s"(q.out)); return q; }
#endif
DI int mod_row(int m) { return m < TC ? 0 : 1 + (m - TC) / DEC_SEQ; }


#ifndef EMU
#define XB_TMO      128
#define XB_XCNT(j)  (256  + 64 * (j))
#define XB_XSUB(j)  (1280 + 64 * (j))
#define XB_XGEN(j)  (2304 + 64 * (j))
#define XB_TOP      3328
#define XB_TOPGEN   3392
#define XCD_BAR_WORDS 3456
#define XB_SPIN_CAP (1u << 22)
DI unsigned xb_ld(unsigned* p) { return __hip_atomic_load(p, __ATOMIC_RELAXED, __HIP_MEMORY_SCOPE_AGENT); }
DI unsigned xb_add(unsigned* p, unsigned v) { return __hip_atomic_fetch_add(p, v, __ATOMIC_RELAXED, __HIP_MEMORY_SCOPE_AGENT); }
DI unsigned xb_xcc_id() { return (unsigned)__builtin_amdgcn_s_getreg((3 << 11) | 20) & 0xFu; }
#define XB_SPIN(cond, bar) do { unsigned _sp = 0; while (cond) { __builtin_amdgcn_s_sleep(1); \
    if ((++_sp & 255u) == 0u) { if (xb_ld(&(bar)[XB_TMO])) break; if (_sp > XB_SPIN_CAP) { atomicAdd(&(bar)[XB_TMO], 1u); break; } } } } while (0)
struct XcdBarrier { unsigned* bar; unsigned x; volatile LAS unsigned* st; };
DI XcdBarrier xcd_barrier_post(unsigned* bar, volatile LAS unsigned* st) {
    XcdBarrier b; b.bar = bar; b.x = xb_xcc_id(); b.st = st;
    if (TIDX() == 0) (void)xb_add(&bar[XB_XCNT(b.x)], 1u);
    return b;
}
DI void xcd_barrier_complete(unsigned* bar, unsigned x, unsigned& nloc, unsigned& nx) {
    const unsigned G = gridDim.x * gridDim.y * gridDim.z;
    unsigned sum, cnt, mine, sp = 0u;
    for (;;) {
        sum = 0u; cnt = 0u; mine = 0u;
#pragma unroll
        for (unsigned j = 0; j < 16; ++j) { const unsigned c = xb_ld(&bar[XB_XCNT(j)]); sum += c; cnt += (c > 0u) ? 1u : 0u; mine = (j == x) ? c : mine; }
        if (sum == G) break;
        __builtin_amdgcn_s_sleep(1);
        if ((++sp & 255u) == 0u) { if (xb_ld(&bar[XB_TMO])) break; if (sp > XB_SPIN_CAP) { atomicAdd(&bar[XB_TMO], 1u); break; } }
    }
    nloc = mine > 0u ? mine : 1u; nx = cnt > 0u ? cnt : 1u;
}
DI void xcd_barrier(const XcdBarrier& b) {
    asm volatile("s_waitcnt vmcnt(0)" ::: "memory");
    __syncthreads();
    if (TIDX() == 0) {
        unsigned* bar = b.bar;
        __builtin_amdgcn_s_waitcnt(0);
        unsigned nloc = b.st[0], nx = b.st[1];
        if (nloc == 0u) { xcd_barrier_complete(bar, b.x, nloc, nx); b.st[0] = nloc; b.st[1] = nx; }
        const unsigned old = xb_add(&bar[XB_XSUB(b.x)], 1u);
        const unsigned gen = old / nloc;
        if (old + 1u == (gen + 1u) * nloc) {
            __builtin_amdgcn_fence(__ATOMIC_RELEASE, "agent");
            asm volatile("s_waitcnt vmcnt(0)" ::: "memory");
            const unsigned og = xb_add(&bar[XB_TOP], 1u);
            const unsigned tg = og / nx;
            if (og + 1u == (tg + 1u) * nx) xb_add(&bar[XB_TOPGEN], 1u);
            else XB_SPIN(xb_ld(&bar[XB_TOPGEN]) == tg, bar);
            __builtin_amdgcn_fence(__ATOMIC_ACQUIRE, "agent");
            xb_add(&bar[XB_XGEN(b.x)], 1u);
            asm volatile("s_waitcnt vmcnt(0)" ::: "memory");
        } else {
            XB_SPIN(xb_ld(&bar[XB_XGEN(b.x)]) == gen, bar);
            __builtin_amdgcn_fence(__ATOMIC_ACQUIRE, "agent");
            asm volatile("s_waitcnt vmcnt(0)" ::: "memory");
        }
    }
    __syncthreads();
}
#endif

DI void p0_transpose_item(const float* W, int K, int N, bf16* WT, int item, char* smem) {
    float* scr = (float*)smem;
    const int tid = TIDX(), nblk = N / 64, k0 = (item / nblk) * 64, n0 = (item % nblk) * 64;
#pragma unroll
    for (int i = 0; i < 8; ++i) { const int kk = (tid >> 6) + 8 * i, nn = tid & 63; scr[kk * 65 + nn] = W[(size_t)(k0 + kk) * N + n0 + nn]; }
    __syncthreads();
    const int n = tid >> 3, c = tid & 7;
    const float* s = scr + (8 * c) * 65 + n;
    u32x4 o; o.x = pack2(s[0], s[65]); o.y = pack2(s[2 * 65], s[3 * 65]); o.z = pack2(s[4 * 65], s[5 * 65]); o.w = pack2(s[6 * 65], s[7 * 65]);
    *(u32x4*)(WT + (size_t)(n0 + n) * K + k0 + 8 * c) = o;
    __syncthreads();
}
DI void p0_mod_item(const Params& p, int item, char* smem) {
    constexpr int NCH = (3 * D_MODEL + 511) / 512;
    float* tab = (float*)smem;
    const int tid = TIDX(), l = item / NCH, col = (item % NCH) * 512 + tid;
    for (int e = tid; e < NR * D_MODEL; e += NTHR) { const int r = e / D_MODEL, k = e % D_MODEL; const float cv = r == 0 ? p.in[I_CCTX][k] : p.in[I_C][(size_t)(r - 1) * D_MODEL + k]; tab[e] = silu_f(cv); }
    __syncthreads();
    if (col < 3 * D_MODEL) {
        float acc[NR];
#pragma unroll
        for (int r = 0; r < NR; ++r) acc[r] = 0.f;
        const float* w = p.in[I_MODW] + (size_t)l * D_MODEL * 3 * D_MODEL + col;
        for (int k = 0; k < D_MODEL; ++k) { const float wv = w[(size_t)k * 3 * D_MODEL];
#pragma unroll
            for (int r = 0; r < NR; ++r) acc[r] += tab[r * D_MODEL + k] * wv; }
        const float bv = p.in[I_MODB][(size_t)l * 3 * D_MODEL + col];
        float* mod = (float*)(p.ws + WS_MOD);
#pragma unroll
        for (int r = 0; r < NR; ++r) mod[((size_t)l * NR + r) * 3 * D_MODEL + col] = acc[r] + bv;
    }
    __syncthreads();
}
DI void p0_rope_item(const Params& p, int item) {
    const int e = item * NTHR + TIDX();
    if (e < DEC_SEQ * 32) {
        const int t = e >> 5, a = (e >> 4) & 1, f = e & 15;
        const float pos = (float)(a ? (t % GRID_W) : (t / GRID_W));
        const float inv = exp2f(-(float)f * (13.287712379549449f / 16.f));
        const float ang = pos * inv;
        f32x2 v; v.x = cosf(ang); v.y = sinf(ang);
        ((f32x2*)(p.ws + WS_ROPE))[e] = v;
    }
}
DI void p0_hid2_item(const Params& p, int item) {
    const int lane = TIDX() & 63, w = TIDX() >> 6;
    const int rr = item * 8 + w;
    if (rr >= DEPTH * (SEQ + DEC_SEQ)) return;
    const int l = rr / (SEQ + DEC_SEQ), q = rr % (SEQ + DEC_SEQ);
    const int L = q < SEQ ? SEQ : DEC_SEQ, t = q < SEQ ? q : q - SEQ;
    float feat = 0.f;
    if (lane == 0) feat = (float)t / (float)(L - 1);
    else if (lane < FE) {
        const int b = (lane - 1) & 15;
        const float fr = 1e-4f + (float)b * ((15.f - 1e-4f) / 15.f);
        const float ang = (6.283185307179586f / (float)L) * (float)t;
        feat = lane <= 16 ? cosf(fr * ang) : -sinf(fr * ang);
    }
    const float* w1 = p.in[I_FW1] + (size_t)l * FE * FH; const float* w2 = p.in[I_FW2] + (size_t)l * FH * FH;
    const float fq = p.in[I_FFREQ][l * FH + lane];
    float a1 = p.in[I_FB1][l * FH + lane];
    for (int i = 0; i < FE; ++i) a1 += __shfl(feat, i) * w1[i * FH + lane];
    const float h1 = sinf(fq * a1);
    float a2 = p.in[I_FB2][l * FH + lane];
    for (int i = 0; i < FH; ++i) a2 += __shfl(h1, i) * w2[i * FH + lane];
    const float h2 = sinf(fq * a2);
    ((float*)(p.ws + WS_HID2))[(size_t)l * (SEQ + DEC_SEQ) * FH + (q < SEQ ? 0 : (size_t)SEQ * FH) + (size_t)lane * L + t] = h2;
}
DI void p0_cache_item(const Params& p, int item) {
    constexpr int NCHUNK = DEC_BATCH * DEPTH * PAST_LEN * KV_W / 8;
    int e = item * NTHR + TIDX();
    if (e < 2 * NCHUNK) {
        const bool isv = e >= NCHUNK; if (isv) e -= NCHUNK;
        const int c8 = e & 7, j = (e >> 3) % PAST_LEN, kvh = (e >> 3) / PAST_LEN % N_KV, bl = (e >> 3) / PAST_LEN / N_KV;
        const float* src = p.in[isv ? I_CV : I_CK] + ((size_t)(bl * PAST_LEN + j) * N_KV + kvh) * HD + c8 * 8;
        u32x4 o; o.x = pack2(src[0], src[1]); o.y = pack2(src[2], src[3]); o.z = pack2(src[4], src[5]); o.w = pack2(src[6], src[7]);
        *(u32x4*)((bf16*)(p.ws + (isv ? WS_CVTB : WS_CKB)) + (size_t)e * 8) = o;
    }
}

DI const float* x_row_src(const Params& p, int l, int m) {
    if (l == 0) return m < TC ? p.in[I_XP] + (size_t)m * D_MODEL : p.in[I_XS] + (size_t)(m - TC) * D_MODEL;
    return p.out + (size_t)m * D_MODEL;
}
DI void norm_item(const Params& p, int l, int item) {
    const int lane = TIDX() & 63, w = TIDX() >> 6, m = item * 8 + w;
    if (m >= T) return;
    const float* xr = x_row_src(p, l, m);
    float ss = 0.f;
    for (int c4 = lane; c4 < D_MODEL / 4; c4 += 64) { const f32x4 v = *(const f32x4*)(xr + 4 * c4); ss += v.x * v.x + v.y * v.y + v.z * v.z + v.w * v.w; }
#pragma unroll
    for (int o = 1; o < 64; o <<= 1) ss += __shfl_xor(ss, o);
    const float rstd = rsqrtf(ss * (1.f / D_MODEL) + 1e-6f);
    if (l < DEPTH) {
        const float* g = p.in[I_NORMG] + (size_t)l * D_MODEL;
        const float* mod = (const float*)(p.ws + WS_MOD) + ((size_t)l * NR + mod_row(m)) * 3 * D_MODEL;
        bf16* xn = (bf16*)(p.ws + WS_XN) + (size_t)m * D_MODEL;
        for (int c4 = lane; c4 < D_MODEL / 4; c4 += 64) {
            const f32x4 v = *(const f32x4*)(xr + 4 * c4), gv = *(const f32x4*)(g + 4 * c4), sh = *(const f32x4*)(mod + 4 * c4), sc = *(const f32x4*)(mod + D_MODEL + 4 * c4);
            u32x2 o; o.x = pack2(v.x * rstd * gv.x * (1.f + sc.x) + sh.x, v.y * rstd * gv.y * (1.f + sc.y) + sh.y);
            o.y = pack2(v.z * rstd * gv.z * (1.f + sc.z) + sh.z, v.w * rstd * gv.w * (1.f + sc.w) + sh.w);
            *(u32x2*)(xn + 4 * c4) = o;
        }
    } else {
        const float* g = p.in[I_FINALG];
        float* yo = p.out + (size_t)m * D_MODEL;
        for (int c4 = lane; c4 < D_MODEL / 4; c4 += 64) {
            const f32x4 v = *(const f32x4*)(xr + 4 * c4), gv = *(const f32x4*)(g + 4 * c4);
            f32x4 o; o.x = v.x * rstd * gv.x; o.y = v.y * rstd * gv.y; o.z = v.z * rstd * gv.z; o.w = v.w * rstd * gv.w;
            *(f32x4*)(yo + 4 * c4) = o;
        }
    }
}

DI int swz128(int row, int c) { return row * 128 + ((c ^ ((row >> 1) & 7)) << 4); }
constexpr int BM = 256, BK = 64, HALFT = 128, HTB = HALFT * BK * 2, STAGE_BYTES = 8 * HTB;
static_assert(STAGE_BYTES <= LDS_BYTES - 16, "lds");
DI int lds_byte(int r, int c) { const int st = (r >> 4) * 2 + (c >> 5), rr = r & 15, cc = c & 31, ob = rr * 64 + cc * 2; return st * 1024 + (ob ^ (((ob >> 9) & 1) << 5)); }
DI void stage_rc(int b, int& R, int& C) { const int st = b / 1024, sb = b % 1024, swz = sb ^ (((sb >> 9) & 1) << 5); R = (st >> 1) * 16 + swz / 64; C = (st & 1) * 32 + (swz % 64) / 2; }
DI int perm32(int rho) { const int n = rho >> 4, i = rho & 15; return 8 * (i >> 2) + 4 * n + (i & 3); }
struct Unit { int pm, pn, kind; };
DI void static_order(int L, int nM, int nN, int& pm, int& pn) {
    constexpr int NXCD = 8, WGM = 8;
    const int nwg = nM * nN;
    int wgid = L; { const int q = nwg / NXCD, r = nwg % NXCD, xcd = wgid % NXCD, off = wgid / NXCD; wgid = (xcd < r ? xcd * (q + 1) : r * (q + 1) + (xcd - r) * q) + off; }
    const int nig = WGM * nN, gid = wgid / nig, fm = gid * WGM, gsz = (nM - fm) < WGM ? (nM - fm) : WGM;
    pm = fm + ((wgid % nig) % gsz); pn = (wgid % nig) / gsz;
}
constexpr int NT_TOK = (IN_COLS - 4 * HYENA_W) / 256, NT_TOKA = C_HV / 256, NT_CH = 4 * HYENA_W / 256, NTM = T / 256;
constexpr int NU_TOK = NTM * NT_TOK, NU_CH = NT_CH * NTM, NU_OUT = NTM * (D_MODEL / 256);
struct GemmJob {
    Params p; int mode, l, K;
    DI bool next(int i, Unit& u) const {
        const int L = i * (int)gridDim.x + BIDX();
        if (mode == 0) {
            if (L < NU_TOK) { u.kind = 0; static_order(L, NTM, NT_TOK, u.pm, u.pn); return true; }
            if (L < NU_TOK + NU_CH) { u.kind = 1; static_order(L - NU_TOK, NT_CH, NTM, u.pm, u.pn); return true; }
            return false;
        }
        if (L < NU_OUT) { u.kind = 2; static_order(L, NTM, D_MODEL / 256, u.pm, u.pn); return true; }
        return false;
    }
    DI int tokcol(int pn) const { return pn < NT_TOKA ? pn * 256 : C_SB + (pn - NT_TOKA) * 256; }
    DI void ptrs(const Unit& u, const char*& a, const char*& b) const {
        const size_t rb = (size_t)K * 2;
        const char* xn = (const char*)(p.ws + WS_XN);
        if (u.kind == 0) { a = xn + (size_t)u.pm * 256 * rb; b = (const char*)(p.ws + WS_WINT) + ((size_t)l * IN_COLS + tokcol(u.pn)) * rb; }
        else if (u.kind == 1) { a = (const char*)(p.ws + WS_WINT) + ((size_t)l * IN_COLS + C_HV + u.pm * 256) * rb; b = xn + (size_t)u.pn * 256 * rb; }
        else { a = xn + (size_t)u.pm * 256 * rb; b = (const char*)(p.ws + WS_WOUTT) + ((size_t)l * D_MODEL + u.pn * 256) * rb; }
    }
    DI void epilogue(const f32x4 (&acc)[2][2][4][2], const Unit& u, int wr, int wc, int fr, int fq) const {
        if (u.kind == 0) {
            const bool ctx = u.pm * 256 < TC;
#pragma unroll 1
            for (int bj = 0; bj < 2; ++bj) {
                const int n0 = tokcol(u.pn) + 128 * bj, c0 = n0 + 32 * wc + 8 * fq;
                bf16* dst; int ld; bool sil = false; int special = 0;
                if (n0 < C_K) { dst = (bf16*)(p.ws + WS_Q) + c0; ld = ATTN_W; }
                else if (n0 < C_V) { dst = (bf16*)(p.ws + WS_KB) + (c0 - C_K); ld = KV_W; special = 1; }
                else if (n0 < C_GA) { dst = (bf16*)(p.ws + WS_VB) + (c0 - C_V); ld = KV_W; special = 2; }
                else if (n0 < C_HV) { dst = (bf16*)(p.ws + WS_GA) + (c0 - C_GA); ld = ATTN_W; sil = true; }
                else { dst = (bf16*)(p.ws + WS_SC) + (c0 - C_SB); ld = 4 * CONV_W; sil = n0 >= C_GC; }
#pragma unroll
                for (int ai = 0; ai < 2; ++ai)
#pragma unroll
                    for (int m = 0; m < 4; ++m) {
                        const int row = u.pm * 256 + 64 * wr + fr + OPQ(128 * ai + 16 * m);
                        f32x4 v0 = bj ? acc[ai][1][m][0] : acc[ai][0][m][0], v1 = bj ? acc[ai][1][m][1] : acc[ai][0][m][1];
                        if (sil) { v0.x = silu_f(v0.x); v0.y = silu_f(v0.y); v0.z = silu_f(v0.z); v0.w = silu_f(v0.w); v1.x = silu_f(v1.x); v1.y = silu_f(v1.y); v1.z = silu_f(v1.z); v1.w = silu_f(v1.w); }
                        if (special && ctx) {
                            float* o = p.out + (special == 1 ? OUT_NK : OUT_NV) + ((size_t)((row / SEQ) * DEPTH + l) * SEQ + (row % SEQ)) * KV_W + (c0 - (special == 1 ? C_K : C_V));
                            *(f32x4*)o = v0; *(f32x4*)(o + 4) = v1;
                        }
                        if (special == 1 && !ctx) {
                            const int pos = (row - TC) % DEC_SEQ, a = wc & 1, pp = fq >> 1, f0 = 8 * (fq & 1);
                            const f32x4* rp = (const f32x4*)((const f32x2*)(p.ws + WS_ROPE) + (pos * 2 + a) * 16 + f0);
                            const f32x4 r0 = rp[0], r1 = rp[1], r2 = rp[2], r3 = rp[3];
                            f32x4 o0, o1;
                            o0.x = __shfl_xor(v0.x, 32); o0.y = __shfl_xor(v0.y, 32); o0.z = __shfl_xor(v0.z, 32); o0.w = __shfl_xor(v0.w, 32);
                            o1.x = __shfl_xor(v1.x, 32); o1.y = __shfl_xor(v1.y, 32); o1.z = __shfl_xor(v1.z, 32); o1.w = __shfl_xor(v1.w, 32);
                            const float sg = pp ? 1.f : -1.f;
                            v0.x = v0.x * r0.x + sg * o0.x * r0.y; v0.y = v0.y * r0.z + sg * o0.y * r0.w; v0.z = v0.z * r1.x + sg * o0.z * r1.y; v0.w = v0.w * r1.z + sg * o0.w * r1.w;
                            v1.x = v1.x * r2.x + sg * o1.x * r2.y; v1.y = v1.y * r2.z + sg * o1.y * r2.w; v1.z = v1.z * r3.x + sg * o1.z * r3.y; v1.w = v1.w * r3.z + sg * o1.w * r3.w;
                        }
                        u32x4 w; w.x = pack2(v0.x, v0.y); w.y = pack2(v0.z, v0.w); w.z = pack2(v1.x, v1.y); w.w = pack2(v1.z, v1.w);
                        *(u32x4*)(dst + (size_t)row * ld) = w;
                        CBAR();
                    }
            }
        } else if (u.kind == 1) {
            bf16* HYT = (bf16*)(p.ws + WS_HYT);
#pragma unroll
            for (int ai = 0; ai < 2; ++ai) {
                const bool sil = u.pm * 256 + 128 * ai >= 3 * HYENA_W;
#pragma unroll
                for (int m = 0; m < 4; ++m) {
                    const int ch = u.pm * 256 + 64 * wr + fr + OPQ(128 * ai + 16 * m);
#pragma unroll
                    for (int bj = 0; bj < 2; ++bj) {
                        f32x4 v0 = acc[ai][bj][m][0], v1 = acc[ai][bj][m][1];
                        if (sil) { v0.x = silu_f(v0.x); v0.y = silu_f(v0.y); v0.z = silu_f(v0.z); v0.w = silu_f(v0.w); v1.x = silu_f(v1.x); v1.y = silu_f(v1.y); v1.z = silu_f(v1.z); v1.w = silu_f(v1.w); }
                        u32x4 w; w.x = pack2(v0.x, v0.y); w.y = pack2(v0.z, v0.w); w.z = pack2(v1.x, v1.y); w.w = pack2(v1.z, v1.w);
                        *(u32x4*)(HYT + (size_t)ch * T + u.pn * 256 + 128 * bj + 32 * wc + 8 * fq) = w;
                        CBAR();
                    }
                }
            }
        } else {
            const float* gate = (const float*)(p.ws + WS_MOD) + ((size_t)l * NR + mod_row(u.pm * 256)) * 3 * D_MODEL + 2 * D_MODEL;
#pragma unroll
            for (int bj = 0; bj < 2; ++bj) {
                const int n = u.pn * 256 + 128 * bj + 32 * wc + 8 * fq;
                const f32x4 g0 = *(const f32x4*)(gate + n), g1 = *(const f32x4*)(gate + n + 4);
#pragma unroll
                for (int ai = 0; ai < 2; ++ai)
#pragma unroll
                    for (int m = 0; m < 4; ++m) {
                        const int row = u.pm * 256 + 64 * wr + fr + OPQ(128 * ai + 16 * m);
                        const float* xs = x_row_src(p, l, row) + n;
                        const f32x4 x0 = *(const f32x4*)xs, x1 = *(const f32x4*)(xs + 4);
                        float* o = p.out + (size_t)row * D_MODEL + n;
                        *(f32x4*)o = x0 + g0 * acc[ai][bj][m][0]; *(f32x4*)(o + 4) = x1 + g1 * acc[ai][bj][m][1];
                        CBAR();
                    }
            }
        }
    }
};

#ifdef EMU
typedef unsigned char* ldsptr_t;
#else
typedef LAS unsigned char* ldsptr_t;
#endif
DI void gemm_phase(ldsptr_t lds, const GemmJob& S) {
    const int tid = TIDX(), wid = RFL(tid >> 6), lane = tid & 63, wr = wid >> 2, wc = wid & 3, fr = lane & 15, fq = lane >> 4;
    const int K = S.K, nt = K / BK;
    unsigned voffA[2], voffB[2];
#pragma unroll
    for (int i = 0; i < 2; ++i) { int R, C; stage_rc(tid * 16 + i * 8192, R, C); const int Rb = (R & ~31) + perm32(R & 31);
        voffA[i] = (unsigned)(R * K + C) * 2u; voffB[i] = (unsigned)(Rb * K + C) * 2u; }
    const size_t kstep = (size_t)(BK * 2);
    const size_t hstep = (size_t)HALFT * K * 2;
    const unsigned ldsw = (unsigned)wid * 1024u;
    const int aoff = lds_byte(wr * 64 + fr, fq * 8), boff = lds_byte(wc * 32 + fr, fq * 8);
#define PG8_SA(b, h) (((b) * 2 + (h)) * HTB)
#define PG8_SB(b, h) ((4 + (b) * 2 + (h)) * HTB)
#define PG8_STAGE(bufoff, gbase, voff) do { _Pragma("unroll") for (int _i = 0; _i < 2; ++_i) GLDS16((const char*)(gbase) + (voff)[_i], lds + (bufoff) + ldsw + _i * 8192); } while (0)
#define PG8_LDA(dst, b, h) do { _Pragma("unroll") for (int m = 0; m < 4; ++m) _Pragma("unroll") for (int k = 0; k < 2; ++k) dst[m][k] = *(const LAS bf16x8*)(lds + PG8_SA(b, h) + aoff + m * 2048 + k * 1024); } while (0)
#define PG8_LDB(dst, b, h) do { _Pragma("unroll") for (int n = 0; n < 2; ++n) _Pragma("unroll") for (int k = 0; k < 2; ++k) dst[n][k] = *(const LAS bf16x8*)(lds + PG8_SB(b, h) + boff + n * 2048 + k * 1024); } while (0)
#define PG8_MMA(ai, bj, At, Bt) do { SETPRIO(1); _Pragma("unroll") for (int m = 0; m < 4; ++m) _Pragma("unroll") for (int n = 0; n < 2; ++n) _Pragma("unroll") for (int k = 0; k < 2; ++k) \
        acc[ai][bj][m][n] = MFMA16(Bt[n][k], At[m][k], acc[ai][bj][m][n]); SETPRIO(0); } while (0)
    Unit cur, nxt; int ui = 0;
    if (!S.next(0, cur)) return;
    f32x4 acc[2][2][4][2];
#pragma unroll
    for (int a = 0; a < 2; ++a)
#pragma unroll
        for (int b = 0; b < 2; ++b)
#pragma unroll
            for (int m = 0; m < 4; ++m)
#pragma unroll
                for (int n = 0; n < 2; ++n) acc[a][b][m][n] = (f32x4){0.f, 0.f, 0.f, 0.f};
    bf16x8 At[4][2], B0[2][2], B1[2][2];
    const char* cA; const char* cB; S.ptrs(cur, cA, cB);
    PG8_STAGE(PG8_SB(0, 0), cB, voffB); PG8_STAGE(PG8_SA(0, 0), cA, voffA); PG8_STAGE(PG8_SB(0, 1), cB + hstep, voffB); PG8_STAGE(PG8_SA(0, 1), cA + hstep, voffA);
    if (wr == 1) S_BARRIER();
    WAIT_V(4); S_BARRIER();
    PG8_STAGE(PG8_SB(1, 0), cB + kstep, voffB); PG8_STAGE(PG8_SA(1, 0), cA + kstep, voffA); PG8_STAGE(PG8_SB(1, 1), cB + hstep + kstep, voffB);
    WAIT_V(6); S_BARRIER();
    for (;;) {
        const bool has_next = S.next(ui + 1, nxt);
        const char* nA = cA; const char* nB = cB; if (has_next) S.ptrs(nxt, nA, nB);
        for (int t = 0; t < nt; t += 2) {
            const bool last = (t == nt - 2);
            const char* a1 = cA + (size_t)(t + 1) * kstep;
            const char* a2 = last ? nA : cA + (size_t)(t + 2) * kstep; const char* b2 = last ? nB : cB + (size_t)(t + 2) * kstep;
            const char* a3 = a2 + kstep; const char* b3 = b2 + kstep;
            PG8_LDB(B0, 0, 0); SCHED_BAR(); PG8_LDA(At, 0, 0); PG8_STAGE(PG8_SA(1, 1), a1 + hstep, voffA);
            WAIT_L(8); S_BARRIER(); WAIT_L(0); PG8_MMA(0, 0, At, B0); S_BARRIER(); SCHED_BAR();
            PG8_LDB(B1, 0, 1); PG8_STAGE(PG8_SB(0, 0), b2, voffB);
            S_BARRIER(); WAIT_L(0); PG8_MMA(0, 1, At, B1); S_BARRIER();
            PG8_LDA(At, 0, 1); PG8_STAGE(PG8_SA(0, 0), a2, voffA);
            S_BARRIER(); WAIT_L(0); PG8_MMA(1, 0, At, B0); S_BARRIER(); SCHED_BAR();
            PG8_STAGE(PG8_SB(0, 1), b2 + hstep, voffB);
            WAIT_V(6); S_BARRIER(); PG8_MMA(1, 1, At, B1); S_BARRIER();
            PG8_LDB(B0, 1, 0); SCHED_BAR(); PG8_LDA(At, 1, 0); PG8_STAGE(PG8_SA(0, 1), a2 + hstep, voffA);
            WAIT_L(8); S_BARRIER(); WAIT_L(0); PG8_MMA(0, 0, At, B0); S_BARRIER(); SCHED_BAR();
            PG8_LDB(B1, 1, 1); PG8_STAGE(PG8_SB(1, 0), b3, voffB);
            S_BARRIER(); WAIT_L(0); PG8_MMA(0, 1, At, B1); S_BARRIER();
            PG8_LDA(At, 1, 1); PG8_STAGE(PG8_SA(1, 0), a3, voffA);
            S_BARRIER(); WAIT_L(0); PG8_MMA(1, 0, At, B0); S_BARRIER(); SCHED_BAR();
            PG8_STAGE(PG8_SB(1, 1), b3 + hstep, voffB);
            WAIT_V(6); S_BARRIER(); PG8_MMA(1, 1, At, B1); S_BARRIER();
        }
        S.epilogue(acc, cur, wr, wc, fr, fq);
        if (!has_next) break;
#pragma unroll
        for (int a = 0; a < 2; ++a)
#pragma unroll
            for (int b = 0; b < 2; ++b)
#pragma unroll
                for (int m = 0; m < 4; ++m)
#pragma unroll
                    for (int n = 0; n < 2; ++n) acc[a][b][m][n] = (f32x4){0.f, 0.f, 0.f, 0.f};
        cur = nxt; cA = nA; cB = nB; ++ui;
    }
    WAIT_V(0);
    if (wr == 0) S_BARRIER();
    S_BARRIER();
#undef PG8_SA
#undef PG8_SB
#undef PG8_STAGE
#undef PG8_LDA
#undef PG8_LDB
#undef PG8_MMA
}

DI int PADX(int i) { return i + (i >> 4); }
template <int SIGN> DI void dft4(cpx& a0, cpx& a1, cpx& a2, cpx& a3) {
    const cpx t0 = cadd(a0, a2), t1 = csub(a0, a2), t2 = cadd(a1, a3), t3 = csub(a1, a3);
    const cpx t3r = SIGN < 0 ? cpx{t3.y, -t3.x} : cpx{-t3.y, t3.x};
    a0 = cadd(t0, t2); a1 = cadd(t1, t3r); a2 = csub(t0, t2); a3 = csub(t1, t3r);
}
template <int SIGN> DI void dft16(cpx (&v)[16]) {
#pragma unroll
    for (int n2 = 0; n2 < 4; ++n2) dft4<SIGN>(v[n2], v[4 + n2], v[8 + n2], v[12 + n2]);
    constexpr float C1 = 0.92387953251128674f, S1 = 0.38268343236508977f, R = 0.70710678118654752f, SG = (float)SIGN;
    v[5] = cmul(v[5], cpx{C1, SG * S1});  v[6] = cmul(v[6], cpx{R, SG * R});     v[7] = cmul(v[7], cpx{S1, SG * C1});
    v[9] = cmul(v[9], cpx{R, SG * R});    v[10] = cmul(v[10], cpx{0.f, SG});     v[11] = cmul(v[11], cpx{-R, SG * R});
    v[13] = cmul(v[13], cpx{S1, SG * C1}); v[14] = cmul(v[14], cpx{-R, SG * R}); v[15] = cmul(v[15], cpx{-C1, -SG * S1});
#pragma unroll
    for (int k1 = 0; k1 < 4; ++k1) dft4<SIGN>(v[4 * k1], v[4 * k1 + 1], v[4 * k1 + 2], v[4 * k1 + 3]);
}
template <int SIGN> DI void fft_pass16(cpx* fb, int j, int Ns, int N16) {
    cpx v[16];
#pragma unroll
    for (int r = 0; r < 16; ++r) v[r] = fb[PADX(j + N16 * r)];
    const int k = j & (Ns - 1);
    if (Ns > 1) {
        float sn, cs; sincospif((float)(SIGN * 2 * k) / (float)(16 * Ns), &sn, &cs);
        const cpx w{cs, sn}; cpx wr = w;
        v[1] = cmul(v[1], wr);
#pragma unroll
        for (int r = 2; r < 16; ++r) { wr = cmul(wr, w); v[r] = cmul(v[r], wr); }
    }
    dft16<SIGN>(v);
    __syncthreads();
    const int base = (j - k) * 16 + k;
#pragma unroll
    for (int kk = 0; kk < 16; ++kk) fb[PADX(base + kk * Ns)] = v[4 * (kk & 3) + (kk >> 2)];
    __syncthreads();
}
template <int SIGN> DI void fft_passes(cpx* fb, int j, int Ns0, int np16, int N16) {
#pragma unroll 1
    for (int ps = 0, Ns = Ns0; ps < np16; ++ps, Ns <<= 4) fft_pass16<SIGN>(fb, j, Ns, N16);
}
DI void fftconv(cpx* fb, int j, const cpx* kf, bool active, int np16, int N16) {
    fft_passes<-1>(fb, j, 2, np16, N16);
    if (active) {
#pragma unroll 4
        for (int i = 0; i < 16; ++i) { const int f = j + N16 * i; fb[PADX(f)] = cmul(fb[PADX(f)], kf[f]); }
    }
    __syncthreads();
    fft_passes<1>(fb, j, 1, np16, N16);
}
DI cpx conv_out(const cpx* fb, int t, int L) {
    const cpx a = fb[PADX(t)], b = fb[PADX(t + L)];
    float sn, cs; sincospif((float)t / (float)L, &sn, &cs);
    const cpx wb = cmul(cpx{cs, sn}, b);
    const float rn = 0.5f / (float)L;
    return cpx{(a.x + wb.x) * rn, (a.y + wb.y) * rn};
}
DI float conv3(const bf16* ptr, int t, int L, float w0, float w1, float w2) {
    const float a = t > 0 ? bf2f(ptr[t - 1]) : 0.f, b = bf2f(ptr[t]), c = t < L - 1 ? bf2f(ptr[t + 1]) : 0.f;
    return a * w0 + b * w1 + c * w2;
}

DI void filter_item(const Params& p, int l, int item, char* smem, bool lat) {
    const int np16 = lat ? 3 : 2, N16 = lat ? 512 : 32, N = 16 * N16, L = N / 2;
    const int NSUB = NTHR / N16;
    const int tid = TIDX(), sub = tid / N16, j = tid % N16;
    const int o = item / (HYENA_W / NSUB), c = (item % (HYENA_W / NSUB)) * NSUB + sub;
    cpx* fb = (cpx*)smem + sub * (N + N / 16);
    float* red = (float*)(smem + 8704 * 8);
    const float* hid = (const float*)(p.ws + WS_HID2) + ((size_t)l * (SEQ + DEC_SEQ) + (lat ? SEQ : 0)) * FH;
    const float* w3 = p.in[I_FW3] + (size_t)l * FH * 4 * HYENA_W;
    const int colf = o * HYENA_W + c, colb = 2 * HYENA_W + o * HYENA_W + c;
    const float min_decay = -4.605170185988091f / 1.5f, max_decay = -4.605170185988091f / 0.3f;
    const float delta = fabsf(min_decay + (max_decay - min_decay) * (float)c / (float)(HYENA_W - 1));
    float asum = 0.f;
#pragma unroll 1
    for (int i = 0; i < 8; ++i) {
        const int t = j + N16 * i;
        const float* hr = hid + t;
        float f = 0.f, b = 0.f;
#pragma unroll 8
        for (int q = 0; q < FH; ++q) { const float hv = hr[(size_t)q * L]; f += hv * w3[(size_t)q * 4 * HYENA_W + colf]; b += hv * w3[(size_t)q * 4 * HYENA_W + colb]; }
        const float dec = __expf(-((float)t / (float)(L - 1)) * delta);
        f *= dec; b *= dec;
        fb[PADX(t)] = cpx{f, 0.f};
        if (t == 0) fb[PADX(L)] = cpx{0.f, 0.f}; else fb[PADX(N - t)] = cpx{b, 0.f};
        asum += fabsf(f) + (t == 0 ? 0.f : fabsf(b));
    }
#pragma unroll
    for (int s = 1; s < 32; s <<= 1) asum += __shfl_xor(asum, s);
    if (lat) {
        asum += __shfl_xor(asum, 32);
        if ((tid & 63) == 0) red[tid >> 6] = asum;
    }
    __syncthreads();
    if (lat) { asum = 0.f;
#pragma unroll
        for (int q = 0; q < 8; ++q) asum += red[q]; }
    const float rn = 1.f / asum;
    {
        cpx a[8], b[8];
#pragma unroll
        for (int i = 0; i < 8; ++i) { const int t = j + N16 * i; a[i] = fb[PADX(t)]; b[i] = fb[PADX(t + L)]; }
        __syncthreads();
#pragma unroll
        for (int i = 0; i < 8; ++i) { const int t = j + N16 * i; fb[PADX(2 * t)] = cadd(a[i], b[i]); fb[PADX(2 * t + 1)] = csub(a[i], b[i]); }
        __syncthreads();
    }
    fft_passes<-1>(fb, j, 2, np16, N16);
    cpx* kf = (cpx*)(p.ws + (lat ? WS_KFL + (l & 1) * KFL_BYTES : WS_KFC + (l & 1) * KFC_BYTES)) + (size_t)(o * HYENA_W + c) * N;
#pragma unroll 4
    for (int i = 0; i < 16; ++i) { const int f = j + N16 * i; const cpx v = fb[PADX(f)]; kf[f] = cpx{v.x * rn, v.y * rn}; }
    __syncthreads();
}

DI void hyena_item(const Params& p, int l, int item, char* smem, bool lat) {
    const int np16 = lat ? 3 : 2, N16 = lat ? 512 : 32, N = 16 * N16, L = N / 2;
    const int NSUB = NTHR / N16;
    const int NPAIR = lat ? DEC_BATCH / 2 : BATCH / 2;
    const int tid = TIDX(), sub = tid / N16, j = tid % N16;
    int c, pr; bool active = true;
    if (lat) { c = item / NPAIR; pr = item % NPAIR; }
    else { constexpr int GPC = (BATCH / 2 + 15) / 16; c = item / GPC; pr = (item % GPC) * NSUB + sub; active = pr < NPAIR; }
    const int tok0 = (lat ? TC : 0) + (active ? 2 * pr : 0) * L, tok1 = tok0 + L;
    cpx* fb = (cpx*)smem + sub * (N + N / 16);
    const bf16* HYT = (const bf16*)(p.ws + WS_HYT);
    const float* cw = p.in[I_HYCW] + (size_t)l * 3 * 3 * HYENA_W;
    const bf16* hv = HYT + (size_t)c * T; const bf16* gh = HYT + (size_t)(3 * HYENA_W + c) * T;
    const cpx* kfbase = (const cpx*)(p.ws + (lat ? WS_KFL + (l & 1) * KFL_BYTES : WS_KFC + (l & 1) * KFC_BYTES));
    f32x2* ub = (f32x2*)(smem + 8704 * 8 + 256) + sub * L;
    {
        const float w0 = cw[c], w1 = cw[3 * HYENA_W + c], w2 = cw[6 * HYENA_W + c];
#pragma unroll 2
        for (int i = 0; i < 8; ++i) {
            const int t = j + N16 * i;
            f32x2 u; u.x = active ? conv3(hv + tok0, t, L, w0, w1, w2) : 0.f; u.y = active ? conv3(hv + tok1, t, L, w0, w1, w2) : 0.f;
            ub[t] = u;
            fb[PADX(2 * t)] = cpx{u.x, u.y}; fb[PADX(2 * t + 1)] = cpx{u.x, u.y};
        }
    }
    __syncthreads();
    bf16* mixed = (bf16*)(p.ws + WS_XN);
#pragma unroll 1
    for (int o = 0; o < 2; ++o) {
        fftconv(fb, j, kfbase + (size_t)(o * HYENA_W + c) * N, active, np16, N16);
        const bf16* hx = HYT + (size_t)((1 + o) * HYENA_W + c) * T;
        const float w0 = cw[(1 + o) * HYENA_W + c], w1 = cw[3 * HYENA_W + (1 + o) * HYENA_W + c], w2 = cw[6 * HYENA_W + (1 + o) * HYENA_W + c];
        const float dd = p.in[I_HYD][(size_t)l * 2 * HYENA_W + o * HYENA_W + c];
#pragma unroll 2
        for (int i = 0; i < 8; ++i) {
            const int t = j + N16 * i;
            const cpx y = conv_out(fb, t, L);
            const f32x2 u = ub[t];
            const float x0 = active ? conv3(hx + tok0, t, L, w0, w1, w2) : 0.f, x1 = active ? conv3(hx + tok1, t, L, w0, w1, w2) : 0.f;
            f32x2 z; z.x = x0 * (y.x + dd * u.x); z.y = x1 * (y.y + dd * u.y);
            if (o == 0) ub[t] = z;
            else if (active) {
                mixed[(size_t)(tok0 + t) * MIX_W + ATTN_W + c] = f2bf(z.x * bf2f(gh[tok0 + t]));
                mixed[(size_t)(tok1 + t) * MIX_W + ATTN_W + c] = f2bf(z.y * bf2f(gh[tok1 + t]));
            }
        }
        __syncthreads();
        if (o == 0) {
#pragma unroll 2
            for (int i = 0; i < 8; ++i) { const int t = j + N16 * i; const f32x2 z = ub[t]; fb[PADX(2 * t)] = cpx{z.x, z.y}; fb[PADX(2 * t + 1)] = cpx{z.x, z.y}; }
            __syncthreads();
        }
    }
}

DI void unpack8(const u32x4 v, float (&f)[8]) {
    f[0] = __uint_as_float(v.x << 16); f[1] = __uint_as_float(v.x & 0xffff0000u); f[2] = __uint_as_float(v.y << 16); f[3] = __uint_as_float(v.y & 0xffff0000u);
    f[4] = __uint_as_float(v.z << 16); f[5] = __uint_as_float(v.z & 0xffff0000u); f[6] = __uint_as_float(v.w << 16); f[7] = __uint_as_float(v.w & 0xffff0000u);
}
DI void shortconv_item(const Params& p, int l, int item) {
    const bf16* SCb = (const bf16*)(p.ws + WS_SC);
    bf16* mixed = (bf16*)(p.ws + WS_XN);
    const float* cw = p.in[I_SCW] + (size_t)l * 3 * CONV_W;
    constexpr int C8 = CONV_W / 8;
    const u32x4 zero4 = {0u, 0u, 0u, 0u};
    for (int e = TIDX(); e < 64 * C8; e += NTHR) {
        const int m = item * 64 + e / C8, c = (e % C8) * 8;
        const int L = m < TC ? SEQ : DEC_SEQ, t = m < TC ? m % SEQ : (m - TC) % DEC_SEQ;
        const bf16* row = SCb + (size_t)m * 4 * CONV_W + c;
        float sb[8], g0[8], x0[8], gm[8], xm[8], gn[8], xn[8], gc[8], w0[8], w1[8], w2[8];
        unpack8(*(const u32x4*)row, sb); unpack8(*(const u32x4*)(row + CONV_W), g0); unpack8(*(const u32x4*)(row + 2 * CONV_W), x0); unpack8(*(const u32x4*)(row + 3 * CONV_W), gc);
        unpack8(t > 0 ? *(const u32x4*)(row - 4 * CONV_W + CONV_W) : zero4, gm); unpack8(t > 0 ? *(const u32x4*)(row - 4 * CONV_W + 2 * CONV_W) : zero4, xm);
        unpack8(t < L - 1 ? *(const u32x4*)(row + 4 * CONV_W + CONV_W) : zero4, gn); unpack8(t < L - 1 ? *(const u32x4*)(row + 4 * CONV_W + 2 * CONV_W) : zero4, xn);
#pragma unroll
        for (int i = 0; i < 2; ++i) {
            const f32x4 a = *(const f32x4*)(cw + c + 4 * i), b = *(const f32x4*)(cw + CONV_W + c + 4 * i), d = *(const f32x4*)(cw + 2 * CONV_W + c + 4 * i);
            w0[4 * i] = a.x; w0[4 * i + 1] = a.y; w0[4 * i + 2] = a.z; w0[4 * i + 3] = a.w;
            w1[4 * i] = b.x; w1[4 * i + 1] = b.y; w1[4 * i + 2] = b.z; w1[4 * i + 3] = b.w;
            w2[4 * i] = d.x; w2[4 * i + 1] = d.y; w2[4 * i + 2] = d.z; w2[4 * i + 3] = d.w;
        }
        float o[8];
#pragma unroll
        for (int i = 0; i < 8; ++i) o[i] = sb[i] * (gm[i] * xm[i] * w0[i] + g0[i] * x0[i] * w1[i] + gn[i] * xn[i] * w2[i]) * gc[i];
        u32x4 ov; ov.x = pack2(o[0], o[1]); ov.y = pack2(o[2], o[3]); ov.z = pack2(o[4], o[5]); ov.w = pack2(o[6], o[7]);
        *(u32x4*)(mixed + (size_t)m * MIX_W + ATTN_W + HYENA_W + c) = ov;
    }
}

constexpr int AT_NKL = 320;
constexpr int AT_KL = 0, AT_VL = AT_KL + AT_NKL * 128, AT_KC = AT_VL + AT_NKL * 128, AT_VC = AT_KC + 256 * 128, AT_END = AT_VC + 256 * 128;
static_assert(AT_END <= LDS_BYTES - 16, "lds");
DI int swzv(int row, int c) { return row * 128 + ((c ^ (((row >> 1) & 1) << 2)) << 4); }
#ifdef EMU
DI void v_tr_frags(const char* a0, const char* a1, bf16x8 (&frag)[4]) {
#pragma unroll
    for (int dt = 0; dt < 2; ++dt)
#pragma unroll
        for (int s = 0; s < 2; ++s) {
            const bf16x4 lo = emu_ds_read_tr16((dt ? a1 : a0) + 2048 * s), hi = emu_ds_read_tr16((dt ? a1 : a0) + 2048 * s + 1024);
            bf16x8 f; f[0] = lo[0]; f[1] = lo[1]; f[2] = lo[2]; f[3] = lo[3]; f[4] = hi[0]; f[5] = hi[1]; f[6] = hi[2]; f[7] = hi[3];
            frag[dt * 2 + s] = f;
        }
}
#else
DI void v_tr_frags(const char* a0, const char* a1, bf16x8 (&frag)[4]) {
    const unsigned x0 = (unsigned)(size_t)(const LAS char*)a0, x1 = (unsigned)(size_t)(const LAS char*)a1;
    u32x2 r0, r1, r2, r3, r4, r5, r6, r7;
    asm volatile("ds_read_b64_tr_b16 %0, %8\n\tds_read_b64_tr_b16 %1, %8 offset:1024\n\tds_read_b64_tr_b16 %2, %8 offset:2048\n\tds_read_b64_tr_b16 %3, %8 offset:3072\n\t"
                 "ds_read_b64_tr_b16 %4, %9\n\tds_read_b64_tr_b16 %5, %9 offset:1024\n\tds_read_b64_tr_b16 %6, %9 offset:2048\n\tds_read_b64_tr_b16 %7, %9 offset:3072\n\ts_waitcnt lgkmcnt(0)"
                 : "=&v"(r0), "=&v"(r1), "=&v"(r2), "=&v"(r3), "=&v"(r4), "=&v"(r5), "=&v"(r6), "=&v"(r7) : "v"(x0), "v"(x1) : "memory");
    u32x4 f; f.x = r0.x; f.y = r0.y; f.z = r1.x; f.w = r1.y; frag[0] = __builtin_bit_cast(bf16x8, f);
    f.x = r2.x; f.y = r2.y; f.z = r3.x; f.w = r3.y; frag[1] = __builtin_bit_cast(bf16x8, f);
    f.x = r4.x; f.y = r4.y; f.z = r5.x; f.w = r5.y; frag[2] = __builtin_bit_cast(bf16x8, f);
    f.x = r6.x; f.y = r6.y; f.z = r7.x; f.w = r7.y; frag[3] = __builtin_bit_cast(bf16x8, f);
}
#endif
DI void softmax_pv(f32x16& S, f32x16 (&O)[2], float& m_run, float& l_run, const char* va0, const char* va1) {
    float tmax = S[0];
#pragma unroll
    for (int e = 1; e < 16; ++e) tmax = fmaxf(tmax, S[e]);
    tmax = fmaxf(tmax, __shfl_xor(tmax, 32));
    const float mnew = fmaxf(m_run, tmax), alpha = exp2f(m_run - mnew);
    m_run = mnew; l_run *= alpha;
#pragma unroll
    for (int e = 0; e < 16; ++e) { O[0][e] *= alpha; O[1][e] *= alpha; }
    float ps = 0.f; unsigned pk[8];
#pragma unroll
    for (int e = 0; e < 8; ++e) { const float p0 = exp2f(S[2 * e] - mnew), p1 = exp2f(S[2 * e + 1] - mnew); ps += p0 + p1; pk[e] = pack2(p0, p1); }
    l_run += ps;
    u32x4 q0; q0.x = pk[0]; q0.y = pk[1]; q0.z = pk[2]; q0.w = pk[3];
    u32x4 q1; q1.x = pk[4]; q1.y = pk[5]; q1.z = pk[6]; q1.w = pk[7];
    const bf16x8 pb0 = __builtin_bit_cast(bf16x8, q0), pb1 = __builtin_bit_cast(bf16x8, q1);
    bf16x8 vf[4];
    v_tr_frags(va0, va1, vf);
    O[0] = MFMA32(vf[0], pb0, O[0]); O[0] = MFMA32(vf[1], pb1, O[0]);
    O[1] = MFMA32(vf[2], pb0, O[1]); O[1] = MFMA32(vf[3], pb1, O[1]);
}
DI void attn_item(const Params& p, int l, int item, char* smem, bool LAT) {
    const int tid = TIDX(), lane = tid & 63, w = tid >> 6, r = lane & 31, h = lane >> 5;
    const int SL = LAT ? DEC_SEQ : SEQ, NQB = SL / 64;
    const int b = item / (N_KV * NQB), kvh = (item / NQB) % N_KV, q0 = (item % NQB) * 64;
    const int tokbase = (LAT ? TC : 0) + b * SL;
    const bf16* Qb = (const bf16*)(p.ws + WS_Q); const bf16* Kb = (const bf16*)(p.ws + WS_KB); const bf16* Vb = (const bf16*)(p.ws + WS_VB);
    const bf16* GAb = (const bf16*)(p.ws + WS_GA); bf16* mixed = (bf16*)(p.ws + WS_XN);
    char* KL = smem + AT_KL; char* VL = smem + AT_VL; char* KC = smem + AT_KC; char* VC = smem + AT_VC;
    const u32x4 zero4 = {0u, 0u, 0u, 0u};
    if (LAT) {
        for (int id = tid; id < AT_NKL * 8; id += NTHR) {
            const int row = id >> 3, c = id & 7, kp = q0 - 128 + row;
            u32x4 kv = zero4, vv = zero4;
            if (kp >= 0 && kp < SL) { const size_t o = (size_t)(tokbase + kp) * KV_W + kvh * HD + c * 8; kv = *(const u32x4*)(Kb + o); vv = *(const u32x4*)(Vb + o); }
            *(u32x4*)(KL + swz128(row, c)) = kv; *(u32x4*)(VL + swzv(row, c)) = vv;
        }
    }
    {
        const bf16* ksrc; const bf16* vsrc; size_t stride;
        if (LAT) { const size_t o = (size_t)((b * DEPTH + l) * N_KV + kvh) * PAST_LEN * HD; ksrc = (const bf16*)(p.ws + WS_CKB) + o; vsrc = (const bf16*)(p.ws + WS_CVTB) + o; stride = HD; }
        else { ksrc = Kb + (size_t)tokbase * KV_W + kvh * HD; vsrc = Vb + (size_t)tokbase * KV_W + kvh * HD; stride = KV_W; }
        for (int id = tid; id < 256 * 8; id += NTHR) {
            const int row = id >> 3, c = id & 7;
            *(u32x4*)(KC + swz128(row, c)) = *(const u32x4*)(ksrc + (size_t)row * stride + c * 8);
            *(u32x4*)(VC + swzv(row, c)) = *(const u32x4*)(vsrc + (size_t)row * stride + c * 8);
        }
    }
    __syncthreads();
    {
        const int g = w >> 1, qt = w & 1, head = kvh * 4 + g;
        const int qpos = q0 + 32 * qt + r;
        const size_t qtok = (size_t)tokbase + qpos;
        bf16x8 qraw[4], qrot[4];
#pragma unroll
        for (int s = 0; s < 4; ++s) { qraw[s] = *(const bf16x8*)(Qb + qtok * ATTN_W + head * HD + 16 * s + 8 * h); qrot[s] = qraw[s]; }
        if (LAT) {
            const f32x2* rope = (const f32x2*)(p.ws + WS_ROPE);
#pragma unroll
            for (int a = 0; a < 2; ++a)
#pragma unroll
                for (int jj = 0; jj < 8; ++jj) {
                    const f32x2 cs = rope[(qpos * 2 + a) * 16 + 8 * h + jj];
                    const float xa = bf2f((bf16)qraw[2 * a][jj]), xb = bf2f((bf16)qraw[2 * a + 1][jj]);
                    qrot[2 * a][jj] = (short)f2bf(xa * cs.x - xb * cs.y);
                    qrot[2 * a + 1][jj] = (short)f2bf(xb * cs.x + xa * cs.y);
                }
        }
        const int qq = (lane & 15) >> 2, pp = lane & 3, g16 = (lane >> 4) & 1, vrow = 4 * h + qq;
        const int voff0 = swzv(vrow, 2 * g16 + (pp >> 1)) + (pp & 1) * 8, voff1 = swzv(vrow, 4 + 2 * g16 + (pp >> 1)) + (pp & 1) * 8;
        const float c1 = 0.125f * 1.4426950408889634f;
        float m_run = p.in[I_SINK][l * N_HEADS + head] * 1.4426950408889634f, l_run = h == 0 ? 1.f : 0.f;
        f32x16 O[2];
#pragma unroll
        for (int e = 0; e < 16; ++e) { O[0][e] = 0.f; O[1][e] = 0.f; }
        if (LAT) {
            for (int jt = qt; jt < qt + 9; ++jt) {
                f32x16 S;
#pragma unroll
                for (int e = 0; e < 16; ++e) S[e] = 0.f;
                const int krow = 32 * jt + r;
#pragma unroll
                for (int s = 0; s < 4; ++s) S = MFMA32(*(const bf16x8*)(KL + swz128(krow, 2 * s + h)), qrot[s], S);
#pragma unroll
                for (int e = 0; e < 16; ++e) {
                    const int kp = q0 - 128 + 32 * jt + (e & 3) + 8 * (e >> 2) + 4 * h, dd = kp - qpos;
                    const bool ok = dd <= 128 && dd >= -128 && kp >= 0 && kp < SL;
                    S[e] = ok ? S[e] * c1 : -1e30f;
                }
                softmax_pv(S, O, m_run, l_run, VL + 4096 * jt + voff0, VL + 4096 * jt + voff1);
            }
        }
        for (int jt = 0; jt < 8; ++jt) {
            f32x16 S;
#pragma unroll
            for (int e = 0; e < 16; ++e) S[e] = 0.f;
            const int krow = 32 * jt + r;
#pragma unroll
            for (int s = 0; s < 4; ++s) S = MFMA32(*(const bf16x8*)(KC + swz128(krow, 2 * s + h)), qraw[s], S);
#pragma unroll
            for (int e = 0; e < 16; ++e) S[e] *= c1;
            softmax_pv(S, O, m_run, l_run, VC + 4096 * jt + voff0, VC + 4096 * jt + voff1);
        }
        const float inv = 1.f / (l_run + __shfl_xor(l_run, 32));
#pragma unroll
        for (int dt = 0; dt < 2; ++dt)
#pragma unroll
            for (int rg = 0; rg < 4; ++rg) {
                const int d0 = dt * 32 + 8 * rg + 4 * h;
                const u32x2 gv = *(const u32x2*)(GAb + qtok * ATTN_W + head * HD + d0);
                const float g0 = bf2f((bf16)(gv.x & 0xffffu)), g1 = bf2f((bf16)(gv.x >> 16)), g2 = bf2f((bf16)(gv.y & 0xffffu)), g3 = bf2f((bf16)(gv.y >> 16));
                u32x2 o; o.x = pack2(O[dt][4 * rg] * inv * g0, O[dt][4 * rg + 1] * inv * g1); o.y = pack2(O[dt][4 * rg + 2] * inv * g2, O[dt][4 * rg + 3] * inv * g3);
                *(u32x2*)(mixed + qtok * MIX_W + head * HD + d0) = o;
            }
    }
    __syncthreads();
}

DI void phase_p0(const Params& p_, char* smem) {
    constexpr int I_T1 = DEPTH * (D_MODEL / 64) * (IN_COLS / 64), I_T2 = DEPTH * (MIX_W / 64) * (D_MODEL / 64);
    constexpr int I_MOD = DEPTH * ((3 * D_MODEL + 511) / 512), I_ROPE = DEC_SEQ * 32 / NTHR, I_HID = (DEPTH * (SEQ + DEC_SEQ) + 7) / 8;
    constexpr int I_CACHE = (2 * DEC_BATCH * DEPTH * PAST_LEN * KV_W / 8 + NTHR - 1) / NTHR;
    constexpr int TOTAL = I_T1 + I_T2 + I_MOD + I_ROPE + I_HID + I_CACHE;
    for (int it = BIDX(); it < TOTAL; it += gridDim.x) {
        const Params p = launder(p_);
        int q = it;
        if (q < I_T1 + I_T2) {
            const bool w1 = q < I_T1; if (!w1) q -= I_T1;
            const int per = w1 ? (D_MODEL / 64) * (IN_COLS / 64) : (MIX_W / 64) * (D_MODEL / 64), l = q / per;
            if (w1) p0_transpose_item(p.in[I_WIN] + (size_t)l * D_MODEL * IN_COLS, D_MODEL, IN_COLS, (bf16*)(p.ws + WS_WINT) + (size_t)l * IN_COLS * D_MODEL, q % per, smem);
            else p0_transpose_item(p.in[I_WOUT] + (size_t)l * MIX_W * D_MODEL, MIX_W, D_MODEL, (bf16*)(p.ws + WS_WOUTT) + (size_t)l * D_MODEL * MIX_W, q % per, smem);
            continue; }
        q -= I_T1 + I_T2;
        if (q < I_MOD) { p0_mod_item(p, q, smem); continue; }
        q -= I_MOD;
        if (q < I_ROPE) { p0_rope_item(p, q); continue; }
        q -= I_ROPE;
        if (q < I_HID) { p0_hid2_item(p, q); continue; }
        q -= I_HID;
        p0_cache_item(p, q);
    }
}
DI void phase_mix(const Params& p_, int l, int fl, char* smem, int mask) {
    constexpr int I_HL = HYENA_W * (DEC_BATCH / 2), I_AL = DEC_BATCH * N_KV * (DEC_SEQ / 64), I_AC = BATCH * N_KV * (SEQ / 64);
    constexpr int I_HC = HYENA_W * ((BATCH / 2 + 15) / 16), I_SC = T / 64, I_FL = 2 * HYENA_W, I_FC = 2 * HYENA_W / 16, I_NRM = T / 8;
    for (int it = BIDX(); it < I_FL + I_FC + I_HL + I_HC + I_AL + I_AC + I_SC + I_NRM; it += gridDim.x) {
        const Params p = launder(p_);
        int q = it;
        if (q < I_FL + I_FC) { const bool lat = q < I_FL; if (mask & 64) filter_item(p, fl, lat ? q : q - I_FL, smem, lat); continue; }
        q -= I_FL + I_FC;
        if (q < I_HL + I_HC) { const bool lat = q < I_HL; if (mask & (lat ? 1 : 2)) hyena_item(p, l, lat ? q : q - I_HL, smem, lat); continue; }
        q -= I_HL + I_HC;
        if (q < I_AL + I_AC) { const bool lat = q < I_AL; if (mask & (lat ? 4 : 8)) attn_item(p, l, lat ? q : q - I_AL, smem, lat); continue; }
        q -= I_AL + I_AC;
        if (q < I_SC) { if (mask & 16) shortconv_item(p, l, q); continue; }
        q -= I_SC;
        if (mask & 32) norm_item(p, 0, q);
    }
}
DI void phase_norm(const Params& p, int l) {
    for (int it = BIDX(); it < T / 8; it += gridDim.x) norm_item(p, l, it);
}

#ifndef PH_STOP
#define PH_STOP 1000
#endif
#ifndef DUP
#define DUP -1
#endif
#ifndef DMASK
#define DMASK 31
#endif
__global__ void __launch_bounds__(NTHR, 2) fwd_kernel(Params p_) {
#ifdef EMU
    char* smem = emu_smem();
#else
    extern __shared__ __attribute__((aligned(16))) char smem[];
    volatile LAS unsigned* xst = (volatile LAS unsigned*)(smem + LDS_BYTES - 16);
    if (TIDX() == 0) { xst[0] = 0u; xst[1] = 0u; }
    __syncthreads();
    const XcdBarrier xbar = xcd_barrier_post((unsigned*)(p_.ws + WS_BAR), xst);
#endif
    constexpr int NPH = 2 + 4 * DEPTH;
#pragma unroll 1
    for (int ph = 0; ph < NPH && ph < PH_STOP; ++ph) {
#pragma unroll 1
        for (int rep = 0; rep < (ph == DUP ? 2 : 1); ++rep) {
            const Params p = launder(p_);
            const int l = ph >= 2 ? (ph - 2) >> 2 : 0, k = ph >= 2 ? (ph - 2) & 3 : -1;
            if (ph == 0) phase_p0(p, smem);
            else if (ph == 1 || k == 1) {
                const int mask = rep ? DMASK : (ph == 1 ? 32 + 64 : 31 + (l + 1 < DEPTH ? 64 : 0));
                phase_mix(p, l, ph == 1 ? 0 : l + 1, smem, mask);
            } else if (k == 0 || k == 2) {
                GemmJob job; job.p = p; job.mode = k == 0 ? 0 : 1; job.l = l; job.K = k == 0 ? D_MODEL : MIX_W;
                gemm_phase((ldsptr_t)smem, job);
            } else phase_norm(p, l + 1);
        }
        if (ph + 1 < NPH) GRID_SYNC();
    }
}

#ifndef EMU
extern "C" void kernel_launch(void* const* d_in, const int* in_sizes, int n_in, void* d_out, int out_size, void* d_ws, size_t ws_size, hipStream_t stream) {
    static int grid = 0;
    if (grid == 0) {
        if (n_in != 22 || (size_t)out_size != OUT_TOTAL || ws_size < WS_END) { fprintf(stderr, "kernel_launch: unexpected sizes n_in %d out %d ws %zu (need %zu)\n", n_in, out_size, ws_size, (size_t)WS_END); grid = -1; return; }
        int dev = 0, cus = 0, per_cu = 0;
        hipGetDevice(&dev); hipDeviceGetAttribute(&cus, hipDeviceAttributeMultiprocessorCount, dev);
        if (hipFuncSetAttribute((const void*)fwd_kernel, hipFuncAttributeMaxDynamicSharedMemorySize, LDS_BYTES) != hipSuccess) { fprintf(stderr, "hipFuncSetAttribute failed\n"); grid = -1; return; }
        hipOccupancyMaxActiveBlocksPerMultiprocessor(&per_cu, (const void*)fwd_kernel, NTHR, LDS_BYTES);
        if (per_cu < 1) { fprintf(stderr, "occupancy query says %d\n", per_cu); grid = -1; return; }
        grid = cus;
    }
    if (grid < 0) return;
    Params p{};
    for (int i = 0; i < 22; ++i) p.in[i] = (const float*)d_in[i];
    p.out = (float*)d_out; p.ws = (unsigned char*)d_ws;
    if (hipMemsetAsync((char*)d_ws + WS_BAR, 0, XCD_BAR_WORDS * 4, stream) != hipSuccess) { fprintf(stderr, "memset failed\n"); return; }
    hipLaunchKernelGGL(fwd_kernel, dim3(grid), dim3(NTHR), LDS_BYTES, stream, p);
    const hipError_t e = hipPeekAtLastError();
    if (e != hipSuccess) fprintf(stderr, "launch failed: %s (grid %d)\n", hipGetErrorString(e), grid);
}
#endif
```

```cpp
#ifdef EMU
#include "emu.h"
#define GRID_SYNC() emu_grid_sync()
#define MFMA32(a, b, c) emu_mfma32((a), (b), (c))
#define MFMA16(a, b, c) emu_mfma16((a), (b), (c))
#define LAS
#define GLDS16(g, l) emu_glds16((const void*)(g), (void*)(l))
#define S_BARRIER() __syncthreads()
#define WAIT_V(n)
#define WAIT_L(n)
#define SCHED_BAR()
#define SETPRIO(x)
#define RFL(x) (x)
#define CBAR()
#define OPQ(x) (x)
#define TIDX() ((int)threadIdx.x)
#define BIDX() ((int)blockIdx.x)
#else
#include <hip/hip_runtime.h>
#include <cstdio>
#include <cstdint>
typedef short bf16x8 __attribute__((ext_vector_type(8)));
typedef float f32x16 __attribute__((ext_vector_type(16)));
typedef float f32x4 __attribute__((ext_vector_type(4)));
#define GRID_SYNC() xcd_barrier(xbar)
#define MFMA32(a, b, c) __builtin_amdgcn_mfma_f32_32x32x16_bf16((a), (b), (c), 0, 0, 0)
#define MFMA16(a, b, c) __builtin_amdgcn_mfma_f32_16x16x32_bf16((a), (b), (c), 0, 0, 0)
#define LAS __attribute__((address_space(3)))
#define GLDS16(g, l) __builtin_amdgcn_global_load_lds((const unsigned*)(g), (LAS unsigned*)(l), 16, 0, 0)
#define S_BARRIER() __builtin_amdgcn_s_barrier()
#define WAIT_V(n) asm volatile("s_waitcnt vmcnt(" #n ")" ::: "memory")
#define WAIT_L(n) asm volatile("s_waitcnt lgkmcnt(" #n ")" ::: "memory")
#define SCHED_BAR() __builtin_amdgcn_sched_barrier(0)
#define SETPRIO(x) __builtin_amdgcn_s_setprio(x)
#define RFL(x) __builtin_amdgcn_readfirstlane(x)
#define CBAR() asm volatile("" ::: "memory")
__device__ __forceinline__ int opq_(int x) { asm volatile("" : "+v"(x)); return x; }
#define OPQ(x) opq_(x)
__device__ __forceinline__ int tidx_() { int t = threadIdx.x; asm volatile("" : "+v"(t)); return t; }
__device__ __forceinline__ int bidx_() { int t = blockIdx.x; asm volatile("" : "+s"(t)); return t; }
#define TIDX() tidx_()
#define BIDX() bidx_()
#endif
typedef unsigned u32x4 __attribute__((ext_vector_type(4)));
typedef unsigned u32x2 __attribute__((ext_vector_type(2)));
typedef float f32x2 __attribute__((ext_vector_type(2)));
typedef unsigned short bf16;
#define DI __device__ __forceinline__

#ifdef CFG_SMALL
constexpr int D_MODEL = 256, BATCH = 2, SEQ = 256, DEPTH = 2, DEC_BATCH = 4, DEC_SEQ = 4096, PAST_LEN = 256, HYENA_W = 128, CONV_W = 128;
#else
constexpr int D_MODEL = 1024, BATCH = 32, SEQ = 256, DEPTH = 4, DEC_BATCH = 8, DEC_SEQ = 4096, PAST_LEN = 256, HYENA_W = 256, CONV_W = 256;
#endif
constexpr int GRID_W = 64, N_HEADS = 8, N_KV = 2, HD = 64, ATTN_W = 512, KV_W = 128;
constexpr int MIX_W = ATTN_W + HYENA_W + CONV_W;
constexpr int C_Q = 0, C_K = ATTN_W, C_V = C_K + KV_W, C_GA = C_V + KV_W, C_HV = C_GA + ATTN_W, C_GH = C_HV + 3 * HYENA_W,
              C_SB = C_GH + HYENA_W, C_GC = C_SB + 3 * CONV_W, IN_COLS = C_GC + CONV_W;
constexpr int TC = BATCH * SEQ, TL = DEC_BATCH * DEC_SEQ, T = TC + TL;
constexpr int NR = 1 + DEC_BATCH;
constexpr int FH = 64, FE = 33;
constexpr int NTHR = 512;
static_assert(T % 256 == 0 && TC % 256 == 0 && C_HV % 256 == 0 && C_SB % 256 == 0 && IN_COLS % 256 == 0 && D_MODEL % 256 == 0 && MIX_W % 128 == 0 && (4 * HYENA_W) % 256 == 0, "tiling");
static_assert(SEQ == 256 && DEC_SEQ == 4096 && PAST_LEN == 256, "fft sizes");

constexpr size_t al256(size_t x) { return (x + 255) & ~(size_t)255; }
constexpr size_t WS_BAR = 0;
constexpr size_t WS_WINT = 65536;
constexpr size_t WS_WOUTT = WS_WINT + al256((size_t)DEPTH * IN_COLS * D_MODEL * 2);
constexpr size_t WS_MOD = WS_WOUTT + al256((size_t)DEPTH * D_MODEL * MIX_W * 2);
constexpr size_t WS_ROPE = WS_MOD + al256((size_t)DEPTH * NR * 3 * D_MODEL * 4);
constexpr size_t WS_HID2 = WS_ROPE + al256((size_t)DEC_SEQ * 32 * 8);
constexpr size_t WS_CKB = WS_HID2 + al256((size_t)DEPTH * (SEQ + DEC_SEQ) * FH * 4);
constexpr size_t WS_CVTB = WS_CKB + al256((size_t)DEC_BATCH * DEPTH * PAST_LEN * KV_W * 2);
constexpr size_t WS_KFL = WS_CVTB + al256((size_t)DEC_BATCH * DEPTH * PAST_LEN * KV_W * 2);
constexpr size_t KFL_BYTES = al256((size_t)2 * HYENA_W * 8192 * 8), KFC_BYTES = al256((size_t)2 * HYENA_W * 512 * 8);
constexpr size_t WS_KFC = WS_KFL + 2 * KFL_BYTES;
constexpr size_t WS_TW = WS_KFC + 2 * KFC_BYTES;
constexpr size_t WS_ZS = WS_TW + al256((size_t)12270 * 8);
constexpr size_t WS_XN = WS_ZS + (size_t)256 * 2 * 4096 * 8;
constexpr size_t WS_Q = WS_XN + al256((size_t)T * (D_MODEL > MIX_W ? D_MODEL : MIX_W) * 2);
constexpr size_t WS_KB = WS_Q + al256((size_t)T * ATTN_W * 2);
constexpr size_t WS_VB = WS_KB + al256((size_t)T * KV_W * 2);
constexpr size_t WS_GA = WS_VB + al256((size_t)T * KV_W * 2);
constexpr size_t WS_HYT = WS_GA + al256((size_t)T * ATTN_W * 2);
constexpr size_t WS_SC = WS_HYT + al256((size_t)4 * HYENA_W * T * 2);
constexpr size_t WS_END = WS_SC + al256((size_t)T * 4 * CONV_W * 2);

constexpr size_t OUT_YS = (size_t)TC * D_MODEL, OUT_NK = (size_t)T * D_MODEL, OUT_NV = OUT_NK + (size_t)BATCH * DEPTH * SEQ * KV_W,
                 OUT_TOTAL = OUT_NV + (size_t)BATCH * DEPTH * SEQ * KV_W;

constexpr int LDS_BYTES = 149504;

struct Params {
    const float* in[22];
    float* out;
    unsigned char* ws;
};
enum { I_XP = 0, I_XS, I_CK, I_CV, I_C, I_CCTX, I_NORMG, I_MODW, I_MODB, I_WIN, I_SINK, I_HYCW, I_FW1, I_FB1, I_FW2, I_FB2, I_FW3, I_FFREQ, I_HYD, I_SCW, I_WOUT, I_FINALG };

DI bf16 f2bf(float f) { unsigned u = __float_as_uint(f); u += 0x7fffu + ((u >> 16) & 1u); return (bf16)(u >> 16); }
DI float bf2f(bf16 h) { return __uint_as_float(((unsigned)h) << 16); }
DI unsigned pack2(float a, float b) { return (unsigned)f2bf(a) | ((unsigned)f2bf(b) << 16); }
DI float silu_f(float x) { return x / (1.f + __expf(-x)); }
typedef float cpx __attribute__((ext_vector_type(2)));
DI cpx cmul(cpx a, cpx b) { cpx r = b * a.x; r += cpx{-b.y, b.x} * a.y; return r; }
#ifdef EMU
DI Params launder(const Params& p) { return p; }
#else
DI Params launder(const Params& p) { Params q = p; int z = 0; asm volatile("" : "+s"(z)); q.ws = p.ws + z; q.out = p.out + z; return q; }
#endif
DI int mod_row(int m) { return m < TC ? 0 : 1 + (m - TC) / DEC_SEQ; }


#ifndef EMU
#define XB_TMO      128
#define XB_XCNT(j)  (256  + 64 * (j))
#define XB_XSUB(j)  (1280 + 64 * (j))
#define XB_XGEN(j)  (2304 + 64 * (j))
#define XB_TOP      3328
#define XB_TOPGEN   3392
#define XCD_BAR_WORDS 3456
#define XB_SPIN_CAP (1u << 22)
DI unsigned xb_ld(unsigned* p) { return __hip_atomic_load(p, __ATOMIC_RELAXED, __HIP_MEMORY_SCOPE_AGENT); }
DI unsigned xb_add(unsigned* p, unsigned v) { return __hip_atomic_fetch_add(p, v, __ATOMIC_RELAXED, __HIP_MEMORY_SCOPE_AGENT); }
DI unsigned xb_xcc_id() { return (unsigned)__builtin_amdgcn_s_getreg((3 << 11) | 20) & 0xFu; }
#define XB_SPIN(cond, bar) do { unsigned _sp = 0; while (cond) { __builtin_amdgcn_s_sleep(1); \
    if ((++_sp & 255u) == 0u) { if (xb_ld(&(bar)[XB_TMO])) break; if (_sp > XB_SPIN_CAP) { atomicAdd(&(bar)[XB_TMO], 1u); break; } } } } while (0)
struct XcdBarrier { unsigned* bar; unsigned x; volatile LAS unsigned* st; };
DI XcdBarrier xcd_barrier_post(unsigned* bar, volatile LAS unsigned* st) {
    XcdBarrier b; b.bar = bar; b.x = xb_xcc_id(); b.st = st;
    if (TIDX() == 0) (void)xb_add(&bar[XB_XCNT(b.x)], 1u);
    return b;
}
DI void xcd_barrier_complete(unsigned* bar, unsigned x, unsigned& nloc, unsigned& nx) {
    const unsigned G = gridDim.x * gridDim.y * gridDim.z;
    unsigned sum, cnt, mine, sp = 0u;
    for (;;) {
        sum = 0u; cnt = 0u; mine = 0u;
#pragma unroll
        for (unsigned j = 0; j < 16; ++j) { const unsigned c = xb_ld(&bar[XB_XCNT(j)]); sum += c; cnt += (c > 0u) ? 1u : 0u; mine = (j == x) ? c : mine; }
        if (sum == G) break;
        __builtin_amdgcn_s_sleep(1);
        if ((++sp & 255u) == 0u) { if (xb_ld(&bar[XB_TMO])) break; if (sp > XB_SPIN_CAP) { atomicAdd(&bar[XB_TMO], 1u); break; } }
    }
    nloc = mine > 0u ? mine : 1u; nx = cnt > 0u ? cnt : 1u;
}
DI void xcd_barrier(const XcdBarrier& b) {
    asm volatile("s_waitcnt vmcnt(0)" ::: "memory");
    __syncthreads();
    if (TIDX() == 0) {
        unsigned* bar = b.bar;
        __builtin_amdgcn_s_waitcnt(0);
        unsigned nloc = b.st[0], nx = b.st[1];
        if (nloc == 0u) { xcd_barrier_complete(bar, b.x, nloc, nx); b.st[0] = nloc; b.st[1] = nx; }
        const unsigned old = xb_add(&bar[XB_XSUB(b.x)], 1u);
        const unsigned gen = old / nloc;
        if (old + 1u == (gen + 1u) * nloc) {
            __builtin_amdgcn_fence(__ATOMIC_RELEASE, "agent");
            asm volatile("s_waitcnt vmcnt(0)" ::: "memory");
            const unsigned og = xb_add(&bar[XB_TOP], 1u);
            const unsigned tg = og / nx;
            if (og + 1u == (tg + 1u) * nx) xb_add(&bar[XB_TOPGEN], 1u);
            else XB_SPIN(xb_ld(&bar[XB_TOPGEN]) == tg, bar);
            __builtin_amdgcn_fence(__ATOMIC_ACQUIRE, "agent");
            xb_add(&bar[XB_XGEN(b.x)], 1u);
            asm volatile("s_waitcnt vmcnt(0)" ::: "memory");
        } else {
            XB_SPIN(xb_ld(&bar[XB_XGEN(b.x)]) == gen, bar);
            __builtin_amdgcn_fence(__ATOMIC_ACQUIRE, "agent");
            asm volatile("s_waitcnt vmcnt(0)" ::: "memory");
        }
    }
    __syncthreads();
}
#endif

DI void p0_transpose_item(const float* W, int K, int N, bf16* WT, int item, char* smem) {
    float* scr = (float*)smem;
    const int tid = TIDX(), nblk = N / 64, k0 = (item / nblk) * 64, n0 = (item % nblk) * 64;
#pragma unroll
    for (int i = 0; i < 8; ++i) { const int kk = (tid >> 6) + 8 * i, nn = tid & 63; scr[kk * 65 + nn] = W[(size_t)(k0 + kk) * N + n0 + nn]; }
    __syncthreads();
    const int n = tid >> 3, c = tid & 7;
    const float* s = scr + (8 * c) * 65 + n;
    u32x4 o; o.x = pack2(s[0], s[65]); o.y = pack2(s[2 * 65], s[3 * 65]); o.z = pack2(s[4 * 65], s[5 * 65]); o.w = pack2(s[6 * 65], s[7 * 65]);
    *(u32x4*)(WT + (size_t)(n0 + n) * K + k0 + 8 * c) = o;
    __syncthreads();
}
DI void p0_mod_item(const Params& p, int item, char* smem) {
    constexpr int NCH = (3 * D_MODEL + 511) / 512;
    float* tab = (float*)smem;
    const int tid = TIDX(), l = item / NCH, col = (item % NCH) * 512 + tid;
    for (int e = tid; e < NR * D_MODEL; e += NTHR) { const int r = e / D_MODEL, k = e % D_MODEL; const float cv = r == 0 ? p.in[I_CCTX][k] : p.in[I_C][(size_t)(r - 1) * D_MODEL + k]; tab[e] = silu_f(cv); }
    __syncthreads();
    if (col < 3 * D_MODEL) {
        float acc[NR];
#pragma unroll
        for (int r = 0; r < NR; ++r) acc[r] = 0.f;
        const float* w = p.in[I_MODW] + (size_t)l * D_MODEL * 3 * D_MODEL + col;
        for (int k = 0; k < D_MODEL; ++k) { const float wv = w[(size_t)k * 3 * D_MODEL];
#pragma unroll
            for (int r = 0; r < NR; ++r) acc[r] += tab[r * D_MODEL + k] * wv; }
        const float bv = p.in[I_MODB][(size_t)l * 3 * D_MODEL + col];
        float* mod = (float*)(p.ws + WS_MOD);
#pragma unroll
        for (int r = 0; r < NR; ++r) mod[((size_t)l * NR + r) * 3 * D_MODEL + col] = acc[r] + bv;
    }
    __syncthreads();
}
DI void p0_rope_item(const Params& p, int item) {
    const int e = item * NTHR + TIDX();
    if (e < DEC_SEQ * 32) {
        const int t = e >> 5, a = (e >> 4) & 1, f = e & 15;
        const float pos = (float)(a ? (t % GRID_W) : (t / GRID_W));
        const float inv = exp2f(-(float)f * (13.287712379549449f / 16.f));
        const float ang = pos * inv;
        f32x2 v; v.x = cosf(ang); v.y = sinf(ang);
        ((f32x2*)(p.ws + WS_ROPE))[e] = v;
    }
}
DI void p0_hid2_item(const Params& p, int item) {
    const int lane = TIDX() & 63, w = TIDX() >> 6;
    const int rr = item * 8 + w;
    if (rr >= DEPTH * (SEQ + DEC_SEQ)) return;
    const int l = rr / (SEQ + DEC_SEQ), q = rr % (SEQ + DEC_SEQ);
    const int L = q < SEQ ? SEQ : DEC_SEQ, t = q < SEQ ? q : q - SEQ;
    float feat = 0.f;
    if (lane == 0) feat = (float)t / (float)(L - 1);
    else if (lane < FE) {
        const int b = (lane - 1) & 15;
        const float fr = 1e-4f + (float)b * ((15.f - 1e-4f) / 15.f);
        const float ang = (6.283185307179586f / (float)L) * (float)t;
        feat = lane <= 16 ? cosf(fr * ang) : -sinf(fr * ang);
    }
    const float* w1 = p.in[I_FW1] + (size_t)l * FE * FH; const float* w2 = p.in[I_FW2] + (size_t)l * FH * FH;
    const float fq = p.in[I_FFREQ][l * FH + lane];
    float a1 = p.in[I_FB1][l * FH + lane];
    for (int i = 0; i < FE; ++i) a1 += __shfl(feat, i) * w1[i * FH + lane];
    const float h1 = sinf(fq * a1);
    float a2 = p.in[I_FB2][l * FH + lane];
    for (int i = 0; i < FH; ++i) a2 += __shfl(h1, i) * w2[i * FH + lane];
    const float h2 = sinf(fq * a2);
    ((float*)(p.ws + WS_HID2))[(size_t)l * (SEQ + DEC_SEQ) * FH + (q < SEQ ? 0 : (size_t)SEQ * FH) + (size_t)lane * L + t] = h2;
}
DI void p0_cache_item(const Params& p, int item) {
    constexpr int NCHUNK = DEC_BATCH * DEPTH * PAST_LEN * KV_W / 8;
    int e = item * NTHR + TIDX();
    if (e < 2 * NCHUNK) {
        const bool isv = e >= NCHUNK; if (isv) e -= NCHUNK;
        const int c8 = e & 7, j = (e >> 3) % PAST_LEN, kvh = (e >> 3) / PAST_LEN % N_KV, bl = (e >> 3) / PAST_LEN / N_KV;
        const float* src = p.in[isv ? I_CV : I_CK] + ((size_t)(bl * PAST_LEN + j) * N_KV + kvh) * HD + c8 * 8;
        u32x4 o; o.x = pack2(src[0], src[1]); o.y = pack2(src[2], src[3]); o.z = pack2(src[4], src[5]); o.w = pack2(src[6], src[7]);
        *(u32x4*)((bf16*)(p.ws + (isv ? WS_CVTB : WS_CKB)) + (size_t)e * 8) = o;
    }
}

DI const float* x_row_src(const Params& p, int l, int m) {
    if (l == 0) return m < TC ? p.in[I_XP] + (size_t)m * D_MODEL : p.in[I_XS] + (size_t)(m - TC) * D_MODEL;
    return p.out + (size_t)m * D_MODEL;
}
DI void norm_item(const Params& p, int l, int item) {
    const int lane = TIDX() & 63, w = TIDX() >> 6, m = item * 8 + w;
    if (m >= T) return;
    const float* xr = x_row_src(p, l, m);
    float ss = 0.f;
    for (int c4 = lane; c4 < D_MODEL / 4; c4 += 64) { const f32x4 v = *(const f32x4*)(xr + 4 * c4); ss += v.x * v.x + v.y * v.y + v.z * v.z + v.w * v.w; }
#pragma unroll
    for (int o = 1; o < 64; o <<= 1) ss += __shfl_xor(ss, o);
    const float rstd = rsqrtf(ss * (1.f / D_MODEL) + 1e-6f);
    if (l < DEPTH) {
        const float* g = p.in[I_NORMG] + (size_t)l * D_MODEL;
        const float* mod = (const float*)(p.ws + WS_MOD) + ((size_t)l * NR + mod_row(m)) * 3 * D_MODEL;
        bf16* xn = (bf16*)(p.ws + WS_XN) + (size_t)m * D_MODEL;
        for (int c4 = lane; c4 < D_MODEL / 4; c4 += 64) {
            const f32x4 v = *(const f32x4*)(xr + 4 * c4), gv = *(const f32x4*)(g + 4 * c4), sh = *(const f32x4*)(mod + 4 * c4), sc = *(const f32x4*)(mod + D_MODEL + 4 * c4);
            u32x2 o; o.x = pack2(v.x * rstd * gv.x * (1.f + sc.x) + sh.x, v.y * rstd * gv.y * (1.f + sc.y) + sh.y);
            o.y = pack2(v.z * rstd * gv.z * (1.f + sc.z) + sh.z, v.w * rstd * gv.w * (1.f + sc.w) + sh.w);
            *(u32x2*)(xn + 4 * c4) = o;
        }
    } else {
        const float* g = p.in[I_FINALG];
        float* yo = p.out + (size_t)m * D_MODEL;
        for (int c4 = lane; c4 < D_MODEL / 4; c4 += 64) {
            const f32x4 v = *(const f32x4*)(xr + 4 * c4), gv = *(const f32x4*)(g + 4 * c4);
            f32x4 o; o.x = v.x * rstd * gv.x; o.y = v.y * rstd * gv.y; o.z = v.z * rstd * gv.z; o.w = v.w * rstd * gv.w;
            *(f32x4*)(yo + 4 * c4) = o;
        }
    }
}

DI int swz128(int row, int c) { return row * 128 + ((c ^ ((row >> 1) & 7)) << 4); }
constexpr int BM = 256, BK = 64, HALFT = 128, HTB = HALFT * BK * 2, STAGE_BYTES = 8 * HTB;
static_assert(STAGE_BYTES <= LDS_BYTES - 16 && 2 * 8704 * 8 + 128 <= LDS_BYTES - 16, "lds");
DI int lds_byte(int r, int c) { const int st = (r >> 4) * 2 + (c >> 5), rr = r & 15, cc = c & 31, ob = rr * 64 + cc * 2; return st * 1024 + (ob ^ (((ob >> 9) & 1) << 5)); }
DI void stage_rc(int b, int& R, int& C) { const int st = b / 1024, sb = b % 1024, swz = sb ^ (((sb >> 9) & 1) << 5); R = (st >> 1) * 16 + swz / 64; C = (st & 1) * 32 + (swz % 64) / 2; }
DI int perm32(int rho) { const int n = rho >> 4, i = rho & 15; return 8 * (i >> 2) + 4 * n + (i & 3); }
struct Unit { int pm, pn, kind; };
DI void static_order(int L, int nM, int nN, int& pm, int& pn) {
    constexpr int NXCD = 8, WGM = 8;
    const int nwg = nM * nN;
    int wgid = L; { const int q = nwg / NXCD, r = nwg % NXCD, xcd = wgid % NXCD, off = wgid / NXCD; wgid = (xcd < r ? xcd * (q + 1) : r * (q + 1) + (xcd - r) * q) + off; }
    const int nig = WGM * nN, gid = wgid / nig, fm = gid * WGM, gsz = (nM - fm) < WGM ? (nM - fm) : WGM;
    pm = fm + ((wgid % nig) % gsz); pn = (wgid % nig) / gsz;
}
constexpr int NT_TOK = (IN_COLS - 4 * HYENA_W) / 256, NT_TOKA = C_HV / 256, NT_CH = 4 * HYENA_W / 256, NTM = T / 256;
constexpr int NU_TOK = NTM * NT_TOK, NU_CH = NT_CH * NTM, NU_OUT = NTM * (D_MODEL / 256);
struct GemmJob {
    Params p; int mode, l, K;
    DI bool next(int i, Unit& u) const {
        const int L = i * (int)gridDim.x + BIDX();
        if (mode == 0) {
            if (L < NU_TOK) { u.kind = 0; static_order(L, NTM, NT_TOK, u.pm, u.pn); return true; }
            if (L < NU_TOK + NU_CH) { u.kind = 1; static_order(L - NU_TOK, NT_CH, NTM, u.pm, u.pn); return true; }
            return false;
        }
        if (L < NU_OUT) { u.kind = 2; static_order(L, NTM, D_MODEL / 256, u.pm, u.pn); return true; }
        return false;
    }
    DI int tokcol(int pn) const { return pn < NT_TOKA ? pn * 256 : C_SB + (pn - NT_TOKA) * 256; }
    DI void ptrs(const Unit& u, const char*& a, const char*& b) const {
        const size_t rb = (size_t)K * 2;
        const char* xn = (const char*)(p.ws + WS_XN);
        if (u.kind == 0) { a = xn + (size_t)u.pm * 256 * rb; b = (const char*)(p.ws + WS_WINT) + ((size_t)l * IN_COLS + tokcol(u.pn)) * rb; }
        else if (u.kind == 1) { a = (const char*)(p.ws + WS_WINT) + ((size_t)l * IN_COLS + C_HV + u.pm * 256) * rb; b = xn + (size_t)u.pn * 256 * rb; }
        else { a = xn + (size_t)u.pm * 256 * rb; b = (const char*)(p.ws + WS_WOUTT) + ((size_t)l * D_MODEL + u.pn * 256) * rb; }
    }
    DI void epilogue(const f32x4 (&acc)[2][2][4][2], const Unit& u, int wr, int wc, int fr, int fq) const {
        if (u.kind == 0) {
            const bool ctx = u.pm * 256 < TC;
#pragma unroll 1
            for (int bj = 0; bj < 2; ++bj) {
                const int n0 = tokcol(u.pn) + 128 * bj, c0 = n0 + 32 * wc + 8 * fq;
                bf16* dst; int ld; bool sil = false; int special = 0;
                if (n0 < C_K) { dst = (bf16*)(p.ws + WS_Q) + c0; ld = ATTN_W; }
                else if (n0 < C_V) { dst = (bf16*)(p.ws + WS_KB) + (c0 - C_K); ld = KV_W; special = 1; }
                else if (n0 < C_GA) { dst = (bf16*)(p.ws + WS_VB) + (c0 - C_V); ld = KV_W; special = 2; }
                else if (n0 < C_HV) { dst = (bf16*)(p.ws + WS_GA) + (c0 - C_GA); ld = ATTN_W; sil = true; }
                else { dst = (bf16*)(p.ws + WS_SC) + (c0 - C_SB); ld = 4 * CONV_W; sil = n0 >= C_GC; }
#pragma unroll
                for (int ai = 0; ai < 2; ++ai)
#pragma unroll
                    for (int m = 0; m < 4; ++m) {
                        const int row = u.pm * 256 + 64 * wr + fr + OPQ(128 * ai + 16 * m);
                        f32x4 v0 = bj ? acc[ai][1][m][0] : acc[ai][0][m][0], v1 = bj ? acc[ai][1][m][1] : acc[ai][0][m][1];
                        if (sil) { v0.x = silu_f(v0.x); v0.y = silu_f(v0.y); v0.z = silu_f(v0.z); v0.w = silu_f(v0.w); v1.x = silu_f(v1.x); v1.y = silu_f(v1.y); v1.z = silu_f(v1.z); v1.w = silu_f(v1.w); }
                        if (special && ctx) {
                            float* o = p.out + (special == 1 ? OUT_NK : OUT_NV) + ((size_t)((row / SEQ) * DEPTH + l) * SEQ + (row % SEQ)) * KV_W + (c0 - (special == 1 ? C_K : C_V));
                            *(f32x4*)o = v0; *(f32x4*)(o + 4) = v1;
                        }
                        if (special == 1 && !ctx) {
                            const int pos = (row - TC) % DEC_SEQ, a = wc & 1, pp = fq >> 1, f0 = 8 * (fq & 1);
                            const f32x4* rp = (const f32x4*)((const f32x2*)(p.ws + WS_ROPE) + (pos * 2 + a) * 16 + f0);
                            const f32x4 r0 = rp[0], r1 = rp[1], r2 = rp[2], r3 = rp[3];
                            f32x4 o0, o1;
                            o0.x = __shfl_xor(v0.x, 32); o0.y = __shfl_xor(v0.y, 32); o0.z = __shfl_xor(v0.z, 32); o0.w = __shfl_xor(v0.w, 32);
                            o1.x = __shfl_xor(v1.x, 32); o1.y = __shfl_xor(v1.y, 32); o1.z = __shfl_xor(v1.z, 32); o1.w = __shfl_xor(v1.w, 32);
                            const float sg = pp ? 1.f : -1.f;
                            v0.x = v0.x * r0.x + sg * o0.x * r0.y; v0.y = v0.y * r0.z + sg * o0.y * r0.w; v0.z = v0.z * r1.x + sg * o0.z * r1.y; v0.w = v0.w * r1.z + sg * o0.w * r1.w;
                            v1.x = v1.x * r2.x + sg * o1.x * r2.y; v1.y = v1.y * r2.z + sg * o1.y * r2.w; v1.z = v1.z * r3.x + sg * o1.z * r3.y; v1.w = v1.w * r3.z + sg * o1.w * r3.w;
                        }
                        u32x4 w; w.x = pack2(v0.x, v0.y); w.y = pack2(v0.z, v0.w); w.z = pack2(v1.x, v1.y); w.w = pack2(v1.z, v1.w);
                        *(u32x4*)(dst + (size_t)row * ld) = w;
                        CBAR();
                    }
            }
        } else if (u.kind == 1) {
            bf16* HYT = (bf16*)(p.ws + WS_HYT);
#pragma unroll
            for (int ai = 0; ai < 2; ++ai) {
                const bool sil = u.pm * 256 + 128 * ai >= 3 * HYENA_W;
#pragma unroll
                for (int m = 0; m < 4; ++m) {
                    const int ch = u.pm * 256 + 64 * wr + fr + OPQ(128 * ai + 16 * m);
#pragma unroll
                    for (int bj = 0; bj < 2; ++bj) {
                        f32x4 v0 = acc[ai][bj][m][0], v1 = acc[ai][bj][m][1];
                        if (sil) { v0.x = silu_f(v0.x); v0.y = silu_f(v0.y); v0.z = silu_f(v0.z); v0.w = silu_f(v0.w); v1.x = silu_f(v1.x); v1.y = silu_f(v1.y); v1.z = silu_f(v1.z); v1.w = silu_f(v1.w); }
                        u32x4 w; w.x = pack2(v0.x, v0.y); w.y = pack2(v0.z, v0.w); w.z = pack2(v1.x, v1.y); w.w = pack2(v1.z, v1.w);
                        *(u32x4*)(HYT + (size_t)ch * T + u.pn * 256 + 128 * bj + 32 * wc + 8 * fq) = w;
                        CBAR();
                    }
                }
            }
        } else {
            const float* gate = (const float*)(p.ws + WS_MOD) + ((size_t)l * NR + mod_row(u.pm * 256)) * 3 * D_MODEL + 2 * D_MODEL;
#pragma unroll
            for (int bj = 0; bj < 2; ++bj) {
                const int n = u.pn * 256 + 128 * bj + 32 * wc + 8 * fq;
                const f32x4 g0 = *(const f32x4*)(gate + n), g1 = *(const f32x4*)(gate + n + 4);
#pragma unroll
                for (int ai = 0; ai < 2; ++ai)
#pragma unroll
                    for (int m = 0; m < 4; ++m) {
                        const int row = u.pm * 256 + 64 * wr + fr + OPQ(128 * ai + 16 * m);
                        const float* xs = x_row_src(p, l, row) + n;
                        const f32x4 x0 = *(const f32x4*)xs, x1 = *(const f32x4*)(xs + 4);
                        float* o = p.out + (size_t)row * D_MODEL + n;
                        *(f32x4*)o = x0 + g0 * acc[ai][bj][m][0]; *(f32x4*)(o + 4) = x1 + g1 * acc[ai][bj][m][1];
                        CBAR();
                    }
            }
        }
    }
};

#ifdef EMU
typedef unsigned char* ldsptr_t;
#else
typedef LAS unsigned char* ldsptr_t;
#endif
DI void gemm_phase(ldsptr_t lds, const GemmJob& S) {
    const int tid = TIDX(), wid = RFL(tid >> 6), lane = tid & 63, wr = wid >> 2, wc = wid & 3, fr = lane & 15, fq = lane >> 4;
    const int K = S.K, nt = K / BK;
    unsigned voffA[2], voffB[2];
#pragma unroll
    for (int i = 0; i < 2; ++i) { int R, C; stage_rc(tid * 16 + i * 8192, R, C); const int Rb = (R & ~31) + perm32(R & 31);
        voffA[i] = (unsigned)(R * K + C) * 2u; voffB[i] = (unsigned)(Rb * K + C) * 2u; }
    const size_t kstep = (size_t)(BK * 2);
    const size_t hstep = (size_t)HALFT * K * 2;
    const unsigned ldsw = (unsigned)wid * 1024u;
    const int aoff = lds_byte(wr * 64 + fr, fq * 8), boff = lds_byte(wc * 32 + fr, fq * 8);
#define PG8_SA(b, h) (((b) * 2 + (h)) * HTB)
#define PG8_SB(b, h) ((4 + (b) * 2 + (h)) * HTB)
#define PG8_STAGE(bufoff, gbase, voff) do { _Pragma("unroll") for (int _i = 0; _i < 2; ++_i) GLDS16((const char*)(gbase) + (voff)[_i], lds + (bufoff) + ldsw + _i * 8192); } while (0)
#define PG8_LDA(dst, b, h) do { _Pragma("unroll") for (int m = 0; m < 4; ++m) _Pragma("unroll") for (int k = 0; k < 2; ++k) dst[m][k] = *(const LAS bf16x8*)(lds + PG8_SA(b, h) + aoff + m * 2048 + k * 1024); } while (0)
#define PG8_LDB(dst, b, h) do { _Pragma("unroll") for (int n = 0; n < 2; ++n) _Pragma("unroll") for (int k = 0; k < 2; ++k) dst[n][k] = *(const LAS bf16x8*)(lds + PG8_SB(b, h) + boff + n * 2048 + k * 1024); } while (0)
#define PG8_MMA(ai, bj, At, Bt) do { SETPRIO(1); _Pragma("unroll") for (int m = 0; m < 4; ++m) _Pragma("unroll") for (int n = 0; n < 2; ++n) _Pragma("unroll") for (int k = 0; k < 2; ++k) \
        acc[ai][bj][m][n] = MFMA16(Bt[n][k], At[m][k], acc[ai][bj][m][n]); SETPRIO(0); } while (0)
    Unit cur, nxt; int ui = 0;
    if (!S.next(0, cur)) return;
    f32x4 acc[2][2][4][2];
#pragma unroll
    for (int a = 0; a < 2; ++a)
#pragma unroll
        for (int b = 0; b < 2; ++b)
#pragma unroll
            for (int m = 0; m < 4; ++m)
#pragma unroll
                for (int n = 0; n < 2; ++n) acc[a][b][m][n] = (f32x4){0.f, 0.f, 0.f, 0.f};
    bf16x8 At[4][2], B0[2][2], B1[2][2];
    const char* cA; const char* cB; S.ptrs(cur, cA, cB);
    PG8_STAGE(PG8_SB(0, 0), cB, voffB); PG8_STAGE(PG8_SA(0, 0), cA, voffA); PG8_STAGE(PG8_SB(0, 1), cB + hstep, voffB); PG8_STAGE(PG8_SA(0, 1), cA + hstep, voffA);
    if (wr == 1) S_BARRIER();
    WAIT_V(4); S_BARRIER();
    PG8_STAGE(PG8_SB(1, 0), cB + kstep, voffB); PG8_STAGE(PG8_SA(1, 0), cA + kstep, voffA); PG8_STAGE(PG8_SB(1, 1), cB + hstep + kstep, voffB);
    WAIT_V(6); S_BARRIER();
    for (;;) {
        const bool has_next = S.next(ui + 1, nxt);
        const char* nA = cA; const char* nB = cB; if (has_next) S.ptrs(nxt, nA, nB);
        for (int t = 0; t < nt; t += 2) {
            const bool last = (t == nt - 2);
            const char* a1 = cA + (size_t)(t + 1) * kstep;
            const char* a2 = last ? nA : cA + (size_t)(t + 2) * kstep; const char* b2 = last ? nB : cB + (size_t)(t + 2) * kstep;
            const char* a3 = a2 + kstep; const char* b3 = b2 + kstep;
            PG8_LDB(B0, 0, 0); SCHED_BAR(); PG8_LDA(At, 0, 0); PG8_STAGE(PG8_SA(1, 1), a1 + hstep, voffA);
            WAIT_L(8); S_BARRIER(); WAIT_L(0); PG8_MMA(0, 0, At, B0); S_BARRIER(); SCHED_BAR();
            PG8_LDB(B1, 0, 1); PG8_STAGE(PG8_SB(0, 0), b2, voffB);
            S_BARRIER(); WAIT_L(0); PG8_MMA(0, 1, At, B1); S_BARRIER();
            PG8_LDA(At, 0, 1); PG8_STAGE(PG8_SA(0, 0), a2, voffA);
            S_BARRIER(); WAIT_L(0); PG8_MMA(1, 0, At, B0); S_BARRIER(); SCHED_BAR();
            PG8_STAGE(PG8_SB(0, 1), b2 + hstep, voffB);
            WAIT_V(6); S_BARRIER(); PG8_MMA(1, 1, At, B1); S_BARRIER();
            PG8_LDB(B0, 1, 0); SCHED_BAR(); PG8_LDA(At, 1, 0); PG8_STAGE(PG8_SA(0, 1), a2 + hstep, voffA);
            WAIT_L(8); S_BARRIER(); WAIT_L(0); PG8_MMA(0, 0, At, B0); S_BARRIER(); SCHED_BAR();
            PG8_LDB(B1, 1, 1); PG8_STAGE(PG8_SB(1, 0), b3, voffB);
            S_BARRIER(); WAIT_L(0); PG8_MMA(0, 1, At, B1); S_BARRIER();
            PG8_LDA(At, 1, 1); PG8_STAGE(PG8_SA(1, 0), a3, voffA);
            S_BARRIER(); WAIT_L(0); PG8_MMA(1, 0, At, B0); S_BARRIER(); SCHED_BAR();
            PG8_STAGE(PG8_SB(1, 1), b3 + hstep, voffB);
            WAIT_V(6); S_BARRIER(); PG8_MMA(1, 1, At, B1); S_BARRIER();
        }
        S.epilogue(acc, cur, wr, wc, fr, fq);
        if (!has_next) break;
#pragma unroll
        for (int a = 0; a < 2; ++a)
#pragma unroll
            for (int b = 0; b < 2; ++b)
#pragma unroll
                for (int m = 0; m < 4; ++m)
#pragma unroll
                    for (int n = 0; n < 2; ++n) acc[a][b][m][n] = (f32x4){0.f, 0.f, 0.f, 0.f};
        cur = nxt; cA = nA; cB = nB; ++ui;
    }
    WAIT_V(0);
    if (wr == 0) S_BARRIER();
    S_BARRIER();
#undef PG8_SA
#undef PG8_SB
#undef PG8_STAGE
#undef PG8_LDA
#undef PG8_LDB
#undef PG8_MMA
}

DI int PADX(int i) { return i + (i >> 4); }
constexpr int FB_BANK = 8704;
template <int SIGN> DI void dft4(cpx& a0, cpx& a1, cpx& a2, cpx& a3) {
    const cpx t0 = a0 + a2, t1 = a0 - a2, t2 = a1 + a3, t3 = a1 - a3;
    const cpx t3r = SIGN < 0 ? cpx{t3.y, -t3.x} : cpx{-t3.y, t3.x};
    a0 = t0 + t2; a1 = t1 + t3r; a2 = t0 - t2; a3 = t1 - t3r;
}
template <int SIGN> DI void dft16(cpx (&v)[16]) {
#pragma unroll
    for (int n2 = 0; n2 < 4; ++n2) dft4<SIGN>(v[n2], v[4 + n2], v[8 + n2], v[12 + n2]);
    constexpr float C1 = 0.92387953251128674f, S1 = 0.38268343236508977f, R = 0.70710678118654752f, SG = (float)SIGN;
    v[5] = cmul(v[5], cpx{C1, SG * S1});  v[6] = cmul(v[6], cpx{R, SG * R});     v[7] = cmul(v[7], cpx{S1, SG * C1});
    v[9] = cmul(v[9], cpx{R, SG * R});    v[10] = cmul(v[10], cpx{0.f, SG});     v[11] = cmul(v[11], cpx{-R, SG * R});
    v[13] = cmul(v[13], cpx{S1, SG * C1}); v[14] = cmul(v[14], cpx{-R, SG * R}); v[15] = cmul(v[15], cpx{-C1, -SG * S1});
#pragma unroll
    for (int k1 = 0; k1 < 4; ++k1) dft4<SIGN>(v[4 * k1], v[4 * k1 + 1], v[4 * k1 + 2], v[4 * k1 + 3]);
}
constexpr int TW_F2 = 0, TW_F32 = TW_F2 + 15 * 2, TW_F512 = TW_F32 + 15 * 32, TW_I16 = TW_F512 + 15 * 512, TW_I256 = TW_I16 + 15 * 16, TW_TOTAL = TW_I256 + 15 * 256;
DI int tw_offset(int Ns, bool inv) { return inv ? (Ns == 16 ? TW_I16 : TW_I256) : (Ns == 2 ? TW_F2 : (Ns == 32 ? TW_F32 : TW_F512)); }
template <int SIGN> DI void fft_pass16x2(cpx* fa, cpx* fb, int j, int Ns, int N16, const cpx* twtab) {
    cpx va[16], vb[16];
#pragma unroll
    for (int r = 0; r < 16; ++r) { const int ix = PADX(j + N16 * r); va[r] = fa[ix]; vb[r] = fb[ix]; }
    const int k = j & (Ns - 1);
    if (Ns > 1) {
        const cpx* tw = twtab + tw_offset(Ns, SIGN > 0) + k;
#pragma unroll
        for (int r = 1; r < 16; ++r) { const cpx w = tw[(r - 1) * Ns]; va[r] = cmul(va[r], w); vb[r] = cmul(vb[r], w); }
    }
    dft16<SIGN>(va); dft16<SIGN>(vb);
    __syncthreads();
    const int base = (j - k) * 16 + k;
#pragma unroll
    for (int kk = 0; kk < 16; ++kk) { const int ix = PADX(base + kk * Ns); fa[ix] = va[4 * (kk & 3) + (kk >> 2)]; fb[ix] = vb[4 * (kk & 3) + (kk >> 2)]; }
    __syncthreads();
}
template <int SIGN> DI void fft_passes(cpx* fa, cpx* fb, int j, int Ns0, int np16, int N16, const cpx* twtab) {
#pragma unroll 1
    for (int ps = 0, Ns = Ns0; ps < np16; ++ps, Ns <<= 4) fft_pass16x2<SIGN>(fa, fb, j, Ns, N16, twtab);
}
DI cpx conv_out(const cpx* fb, int t, int L) {
    const cpx a = fb[PADX(t)], b = fb[PADX(t + L)];
    float sn, cs; sincospif((float)t / (float)L, &sn, &cs);
    const cpx wb = cmul(cpx{cs, sn}, b);
    const float rn = 0.5f / (float)L;
    return (a + wb) * rn;
}
DI float conv3(const bf16* ptr, int t, int L, float w0, float w1, float w2) {
    const float a = t > 0 ? bf2f(ptr[t - 1]) : 0.f, b = bf2f(ptr[t]), c = t < L - 1 ? bf2f(ptr[t + 1]) : 0.f;
    return a * w0 + b * w1 + c * w2;
}
DI void p0_twiddle_item(const Params& p, int item) {
    const int e = item * NTHR + TIDX();
    if (e < TW_TOTAL) {
        int Ns, o; float sg;
        if (e < TW_F32) { Ns = 2; o = e - TW_F2; sg = -1.f; } else if (e < TW_F512) { Ns = 32; o = e - TW_F32; sg = -1.f; } else if (e < TW_I16) { Ns = 512; o = e - TW_F512; sg = -1.f; }
        else if (e < TW_I256) { Ns = 16; o = e - TW_I16; sg = 1.f; } else { Ns = 256; o = e - TW_I256; sg = 1.f; }
        const int r = o / Ns + 1, k = o % Ns;
        float sn, cs; sincospif(sg * (float)(2 * k * r) / (float)(16 * Ns), &sn, &cs);
        ((cpx*)(p.ws + WS_TW))[e] = cpx{cs, sn};
    }
}

DI void filter_item(const Params& p, int l, int item, char* smem, bool lat) {
    const int np16 = lat ? 3 : 2, N16 = lat ? 512 : 32, N = 16 * N16, L = N / 2;
    const int tid = TIDX(), sub = tid / N16, j = tid % N16;
    const int c = lat ? item : item * 16 + sub;
    cpx* fa = (cpx*)smem + sub * (N + N / 16); cpx* fb = fa + FB_BANK;
    float* red = (float*)(smem + 2 * FB_BANK * 8);
    const float* hid = (const float*)(p.ws + WS_HID2) + ((size_t)l * (SEQ + DEC_SEQ) + (lat ? SEQ : 0)) * FH + j;
    const float* w3 = p.in[I_FW3] + (size_t)l * FH * 4 * HYENA_W + c;
    float f0[8], f1[8], b0[8], b1[8];
#pragma unroll
    for (int i = 0; i < 8; ++i) { f0[i] = 0.f; f1[i] = 0.f; b0[i] = 0.f; b1[i] = 0.f; }
#pragma unroll 2
    for (int q = 0; q < FH; ++q) {
        const float* wq = w3 + (size_t)q * 4 * HYENA_W;
        const float wf0 = wq[0], wf1 = wq[HYENA_W], wb0 = wq[2 * HYENA_W], wb1 = wq[3 * HYENA_W];
#pragma unroll
        for (int i = 0; i < 8; ++i) { const float hv = hid[(size_t)q * L + N16 * i]; f0[i] += hv * wf0; f1[i] += hv * wf1; b0[i] += hv * wb0; b1[i] += hv * wb1; }
    }
    const float min_decay = -4.605170185988091f / 1.5f, max_decay = -4.605170185988091f / 0.3f;
    const float delta = fabsf(min_decay + (max_decay - min_decay) * (float)c / (float)(HYENA_W - 1));
    float as0 = 0.f, as1 = 0.f;
#pragma unroll
    for (int i = 0; i < 8; ++i) {
        const int t = j + N16 * i;
        const float dec = __expf(-((float)t / (float)(L - 1)) * delta);
        const float vf0 = f0[i] * dec, vf1 = f1[i] * dec, vb0 = b0[i] * dec, vb1 = b1[i] * dec;
        fa[PADX(t)] = cpx{vf0, 0.f}; fb[PADX(t)] = cpx{vf1, 0.f};
        if (t == 0) { fa[PADX(L)] = cpx{0.f, 0.f}; fb[PADX(L)] = cpx{0.f, 0.f}; } else { fa[PADX(N - t)] = cpx{vb0, 0.f}; fb[PADX(N - t)] = cpx{vb1, 0.f}; }
        as0 += fabsf(vf0) + (t == 0 ? 0.f : fabsf(vb0)); as1 += fabsf(vf1) + (t == 0 ? 0.f : fabsf(vb1));
    }
#pragma unroll
    for (int s = 1; s < 32; s <<= 1) { as0 += __shfl_xor(as0, s); as1 += __shfl_xor(as1, s); }
    if (lat) {
        as0 += __shfl_xor(as0, 32); as1 += __shfl_xor(as1, 32);
        if ((tid & 63) == 0) { red[tid >> 6] = as0; red[8 + (tid >> 6)] = as1; }
    }
    __syncthreads();
    if (lat) { as0 = 0.f; as1 = 0.f;
#pragma unroll
        for (int q = 0; q < 8; ++q) { as0 += red[q]; as1 += red[8 + q]; } }
    const float rn0 = 1.f / as0, rn1 = 1.f / as1;
    {
        cpx a0[8], a1[8], c0[8], c1[8];
#pragma unroll
        for (int i = 0; i < 8; ++i) { const int t = j + N16 * i; a0[i] = fa[PADX(t)]; c0[i] = fa[PADX(t + L)]; a1[i] = fb[PADX(t)]; c1[i] = fb[PADX(t + L)]; }
        __syncthreads();
#pragma unroll
        for (int i = 0; i < 8; ++i) { const int t = j + N16 * i; fa[PADX(2 * t)] = a0[i] + c0[i]; fa[PADX(2 * t + 1)] = a0[i] - c0[i]; fb[PADX(2 * t)] = a1[i] + c1[i]; fb[PADX(2 * t + 1)] = a1[i] - c1[i]; }
        __syncthreads();
    }
    fft_passes<-1>(fa, fb, j, 2, np16, N16, (const cpx*)(p.ws + WS_TW));
    cpx* kf0 = (cpx*)(p.ws + (lat ? WS_KFL + (l & 1) * KFL_BYTES : WS_KFC + (l & 1) * KFC_BYTES)) + (size_t)c * N; cpx* kf1 = kf0 + (size_t)HYENA_W * N;
#pragma unroll 4
    for (int i = 0; i < 16; ++i) { const int f = j + N16 * i; kf0[f] = fa[PADX(f)] * rn0; kf1[f] = fb[PADX(f)] * rn1; }
    __syncthreads();
}

DI void hyena_item(const Params& p, int l, int item, char* smem, bool lat) {
    const int np16 = lat ? 3 : 2, N16 = lat ? 512 : 32, N = 16 * N16, L = N / 2;
    const int NPAIR = lat ? DEC_BATCH / 2 : BATCH / 2;
    const int tid = TIDX(), sub = tid / N16, j = tid % N16;
    constexpr int IPC = (DEC_BATCH / 2 + 1) / 2;
    int cA, cB, prA, prB; bool actA, actB;
    if (lat) { cA = cB = item / IPC; prA = 2 * (item % IPC); prB = prA + 1; actA = true; actB = prB < NPAIR; }
    else { cA = 2 * item; cB = cA + 1; prA = prB = sub; actA = actB = sub < NPAIR; }
    const int tokA = (lat ? TC : 0) + (actA ? 2 * prA : 0) * L, tokB = (lat ? TC : 0) + (actB ? 2 * prB : 0) * L;
    cpx* fa = (cpx*)smem + sub * (N + N / 16); cpx* fb = fa + FB_BANK;
    const bf16* HYT = (const bf16*)(p.ws + WS_HYT);
    const float* cw = p.in[I_HYCW] + (size_t)l * 3 * 3 * HYENA_W;
    const cpx* kfbase = (const cpx*)(p.ws + (lat ? WS_KFL + (l & 1) * KFL_BYTES : WS_KFC + (l & 1) * KFC_BYTES));
    const cpx* twtab = (const cpx*)(p.ws + WS_TW);
    cpx* zsA = (cpx*)(p.ws + WS_ZS) + (size_t)BIDX() * 2 * 4096 + sub * L; cpx* zsB = zsA + 4096;
    bf16* zoutA = (bf16*)(p.ws + WS_HYT) + (size_t)cA * T; bf16* zoutB = (bf16*)(p.ws + WS_HYT) + (size_t)cB * T;
    {
        const bf16* hvA = HYT + (size_t)cA * T; const bf16* hvB = HYT + (size_t)cB * T;
        const float a0 = cw[cA], a1 = cw[3 * HYENA_W + cA], a2 = cw[6 * HYENA_W + cA], b0 = cw[cB], b1 = cw[3 * HYENA_W + cB], b2 = cw[6 * HYENA_W + cB];
#pragma unroll 2
        for (int i = 0; i < 8; ++i) {
            const int t = j + N16 * i;
            cpx ua = cpx{0.f, 0.f}, ub = cpx{0.f, 0.f};
            if (actA) { ua.x = conv3(hvA + tokA, t, L, a0, a1, a2); ua.y = conv3(hvA + tokA + L, t, L, a0, a1, a2); }
            if (actB) { ub.x = conv3(hvB + tokB, t, L, b0, b1, b2); ub.y = conv3(hvB + tokB + L, t, L, b0, b1, b2); }
            zsA[t] = ua; zsB[t] = ub;
            fa[PADX(2 * t)] = ua; fa[PADX(2 * t + 1)] = ua; fb[PADX(2 * t)] = ub; fb[PADX(2 * t + 1)] = ub;
        }
    }
    __syncthreads();
#pragma unroll 1
    for (int o = 0; o < 2; ++o) {
        fft_passes<-1>(fa, fb, j, 2, np16, N16, twtab);
        {
            const cpx* kfA = kfbase + (size_t)(o * HYENA_W + cA) * N; const cpx* kfB = kfbase + (size_t)(o * HYENA_W + cB) * N;
#pragma unroll 4
            for (int i = 0; i < 16; ++i) { const int f = j + N16 * i; const int ix = PADX(f); fa[ix] = cmul(fa[ix], kfA[f]); fb[ix] = cmul(fb[ix], kfB[f]); }
        }
        __syncthreads();
        fft_passes<1>(fa, fb, j, 1, np16, N16, twtab);
        const bf16* hxA = HYT + (size_t)((1 + o) * HYENA_W + cA) * T; const bf16* hxB = HYT + (size_t)((1 + o) * HYENA_W + cB) * T;
        const float a0 = cw[(1 + o) * HYENA_W + cA], a1 = cw[3 * HYENA_W + (1 + o) * HYENA_W + cA], a2 = cw[6 * HYENA_W + (1 + o) * HYENA_W + cA];
        const float b0 = cw[(1 + o) * HYENA_W + cB], b1 = cw[3 * HYENA_W + (1 + o) * HYENA_W + cB], b2 = cw[6 * HYENA_W + (1 + o) * HYENA_W + cB];
        const float ddA = p.in[I_HYD][(size_t)l * 2 * HYENA_W + o * HYENA_W + cA], ddB = p.in[I_HYD][(size_t)l * 2 * HYENA_W + o * HYENA_W + cB];
        const bf16* ghA = HYT + (size_t)(3 * HYENA_W + cA) * T; const bf16* ghB = HYT + (size_t)(3 * HYENA_W + cB) * T;
#pragma unroll 2
        for (int i = 0; i < 8; ++i) {
            const int t = j + N16 * i;
            const cpx ya = conv_out(fa, t, L), yb = conv_out(fb, t, L);
            const cpx ua = zsA[t], ub = zsB[t];
            cpx za = cpx{0.f, 0.f}, zb = cpx{0.f, 0.f};
            if (actA) { za.x = conv3(hxA + tokA, t, L, a0, a1, a2) * (ya.x + ddA * ua.x); za.y = conv3(hxA + tokA + L, t, L, a0, a1, a2) * (ya.y + ddA * ua.y); }
            if (actB) { zb.x = conv3(hxB + tokB, t, L, b0, b1, b2) * (yb.x + ddB * ub.x); zb.y = conv3(hxB + tokB + L, t, L, b0, b1, b2) * (yb.y + ddB * ub.y); }
            if (o == 0) { zsA[t] = za; zsB[t] = zb; }
            else {
                if (actA) { zoutA[tokA + t] = f2bf(za.x * bf2f(ghA[tokA + t])); zoutA[tokA + L + t] = f2bf(za.y * bf2f(ghA[tokA + L + t])); }
                if (actB) { zoutB[tokB + t] = f2bf(zb.x * bf2f(ghB[tokB + t])); zoutB[tokB + L + t] = f2bf(zb.y * bf2f(ghB[tokB + L + t])); }
            }
        }
        __syncthreads();
        if (o == 0) {
#pragma unroll 2
            for (int i = 0; i < 8; ++i) { const int t = j + N16 * i; const cpx za = zsA[t], zb = zsB[t]; fa[PADX(2 * t)] = za; fa[PADX(2 * t + 1)] = za; fb[PADX(2 * t)] = zb; fb[PADX(2 * t + 1)] = zb; }
            __syncthreads();
        }
    }
}

DI void hytr_item(const Params& p, int item, char* smem) {
    const int tid = TIDX(), tok0 = item * 64;
    const bf16* HYT = (const bf16*)(p.ws + WS_HYT); bf16* mixed = (bf16*)(p.ws + WS_XN);
    unsigned* tile = (unsigned*)smem;
    for (int id = tid; id < HYENA_W * 8; id += NTHR) {
        const int ch = id >> 3, ck = id & 7, x = (ch >> 3) & 31;
        const u32x4 v = *(const u32x4*)(HYT + (size_t)ch * T + tok0 + ck * 8);
        unsigned* row = tile + ch * 32;
        row[(4 * ck) ^ x] = v.x; row[(4 * ck + 1) ^ x] = v.y; row[(4 * ck + 2) ^ x] = v.z; row[(4 * ck + 3) ^ x] = v.w;
    }
    __syncthreads();
    for (int id = tid; id < 64 * (HYENA_W / 8); id += NTHR) {
        const int cg = id % (HYENA_W / 8), tok = id / (HYENA_W / 8), x = cg & 31, sh = (tok & 1) * 16;
        unsigned e[8];
#pragma unroll
        for (int k = 0; k < 8; ++k) e[k] = (tile[(8 * cg + k) * 32 + ((tok >> 1) ^ x)] >> sh) & 0xffffu;
        u32x4 o; o.x = e[0] | (e[1] << 16); o.y = e[2] | (e[3] << 16); o.z = e[4] | (e[5] << 16); o.w = e[6] | (e[7] << 16);
        *(u32x4*)(mixed + (size_t)(tok0 + tok) * MIX_W + ATTN_W + 8 * cg) = o;
    }
    __syncthreads();
}

DI void unpack8(const u32x4 v, float (&f)[8]) {
    f[0] = __uint_as_float(v.x << 16); f[1] = __uint_as_float(v.x & 0xffff0000u); f[2] = __uint_as_float(v.y << 16); f[3] = __uint_as_float(v.y & 0xffff0000u);
    f[4] = __uint_as_float(v.z << 16); f[5] = __uint_as_float(v.z & 0xffff0000u); f[6] = __uint_as_float(v.w << 16); f[7] = __uint_as_float(v.w & 0xffff0000u);
}
DI void shortconv_item(const Params& p, int l, int item) {
    const bf16* SCb = (const bf16*)(p.ws + WS_SC);
    bf16* mixed = (bf16*)(p.ws + WS_XN);
    const float* cw = p.in[I_SCW] + (size_t)l * 3 * CONV_W;
    constexpr int C8 = CONV_W / 8;
    const u32x4 zero4 = {0u, 0u, 0u, 0u};
    for (int e = TIDX(); e < 64 * C8; e += NTHR) {
        const int m = item * 64 + e / C8, c = (e % C8) * 8;
        const int L = m < TC ? SEQ : DEC_SEQ, t = m < TC ? m % SEQ : (m - TC) % DEC_SEQ;
        const bf16* row = SCb + (size_t)m * 4 * CONV_W + c;
        float sb[8], g0[8], x0[8], gm[8], xm[8], gn[8], xn[8], gc[8], w0[8], w1[8], w2[8];
        unpack8(*(const u32x4*)row, sb); unpack8(*(const u32x4*)(row + CONV_W), g0); unpack8(*(const u32x4*)(row + 2 * CONV_W), x0); unpack8(*(const u32x4*)(row + 3 * CONV_W), gc);
        unpack8(t > 0 ? *(const u32x4*)(row - 4 * CONV_W + CONV_W) : zero4, gm); unpack8(t > 0 ? *(const u32x4*)(row - 4 * CONV_W + 2 * CONV_W) : zero4, xm);
        unpack8(t < L - 1 ? *(const u32x4*)(row + 4 * CONV_W + CONV_W) : zero4, gn); unpack8(t < L - 1 ? *(const u32x4*)(row + 4 * CONV_W + 2 * CONV_W) : zero4, xn);
#pragma unroll
        for (int i = 0; i < 2; ++i) {
            const f32x4 a = *(const f32x4*)(cw + c + 4 * i), b = *(const f32x4*)(cw + CONV_W + c + 4 * i), d = *(const f32x4*)(cw + 2 * CONV_W + c + 4 * i);
            w0[4 * i] = a.x; w0[4 * i + 1] = a.y; w0[4 * i + 2] = a.z; w0[4 * i + 3] = a.w;
            w1[4 * i] = b.x; w1[4 * i + 1] = b.y; w1[4 * i + 2] = b.z; w1[4 * i + 3] = b.w;
            w2[4 * i] = d.x; w2[4 * i + 1] = d.y; w2[4 * i + 2] = d.z; w2[4 * i + 3] = d.w;
        }
        float o[8];
#pragma unroll
        for (int i = 0; i < 8; ++i) o[i] = sb[i] * (gm[i] * xm[i] * w0[i] + g0[i] * x0[i] * w1[i] + gn[i] * xn[i] * w2[i]) * gc[i];
        u32x4 ov; ov.x = pack2(o[0], o[1]); ov.y = pack2(o[2], o[3]); ov.z = pack2(o[4], o[5]); ov.w = pack2(o[6], o[7]);
        *(u32x4*)(mixed + (size_t)m * MIX_W + ATTN_W + HYENA_W + c) = ov;
    }
}

constexpr int AT_NKL = 320;
constexpr int AT_KL = 0, AT_VL = AT_KL + AT_NKL * 128, AT_KC = AT_VL + AT_NKL * 128, AT_VC = AT_KC + 256 * 128, AT_END = AT_VC + 256 * 128;
static_assert(AT_END <= LDS_BYTES - 16, "lds");
DI int swzv(int row, int c) { return row * 128 + ((c ^ (((row >> 1) & 1) << 2)) << 4); }
#ifdef EMU
DI void v_tr_frags(const char* a0, const char* a1, bf16x8 (&frag)[4]) {
#pragma unroll
    for (int dt = 0; dt < 2; ++dt)
#pragma unroll
        for (int s = 0; s < 2; ++s) {
            const bf16x4 lo = emu_ds_read_tr16((dt ? a1 : a0) + 2048 * s), hi = emu_ds_read_tr16((dt ? a1 : a0) + 2048 * s + 1024);
            bf16x8 f; f[0] = lo[0]; f[1] = lo[1]; f[2] = lo[2]; f[3] = lo[3]; f[4] = hi[0]; f[5] = hi[1]; f[6] = hi[2]; f[7] = hi[3];
            frag[dt * 2 + s] = f;
        }
}
#else
DI void v_tr_frags(const char* a0, const char* a1, bf16x8 (&frag)[4]) {
    const unsigned x0 = (unsigned)(size_t)(const LAS char*)a0, x1 = (unsigned)(size_t)(const LAS char*)a1;
    u32x2 r0, r1, r2, r3, r4, r5, r6, r7;
    asm volatile("ds_read_b64_tr_b16 %0, %8\n\tds_read_b64_tr_b16 %1, %8 offset:1024\n\tds_read_b64_tr_b16 %2, %8 offset:2048\n\tds_read_b64_tr_b16 %3, %8 offset:3072\n\t"
                 "ds_read_b64_tr_b16 %4, %9\n\tds_read_b64_tr_b16 %5, %9 offset:1024\n\tds_read_b64_tr_b16 %6, %9 offset:2048\n\tds_read_b64_tr_b16 %7, %9 offset:3072\n\ts_waitcnt lgkmcnt(0)"
                 : "=&v"(r0), "=&v"(r1), "=&v"(r2), "=&v"(r3), "=&v"(r4), "=&v"(r5), "=&v"(r6), "=&v"(r7) : "v"(x0), "v"(x1) : "memory");
    u32x4 f; f.x = r0.x; f.y = r0.y; f.z = r1.x; f.w = r1.y; frag[0] = __builtin_bit_cast(bf16x8, f);
    f.x = r2.x; f.y = r2.y; f.z = r3.x; f.w = r3.y; frag[1] = __builtin_bit_cast(bf16x8, f);
    f.x = r4.x; f.y = r4.y; f.z = r5.x; f.w = r5.y; frag[2] = __builtin_bit_cast(bf16x8, f);
    f.x = r6.x; f.y = r6.y; f.z = r7.x; f.w = r7.y; frag[3] = __builtin_bit_cast(bf16x8, f);
}
#endif
DI void softmax_pv(f32x16& S, f32x16 (&O)[2], float& m_run, float& l_run, const char* va0, const char* va1) {
    float tmax = S[0];
#pragma unroll
    for (int e = 1; e < 16; ++e) tmax = fmaxf(tmax, S[e]);
    tmax = fmaxf(tmax, __shfl_xor(tmax, 32));
    const float mnew = fmaxf(m_run, tmax), alpha = exp2f(m_run - mnew);
    m_run = mnew; l_run *= alpha;
#pragma unroll
    for (int e = 0; e < 16; ++e) { O[0][e] *= alpha; O[1][e] *= alpha; }
    float ps = 0.f; unsigned pk[8];
#pragma unroll
    for (int e = 0; e < 8; ++e) { const float p0 = exp2f(S[2 * e] - mnew), p1 = exp2f(S[2 * e + 1] - mnew); ps += p0 + p1; pk[e] = pack2(p0, p1); }
    l_run += ps;
    u32x4 q0; q0.x = pk[0]; q0.y = pk[1]; q0.z = pk[2]; q0.w = pk[3];
    u32x4 q1; q1.x = pk[4]; q1.y = pk[5]; q1.z = pk[6]; q1.w = pk[7];
    const bf16x8 pb0 = __builtin_bit_cast(bf16x8, q0), pb1 = __builtin_bit_cast(bf16x8, q1);
    bf16x8 vf[4];
    v_tr_frags(va0, va1, vf);
    O[0] = MFMA32(vf[0], pb0, O[0]); O[0] = MFMA32(vf[1], pb1, O[0]);
    O[1] = MFMA32(vf[2], pb0, O[1]); O[1] = MFMA32(vf[3], pb1, O[1]);
}
DI void attn_item(const Params& p, int l, int item, char* smem, bool LAT) {
    const int tid = TIDX(), lane = tid & 63, w = tid >> 6, r = lane & 31, h = lane >> 5;
    const int SL = LAT ? DEC_SEQ : SEQ, NQB = SL / 64;
    const int b = item / (N_KV * NQB), kvh = (item / NQB) % N_KV, q0 = (item % NQB) * 64;
    const int tokbase = (LAT ? TC : 0) + b * SL;
    const bf16* Qb = (const bf16*)(p.ws + WS_Q); const bf16* Kb = (const bf16*)(p.ws + WS_KB); const bf16* Vb = (const bf16*)(p.ws + WS_VB);
    const bf16* GAb = (const bf16*)(p.ws + WS_GA); bf16* mixed = (bf16*)(p.ws + WS_XN);
    char* KL = smem + AT_KL; char* VL = smem + AT_VL; char* KC = smem + AT_KC; char* VC = smem + AT_VC;
    const u32x4 zero4 = {0u, 0u, 0u, 0u};
    if (LAT) {
        for (int id = tid; id < AT_NKL * 8; id += NTHR) {
            const int row = id >> 3, c = id & 7, kp = q0 - 128 + row;
            u32x4 kv = zero4, vv = zero4;
            if (kp >= 0 && kp < SL) { const size_t o = (size_t)(tokbase + kp) * KV_W + kvh * HD + c * 8; kv = *(const u32x4*)(Kb + o); vv = *(const u32x4*)(Vb + o); }
            *(u32x4*)(KL + swz128(row, c)) = kv; *(u32x4*)(VL + swzv(row, c)) = vv;
        }
    }
    {
        const bf16* ksrc; const bf16* vsrc; size_t stride;
        if (LAT) { const size_t o = (size_t)((b * DEPTH + l) * N_KV + kvh) * PAST_LEN * HD; ksrc = (const bf16*)(p.ws + WS_CKB) + o; vsrc = (const bf16*)(p.ws + WS_CVTB) + o; stride = HD; }
        else { ksrc = Kb + (size_t)tokbase * KV_W + kvh * HD; vsrc = Vb + (size_t)tokbase * KV_W + kvh * HD; stride = KV_W; }
        for (int id = tid; id < 256 * 8; id += NTHR) {
            const int row = id >> 3, c = id & 7;
            *(u32x4*)(KC + swz128(row, c)) = *(const u32x4*)(ksrc + (size_t)row * stride + c * 8);
            *(u32x4*)(VC + swzv(row, c)) = *(const u32x4*)(vsrc + (size_t)row * stride + c * 8);
        }
    }
    __syncthreads();
    {
        const int g = w >> 1, qt = w & 1, head = kvh * 4 + g;
        const int qpos = q0 + 32 * qt + r;
        const size_t qtok = (size_t)tokbase + qpos;
        bf16x8 qraw[4], qrot[4];
#pragma unroll
        for (int s = 0; s < 4; ++s) { qraw[s] = *(const bf16x8*)(Qb + qtok * ATTN_W + head * HD + 16 * s + 8 * h); qrot[s] = qraw[s]; }
        if (LAT) {
            const f32x2* rope = (const f32x2*)(p.ws + WS_ROPE);
#pragma unroll
            for (int a = 0; a < 2; ++a)
#pragma unroll
                for (int jj = 0; jj < 8; ++jj) {
                    const f32x2 cs = rope[(qpos * 2 + a) * 16 + 8 * h + jj];
                    const float xa = bf2f((bf16)qraw[2 * a][jj]), xb = bf2f((bf16)qraw[2 * a + 1][jj]);
                    qrot[2 * a][jj] = (short)f2bf(xa * cs.x - xb * cs.y);
                    qrot[2 * a + 1][jj] = (short)f2bf(xb * cs.x + xa * cs.y);
                }
        }
        const int qq = (lane & 15) >> 2, pp = lane & 3, g16 = (lane >> 4) & 1, vrow = 4 * h + qq;
        const int voff0 = swzv(vrow, 2 * g16 + (pp >> 1)) + (pp & 1) * 8, voff1 = swzv(vrow, 4 + 2 * g16 + (pp >> 1)) + (pp & 1) * 8;
        const float c1 = 0.125f * 1.4426950408889634f;
        float m_run = p.in[I_SINK][l * N_HEADS + head] * 1.4426950408889634f, l_run = h == 0 ? 1.f : 0.f;
        f32x16 O[2];
#pragma unroll
        for (int e = 0; e < 16; ++e) { O[0][e] = 0.f; O[1][e] = 0.f; }
        if (LAT) {
            for (int jt = qt; jt < qt + 9; ++jt) {
                f32x16 S;
#pragma unroll
                for (int e = 0; e < 16; ++e) S[e] = 0.f;
                const int krow = 32 * jt + r;
#pragma unroll
                for (int s = 0; s < 4; ++s) S = MFMA32(*(const bf16x8*)(KL + swz128(krow, 2 * s + h)), qrot[s], S);
#pragma unroll
                for (int e = 0; e < 16; ++e) {
                    const int kp = q0 - 128 + 32 * jt + (e & 3) + 8 * (e >> 2) + 4 * h, dd = kp - qpos;
                    const bool ok = dd <= 128 && dd >= -128 && kp >= 0 && kp < SL;
                    S[e] = ok ? S[e] * c1 : -1e30f;
                }
                softmax_pv(S, O, m_run, l_run, VL + 4096 * jt + voff0, VL + 4096 * jt + voff1);
            }
        }
        for (int jt = 0; jt < 8; ++jt) {
            f32x16 S;
#pragma unroll
            for (int e = 0; e < 16; ++e) S[e] = 0.f;
            const int krow = 32 * jt + r;
#pragma unroll
            for (int s = 0; s < 4; ++s) S = MFMA32(*(const bf16x8*)(KC + swz128(krow, 2 * s + h)), qraw[s], S);
#pragma unroll
            for (int e = 0; e < 16; ++e) S[e] *= c1;
            softmax_pv(S, O, m_run, l_run, VC + 4096 * jt + voff0, VC + 4096 * jt + voff1);
        }
        const float inv = 1.f / (l_run + __shfl_xor(l_run, 32));
#pragma unroll
        for (int dt = 0; dt < 2; ++dt)
#pragma unroll
            for (int rg = 0; rg < 4; ++rg) {
                const int d0 = dt * 32 + 8 * rg + 4 * h;
                const u32x2 gv = *(const u32x2*)(GAb + qtok * ATTN_W + head * HD + d0);
                const float g0 = bf2f((bf16)(gv.x & 0xffffu)), g1 = bf2f((bf16)(gv.x >> 16)), g2 = bf2f((bf16)(gv.y & 0xffffu)), g3 = bf2f((bf16)(gv.y >> 16));
                u32x2 o; o.x = pack2(O[dt][4 * rg] * inv * g0, O[dt][4 * rg + 1] * inv * g1); o.y = pack2(O[dt][4 * rg + 2] * inv * g2, O[dt][4 * rg + 3] * inv * g3);
                *(u32x2*)(mixed + qtok * MIX_W + head * HD + d0) = o;
            }
    }
    __syncthreads();
}

DI void phase_p0(const Params& p_, char* smem) {
    constexpr int I_T1 = DEPTH * (D_MODEL / 64) * (IN_COLS / 64), I_T2 = DEPTH * (MIX_W / 64) * (D_MODEL / 64);
    constexpr int I_MOD = DEPTH * ((3 * D_MODEL + 511) / 512), I_ROPE = DEC_SEQ * 32 / NTHR, I_HID = (DEPTH * (SEQ + DEC_SEQ) + 7) / 8;
    constexpr int I_CACHE = (2 * DEC_BATCH * DEPTH * PAST_LEN * KV_W / 8 + NTHR - 1) / NTHR;
    constexpr int I_TW = (TW_TOTAL + NTHR - 1) / NTHR;
    constexpr int TOTAL = I_T1 + I_T2 + I_MOD + I_ROPE + I_HID + I_CACHE + I_TW;
    for (int it = BIDX(); it < TOTAL; it += gridDim.x) {
        const Params p = launder(p_);
        int q = it;
        if (q < I_T1 + I_T2) {
            const bool w1 = q < I_T1; if (!w1) q -= I_T1;
            const int per = w1 ? (D_MODEL / 64) * (IN_COLS / 64) : (MIX_W / 64) * (D_MODEL / 64), l = q / per;
            if (w1) p0_transpose_item(p.in[I_WIN] + (size_t)l * D_MODEL * IN_COLS, D_MODEL, IN_COLS, (bf16*)(p.ws + WS_WINT) + (size_t)l * IN_COLS * D_MODEL, q % per, smem);
            else p0_transpose_item(p.in[I_WOUT] + (size_t)l * MIX_W * D_MODEL, MIX_W, D_MODEL, (bf16*)(p.ws + WS_WOUTT) + (size_t)l * D_MODEL * MIX_W, q % per, smem);
            continue; }
        q -= I_T1 + I_T2;
        if (q < I_MOD) { p0_mod_item(p, q, smem); continue; }
        q -= I_MOD;
        if (q < I_ROPE) { p0_rope_item(p, q); continue; }
        q -= I_ROPE;
        if (q < I_HID) { p0_hid2_item(p, q); continue; }
        q -= I_HID;
        if (q < I_CACHE) { p0_cache_item(p, q); continue; }
        q -= I_CACHE;
        p0_twiddle_item(p, q);
    }
}
DI void phase_mix(const Params& p_, int l, int fl, char* smem, int mask) {
    constexpr int I_HL = HYENA_W * ((DEC_BATCH / 2 + 1) / 2), I_AL = DEC_BATCH * N_KV * (DEC_SEQ / 64), I_AC = BATCH * N_KV * (SEQ / 64);
    constexpr int I_HC = HYENA_W / 2, I_SC = T / 64, I_FL = HYENA_W, I_FC = HYENA_W / 16, I_NRM = T / 8;
    static_assert(BATCH / 2 <= 16, "ctx hyena: one bank holds 16 batch pairs");
    for (int it = BIDX(); it < I_FL + I_FC + I_HL + I_HC + I_AL + I_AC + I_SC + I_NRM; it += gridDim.x) {
        const Params p = launder(p_);
        int q = it;
        if (q < I_FL + I_FC) { const bool lat = q < I_FL; if (mask & 64) filter_item(p, fl, lat ? q : q - I_FL, smem, lat); continue; }
        q -= I_FL + I_FC;
        if (q < I_HL + I_HC) { const bool lat = q < I_HL; if (mask & (lat ? 1 : 2)) hyena_item(p, l, lat ? q : q - I_HL, smem, lat); continue; }
        q -= I_HL + I_HC;
        if (q < I_AL + I_AC) { const bool lat = q < I_AL; if (mask & (lat ? 4 : 8)) attn_item(p, l, lat ? q : q - I_AL, smem, lat); continue; }
        q -= I_AL + I_AC;
        if (q < I_SC) { if (mask & 16) shortconv_item(p, l, q); continue; }
        q -= I_SC;
        if (mask & 32) norm_item(p, 0, q);
    }
}
DI void phase_norm(const Params& p, int l) {
    for (int it = BIDX(); it < T / 8; it += gridDim.x) norm_item(p, l, it);
}
DI void phase_hytr(const Params& p, char* smem) {
    for (int it = BIDX(); it < T / 64; it += gridDim.x) hytr_item(p, it, smem);
}

#ifndef PH_STOP
#define PH_STOP 1000
#endif
#ifndef DUP
#define DUP -1
#endif
#ifndef DMASK
#define DMASK 31
#endif
__global__ void __launch_bounds__(NTHR, 2) fwd_kernel(Params p_) {
#ifdef EMU
    char* smem = emu_smem();
#else
    extern __shared__ __attribute__((aligned(16))) char smem[];
    volatile LAS unsigned* xst = (volatile LAS unsigned*)(smem + LDS_BYTES - 16);
    if (TIDX() == 0) { xst[0] = 0u; xst[1] = 0u; }
    __syncthreads();
    const XcdBarrier xbar = xcd_barrier_post((unsigned*)(p_.ws + WS_BAR), xst);
#endif
    constexpr int NPH = 2 + 5 * DEPTH;
#pragma unroll 1
    for (int ph = 0; ph < NPH && ph < PH_STOP; ++ph) {
#pragma unroll 1
        for (int rep = 0; rep < (ph == DUP ? 2 : 1); ++rep) {
            const Params p = launder(p_);
            const int l = ph >= 2 ? (ph - 2) / 5 : 0, k = ph >= 2 ? (ph - 2) % 5 : -1;
            if (ph == 0) phase_p0(p, smem);
            else if (ph == 1 || k == 1) {
                const int mask = rep ? DMASK : (ph == 1 ? 32 + 64 : 31 + (l + 1 < DEPTH ? 64 : 0));
                phase_mix(p, l, ph == 1 ? 0 : l + 1, smem, mask);
            } else if (k == 0 || k == 3) {
                GemmJob job; job.p = p; job.mode = k == 0 ? 0 : 1; job.l = l; job.K = k == 0 ? D_MODEL : MIX_W;
                gemm_phase((ldsptr_t)smem, job);
            } else if (k == 2) phase_hytr(p, smem);
            else phase_norm(p, l + 1);
        }
        if (ph + 1 < NPH) GRID_SYNC();
    }
}

#ifndef EMU
extern "C" void kernel_launch(void* const* d_in, const int* in_sizes, int n_in, void* d_out, int out_size, void* d_ws, size_t ws_size, hipStream_t stream) {
    static int grid = 0;
    if (grid == 0) {
        if (n_in != 22 || (size_t)out_size != OUT_TOTAL || ws_size < WS_END) { fprintf(stderr, "kernel_launch: unexpected sizes n_in %d out %d ws %zu (need %zu)\n", n_in, out_size, ws_size, (size_t)WS_END); grid = -1; return; }
        int dev = 0, cus = 0, per_cu = 0;
        hipGetDevice(&dev); hipDeviceGetAttribute(&cus, hipDeviceAttributeMultiprocessorCount, dev);
        if (hipFuncSetAttribute((const void*)fwd_kernel, hipFuncAttributeMaxDynamicSharedMemorySize, LDS_BYTES) != hipSuccess) { fprintf(stderr, "hipFuncSetAttribute failed\n"); grid = -1; return; }
        hipOccupancyMaxActiveBlocksPerMultiprocessor(&per_cu, (const void*)fwd_kernel, NTHR, LDS_BYTES);
        if (per_cu < 1) { fprintf(stderr, "occupancy query says %d\n", per_cu); grid = -1; return; }
        grid = cus;
    }
    if (grid < 0) return;
    Params p{};
    for (int i = 0; i < 22; ++i) p.in[i] = (const float*)d_in[i];
    p.out = (float*)d_out; p.ws = (unsigned char*)d_ws;
    if (hipMemsetAsync((char*)d_ws + WS_BAR, 0, XCD_BAR_WORDS * 4, stream) != hipSuccess) { fprintf(stderr, "memset failed\n"); return; }
    hipLaunchKernelGGL(fwd_kernel, dim3(grid), dim3(NTHR), LDS_BYTES, stream, p);
    const hipError_t e = hipPeekAtLastError();
    if (e != hipSuccess) fprintf(stderr, "launch failed: %s (grid %d)\n", hipGetErrorString(e), grid);
}
#endif
```

```cpp
#ifdef EMU
#include "emu.h"
#define GRID_SYNC() emu_grid_sync()
#define MFMA32(a, b, c) emu_mfma32((a), (b), (c))
#define MFMA16(a, b, c) emu_mfma16((a), (b), (c))
#define LAS
#define GLDS16(g, l) emu_glds16((const void*)(g), (void*)(l))
#define S_BARRIER() __syncthreads()
#define WAIT_V(n)
#define WAIT_L(n)
#define SCHED_BAR()
#define SETPRIO(x)
#define RFL(x) (x)
#define CBAR()
#define OPQ(x) (x)
#define TIDX() ((int)threadIdx.x)
#define BIDX() ((int)blockIdx.x)
#else
#include <hip/hip_runtime.h>
#include <cstdio>
#include <cstdint>
typedef short bf16x8 __attribute__((ext_vector_type(8)));
typedef float f32x16 __attribute__((ext_vector_type(16)));
typedef float f32x4 __attribute__((ext_vector_type(4)));
#define GRID_SYNC() xcd_barrier(xbar)
#define MFMA32(a, b, c) __builtin_amdgcn_mfma_f32_32x32x16_bf16((a), (b), (c), 0, 0, 0)
#define MFMA16(a, b, c) __builtin_amdgcn_mfma_f32_16x16x32_bf16((a), (b), (c), 0, 0, 0)
#define LAS __attribute__((address_space(3)))
#define GLDS16(g, l) __builtin_amdgcn_global_load_lds((const unsigned*)(g), (LAS unsigned*)(l), 16, 0, 0)
#define S_BARRIER() __builtin_amdgcn_s_barrier()
#define WAIT_V(n) asm volatile("s_waitcnt vmcnt(" #n ")" ::: "memory")
#define WAIT_L(n) asm volatile("s_waitcnt lgkmcnt(" #n ")" ::: "memory")
#define SCHED_BAR() __builtin_amdgcn_sched_barrier(0)
#define SETPRIO(x) __builtin_amdgcn_s_setprio(x)
#define RFL(x) __builtin_amdgcn_readfirstlane(x)
#define CBAR() asm volatile("" ::: "memory")
__device__ __forceinline__ int opq_(int x) { asm volatile("" : "+v"(x)); return x; }
#define OPQ(x) opq_(x)
__device__ __forceinline__ int tidx_() { int t = threadIdx.x; asm volatile("" : "+v"(t)); return t; }
__device__ __forceinline__ int bidx_() { int t = blockIdx.x; asm volatile("" : "+s"(t)); return t; }
#define TIDX() tidx_()
#define BIDX() bidx_()
#endif
typedef unsigned u32x4 __attribute__((ext_vector_type(4)));
typedef unsigned u32x2 __attribute__((ext_vector_type(2)));
typedef float f32x2 __attribute__((ext_vector_type(2)));
typedef unsigned short bf16;
#define DI __device__ __forceinline__

#ifdef CFG_SMALL
constexpr int D_MODEL = 256, BATCH = 2, SEQ = 256, DEPTH = 2, DEC_BATCH = 4, DEC_SEQ = 4096, PAST_LEN = 256, HYENA_W = 128, CONV_W = 128;
#else
constexpr int D_MODEL = 1024, BATCH = 32, SEQ = 256, DEPTH = 4, DEC_BATCH = 8, DEC_SEQ = 4096, PAST_LEN = 256, HYENA_W = 256, CONV_W = 256;
#endif
constexpr int GRID_W = 64, N_HEADS = 8, N_KV = 2, HD = 64, ATTN_W = 512, KV_W = 128;
constexpr int MIX_W = ATTN_W + HYENA_W + CONV_W;
constexpr int C_Q = 0, C_K = ATTN_W, C_V = C_K + KV_W, C_GA = C_V + KV_W, C_HV = C_GA + ATTN_W, C_GH = C_HV + 3 * HYENA_W,
              C_SB = C_GH + HYENA_W, C_GC = C_SB + 3 * CONV_W, IN_COLS = C_GC + CONV_W;
constexpr int TC = BATCH * SEQ, TL = DEC_BATCH * DEC_SEQ, T = TC + TL;
constexpr int NR = 1 + DEC_BATCH;
constexpr int FH = 64, FE = 33;
constexpr int NTHR = 512;
static_assert(T % 256 == 0 && TC % 256 == 0 && C_HV % 256 == 0 && C_SB % 256 == 0 && IN_COLS % 256 == 0 && D_MODEL % 256 == 0 && MIX_W % 128 == 0 && (4 * HYENA_W) % 256 == 0, "tiling");
static_assert(SEQ == 256 && DEC_SEQ == 4096 && PAST_LEN == 256, "fft sizes");

constexpr size_t al256(size_t x) { return (x + 255) & ~(size_t)255; }
constexpr size_t WS_BAR = 0;
constexpr size_t WS_WINT = 65536;
constexpr size_t WS_WOUTT = WS_WINT + al256((size_t)DEPTH * IN_COLS * D_MODEL * 2);
constexpr size_t WS_MOD = WS_WOUTT + al256((size_t)DEPTH * D_MODEL * MIX_W * 2);
constexpr size_t WS_ROPE = WS_MOD + al256((size_t)DEPTH * NR * 3 * D_MODEL * 4);
constexpr size_t WS_HID2 = WS_ROPE + al256((size_t)DEC_SEQ * 32 * 8);
constexpr size_t WS_CKB = WS_HID2 + al256((size_t)DEPTH * (SEQ + DEC_SEQ) * FH * 4);
constexpr size_t WS_CVTB = WS_CKB + al256((size_t)DEC_BATCH * DEPTH * PAST_LEN * KV_W * 2);
constexpr size_t WS_KFL = WS_CVTB + al256((size_t)DEC_BATCH * DEPTH * PAST_LEN * KV_W * 2);
constexpr size_t KFL_BYTES = al256((size_t)2 * HYENA_W * 8192 * 8), KFC_BYTES = al256((size_t)2 * HYENA_W * 512 * 8);
constexpr size_t WS_KFC = WS_KFL + 2 * KFL_BYTES;
constexpr size_t WS_TW = WS_KFC + 2 * KFC_BYTES;
constexpr size_t WS_ZS = WS_TW + al256((size_t)12270 * 8);
constexpr size_t WS_XN = WS_ZS + (size_t)256 * 2 * 4096 * 8;
constexpr size_t WS_Q = WS_XN + al256((size_t)T * (D_MODEL > MIX_W ? D_MODEL : MIX_W) * 2);
constexpr size_t WS_KB = WS_Q + al256((size_t)T * ATTN_W * 2);
constexpr size_t WS_VB = WS_KB + al256((size_t)T * KV_W * 2);
constexpr size_t WS_GA = WS_VB + al256((size_t)T * KV_W * 2);
constexpr size_t WS_HYT = WS_GA + al256((size_t)T * ATTN_W * 2);
constexpr size_t WS_SC = WS_HYT + al256((size_t)4 * HYENA_W * T * 2);
constexpr size_t WS_END0 = WS_SC + al256((size_t)T * 4 * CONV_W * 2);
#ifndef DUP
#define DUP -1
#endif
constexpr size_t WS_ZT = DUP >= 0 ? WS_END0 : WS_HYT;
constexpr size_t WS_END = WS_END0 + (DUP >= 0 ? al256((size_t)HYENA_W * T * 2) : 0);

constexpr size_t OUT_YS = (size_t)TC * D_MODEL, OUT_NK = (size_t)T * D_MODEL, OUT_NV = OUT_NK + (size_t)BATCH * DEPTH * SEQ * KV_W,
                 OUT_TOTAL = OUT_NV + (size_t)BATCH * DEPTH * SEQ * KV_W;

constexpr int LDS_BYTES = 149504;

struct Params {
    const float* in[22];
    float* out;
    unsigned char* ws;
};
enum { I_XP = 0, I_XS, I_CK, I_CV, I_C, I_CCTX, I_NORMG, I_MODW, I_MODB, I_WIN, I_SINK, I_HYCW, I_FW1, I_FB1, I_FW2, I_FB2, I_FW3, I_FFREQ, I_HYD, I_SCW, I_WOUT, I_FINALG };

DI bf16 f2bf(float f) { unsigned u = __float_as_uint(f); u += 0x7fffu + ((u >> 16) & 1u); return (bf16)(u >> 16); }
DI float bf2f(bf16 h) { return __uint_as_float(((unsigned)h) << 16); }
#ifdef EMU
DI unsigned pack2(float a, float b) { return (unsigned)f2bf(a) | ((unsigned)f2bf(b) << 16); }
DI float silu_f(float x) { return x / (1.f + __expf(-x)); }
#else
DI unsigned pack2(float a, float b) { unsigned r; asm("v_cvt_pk_bf16_f32 %0, %1, %2" : "=v"(r) : "v"(a), "v"(b)); return r; }
DI float silu_f(float x) { return x * __builtin_amdgcn_rcpf(1.f + __builtin_amdgcn_exp2f(x * -1.4426950408889634f)); }
#endif
typedef float cpx __attribute__((ext_vector_type(2)));
DI cpx cmul(cpx a, cpx b) { cpx r = b * a.x; r += cpx{-b.y, b.x} * a.y; return r; }
#ifdef EMU
DI Params launder(const Params& p) { return p; }
#else
DI Params launder(const Params& p) { Params q = p; int z = 0; asm volatile("" : "+s"(z)); q.ws = p.ws + z; q.out = p.out + z; return q; }
#endif
DI int mod_row(int m) { return m < TC ? 0 : 1 + (m - TC) / DEC_SEQ; }


#ifndef EMU
#define XB_TMO      128
#define XB_XCNT(j)  (256  + 64 * (j))
#define XB_XSUB(j)  (1280 + 64 * (j))
#define XB_XGEN(j)  (2304 + 64 * (j))
#define XB_TOP      3328
#define XB_TOPGEN   3392
#define XCD_BAR_WORDS 3456
#define XB_SPIN_CAP (1u << 22)
DI unsigned xb_ld(unsigned* p) { return __hip_atomic_load(p, __ATOMIC_RELAXED, __HIP_MEMORY_SCOPE_AGENT); }
DI unsigned xb_add(unsigned* p, unsigned v) { return __hip_atomic_fetch_add(p, v, __ATOMIC_RELAXED, __HIP_MEMORY_SCOPE_AGENT); }
DI unsigned xb_xcc_id() { return (unsigned)__builtin_amdgcn_s_getreg((3 << 11) | 20) & 0xFu; }
#define XB_SPIN(cond, bar) do { unsigned _sp = 0; while (cond) { __builtin_amdgcn_s_sleep(1); \
    if ((++_sp & 255u) == 0u) { if (xb_ld(&(bar)[XB_TMO])) break; if (_sp > XB_SPIN_CAP) { atomicAdd(&(bar)[XB_TMO], 1u); break; } } } } while (0)
struct XcdBarrier { unsigned* bar; unsigned x; volatile LAS unsigned* st; };
DI XcdBarrier xcd_barrier_post(unsigned* bar, volatile LAS unsigned* st) {
    XcdBarrier b; b.bar = bar; b.x = xb_xcc_id(); b.st = st;
    if (TIDX() == 0) (void)xb_add(&bar[XB_XCNT(b.x)], 1u);
    return b;
}
DI void xcd_barrier_complete(unsigned* bar, unsigned x, unsigned& nloc, unsigned& nx) {
    const unsigned G = gridDim.x * gridDim.y * gridDim.z;
    unsigned sum, cnt, mine, sp = 0u;
    for (;;) {
        sum = 0u; cnt = 0u; mine = 0u;
#pragma unroll
        for (unsigned j = 0; j < 16; ++j) { const unsigned c = xb_ld(&bar[XB_XCNT(j)]); sum += c; cnt += (c > 0u) ? 1u : 0u; mine = (j == x) ? c : mine; }
        if (sum == G) break;
        __builtin_amdgcn_s_sleep(1);
        if ((++sp & 255u) == 0u) { if (xb_ld(&bar[XB_TMO])) break; if (sp > XB_SPIN_CAP) { atomicAdd(&bar[XB_TMO], 1u); break; } }
    }
    nloc = mine > 0u ? mine : 1u; nx = cnt > 0u ? cnt : 1u;
}
DI void xcd_barrier(const XcdBarrier& b) {
    asm volatile("s_waitcnt vmcnt(0)" ::: "memory");
    __syncthreads();
    if (TIDX() == 0) {
        unsigned* bar = b.bar;
        __builtin_amdgcn_s_waitcnt(0);
        unsigned nloc = b.st[0], nx = b.st[1];
        if (nloc == 0u) { xcd_barrier_complete(bar, b.x, nloc, nx); b.st[0] = nloc; b.st[1] = nx; }
        const unsigned old = xb_add(&bar[XB_XSUB(b.x)], 1u);
        const unsigned gen = old / nloc;
        if (old + 1u == (gen + 1u) * nloc) {
            __builtin_amdgcn_fence(__ATOMIC_RELEASE, "agent");
            asm volatile("s_waitcnt vmcnt(0)" ::: "memory");
            const unsigned og = xb_add(&bar[XB_TOP], 1u);
            const unsigned tg = og / nx;
            if (og + 1u == (tg + 1u) * nx) xb_add(&bar[XB_TOPGEN], 1u);
            else XB_SPIN(xb_ld(&bar[XB_TOPGEN]) == tg, bar);
            __builtin_amdgcn_fence(__ATOMIC_ACQUIRE, "agent");
            xb_add(&bar[XB_XGEN(b.x)], 1u);
            asm volatile("s_waitcnt vmcnt(0)" ::: "memory");
        } else {
            XB_SPIN(xb_ld(&bar[XB_XGEN(b.x)]) == gen, bar);
            __builtin_amdgcn_fence(__ATOMIC_ACQUIRE, "agent");
            asm volatile("s_waitcnt vmcnt(0)" ::: "memory");
        }
    }
    __syncthreads();
}
#endif

DI void p0_transpose_item(const float* W, int K, int N, bf16* WT, int item, char* smem) {
    float* scr = (float*)smem;
    const int tid = TIDX(), nblk = N / 64, k0 = (item / nblk) * 64, n0 = (item % nblk) * 64;
#pragma unroll
    for (int i = 0; i < 8; ++i) { const int kk = (tid >> 6) + 8 * i, nn = tid & 63; scr[kk * 65 + nn] = W[(size_t)(k0 + kk) * N + n0 + nn]; }
    __syncthreads();
    const int n = tid >> 3, c = tid & 7;
    const float* s = scr + (8 * c) * 65 + n;
    u32x4 o; o.x = pack2(s[0], s[65]); o.y = pack2(s[2 * 65], s[3 * 65]); o.z = pack2(s[4 * 65], s[5 * 65]); o.w = pack2(s[6 * 65], s[7 * 65]);
    *(u32x4*)(WT + (size_t)(n0 + n) * K + k0 + 8 * c) = o;
    __syncthreads();
}
DI void p0_mod_item(const Params& p, int item, char* smem) {
    constexpr int NCH = (3 * D_MODEL + 511) / 512;
    float* tab = (float*)smem;
    const int tid = TIDX(), l = item / NCH, col = (item % NCH) * 512 + tid;
    for (int e = tid; e < NR * D_MODEL; e += NTHR) { const int r = e / D_MODEL, k = e % D_MODEL; const float cv = r == 0 ? p.in[I_CCTX][k] : p.in[I_C][(size_t)(r - 1) * D_MODEL + k]; tab[e] = silu_f(cv); }
    __syncthreads();
    if (col < 3 * D_MODEL) {
        float acc[NR];
#pragma unroll
        for (int r = 0; r < NR; ++r) acc[r] = 0.f;
        const float* w = p.in[I_MODW] + (size_t)l * D_MODEL * 3 * D_MODEL + col;
        for (int k = 0; k < D_MODEL; ++k) { const float wv = w[(size_t)k * 3 * D_MODEL];
#pragma unroll
            for (int r = 0; r < NR; ++r) acc[r] += tab[r * D_MODEL + k] * wv; }
        const float bv = p.in[I_MODB][(size_t)l * 3 * D_MODEL + col];
        float* mod = (float*)(p.ws + WS_MOD);
#pragma unroll
        for (int r = 0; r < NR; ++r) mod[((size_t)l * NR + r) * 3 * D_MODEL + col] = acc[r] + bv;
    }
    __syncthreads();
}
DI void p0_rope_item(const Params& p, int item) {
    const int e = item * NTHR + TIDX();
    if (e < DEC_SEQ * 32) {
        const int t = e >> 5, a = (e >> 4) & 1, f = e & 15;
        const float pos = (float)(a ? (t % GRID_W) : (t / GRID_W));
        const float inv = exp2f(-(float)f * (13.287712379549449f / 16.f));
        const float ang = pos * inv;
        f32x2 v; v.x = cosf(ang); v.y = sinf(ang);
        ((f32x2*)(p.ws + WS_ROPE))[e] = v;
    }
}
DI void p0_hid2_item(const Params& p, int item) {
    const int lane = TIDX() & 63, w = TIDX() >> 6;
    const int rr = item * 8 + w;
    if (rr >= DEPTH * (SEQ + DEC_SEQ)) return;
    const int l = rr / (SEQ + DEC_SEQ), q = rr % (SEQ + DEC_SEQ);
    const int L = q < SEQ ? SEQ : DEC_SEQ, t = q < SEQ ? q : q - SEQ;
    float feat = 0.f;
    if (lane == 0) feat = (float)t / (float)(L - 1);
    else if (lane < FE) {
        const int b = (lane - 1) & 15;
        const float fr = 1e-4f + (float)b * ((15.f - 1e-4f) / 15.f);
        const float ang = (6.283185307179586f / (float)L) * (float)t;
        feat = lane <= 16 ? cosf(fr * ang) : -sinf(fr * ang);
    }
    const float* w1 = p.in[I_FW1] + (size_t)l * FE * FH; const float* w2 = p.in[I_FW2] + (size_t)l * FH * FH;
    const float fq = p.in[I_FFREQ][l * FH + lane];
    float a1 = p.in[I_FB1][l * FH + lane];
    for (int i = 0; i < FE; ++i) a1 += __shfl(feat, i) * w1[i * FH + lane];
    const float h1 = sinf(fq * a1);
    float a2 = p.in[I_FB2][l * FH + lane];
    for (int i = 0; i < FH; ++i) a2 += __shfl(h1, i) * w2[i * FH + lane];
    const float h2 = sinf(fq * a2);
    ((float*)(p.ws + WS_HID2))[(size_t)l * (SEQ + DEC_SEQ) * FH + (q < SEQ ? 0 : (size_t)SEQ * FH) + (size_t)lane * L + t] = h2;
}
DI void p0_cache_item(const Params& p, int item) {
    constexpr int NCHUNK = DEC_BATCH * DEPTH * PAST_LEN * KV_W / 8;
    int e = item * NTHR + TIDX();
    if (e < 2 * NCHUNK) {
        const bool isv = e >= NCHUNK; if (isv) e -= NCHUNK;
        const int c8 = e & 7, j = (e >> 3) % PAST_LEN, kvh = (e >> 3) / PAST_LEN % N_KV, bl = (e >> 3) / PAST_LEN / N_KV;
        const float* src = p.in[isv ? I_CV : I_CK] + ((size_t)(bl * PAST_LEN + j) * N_KV + kvh) * HD + c8 * 8;
        u32x4 o; o.x = pack2(src[0], src[1]); o.y = pack2(src[2], src[3]); o.z = pack2(src[4], src[5]); o.w = pack2(src[6], src[7]);
        *(u32x4*)((bf16*)(p.ws + (isv ? WS_CVTB : WS_CKB)) + (size_t)e * 8) = o;
    }
}

DI const float* x_row_src(const Params& p, int l, int m) {
    if (l == 0) return m < TC ? p.in[I_XP] + (size_t)m * D_MODEL : p.in[I_XS] + (size_t)(m - TC) * D_MODEL;
    return p.out + (size_t)m * D_MODEL;
}
DI void norm_item(const Params& p, int l, int item) {
    const int lane = TIDX() & 63, w = TIDX() >> 6, m = item * 8 + w;
    if (m >= T) return;
    const float* xr = x_row_src(p, l, m);
    float ss = 0.f;
    for (int c4 = lane; c4 < D_MODEL / 4; c4 += 64) { const f32x4 v = *(const f32x4*)(xr + 4 * c4); ss += v.x * v.x + v.y * v.y + v.z * v.z + v.w * v.w; }
#pragma unroll
    for (int o = 1; o < 64; o <<= 1) ss += __shfl_xor(ss, o);
    const float rstd = rsqrtf(ss * (1.f / D_MODEL) + 1e-6f);
    if (l < DEPTH) {
        const float* g = p.in[I_NORMG] + (size_t)l * D_MODEL;
        const float* mod = (const float*)(p.ws + WS_MOD) + ((size_t)l * NR + mod_row(m)) * 3 * D_MODEL;
        bf16* xn = (bf16*)(p.ws + WS_XN) + (size_t)m * D_MODEL;
        for (int c4 = lane; c4 < D_MODEL / 4; c4 += 64) {
            const f32x4 v = *(const f32x4*)(xr + 4 * c4), gv = *(const f32x4*)(g + 4 * c4), sh = *(const f32x4*)(mod + 4 * c4), sc = *(const f32x4*)(mod + D_MODEL + 4 * c4);
            u32x2 o; o.x = pack2(v.x * rstd * gv.x * (1.f + sc.x) + sh.x, v.y * rstd * gv.y * (1.f + sc.y) + sh.y);
            o.y = pack2(v.z * rstd * gv.z * (1.f + sc.z) + sh.z, v.w * rstd * gv.w * (1.f + sc.w) + sh.w);
            *(u32x2*)(xn + 4 * c4) = o;
        }
    } else {
        const float* g = p.in[I_FINALG];
        float* yo = p.out + (size_t)m * D_MODEL;
        for (int c4 = lane; c4 < D_MODEL / 4; c4 += 64) {
            const f32x4 v = *(const f32x4*)(xr + 4 * c4), gv = *(const f32x4*)(g + 4 * c4);
            f32x4 o; o.x = v.x * rstd * gv.x; o.y = v.y * rstd * gv.y; o.z = v.z * rstd * gv.z; o.w = v.w * rstd * gv.w;
            *(f32x4*)(yo + 4 * c4) = o;
        }
    }
}

DI int swz128(int row, int c) { return row * 128 + ((c ^ ((row >> 1) & 7)) << 4); }
constexpr int BM = 256, BK = 64, HALFT = 128, HTB = HALFT * BK * 2, STAGE_BYTES = 8 * HTB;
static_assert(STAGE_BYTES <= LDS_BYTES - 16 && 2 * 8704 * 8 + 128 <= LDS_BYTES - 16, "lds");
DI int lds_byte(int r, int c) { const int st = (r >> 4) * 2 + (c >> 5), rr = r & 15, cc = c & 31, ob = rr * 64 + cc * 2; return st * 1024 + (ob ^ (((ob >> 9) & 1) << 5)); }
DI void stage_rc(int b, int& R, int& C) { const int st = b / 1024, sb = b % 1024, swz = sb ^ (((sb >> 9) & 1) << 5); R = (st >> 1) * 16 + swz / 64; C = (st & 1) * 32 + (swz % 64) / 2; }
DI int perm32(int rho) { const int n = rho >> 4, i = rho & 15; return 8 * (i >> 2) + 4 * n + (i & 3); }
struct Unit { int pm, pn, kind; };
DI void static_order(int L, int nM, int nN, int& pm, int& pn) {
    constexpr int NXCD = 8, WGM = 8;
    const int nwg = nM * nN;
    int wgid = L; { const int q = nwg / NXCD, r = nwg % NXCD, xcd = wgid % NXCD, off = wgid / NXCD; wgid = (xcd < r ? xcd * (q + 1) : r * (q + 1) + (xcd - r) * q) + off; }
    const int nig = WGM * nN, gid = wgid / nig, fm = gid * WGM, gsz = (nM - fm) < WGM ? (nM - fm) : WGM;
    pm = fm + ((wgid % nig) % gsz); pn = (wgid % nig) / gsz;
}
constexpr int NT_TOK = (IN_COLS - 4 * HYENA_W) / 256, NT_TOKA = C_HV / 256, NT_CH = 4 * HYENA_W / 256, NTM = T / 256;
constexpr int NU_TOK = NTM * NT_TOK, NU_CH = NT_CH * NTM, NU_OUT = NTM * (D_MODEL / 256);
struct GemmJob {
    Params p; int mode, l, K;
    DI bool next(int i, Unit& u) const {
        const int L = i * (int)gridDim.x + BIDX();
        if (mode == 0) {
            if (L < NU_TOK) { u.kind = 0; static_order(L, NTM, NT_TOK, u.pm, u.pn); return true; }
            if (L < NU_TOK + NU_CH) { u.kind = 1; static_order(L - NU_TOK, NT_CH, NTM, u.pm, u.pn); return true; }
            return false;
        }
        if (L < NU_OUT) { u.kind = 2; static_order(L, NTM, D_MODEL / 256, u.pm, u.pn); return true; }
        return false;
    }
    DI int tokcol(int pn) const { return pn < NT_TOKA ? pn * 256 : C_SB + (pn - NT_TOKA) * 256; }
    DI void ptrs(const Unit& u, const char*& a, const char*& b) const {
        const size_t rb = (size_t)K * 2;
        const char* xn = (const char*)(p.ws + WS_XN);
        if (u.kind == 0) { a = xn + (size_t)u.pm * 256 * rb; b = (const char*)(p.ws + WS_WINT) + ((size_t)l * IN_COLS + tokcol(u.pn)) * rb; }
        else if (u.kind == 1) { a = (const char*)(p.ws + WS_WINT) + ((size_t)l * IN_COLS + C_HV + u.pm * 256) * rb; b = xn + (size_t)u.pn * 256 * rb; }
        else { a = xn + (size_t)u.pm * 256 * rb; b = (const char*)(p.ws + WS_WOUTT) + ((size_t)l * D_MODEL + u.pn * 256) * rb; }
    }
    DI void epilogue(const f32x4 (&acc)[2][2][4][2], const Unit& u, int wr, int wc, int fr, int fq) const {
        if (u.kind == 0) {
            const bool ctx = u.pm * 256 < TC;
#pragma unroll 1
            for (int bj = 0; bj < 2; ++bj) {
                const int n0 = tokcol(u.pn) + 128 * bj, c0 = n0 + 32 * wc + 8 * fq;
                bf16* dst; int ld; bool sil = false; int special = 0;
                if (n0 < C_K) { dst = (bf16*)(p.ws + WS_Q) + c0; ld = ATTN_W; }
                else if (n0 < C_V) { dst = (bf16*)(p.ws + WS_KB) + (c0 - C_K); ld = KV_W; special = 1; }
                else if (n0 < C_GA) { dst = (bf16*)(p.ws + WS_VB) + (c0 - C_V); ld = KV_W; special = 2; }
                else if (n0 < C_HV) { dst = (bf16*)(p.ws + WS_GA) + (c0 - C_GA); ld = ATTN_W; sil = true; }
                else { dst = (bf16*)(p.ws + WS_SC) + (c0 - C_SB); ld = 4 * CONV_W; sil = n0 >= C_GC; }
#pragma unroll
                for (int ai = 0; ai < 2; ++ai)
#pragma unroll
                    for (int m = 0; m < 4; ++m) {
                        const int row = u.pm * 256 + 64 * wr + fr + OPQ(128 * ai + 16 * m);
                        f32x4 v0 = bj ? acc[ai][1][m][0] : acc[ai][0][m][0], v1 = bj ? acc[ai][1][m][1] : acc[ai][0][m][1];
                        if (sil) { v0.x = silu_f(v0.x); v0.y = silu_f(v0.y); v0.z = silu_f(v0.z); v0.w = silu_f(v0.w); v1.x = silu_f(v1.x); v1.y = silu_f(v1.y); v1.z = silu_f(v1.z); v1.w = silu_f(v1.w); }
                        if (special && ctx) {
                            float* o = p.out + (special == 1 ? OUT_NK : OUT_NV) + ((size_t)((row / SEQ) * DEPTH + l) * SEQ + (row % SEQ)) * KV_W + (c0 - (special == 1 ? C_K : C_V));
                            *(f32x4*)o = v0; *(f32x4*)(o + 4) = v1;
                        }
                        if (special == 1 && !ctx) {
                            const int pos = (row - TC) % DEC_SEQ, a = wc & 1, pp = fq >> 1, f0 = 8 * (fq & 1);
                            const f32x4* rp = (const f32x4*)((const f32x2*)(p.ws + WS_ROPE) + (pos * 2 + a) * 16 + f0);
                            const f32x4 r0 = rp[0], r1 = rp[1], r2 = rp[2], r3 = rp[3];
                            f32x4 o0, o1;
                            o0.x = __shfl_xor(v0.x, 32); o0.y = __shfl_xor(v0.y, 32); o0.z = __shfl_xor(v0.z, 32); o0.w = __shfl_xor(v0.w, 32);
                            o1.x = __shfl_xor(v1.x, 32); o1.y = __shfl_xor(v1.y, 32); o1.z = __shfl_xor(v1.z, 32); o1.w = __shfl_xor(v1.w, 32);
                            const float sg = pp ? 1.f : -1.f;
                            v0.x = v0.x * r0.x + sg * o0.x * r0.y; v0.y = v0.y * r0.z + sg * o0.y * r0.w; v0.z = v0.z * r1.x + sg * o0.z * r1.y; v0.w = v0.w * r1.z + sg * o0.w * r1.w;
                            v1.x = v1.x * r2.x + sg * o1.x * r2.y; v1.y = v1.y * r2.z + sg * o1.y * r2.w; v1.z = v1.z * r3.x + sg * o1.z * r3.y; v1.w = v1.w * r3.z + sg * o1.w * r3.w;
                        }
                        u32x4 w; w.x = pack2(v0.x, v0.y); w.y = pack2(v0.z, v0.w); w.z = pack2(v1.x, v1.y); w.w = pack2(v1.z, v1.w);
                        *(u32x4*)(dst + (size_t)row * ld) = w;
                        CBAR();
                    }
            }
        } else if (u.kind == 1) {
            bf16* HYT = (bf16*)(p.ws + WS_HYT);
#pragma unroll
            for (int ai = 0; ai < 2; ++ai) {
                const bool sil = u.pm * 256 + 128 * ai >= 3 * HYENA_W;
#pragma unroll
                for (int m = 0; m < 4; ++m) {
                    const int ch = u.pm * 256 + 64 * wr + fr + OPQ(128 * ai + 16 * m);
#pragma unroll
                    for (int bj = 0; bj < 2; ++bj) {
                        f32x4 v0 = acc[ai][bj][m][0], v1 = acc[ai][bj][m][1];
                        if (sil) { v0.x = silu_f(v0.x); v0.y = silu_f(v0.y); v0.z = silu_f(v0.z); v0.w = silu_f(v0.w); v1.x = silu_f(v1.x); v1.y = silu_f(v1.y); v1.z = silu_f(v1.z); v1.w = silu_f(v1.w); }
                        u32x4 w; w.x = pack2(v0.x, v0.y); w.y = pack2(v0.z, v0.w); w.z = pack2(v1.x, v1.y); w.w = pack2(v1.z, v1.w);
                        *(u32x4*)(HYT + (size_t)ch * T + u.pn * 256 + 128 * bj + 32 * wc + 8 * fq) = w;
                        CBAR();
                    }
                }
            }
        } else {
            const float* gate = (const float*)(p.ws + WS_MOD) + ((size_t)l * NR + mod_row(u.pm * 256)) * 3 * D_MODEL + 2 * D_MODEL;
#pragma unroll
            for (int bj = 0; bj < 2; ++bj) {
                const int n = u.pn * 256 + 128 * bj + 32 * wc + 8 * fq;
                const f32x4 g0 = *(const f32x4*)(gate + n), g1 = *(const f32x4*)(gate + n + 4);
#pragma unroll
                for (int ai = 0; ai < 2; ++ai)
#pragma unroll
                    for (int m = 0; m < 4; ++m) {
                        const int row = u.pm * 256 + 64 * wr + fr + OPQ(128 * ai + 16 * m);
                        const float* xs = x_row_src(p, l, row) + n;
                        const f32x4 x0 = *(const f32x4*)xs, x1 = *(const f32x4*)(xs + 4);
                        float* o = p.out + (size_t)row * D_MODEL + n;
                        *(f32x4*)o = x0 + g0 * acc[ai][bj][m][0]; *(f32x4*)(o + 4) = x1 + g1 * acc[ai][bj][m][1];
                        CBAR();
                    }
            }
        }
    }
};

#ifdef EMU
typedef unsigned char* ldsptr_t;
#else
typedef LAS unsigned char* ldsptr_t;
#endif
DI void gemm_phase(ldsptr_t lds, const GemmJob& S) {
    const int tid = TIDX(), wid = RFL(tid >> 6), lane = tid & 63, wr = wid >> 2, wc = wid & 3, fr = lane & 15, fq = lane >> 4;
    const int K = S.K, nt = K / BK;
    unsigned voffA[2], voffB[2];
#pragma unroll
    for (int i = 0; i < 2; ++i) { int R, C; stage_rc(tid * 16 + i * 8192, R, C); const int Rb = (R & ~31) + perm32(R & 31);
        voffA[i] = (unsigned)(R * K + C) * 2u; voffB[i] = (unsigned)(Rb * K + C) * 2u; }
    const size_t kstep = (size_t)(BK * 2);
    const size_t hstep = (size_t)HALFT * K * 2;
    const unsigned ldsw = (unsigned)wid * 1024u;
    const int aoff = lds_byte(wr * 64 + fr, fq * 8), boff = lds_byte(wc * 32 + fr, fq * 8);
#define PG8_SA(b, h) (((b) * 2 + (h)) * HTB)
#define PG8_SB(b, h) ((4 + (b) * 2 + (h)) * HTB)
#define PG8_STAGE(bufoff, gbase, voff) do { _Pragma("unroll") for (int _i = 0; _i < 2; ++_i) GLDS16((const char*)(gbase) + (voff)[_i], lds + (bufoff) + ldsw + _i * 8192); } while (0)
#define PG8_LDA(dst, b, h) do { _Pragma("unroll") for (int m = 0; m < 4; ++m) _Pragma("unroll") for (int k = 0; k < 2; ++k) dst[m][k] = *(const LAS bf16x8*)(lds + PG8_SA(b, h) + aoff + m * 2048 + k * 1024); } while (0)
#define PG8_LDB(dst, b, h) do { _Pragma("unroll") for (int n = 0; n < 2; ++n) _Pragma("unroll") for (int k = 0; k < 2; ++k) dst[n][k] = *(const LAS bf16x8*)(lds + PG8_SB(b, h) + boff + n * 2048 + k * 1024); } while (0)
#define PG8_MMA(ai, bj, At, Bt) do { SETPRIO(1); _Pragma("unroll") for (int m = 0; m < 4; ++m) _Pragma("unroll") for (int n = 0; n < 2; ++n) _Pragma("unroll") for (int k = 0; k < 2; ++k) \
        acc[ai][bj][m][n] = MFMA16(Bt[n][k], At[m][k], acc[ai][bj][m][n]); SETPRIO(0); } while (0)
    Unit cur, nxt; int ui = 0;
    if (!S.next(0, cur)) return;
    f32x4 acc[2][2][4][2];
#pragma unroll
    for (int a = 0; a < 2; ++a)
#pragma unroll
        for (int b = 0; b < 2; ++b)
#pragma unroll
            for (int m = 0; m < 4; ++m)
#pragma unroll
                for (int n = 0; n < 2; ++n) acc[a][b][m][n] = (f32x4){0.f, 0.f, 0.f, 0.f};
    bf16x8 At[4][2], B0[2][2], B1[2][2];
    const char* cA; const char* cB; S.ptrs(cur, cA, cB);
    PG8_STAGE(PG8_SB(0, 0), cB, voffB); PG8_STAGE(PG8_SA(0, 0), cA, voffA); PG8_STAGE(PG8_SB(0, 1), cB + hstep, voffB); PG8_STAGE(PG8_SA(0, 1), cA + hstep, voffA);
    if (wr == 1) S_BARRIER();
    WAIT_V(4); S_BARRIER();
    PG8_STAGE(PG8_SB(1, 0), cB + kstep, voffB); PG8_STAGE(PG8_SA(1, 0), cA + kstep, voffA); PG8_STAGE(PG8_SB(1, 1), cB + hstep + kstep, voffB);
    WAIT_V(6); S_BARRIER();
    for (;;) {
        const bool has_next = S.next(ui + 1, nxt);
        const char* nA = cA; const char* nB = cB; if (has_next) S.ptrs(nxt, nA, nB);
        for (int t = 0; t < nt; t += 2) {
            const bool last = (t == nt - 2);
            const char* a1 = cA + (size_t)(t + 1) * kstep;
            const char* a2 = last ? nA : cA + (size_t)(t + 2) * kstep; const char* b2 = last ? nB : cB + (size_t)(t + 2) * kstep;
            const char* a3 = a2 + kstep; const char* b3 = b2 + kstep;
            PG8_LDB(B0, 0, 0); SCHED_BAR(); PG8_LDA(At, 0, 0); PG8_STAGE(PG8_SA(1, 1), a1 + hstep, voffA);
            WAIT_L(8); S_BARRIER(); WAIT_L(0); PG8_MMA(0, 0, At, B0); S_BARRIER(); SCHED_BAR();
            PG8_LDB(B1, 0, 1); PG8_STAGE(PG8_SB(0, 0), b2, voffB);
            S_BARRIER(); WAIT_L(0); PG8_MMA(0, 1, At, B1); S_BARRIER();
            PG8_LDA(At, 0, 1); PG8_STAGE(PG8_SA(0, 0), a2, voffA);
            S_BARRIER(); WAIT_L(0); PG8_MMA(1, 0, At, B0); S_BARRIER(); SCHED_BAR();
            PG8_STAGE(PG8_SB(0, 1), b2 + hstep, voffB);
            WAIT_V(6); S_BARRIER(); PG8_MMA(1, 1, At, B1); S_BARRIER();
            PG8_LDB(B0, 1, 0); SCHED_BAR(); PG8_LDA(At, 1, 0); PG8_STAGE(PG8_SA(0, 1), a2 + hstep, voffA);
            WAIT_L(8); S_BARRIER(); WAIT_L(0); PG8_MMA(0, 0, At, B0); S_BARRIER(); SCHED_BAR();
            PG8_LDB(B1, 1, 1); PG8_STAGE(PG8_SB(1, 0), b3, voffB);
            S_BARRIER(); WAIT_L(0); PG8_MMA(0, 1, At, B1); S_BARRIER();
            PG8_LDA(At, 1, 1); PG8_STAGE(PG8_SA(1, 0), a3, voffA);
            S_BARRIER(); WAIT_L(0); PG8_MMA(1, 0, At, B0); S_BARRIER(); SCHED_BAR();
            PG8_STAGE(PG8_SB(1, 1), b3 + hstep, voffB);
            WAIT_V(6); S_BARRIER(); PG8_MMA(1, 1, At, B1); S_BARRIER();
        }
        S.epilogue(acc, cur, wr, wc, fr, fq);
        if (!has_next) break;
#pragma unroll
        for (int a = 0; a < 2; ++a)
#pragma unroll
            for (int b = 0; b < 2; ++b)
#pragma unroll
                for (int m = 0; m < 4; ++m)
#pragma unroll
                    for (int n = 0; n < 2; ++n) acc[a][b][m][n] = (f32x4){0.f, 0.f, 0.f, 0.f};
        cur = nxt; cA = nA; cB = nB; ++ui;
    }
    WAIT_V(0);
    if (wr == 0) S_BARRIER();
    S_BARRIER();
#undef PG8_SA
#undef PG8_SB
#undef PG8_STAGE
#undef PG8_LDA
#undef PG8_LDB
#undef PG8_MMA
}

DI void unpack8(const u32x4 v, float (&f)[8]) {
    f[0] = __uint_as_float(v.x << 16); f[1] = __uint_as_float(v.x & 0xffff0000u); f[2] = __uint_as_float(v.y << 16); f[3] = __uint_as_float(v.y & 0xffff0000u);
    f[4] = __uint_as_float(v.z << 16); f[5] = __uint_as_float(v.z & 0xffff0000u); f[6] = __uint_as_float(v.w << 16); f[7] = __uint_as_float(v.w & 0xffff0000u);
}
DI int PADX(int i) { return i + (i >> 4); }
constexpr int FB_BANK = 8704;
template <int SIGN> DI void dft4(cpx& a0, cpx& a1, cpx& a2, cpx& a3) {
    const cpx t0 = a0 + a2, t1 = a0 - a2, t2 = a1 + a3, t3 = a1 - a3;
    const cpx t3r = SIGN < 0 ? cpx{t3.y, -t3.x} : cpx{-t3.y, t3.x};
    a0 = t0 + t2; a1 = t1 + t3r; a2 = t0 - t2; a3 = t1 - t3r;
}
template <int SIGN> DI void dft16(cpx (&v)[16]) {
#pragma unroll
    for (int n2 = 0; n2 < 4; ++n2) dft4<SIGN>(v[n2], v[4 + n2], v[8 + n2], v[12 + n2]);
    constexpr float C1 = 0.92387953251128674f, S1 = 0.38268343236508977f, R = 0.70710678118654752f, SG = (float)SIGN;
    v[5] = cmul(v[5], cpx{C1, SG * S1});  v[6] = cmul(v[6], cpx{R, SG * R});     v[7] = cmul(v[7], cpx{S1, SG * C1});
    v[9] = cmul(v[9], cpx{R, SG * R});    v[10] = cmul(v[10], cpx{0.f, SG});     v[11] = cmul(v[11], cpx{-R, SG * R});
    v[13] = cmul(v[13], cpx{S1, SG * C1}); v[14] = cmul(v[14], cpx{-R, SG * R}); v[15] = cmul(v[15], cpx{-C1, -SG * S1});
#pragma unroll
    for (int k1 = 0; k1 < 4; ++k1) dft4<SIGN>(v[4 * k1], v[4 * k1 + 1], v[4 * k1 + 2], v[4 * k1 + 3]);
}
template <int SIGN> DI void fft_pass16x2(cpx* fa, cpx* fb, int j, int Ns, int N16) {
    cpx va[16], vb[16];
#pragma unroll
    for (int r = 0; r < 16; ++r) { const int ix = PADX(j + N16 * r); va[r] = fa[ix]; vb[r] = fb[ix]; }
    const int k = j & (Ns - 1);
    if (Ns > 1) {
        float sn, cs; sincospif((float)(SIGN * 2 * k) / (float)(16 * Ns), &sn, &cs);
        cpx w[16];
        w[1] = cpx{cs, sn}; w[2] = cmul(w[1], w[1]); w[3] = cmul(w[2], w[1]); w[4] = cmul(w[2], w[2]); w[5] = cmul(w[4], w[1]); w[6] = cmul(w[4], w[2]); w[7] = cmul(w[4], w[3]); w[8] = cmul(w[4], w[4]);
#pragma unroll
        for (int r = 9; r < 16; ++r) w[r] = cmul(w[8], w[r - 8]);
#pragma unroll
        for (int r = 1; r < 16; ++r) { va[r] = cmul(va[r], w[r]); vb[r] = cmul(vb[r], w[r]); }
    }
    dft16<SIGN>(va); dft16<SIGN>(vb);
    __syncthreads();
    const int base = (j - k) * 16 + k;
#pragma unroll
    for (int kk = 0; kk < 16; ++kk) { const int ix = PADX(base + kk * Ns); fa[ix] = va[4 * (kk & 3) + (kk >> 2)]; fb[ix] = vb[4 * (kk & 3) + (kk >> 2)]; }
    __syncthreads();
}
template <int SIGN> DI void fft_passes(cpx* fa, cpx* fb, int j, int Ns0, int np16, int N16) {
#pragma unroll 1
    for (int ps = 0, Ns = Ns0; ps < np16; ++ps, Ns <<= 4) fft_pass16x2<SIGN>(fa, fb, j, Ns, N16);
}
DI cpx conv_out(const cpx* fb, int t, int L) {
    const cpx a = fb[PADX(t)], b = fb[PADX(t + L)];
    float sn, cs; sincospif((float)t / (float)L, &sn, &cs);
    const cpx wb = cmul(cpx{cs, sn}, b);
    const float rn = 0.5f / (float)L;
    return (a + wb) * rn;
}
DI float conv3(const bf16* ptr, int t, int L, float w0, float w1, float w2) {
    const float a = t > 0 ? bf2f(ptr[t - 1]) : 0.f, b = bf2f(ptr[t]), c = t < L - 1 ? bf2f(ptr[t + 1]) : 0.f;
    return a * w0 + b * w1 + c * w2;
}
DI void filter_item(const Params& p, int l, int item, char* smem, bool lat) {
    const int np16 = lat ? 3 : 2, N16 = lat ? 512 : 32, N = 16 * N16, L = N / 2;
    const int tid = TIDX(), sub = tid / N16, j = tid % N16;
    const int c = lat ? item : item * 16 + sub;
    cpx* fa = (cpx*)smem + sub * (N + N / 16); cpx* fb = fa + FB_BANK;
    float* red = (float*)(smem + 2 * FB_BANK * 8);
    const float* hid = (const float*)(p.ws + WS_HID2) + ((size_t)l * (SEQ + DEC_SEQ) + (lat ? SEQ : 0)) * FH + j;
    const float* w3 = p.in[I_FW3] + (size_t)l * FH * 4 * HYENA_W + c;
    float f0[8], f1[8], b0[8], b1[8];
#pragma unroll
    for (int i = 0; i < 8; ++i) { f0[i] = 0.f; f1[i] = 0.f; b0[i] = 0.f; b1[i] = 0.f; }
#pragma unroll 2
    for (int q = 0; q < FH; ++q) {
        const float* wq = w3 + (size_t)q * 4 * HYENA_W;
        const float wf0 = wq[0], wf1 = wq[HYENA_W], wb0 = wq[2 * HYENA_W], wb1 = wq[3 * HYENA_W];
#pragma unroll
        for (int i = 0; i < 8; ++i) { const float hv = hid[(size_t)q * L + N16 * i]; f0[i] += hv * wf0; f1[i] += hv * wf1; b0[i] += hv * wb0; b1[i] += hv * wb1; }
    }
    const float min_decay = -4.605170185988091f / 1.5f, max_decay = -4.605170185988091f / 0.3f;
    const float delta = fabsf(min_decay + (max_decay - min_decay) * (float)c / (float)(HYENA_W - 1));
    float as0 = 0.f, as1 = 0.f;
#pragma unroll
    for (int i = 0; i < 8; ++i) {
        const int t = j + N16 * i;
        const float dec = __expf(-((float)t / (float)(L - 1)) * delta);
        const float vf0 = f0[i] * dec, vf1 = f1[i] * dec, vb0 = b0[i] * dec, vb1 = b1[i] * dec;
        fa[PADX(t)] = cpx{vf0, 0.f}; fb[PADX(t)] = cpx{vf1, 0.f};
        if (t == 0) { fa[PADX(L)] = cpx{0.f, 0.f}; fb[PADX(L)] = cpx{0.f, 0.f}; } else { fa[PADX(N - t)] = cpx{vb0, 0.f}; fb[PADX(N - t)] = cpx{vb1, 0.f}; }
        as0 += fabsf(vf0) + (t == 0 ? 0.f : fabsf(vb0)); as1 += fabsf(vf1) + (t == 0 ? 0.f : fabsf(vb1));
    }
#pragma unroll
    for (int s = 1; s < 32; s <<= 1) { as0 += __shfl_xor(as0, s); as1 += __shfl_xor(as1, s); }
    if (lat) {
        as0 += __shfl_xor(as0, 32); as1 += __shfl_xor(as1, 32);
        if ((tid & 63) == 0) { red[tid >> 6] = as0; red[8 + (tid >> 6)] = as1; }
    }
    __syncthreads();
    if (lat) { as0 = 0.f; as1 = 0.f;
#pragma unroll
        for (int q = 0; q < 8; ++q) { as0 += red[q]; as1 += red[8 + q]; } }
    const float rn0 = 1.f / as0, rn1 = 1.f / as1;
    {
        cpx a0[8], a1[8], c0[8], c1[8];
#pragma unroll
        for (int i = 0; i < 8; ++i) { const int t = j + N16 * i; a0[i] = fa[PADX(t)]; c0[i] = fa[PADX(t + L)]; a1[i] = fb[PADX(t)]; c1[i] = fb[PADX(t + L)]; }
        __syncthreads();
#pragma unroll
        for (int i = 0; i < 8; ++i) { const int t = j + N16 * i; fa[PADX(2 * t)] = a0[i] + c0[i]; fa[PADX(2 * t + 1)] = a0[i] - c0[i]; fb[PADX(2 * t)] = a1[i] + c1[i]; fb[PADX(2 * t + 1)] = a1[i] - c1[i]; }
        __syncthreads();
    }
    fft_passes<-1>(fa, fb, j, 2, np16, N16);
    cpx* kf0 = (cpx*)(p.ws + (lat ? WS_KFL + (l & 1) * KFL_BYTES : WS_KFC + (l & 1) * KFC_BYTES)) + (size_t)c * N; cpx* kf1 = kf0 + (size_t)HYENA_W * N;
#pragma unroll 4
    for (int i = 0; i < 16; ++i) { const int f = j + N16 * i; kf0[f] = fa[PADX(f)] * rn0; kf1[f] = fb[PADX(f)] * rn1; }
    __syncthreads();
}

DI void conv3x8(const bf16* row, int t0, int L, float w0, float w1, float w2, float (&o)[8]) {
    float v[8]; unpack8(*(const u32x4*)(row + t0), v);
    const bf16 pr = row[t0 > 0 ? t0 - 1 : 0], nr = row[t0 + 8 < L ? t0 + 8 : t0];
    const float pv = t0 > 0 ? bf2f(pr) : 0.f, nx = t0 + 8 < L ? bf2f(nr) : 0.f;
    o[0] = pv * w0 + v[0] * w1 + v[1] * w2;
#pragma unroll
    for (int i = 1; i < 7; ++i) o[i] = v[i - 1] * w0 + v[i] * w1 + v[i + 1] * w2;
    o[7] = v[6] * w0 + v[7] * w1 + nx * w2;
}
DI void hyena_item(const Params& p, int l, int item, char* smem, bool lat) {
    const int np16 = lat ? 3 : 2, N16 = lat ? 512 : 32, N = 16 * N16, L = N / 2;
    const int NPAIR = lat ? DEC_BATCH / 2 : BATCH / 2;
    const int tid = TIDX(), sub = tid / N16, j = tid % N16, t0 = 8 * j;
    constexpr int IPC = (DEC_BATCH / 2 + 1) / 2;
    int cA, cB, prA, prB; bool actA, actB;
    if (lat) { cA = cB = item / IPC; prA = 2 * (item % IPC); prB = prA + 1; actA = true; actB = prB < NPAIR; }
    else { cA = 2 * item; cB = cA + 1; prA = prB = sub; actA = actB = sub < NPAIR; }
    const int tokA = (lat ? TC : 0) + (actA ? 2 * prA : 0) * L, tokB = (lat ? TC : 0) + (actB ? 2 * prB : 0) * L;
    cpx* fa = (cpx*)smem + sub * (N + N / 16); cpx* fb = fa + FB_BANK;
    const bf16* HYT = (const bf16*)(p.ws + WS_HYT);
    const float* cw = p.in[I_HYCW] + (size_t)l * 3 * 3 * HYENA_W;
    const cpx* kfbase = (const cpx*)(p.ws + (lat ? WS_KFL + (l & 1) * KFL_BYTES : WS_KFC + (l & 1) * KFC_BYTES));
    cpx* zsA = (cpx*)(p.ws + WS_ZS) + (size_t)BIDX() * 2 * 4096 + sub * L + t0; cpx* zsB = zsA + 4096;
    bf16* zoutA = (bf16*)(p.ws + WS_ZT) + (size_t)cA * T; bf16* zoutB = (bf16*)(p.ws + WS_ZT) + (size_t)cB * T;
    {
        const bf16* hvA = HYT + (size_t)cA * T + tokA;
        float a0[8], a1[8];
        conv3x8(hvA, t0, L, cw[cA], cw[3 * HYENA_W + cA], cw[6 * HYENA_W + cA], a0); conv3x8(hvA + L, t0, L, cw[cA], cw[3 * HYENA_W + cA], cw[6 * HYENA_W + cA], a1);
#pragma unroll
        for (int i = 0; i < 8; ++i) {
            const cpx ua = actA ? cpx{a0[i], a1[i]} : cpx{0.f, 0.f};
            zsA[i] = ua;
            const int ix = PADX(2 * (t0 + i));
            fa[ix] = ua; fa[ix + 1] = ua;
        }
    }
    SCHED_BAR();
    {
        const bf16* hvB = HYT + (size_t)cB * T + tokB;
        float b0[8], b1[8];
        conv3x8(hvB, t0, L, cw[cB], cw[3 * HYENA_W + cB], cw[6 * HYENA_W + cB], b0); conv3x8(hvB + L, t0, L, cw[cB], cw[3 * HYENA_W + cB], cw[6 * HYENA_W + cB], b1);
#pragma unroll
        for (int i = 0; i < 8; ++i) {
            const cpx ub = actB ? cpx{b0[i], b1[i]} : cpx{0.f, 0.f};
            zsB[i] = ub;
            const int ix = PADX(2 * (t0 + i));
            fb[ix] = ub; fb[ix + 1] = ub;
        }
    }
    __syncthreads();
#pragma unroll 1
    for (int o = 0; o < 2; ++o) {
        fft_passes<-1>(fa, fb, j, 2, np16, N16);
        const int t0o = OPQ(t0), tokAo = OPQ(tokA), tokBo = OPQ(tokB);
        cpx* zsAo = (cpx*)(p.ws + WS_ZS) + (size_t)BIDX() * 2 * 4096 + sub * L + t0o; cpx* zsBo = zsAo + 4096;
        {
            const cpx* kfA = kfbase + (size_t)(o * HYENA_W + cA) * N + j; const cpx* kfB = kfbase + (size_t)(o * HYENA_W + cB) * N + j;
#pragma unroll 8
            for (int i = 0; i < 16; ++i) { const int ix = PADX(j + N16 * i); const cpx ka = kfA[N16 * i], kb = lat ? ka : kfB[N16 * i]; fa[ix] = cmul(fa[ix], ka); fb[ix] = cmul(fb[ix], kb); }
        }
        __syncthreads();
        fft_passes<1>(fa, fb, j, 1, np16, N16);
        const int wo = (1 + o) * HYENA_W;
        float sn, cs; sincospif((float)t0o / (float)L, &sn, &cs); const cpx wbase = cpx{cs, sn};
        sincospif(1.f / (float)L, &sn, &cs); const cpx wstep = cpx{cs, sn};
        const float rn = 0.5f / (float)L;
        cpx za[8], zb[8];
        {
            float x0[8], x1[8];
            conv3x8(HYT + (size_t)(wo + cA) * T + tokAo, t0o, L, cw[wo + cA], cw[3 * HYENA_W + wo + cA], cw[6 * HYENA_W + wo + cA], x0);
            conv3x8(HYT + (size_t)(wo + cA) * T + tokAo + L, t0o, L, cw[wo + cA], cw[3 * HYENA_W + wo + cA], cw[6 * HYENA_W + wo + cA], x1);
            const float dd = p.in[I_HYD][(size_t)l * 2 * HYENA_W + o * HYENA_W + cA];
            cpx w = wbase;
#pragma unroll
            for (int i = 0; i < 8; ++i) {
                const cpx y = (fa[PADX(t0o + i)] + cmul(w, fa[PADX(t0o + i + L)])) * rn; w = cmul(w, wstep);
                const cpx u = zsAo[i];
                za[i] = cpx{x0[i] * (y.x + dd * u.x), x1[i] * (y.y + dd * u.y)};
            }
        }
        SCHED_BAR();
        {
            float x0[8], x1[8];
            conv3x8(HYT + (size_t)(wo + cB) * T + tokBo, t0o, L, cw[wo + cB], cw[3 * HYENA_W + wo + cB], cw[6 * HYENA_W + wo + cB], x0);
            conv3x8(HYT + (size_t)(wo + cB) * T + tokBo + L, t0o, L, cw[wo + cB], cw[3 * HYENA_W + wo + cB], cw[6 * HYENA_W + wo + cB], x1);
            const float dd = p.in[I_HYD][(size_t)l * 2 * HYENA_W + o * HYENA_W + cB];
            cpx w = wbase;
#pragma unroll
            for (int i = 0; i < 8; ++i) {
                const cpx y = (fb[PADX(t0o + i)] + cmul(w, fb[PADX(t0o + i + L)])) * rn; w = cmul(w, wstep);
                const cpx u = zsBo[i];
                zb[i] = cpx{x0[i] * (y.x + dd * u.x), x1[i] * (y.y + dd * u.y)};
            }
        }
        __syncthreads();
        if (o == 0) {
#pragma unroll
            for (int i = 0; i < 8; ++i) {
                const cpx ua = actA ? za[i] : cpx{0.f, 0.f}, ub = actB ? zb[i] : cpx{0.f, 0.f};
                zsAo[i] = ua; zsBo[i] = ub;
                const int ix = PADX(2 * (t0o + i));
                fa[ix] = ua; fa[ix + 1] = ua; fb[ix] = ub; fb[ix + 1] = ub;
            }
            __syncthreads();
        } else {
            const bf16* ghA = HYT + (size_t)(3 * HYENA_W + cA) * T + tokAo + t0o; const bf16* ghB = HYT + (size_t)(3 * HYENA_W + cB) * T + tokBo + t0o;
            float g[8]; u32x4 ov;
            if (actA) {
                unpack8(*(const u32x4*)ghA, g);
                ov.x = pack2(za[0].x * g[0], za[1].x * g[1]); ov.y = pack2(za[2].x * g[2], za[3].x * g[3]); ov.z = pack2(za[4].x * g[4], za[5].x * g[5]); ov.w = pack2(za[6].x * g[6], za[7].x * g[7]);
                *(u32x4*)(zoutA + tokAo + t0o) = ov;
                unpack8(*(const u32x4*)(ghA + L), g);
                ov.x = pack2(za[0].y * g[0], za[1].y * g[1]); ov.y = pack2(za[2].y * g[2], za[3].y * g[3]); ov.z = pack2(za[4].y * g[4], za[5].y * g[5]); ov.w = pack2(za[6].y * g[6], za[7].y * g[7]);
                *(u32x4*)(zoutA + tokAo + L + t0o) = ov;
            }
            if (actB) {
                unpack8(*(const u32x4*)ghB, g);
                ov.x = pack2(zb[0].x * g[0], zb[1].x * g[1]); ov.y = pack2(zb[2].x * g[2], zb[3].x * g[3]); ov.z = pack2(zb[4].x * g[4], zb[5].x * g[5]); ov.w = pack2(zb[6].x * g[6], zb[7].x * g[7]);
                *(u32x4*)(zoutB + tokBo + t0o) = ov;
                unpack8(*(const u32x4*)(ghB + L), g);
                ov.x = pack2(zb[0].y * g[0], zb[1].y * g[1]); ov.y = pack2(zb[2].y * g[2], zb[3].y * g[3]); ov.z = pack2(zb[4].y * g[4], zb[5].y * g[5]); ov.w = pack2(zb[6].y * g[6], zb[7].y * g[7]);
                *(u32x4*)(zoutB + tokBo + L + t0o) = ov;
            }
        }
    }
}

DI void hytr_item(const Params& p, int item, char* smem) {
    const int tid = TIDX(), tok0 = item * 64;
    const bf16* HYT = (const bf16*)(p.ws + WS_ZT); bf16* mixed = (bf16*)(p.ws + WS_XN);
    unsigned* tile = (unsigned*)smem;
    for (int id = tid; id < HYENA_W * 8; id += NTHR) {
        const int ch = id >> 3, ck = id & 7, x = (ch >> 3) & 31;
        const u32x4 v = *(const u32x4*)(HYT + (size_t)ch * T + tok0 + ck * 8);
        unsigned* row = tile + ch * 32;
        row[(4 * ck) ^ x] = v.x; row[(4 * ck + 1) ^ x] = v.y; row[(4 * ck + 2) ^ x] = v.z; row[(4 * ck + 3) ^ x] = v.w;
    }
    __syncthreads();
    for (int id = tid; id < 64 * (HYENA_W / 8); id += NTHR) {
        const int cg = id % (HYENA_W / 8), tok = id / (HYENA_W / 8), x = cg & 31, sh = (tok & 1) * 16;
        unsigned e[8];
#pragma unroll
        for (int k = 0; k < 8; ++k) e[k] = (tile[(8 * cg + k) * 32 + ((tok >> 1) ^ x)] >> sh) & 0xffffu;
        u32x4 o; o.x = e[0] | (e[1] << 16); o.y = e[2] | (e[3] << 16); o.z = e[4] | (e[5] << 16); o.w = e[6] | (e[7] << 16);
        *(u32x4*)(mixed + (size_t)(tok0 + tok) * MIX_W + ATTN_W + 8 * cg) = o;
    }
    __syncthreads();
}

DI void shortconv_item(const Params& p, int l, int item) {
    const bf16* SCb = (const bf16*)(p.ws + WS_SC);
    bf16* mixed = (bf16*)(p.ws + WS_XN);
    const float* cw = p.in[I_SCW] + (size_t)l * 3 * CONV_W;
    constexpr int C8 = CONV_W / 8;
    const u32x4 zero4 = {0u, 0u, 0u, 0u};
    for (int e = TIDX(); e < 64 * C8; e += NTHR) {
        const int m = item * 64 + e / C8, c = (e % C8) * 8;
        const int L = m < TC ? SEQ : DEC_SEQ, t = m < TC ? m % SEQ : (m - TC) % DEC_SEQ;
        const bf16* row = SCb + (size_t)m * 4 * CONV_W + c;
        float sb[8], g0[8], x0[8], gm[8], xm[8], gn[8], xn[8], gc[8], w0[8], w1[8], w2[8];
        unpack8(*(const u32x4*)row, sb); unpack8(*(const u32x4*)(row + CONV_W), g0); unpack8(*(const u32x4*)(row + 2 * CONV_W), x0); unpack8(*(const u32x4*)(row + 3 * CONV_W), gc);
        const bf16* rowm = t > 0 ? row - 4 * CONV_W : row; const bf16* rown = t < L - 1 ? row + 4 * CONV_W : row;
        u32x4 vgm = *(const u32x4*)(rowm + CONV_W), vxm = *(const u32x4*)(rowm + 2 * CONV_W), vgn = *(const u32x4*)(rown + CONV_W), vxn = *(const u32x4*)(rown + 2 * CONV_W);
        if (t == 0) { vgm = zero4; vxm = zero4; } if (t == L - 1) { vgn = zero4; vxn = zero4; }
        unpack8(vgm, gm); unpack8(vxm, xm); unpack8(vgn, gn); unpack8(vxn, xn);
#pragma unroll
        for (int i = 0; i < 2; ++i) {
            const f32x4 a = *(const f32x4*)(cw + c + 4 * i), b = *(const f32x4*)(cw + CONV_W + c + 4 * i), d = *(const f32x4*)(cw + 2 * CONV_W + c + 4 * i);
            w0[4 * i] = a.x; w0[4 * i + 1] = a.y; w0[4 * i + 2] = a.z; w0[4 * i + 3] = a.w;
            w1[4 * i] = b.x; w1[4 * i + 1] = b.y; w1[4 * i + 2] = b.z; w1[4 * i + 3] = b.w;
            w2[4 * i] = d.x; w2[4 * i + 1] = d.y; w2[4 * i + 2] = d.z; w2[4 * i + 3] = d.w;
        }
        float o[8];
#pragma unroll
        for (int i = 0; i < 8; ++i) o[i] = sb[i] * (gm[i] * xm[i] * w0[i] + g0[i] * x0[i] * w1[i] + gn[i] * xn[i] * w2[i]) * gc[i];
        u32x4 ov; ov.x = pack2(o[0], o[1]); ov.y = pack2(o[2], o[3]); ov.z = pack2(o[4], o[5]); ov.w = pack2(o[6], o[7]);
        *(u32x4*)(mixed + (size_t)m * MIX_W + ATTN_W + HYENA_W + c) = ov;
    }
}

constexpr int AT_NKL = 320;
constexpr int AT_KL = 0, AT_VL = AT_KL + AT_NKL * 128, AT_KC = AT_VL + AT_NKL * 128, AT_VC = AT_KC + 256 * 128, AT_END = AT_VC + 256 * 128;
static_assert(AT_END <= LDS_BYTES - 16, "lds");
DI int swzv(int row, int c) { return row * 128 + ((c ^ (((row >> 1) & 1) << 2)) << 4); }
#ifdef EMU
DI void v_tr_frags(const char* a0, const char* a1, bf16x8 (&frag)[4]) {
#pragma unroll
    for (int dt = 0; dt < 2; ++dt)
#pragma unroll
        for (int s = 0; s < 2; ++s) {
            const bf16x4 lo = emu_ds_read_tr16((dt ? a1 : a0) + 2048 * s), hi = emu_ds_read_tr16((dt ? a1 : a0) + 2048 * s + 1024);
            bf16x8 f; f[0] = lo[0]; f[1] = lo[1]; f[2] = lo[2]; f[3] = lo[3]; f[4] = hi[0]; f[5] = hi[1]; f[6] = hi[2]; f[7] = hi[3];
            frag[dt * 2 + s] = f;
        }
}
#else
DI void v_tr_frags(const char* a0, const char* a1, bf16x8 (&frag)[4]) {
    const unsigned x0 = (unsigned)(size_t)(const LAS char*)a0, x1 = (unsigned)(size_t)(const LAS char*)a1;
    u32x2 r0, r1, r2, r3, r4, r5, r6, r7;
    asm volatile("ds_read_b64_tr_b16 %0, %8\n\tds_read_b64_tr_b16 %1, %8 offset:1024\n\tds_read_b64_tr_b16 %2, %8 offset:2048\n\tds_read_b64_tr_b16 %3, %8 offset:3072\n\t"
                 "ds_read_b64_tr_b16 %4, %9\n\tds_read_b64_tr_b16 %5, %9 offset:1024\n\tds_read_b64_tr_b16 %6, %9 offset:2048\n\tds_read_b64_tr_b16 %7, %9 offset:3072\n\ts_waitcnt lgkmcnt(0)"
                 : "=&v"(r0), "=&v"(r1), "=&v"(r2), "=&v"(r3), "=&v"(r4), "=&v"(r5), "=&v"(r6), "=&v"(r7) : "v"(x0), "v"(x1) : "memory");
    u32x4 f; f.x = r0.x; f.y = r0.y; f.z = r1.x; f.w = r1.y; frag[0] = __builtin_bit_cast(bf16x8, f);
    f.x = r2.x; f.y = r2.y; f.z = r3.x; f.w = r3.y; frag[1] = __builtin_bit_cast(bf16x8, f);
    f.x = r4.x; f.y = r4.y; f.z = r5.x; f.w = r5.y; frag[2] = __builtin_bit_cast(bf16x8, f);
    f.x = r6.x; f.y = r6.y; f.z = r7.x; f.w = r7.y; frag[3] = __builtin_bit_cast(bf16x8, f);
}
#endif
DI void softmax_pv(f32x16& S, f32x16 (&O)[2], float& m_run, float& l_run, const char* va0, const char* va1) {
    float tmax = S[0];
#pragma unroll
    for (int e = 1; e < 16; ++e) tmax = fmaxf(tmax, S[e]);
    tmax = fmaxf(tmax, __shfl_xor(tmax, 32));
    const float mnew = fmaxf(m_run, tmax), alpha = exp2f(m_run - mnew);
    m_run = mnew; l_run *= alpha;
#pragma unroll
    for (int e = 0; e < 16; ++e) { O[0][e] *= alpha; O[1][e] *= alpha; }
    float ps = 0.f; unsigned pk[8];
#pragma unroll
    for (int e = 0; e < 8; ++e) { const float p0 = exp2f(S[2 * e] - mnew), p1 = exp2f(S[2 * e + 1] - mnew); ps += p0 + p1; pk[e] = pack2(p0, p1); }
    l_run += ps;
    u32x4 q0; q0.x = pk[0]; q0.y = pk[1]; q0.z = pk[2]; q0.w = pk[3];
    u32x4 q1; q1.x = pk[4]; q1.y = pk[5]; q1.z = pk[6]; q1.w = pk[7];
    const bf16x8 pb0 = __builtin_bit_cast(bf16x8, q0), pb1 = __builtin_bit_cast(bf16x8, q1);
    bf16x8 vf[4];
    v_tr_frags(va0, va1, vf);
    O[0] = MFMA32(vf[0], pb0, O[0]); O[0] = MFMA32(vf[1], pb1, O[0]);
    O[1] = MFMA32(vf[2], pb0, O[1]); O[1] = MFMA32(vf[3], pb1, O[1]);
}
DI void attn_item(const Params& p, int l, int item, char* smem, bool LAT) {
    const int tid = TIDX(), lane = tid & 63, w = tid >> 6, r = lane & 31, h = lane >> 5;
    const int SL = LAT ? DEC_SEQ : SEQ, NQB = SL / 64;
    const int b = item / (N_KV * NQB), kvh = (item / NQB) % N_KV, q0 = (item % NQB) * 64;
    const int tokbase = (LAT ? TC : 0) + b * SL;
    const bf16* Qb = (const bf16*)(p.ws + WS_Q); const bf16* Kb = (const bf16*)(p.ws + WS_KB); const bf16* Vb = (const bf16*)(p.ws + WS_VB);
    const bf16* GAb = (const bf16*)(p.ws + WS_GA); bf16* mixed = (bf16*)(p.ws + WS_XN);
    char* KL = smem + AT_KL; char* VL = smem + AT_VL; char* KC = smem + AT_KC; char* VC = smem + AT_VC;
    const u32x4 zero4 = {0u, 0u, 0u, 0u};
    if (LAT) {
        for (int id = tid; id < AT_NKL * 8; id += NTHR) {
            const int row = id >> 3, c = id & 7, kp = q0 - 128 + row;
            const bool inr = kp >= 0 && kp < SL;
            const size_t o = (size_t)(tokbase + (inr ? kp : 0)) * KV_W + kvh * HD + c * 8;
            u32x4 kv = *(const u32x4*)(Kb + o), vv = *(const u32x4*)(Vb + o);
            if (!inr) { kv = zero4; vv = zero4; }
            *(u32x4*)(KL + swz128(row, c)) = kv; *(u32x4*)(VL + swzv(row, c)) = vv;
        }
    }
    {
        const bf16* ksrc; const bf16* vsrc; size_t stride;
        if (LAT) { const size_t o = (size_t)((b * DEPTH + l) * N_KV + kvh) * PAST_LEN * HD; ksrc = (const bf16*)(p.ws + WS_CKB) + o; vsrc = (const bf16*)(p.ws + WS_CVTB) + o; stride = HD; }
        else { ksrc = Kb + (size_t)tokbase * KV_W + kvh * HD; vsrc = Vb + (size_t)tokbase * KV_W + kvh * HD; stride = KV_W; }
        for (int id = tid; id < 256 * 8; id += NTHR) {
            const int row = id >> 3, c = id & 7;
            *(u32x4*)(KC + swz128(row, c)) = *(const u32x4*)(ksrc + (size_t)row * stride + c * 8);
            *(u32x4*)(VC + swzv(row, c)) = *(const u32x4*)(vsrc + (size_t)row * stride + c * 8);
        }
    }
    __syncthreads();
    {
        const int g = w >> 1, qt = w & 1, head = kvh * 4 + g;
        const int qpos = q0 + 32 * qt + r;
        const size_t qtok = (size_t)tokbase + qpos;
        bf16x8 qraw[4], qrot[4];
#pragma unroll
        for (int s = 0; s < 4; ++s) { qraw[s] = *(const bf16x8*)(Qb + qtok * ATTN_W + head * HD + 16 * s + 8 * h); qrot[s] = qraw[s]; }
        if (LAT) {
            const f32x2* rope = (const f32x2*)(p.ws + WS_ROPE);
#pragma unroll
            for (int a = 0; a < 2; ++a)
#pragma unroll
                for (int jj = 0; jj < 8; ++jj) {
                    const f32x2 cs = rope[(qpos * 2 + a) * 16 + 8 * h + jj];
                    const float xa = bf2f((bf16)qraw[2 * a][jj]), xb = bf2f((bf16)qraw[2 * a + 1][jj]);
                    qrot[2 * a][jj] = (short)f2bf(xa * cs.x - xb * cs.y);
                    qrot[2 * a + 1][jj] = (short)f2bf(xb * cs.x + xa * cs.y);
                }
        }
        const int qq = (lane & 15) >> 2, pp = lane & 3, g16 = (lane >> 4) & 1, vrow = 4 * h + qq;
        const int voff0 = swzv(vrow, 2 * g16 + (pp >> 1)) + (pp & 1) * 8, voff1 = swzv(vrow, 4 + 2 * g16 + (pp >> 1)) + (pp & 1) * 8;
        const float c1 = 0.125f * 1.4426950408889634f;
        float m_run = p.in[I_SINK][l * N_HEADS + head] * 1.4426950408889634f, l_run = h == 0 ? 1.f : 0.f;
        f32x16 O[2];
#pragma unroll
        for (int e = 0; e < 16; ++e) { O[0][e] = 0.f; O[1][e] = 0.f; }
        if (LAT) {
            for (int jt = qt; jt < qt + 9; ++jt) {
                f32x16 S;
#pragma unroll
                for (int e = 0; e < 16; ++e) S[e] = 0.f;
                const int krow = 32 * jt + r;
#pragma unroll
                for (int s = 0; s < 4; ++s) S = MFMA32(*(const bf16x8*)(KL + swz128(krow, 2 * s + h)), qrot[s], S);
#pragma unroll
                for (int e = 0; e < 16; ++e) {
                    const int kp = q0 - 128 + 32 * jt + (e & 3) + 8 * (e >> 2) + 4 * h, dd = kp - qpos;
                    const bool ok = dd <= 128 && dd >= -128 && kp >= 0 && kp < SL;
                    S[e] = ok ? S[e] * c1 : -1e30f;
                }
                softmax_pv(S, O, m_run, l_run, VL + 4096 * jt + voff0, VL + 4096 * jt + voff1);
            }
        }
        for (int jt = 0; jt < 8; ++jt) {
            f32x16 S;
#pragma unroll
            for (int e = 0; e < 16; ++e) S[e] = 0.f;
            const int krow = 32 * jt + r;
#pragma unroll
            for (int s = 0; s < 4; ++s) S = MFMA32(*(const bf16x8*)(KC + swz128(krow, 2 * s + h)), qraw[s], S);
#pragma unroll
            for (int e = 0; e < 16; ++e) S[e] *= c1;
            softmax_pv(S, O, m_run, l_run, VC + 4096 * jt + voff0, VC + 4096 * jt + voff1);
        }
        const float inv = 1.f / (l_run + __shfl_xor(l_run, 32));
#pragma unroll
        for (int dt = 0; dt < 2; ++dt)
#pragma unroll
            for (int rg = 0; rg < 4; ++rg) {
                const int d0 = dt * 32 + 8 * rg + 4 * h;
                const u32x2 gv = *(const u32x2*)(GAb + qtok * ATTN_W + head * HD + d0);
                const float g0 = bf2f((bf16)(gv.x & 0xffffu)), g1 = bf2f((bf16)(gv.x >> 16)), g2 = bf2f((bf16)(gv.y & 0xffffu)), g3 = bf2f((bf16)(gv.y >> 16));
                u32x2 o; o.x = pack2(O[dt][4 * rg] * inv * g0, O[dt][4 * rg + 1] * inv * g1); o.y = pack2(O[dt][4 * rg + 2] * inv * g2, O[dt][4 * rg + 3] * inv * g3);
                *(u32x2*)(mixed + qtok * MIX_W + head * HD + d0) = o;
            }
    }
    __syncthreads();
}

DI void phase_p0(const Params& p_, char* smem) {
    constexpr int I_T1 = DEPTH * (D_MODEL / 64) * (IN_COLS / 64), I_T2 = DEPTH * (MIX_W / 64) * (D_MODEL / 64);
    constexpr int I_MOD = DEPTH * ((3 * D_MODEL + 511) / 512), I_ROPE = DEC_SEQ * 32 / NTHR, I_HID = (DEPTH * (SEQ + DEC_SEQ) + 7) / 8;
    constexpr int I_CACHE = (2 * DEC_BATCH * DEPTH * PAST_LEN * KV_W / 8 + NTHR - 1) / NTHR;
    constexpr int TOTAL = I_T1 + I_T2 + I_MOD + I_ROPE + I_HID + I_CACHE;
    for (int it = BIDX(); it < TOTAL; it += gridDim.x) {
        const Params p = launder(p_);
        int q = it;
        if (q < I_T1 + I_T2) {
            const bool w1 = q < I_T1; if (!w1) q -= I_T1;
            const int per = w1 ? (D_MODEL / 64) * (IN_COLS / 64) : (MIX_W / 64) * (D_MODEL / 64), l = q / per;
            if (w1) p0_transpose_item(p.in[I_WIN] + (size_t)l * D_MODEL * IN_COLS, D_MODEL, IN_COLS, (bf16*)(p.ws + WS_WINT) + (size_t)l * IN_COLS * D_MODEL, q % per, smem);
            else p0_transpose_item(p.in[I_WOUT] + (size_t)l * MIX_W * D_MODEL, MIX_W, D_MODEL, (bf16*)(p.ws + WS_WOUTT) + (size_t)l * D_MODEL * MIX_W, q % per, smem);
            continue; }
        q -= I_T1 + I_T2;
        if (q < I_MOD) { p0_mod_item(p, q, smem); continue; }
        q -= I_MOD;
        if (q < I_ROPE) { p0_rope_item(p, q); continue; }
        q -= I_ROPE;
        if (q < I_HID) { p0_hid2_item(p, q); continue; }
        q -= I_HID;
        p0_cache_item(p, q);
    }
}
DI void phase_mix(const Params& p_, int l, int fl, char* smem, int mask) {
    constexpr int I_HL = HYENA_W * ((DEC_BATCH / 2 + 1) / 2), I_AL = DEC_BATCH * N_KV * (DEC_SEQ / 64), I_AC = BATCH * N_KV * (SEQ / 64);
    constexpr int I_HC = HYENA_W / 2, I_SC = T / 64, I_FL = HYENA_W, I_FC = HYENA_W / 16, I_NRM = T / 8;
    static_assert(BATCH / 2 <= 16, "ctx hyena: one bank holds 16 batch pairs");
    for (int it = BIDX(); it < I_FL + I_FC + I_HL + I_HC + I_AL + I_AC + I_SC + I_NRM; it += gridDim.x) {
        const Params p = launder(p_);
        int q = it;
        if (q < I_FL + I_FC) { const bool lat = q < I_FL; if (mask & 64) filter_item(p, fl, lat ? q : q - I_FL, smem, lat); continue; }
        q -= I_FL + I_FC;
        if (q < I_HL + I_HC) { const bool lat = q < I_HL; if (mask & (lat ? 1 : 2)) hyena_item(p, l, lat ? q : q - I_HL, smem, lat); continue; }
        q -= I_HL + I_HC;
        if (q < I_AL + I_AC) { const bool lat = q < I_AL; if (mask & (lat ? 4 : 8)) attn_item(p, l, lat ? q : q - I_AL, smem, lat); continue; }
        q -= I_AL + I_AC;
        if (q < I_SC) { if (mask & 16) shortconv_item(p, l, q); continue; }
        q -= I_SC;
        if (mask & 32) norm_item(p, 0, q);
    }
}
DI void phase_norm(const Params& p, int l) {
    for (int it = BIDX(); it < T / 8; it += gridDim.x) norm_item(p, l, it);
}
DI void phase_hytr(const Params& p, char* smem) {
    for (int it = BIDX(); it < T / 64; it += gridDim.x) hytr_item(p, it, smem);
}

#ifndef PH_STOP
#define PH_STOP 1000
#endif
#ifndef DUP
#define DUP -1
#endif
#ifndef DMASK
#define DMASK 31
#endif
__global__ void __launch_bounds__(NTHR, 2) fwd_kernel(Params p_) {
#ifdef EMU
    char* smem = emu_smem();
#else
    extern __shared__ __attribute__((aligned(16))) char smem[];
    volatile LAS unsigned* xst = (volatile LAS unsigned*)(smem + LDS_BYTES - 16);
    if (TIDX() == 0) { xst[0] = 0u; xst[1] = 0u; }
    __syncthreads();
    const XcdBarrier xbar = xcd_barrier_post((unsigned*)(p_.ws + WS_BAR), xst);
#endif
    constexpr int NPH = 2 + 5 * DEPTH;
#pragma unroll 1
    for (int ph = 0; ph < NPH && ph < PH_STOP; ++ph) {
#pragma unroll 1
        for (int rep = 0; rep < (ph == DUP ? 2 : 1); ++rep) {
            const Params p = launder(p_);
            const int l = ph >= 2 ? (ph - 2) / 5 : 0, k = ph >= 2 ? (ph - 2) % 5 : -1;
            if (ph == 0) phase_p0(p, smem);
            else if (ph == 1 || k == 1) {
                const int mask = rep ? DMASK : (ph == 1 ? 32 + 64 : 31 + (l + 1 < DEPTH ? 64 : 0));
                phase_mix(p, l, ph == 1 ? 0 : l + 1, smem, mask);
            } else if (k == 0 || k == 3) {
                GemmJob job; job.p = p; job.mode = k == 0 ? 0 : 1; job.l = l; job.K = k == 0 ? D_MODEL : MIX_W;
                gemm_phase((ldsptr_t)smem, job);
            } else if (k == 2) phase_hytr(p, smem);
            else phase_norm(p, l + 1);
        }
        if (ph + 1 < NPH) GRID_SYNC();
    }
}

#ifndef EMU
extern "C" void kernel_launch(void* const* d_in, const int* in_sizes, int n_in, void* d_out, int out_size, void* d_ws, size_t ws_size, hipStream_t stream) {
    static int grid = 0;
    if (grid == 0) {
        if (n_in != 22 || (size_t)out_size != OUT_TOTAL || ws_size < WS_END) { fprintf(stderr, "kernel_launch: unexpected sizes n_in %d out %d ws %zu (need %zu)\n", n_in, out_size, ws_size, (size_t)WS_END); grid = -1; return; }
        int dev = 0, cus = 0, per_cu = 0;
        hipGetDevice(&dev); hipDeviceGetAttribute(&cus, hipDeviceAttributeMultiprocessorCount, dev);
        if (hipFuncSetAttribute((const void*)fwd_kernel, hipFuncAttributeMaxDynamicSharedMemorySize, LDS_BYTES) != hipSuccess) { fprintf(stderr, "hipFuncSetAttribute failed\n"); grid = -1; return; }
        hipOccupancyMaxActiveBlocksPerMultiprocessor(&per_cu, (const void*)fwd_kernel, NTHR, LDS_BYTES);
        if (per_cu < 1) { fprintf(stderr, "occupancy query says %d\n", per_cu); grid = -1; return; }
        grid = cus;
    }
    if (grid < 0) return;
    Params p{};
    for (int i = 0; i < 22; ++i) p.in[i] = (const float*)d_in[i];
    p.out = (float*)d_out; p.ws = (unsigned char*)d_ws;
    if (hipMemsetAsync((char*)d_ws + WS_BAR, 0, XCD_BAR_WORDS * 4, stream) != hipSuccess) { fprintf(stderr, "memset failed\n"); return; }
    hipLaunchKernelGGL(fwd_kernel, dim3(grid), dim3(NTHR), LDS_BYTES, stream, p);
    const hipError_t e = hipPeekAtLastError();
    if (e != hipSuccess) fprintf(stderr, "launch failed: %s (grid %d)\n", hipGetErrorString(e), grid);
}
#endif
```

```cpp
#ifdef EMU
#include "emu.h"
#define GRID_SYNC() emu_grid_sync()
#define MFMA32(a, b, c) emu_mfma32((a), (b), (c))
#define MFMA16(a, b, c) emu_mfma16((a), (b), (c))
#define LAS
#define GLDS16(g, l) emu_glds16((const void*)(g), (void*)(l))
#define S_BARRIER() __syncthreads()
#define WAIT_V(n)
#define WAIT_L(n)
#define SCHED_BAR()
#define SETPRIO(x)
#define RFL(x) (x)
#define CBAR()
#define OPQ(x) (x)
#define TIDX() ((int)threadIdx.x)
#define BIDX() ((int)blockIdx.x)
#else
#include <hip/hip_runtime.h>
#include <cstdio>
#include <cstdint>
typedef short bf16x8 __attribute__((ext_vector_type(8)));
typedef float f32x16 __attribute__((ext_vector_type(16)));
typedef float f32x4 __attribute__((ext_vector_type(4)));
#define GRID_SYNC() xcd_barrier(xbar)
#define MFMA32(a, b, c) __builtin_amdgcn_mfma_f32_32x32x16_bf16((a), (b), (c), 0, 0, 0)
#define MFMA16(a, b, c) __builtin_amdgcn_mfma_f32_16x16x32_bf16((a), (b), (c), 0, 0, 0)
#define LAS __attribute__((address_space(3)))
#define GLDS16(g, l) __builtin_amdgcn_global_load_lds((const unsigned*)(g), (LAS unsigned*)(l), 16, 0, 0)
#define S_BARRIER() __builtin_amdgcn_s_barrier()
#define WAIT_V(n) asm volatile("s_waitcnt vmcnt(" #n ")" ::: "memory")
#define WAIT_L(n) asm volatile("s_waitcnt lgkmcnt(" #n ")" ::: "memory")
#define SCHED_BAR() __builtin_amdgcn_sched_barrier(0)
#define SETPRIO(x) __builtin_amdgcn_s_setprio(x)
#define RFL(x) __builtin_amdgcn_readfirstlane(x)
#define CBAR() asm volatile("" ::: "memory")
__device__ __forceinline__ int opq_(int x) { asm volatile("" : "+v"(x)); return x; }
#define OPQ(x) opq_(x)
__device__ __forceinline__ int tidx_() { int t = threadIdx.x; asm volatile("" : "+v"(t)); return t; }
__device__ __forceinline__ int bidx_() { int t = blockIdx.x; asm volatile("" : "+s"(t)); return t; }
#define TIDX() tidx_()
#define BIDX() bidx_()
#endif
typedef unsigned u32x4 __attribute__((ext_vector_type(4)));
typedef unsigned u32x2 __attribute__((ext_vector_type(2)));
typedef float f32x2 __attribute__((ext_vector_type(2)));
typedef unsigned short bf16;
#define DI __device__ __forceinline__
#if defined(PROBE_SEC_ON) && !defined(EMU)
#define PRB_BEGIN(id) unsigned long long _prb_t0_##id = 0; if (PROBE_SEC_ON == (id)) { __syncthreads(); _prb_t0_##id = __builtin_amdgcn_s_memrealtime(); }
#define PRB_END(id, smem) if (PROBE_SEC_ON == (id)) { __syncthreads(); if (BIDX() == 0 && TIDX() == 0) *(volatile unsigned long long*)((smem) + LDS_BYTES - 48) += __builtin_amdgcn_s_memrealtime() - _prb_t0_##id; }
#else
#define PRB_BEGIN(id)
#define PRB_END(id, smem)
#endif

#ifdef CFG_SMALL
constexpr int D_MODEL = 256, BATCH = 2, SEQ = 256, DEPTH = 2, DEC_BATCH = 4, DEC_SEQ = 4096, PAST_LEN = 256, HYENA_W = 128, CONV_W = 128;
#else
constexpr int D_MODEL = 1024, BATCH = 32, SEQ = 256, DEPTH = 4, DEC_BATCH = 8, DEC_SEQ = 4096, PAST_LEN = 256, HYENA_W = 256, CONV_W = 256;
#endif
constexpr int GRID_W = 64, N_HEADS = 8, N_KV = 2, HD = 64, ATTN_W = 512, KV_W = 128;
constexpr int MIX_W = ATTN_W + HYENA_W + CONV_W;
constexpr int C_Q = 0, C_K = ATTN_W, C_V = C_K + KV_W, C_GA = C_V + KV_W, C_HV = C_GA + ATTN_W, C_GH = C_HV + 3 * HYENA_W,
              C_SB = C_GH + HYENA_W, C_GC = C_SB + 3 * CONV_W, IN_COLS = C_GC + CONV_W;
constexpr int TC = BATCH * SEQ, TL = DEC_BATCH * DEC_SEQ, T = TC + TL;
constexpr int NR = 1 + DEC_BATCH;
constexpr int FH = 64, FE = 33;
constexpr int NTHR = 512;
static_assert(T % 256 == 0 && TC % 256 == 0 && C_HV % 256 == 0 && C_SB % 256 == 0 && IN_COLS % 256 == 0 && D_MODEL % 256 == 0 && MIX_W % 128 == 0 && (4 * HYENA_W) % 256 == 0, "tiling");
static_assert(SEQ == 256 && DEC_SEQ == 4096 && PAST_LEN == 256, "fft sizes");

constexpr size_t al256(size_t x) { return (x + 255) & ~(size_t)255; }
constexpr size_t WS_BAR = 0;
constexpr size_t WS_WINT = 65536;
constexpr size_t WS_WOUTT = WS_WINT + al256((size_t)DEPTH * IN_COLS * D_MODEL * 2);
constexpr size_t WS_MOD = WS_WOUTT + al256((size_t)DEPTH * D_MODEL * MIX_W * 2);
constexpr size_t WS_ROPE = WS_MOD + al256((size_t)DEPTH * NR * 3 * D_MODEL * 4);
constexpr size_t WS_HID2 = WS_ROPE + al256((size_t)DEC_SEQ * 32 * 8);
constexpr size_t WS_CKB = WS_HID2 + al256((size_t)DEPTH * (SEQ + DEC_SEQ) * FH * 4);
constexpr size_t WS_CVTB = WS_CKB + al256((size_t)DEC_BATCH * DEPTH * PAST_LEN * KV_W * 2);
constexpr size_t WS_KFL = WS_CVTB + al256((size_t)DEC_BATCH * DEPTH * PAST_LEN * KV_W * 2);
constexpr size_t KFL_BYTES = al256((size_t)2 * HYENA_W * 8192 * 8), KFC_BYTES = al256((size_t)2 * HYENA_W * 512 * 8);
constexpr size_t WS_KFC = WS_KFL + KFL_BYTES;
constexpr size_t WS_ZS = WS_KFC + KFC_BYTES;
constexpr size_t WS_XN = WS_ZS + (size_t)256 * 2 * 4096 * 8;
constexpr size_t WS_Q = WS_XN + al256((size_t)T * (D_MODEL > MIX_W ? D_MODEL : MIX_W) * 2);
constexpr size_t WS_KB = WS_Q + al256((size_t)T * ATTN_W * 2);
constexpr size_t WS_VB = WS_KB + al256((size_t)T * KV_W * 2);
constexpr size_t WS_GA = WS_VB + al256((size_t)T * KV_W * 2);
constexpr size_t WS_HYT = WS_GA + al256((size_t)T * ATTN_W * 2);
constexpr size_t WS_SC = WS_HYT + al256((size_t)4 * HYENA_W * T * 2);
constexpr size_t WS_END0 = WS_SC + al256((size_t)T * 4 * CONV_W * 2);
#ifndef DUP
#define DUP -1
#endif
constexpr size_t WS_ZT = DUP >= 0 ? WS_END0 : WS_HYT;
constexpr size_t WS_END = WS_END0 + (DUP >= 0 ? al256((size_t)HYENA_W * T * 2) : 0);

constexpr size_t OUT_YS = (size_t)TC * D_MODEL, OUT_NK = (size_t)T * D_MODEL, OUT_NV = OUT_NK + (size_t)BATCH * DEPTH * SEQ * KV_W,
                 OUT_TOTAL = OUT_NV + (size_t)BATCH * DEPTH * SEQ * KV_W;

constexpr int LDS_BYTES = 149504;

struct Params {
    const float* in[22];
    float* out;
    unsigned char* ws;
};
enum { I_XP = 0, I_XS, I_CK, I_CV, I_C, I_CCTX, I_NORMG, I_MODW, I_MODB, I_WIN, I_SINK, I_HYCW, I_FW1, I_FB1, I_FW2, I_FB2, I_FW3, I_FFREQ, I_HYD, I_SCW, I_WOUT, I_FINALG };

DI bf16 f2bf(float f) { unsigned u = __float_as_uint(f); u += 0x7fffu + ((u >> 16) & 1u); return (bf16)(u >> 16); }
DI float bf2f(bf16 h) { return __uint_as_float(((unsigned)h) << 16); }
#ifdef EMU
DI unsigned pack2(float a, float b) { return (unsigned)f2bf(a) | ((unsigned)f2bf(b) << 16); }
DI float silu_f(float x) { return x / (1.f + __expf(-x)); }
#else
DI unsigned pack2(float a, float b) { unsigned r; asm("v_cvt_pk_bf16_f32 %0, %1, %2" : "=v"(r) : "v"(a), "v"(b)); return r; }
DI float silu_f(float x) { return x * __builtin_amdgcn_rcpf(1.f + __builtin_amdgcn_exp2f(x * -1.4426950408889634f)); }
#endif
typedef float cpx __attribute__((ext_vector_type(2)));
DI cpx cmul(cpx a, cpx b) { cpx r = b * a.x; r += cpx{-b.y, b.x} * a.y; return r; }
#ifdef EMU
DI Params launder(const Params& p) { return p; }
#else
DI Params launder(const Params& p) { Params q = p; int z = 0; asm volatile("" : "+s"(z)); q.ws = p.ws + z; q.out = p.out + z; return q; }
#endif
DI int mod_row(int m) { return m < TC ? 0 : 1 + (m - TC) / DEC_SEQ; }


#ifndef EMU
#define XB_TMO      128
#define XB_XCNT(j)  (256  + 64 * (j))
#define XB_XSUB(j)  (1280 + 64 * (j))
#define XB_XGEN(j)  (2304 + 64 * (j))
#define XB_TOP      3328
#define XB_TOPGEN   3392
#define XCD_BAR_WORDS 3456
#define XB_SPIN_CAP (1u << 22)
DI unsigned xb_ld(unsigned* p) { return __hip_atomic_load(p, __ATOMIC_RELAXED, __HIP_MEMORY_SCOPE_AGENT); }
DI unsigned xb_add(unsigned* p, unsigned v) { return __hip_atomic_fetch_add(p, v, __ATOMIC_RELAXED, __HIP_MEMORY_SCOPE_AGENT); }
DI unsigned xb_xcc_id() { return (unsigned)__builtin_amdgcn_s_getreg((3 << 11) | 20) & 0xFu; }
#define XB_SPIN(cond, bar) do { unsigned _sp = 0; while (cond) { __builtin_amdgcn_s_sleep(1); \
    if ((++_sp & 255u) == 0u) { if (xb_ld(&(bar)[XB_TMO])) break; if (_sp > XB_SPIN_CAP) { atomicAdd(&(bar)[XB_TMO], 1u); break; } } } } while (0)
struct XcdBarrier { unsigned* bar; unsigned x; volatile LAS unsigned* st; };
DI XcdBarrier xcd_barrier_post(unsigned* bar, volatile LAS unsigned* st) {
    XcdBarrier b; b.bar = bar; b.x = xb_xcc_id(); b.st = st;
    if (TIDX() == 0) (void)xb_add(&bar[XB_XCNT(b.x)], 1u);
    return b;
}
DI void xcd_barrier_complete(unsigned* bar, unsigned x, unsigned& nloc, unsigned& nx) {
    const unsigned G = gridDim.x * gridDim.y * gridDim.z;
    unsigned sum, cnt, mine, sp = 0u;
    for (;;) {
        sum = 0u; cnt = 0u; mine = 0u;
#pragma unroll
        for (unsigned j = 0; j < 16; ++j) { const unsigned c = xb_ld(&bar[XB_XCNT(j)]); sum += c; cnt += (c > 0u) ? 1u : 0u; mine = (j == x) ? c : mine; }
        if (sum == G) break;
        __builtin_amdgcn_s_sleep(1);
        if ((++sp & 255u) == 0u) { if (xb_ld(&bar[XB_TMO])) break; if (sp > XB_SPIN_CAP) { atomicAdd(&bar[XB_TMO], 1u); break; } }
    }
    nloc = mine > 0u ? mine : 1u; nx = cnt > 0u ? cnt : 1u;
}
DI void xcd_barrier(const XcdBarrier& b) {
    asm volatile("s_waitcnt vmcnt(0)" ::: "memory");
    __syncthreads();
    if (TIDX() == 0) {
        unsigned* bar = b.bar;
        __builtin_amdgcn_s_waitcnt(0);
        unsigned nloc = b.st[0], nx = b.st[1];
        if (nloc == 0u) { xcd_barrier_complete(bar, b.x, nloc, nx); b.st[0] = nloc; b.st[1] = nx; }
        const unsigned old = xb_add(&bar[XB_XSUB(b.x)], 1u);
        const unsigned gen = old / nloc;
        if (old + 1u == (gen + 1u) * nloc) {
            __builtin_amdgcn_fence(__ATOMIC_RELEASE, "agent");
            asm volatile("s_waitcnt vmcnt(0)" ::: "memory");
            const unsigned og = xb_add(&bar[XB_TOP], 1u);
            const unsigned tg = og / nx;
            if (og + 1u == (tg + 1u) * nx) xb_add(&bar[XB_TOPGEN], 1u);
            else XB_SPIN(xb_ld(&bar[XB_TOPGEN]) == tg, bar);
            __builtin_amdgcn_fence(__ATOMIC_ACQUIRE, "agent");
            xb_add(&bar[XB_XGEN(b.x)], 1u);
            asm volatile("s_waitcnt vmcnt(0)" ::: "memory");
        } else {
            XB_SPIN(xb_ld(&bar[XB_XGEN(b.x)]) == gen, bar);
            __builtin_amdgcn_fence(__ATOMIC_ACQUIRE, "agent");
            asm volatile("s_waitcnt vmcnt(0)" ::: "memory");
        }
    }
    __syncthreads();
}
#endif

constexpr size_t WS_WQ = WS_BAR + 16384;
#ifdef EMU
DI int wq_fetch(unsigned* c) { const unsigned v = *c; *c = v + 1; return (int)v; }
#else
DI int wq_fetch(unsigned* c) { return (int)__hip_atomic_fetch_add(c, 1u, __ATOMIC_RELAXED, __HIP_MEMORY_SCOPE_AGENT); }
#endif
DI int wq_next(const Params& p, int qid, char* smem) {
    volatile int* slot = (volatile int*)(smem + LDS_BYTES - 32);
    __syncthreads();
    if (TIDX() == 0) *slot = wq_fetch((unsigned*)(p.ws + WS_WQ) + qid * 64);
    __syncthreads();
    return *slot;
}

DI void p0_transpose_item(const float* W, int K, int N, bf16* WT, int item, char* smem) {
    float* scr = (float*)smem;
    const int tid = TIDX(), nblk = N / 64, k0 = (item / nblk) * 64, n0 = (item % nblk) * 64;
#pragma unroll
    for (int i = 0; i < 8; ++i) { const int kk = (tid >> 6) + 8 * i, nn = tid & 63; scr[kk * 65 + nn] = W[(size_t)(k0 + kk) * N + n0 + nn]; }
    __syncthreads();
    const int n = tid >> 3, c = tid & 7;
    const float* s = scr + (8 * c) * 65 + n;
    u32x4 o; o.x = pack2(s[0], s[65]); o.y = pack2(s[2 * 65], s[3 * 65]); o.z = pack2(s[4 * 65], s[5 * 65]); o.w = pack2(s[6 * 65], s[7 * 65]);
    *(u32x4*)(WT + (size_t)(n0 + n) * K + k0 + 8 * c) = o;
    __syncthreads();
}
DI void p0_mod_item(const Params& p, int item, char* smem) {
    constexpr int NCH = 3 * D_MODEL / 64, KG = D_MODEL / 8;
    float* tab = (float*)smem;
    float* red = tab + NR * D_MODEL;
    const int tid = TIDX(), l = item / NCH, col = (item % NCH) * 64 + (tid & 63), kg = tid >> 6;
    for (int e = tid; e < NR * D_MODEL; e += NTHR) { const int r = e / D_MODEL, k = e % D_MODEL; const float cv = r == 0 ? p.in[I_CCTX][k] : p.in[I_C][(size_t)(r - 1) * D_MODEL + k]; tab[e] = silu_f(cv); }
    __syncthreads();
    float acc[NR];
#pragma unroll
    for (int r = 0; r < NR; ++r) acc[r] = 0.f;
    const float* w = p.in[I_MODW] + (size_t)l * D_MODEL * 3 * D_MODEL + (size_t)(kg * KG) * 3 * D_MODEL + col;
#pragma unroll 16
    for (int k = 0; k < KG; ++k) { const float wv = w[(size_t)k * 3 * D_MODEL];
#pragma unroll
        for (int r = 0; r < NR; ++r) acc[r] += tab[r * D_MODEL + kg * KG + k] * wv; }
#pragma unroll
    for (int r = 0; r < NR; ++r) red[(kg * NR + r) * 64 + (tid & 63)] = acc[r];
    __syncthreads();
    for (int e = tid; e < NR * 64; e += NTHR) {
        const int r = e >> 6, c = e & 63, cc = (item % NCH) * 64 + c;
        float s = p.in[I_MODB][(size_t)l * 3 * D_MODEL + cc];
#pragma unroll
        for (int g = 0; g < 8; ++g) s += red[(g * NR + r) * 64 + c];
        ((float*)(p.ws + WS_MOD))[((size_t)l * NR + r) * 3 * D_MODEL + cc] = s;
    }
    __syncthreads();
}
DI void p0_rope_item(const Params& p, int item) {
    const int e = item * NTHR + TIDX();
    if (e < DEC_SEQ * 32) {
        const int t = e >> 5, a = (e >> 4) & 1, f = e & 15;
        const float pos = (float)(a ? (t % GRID_W) : (t / GRID_W));
        const float inv = exp2f(-(float)f * (13.287712379549449f / 16.f));
        const float ang = pos * inv;
        f32x2 v; v.x = cosf(ang); v.y = sinf(ang);
        ((f32x2*)(p.ws + WS_ROPE))[e] = v;
    }
}
DI void p0_hid2_item(const Params& p, int item) {
    const int lane = TIDX() & 63, w = TIDX() >> 6;
    const int r0 = item * 64, l = r0 / (SEQ + DEC_SEQ), q0 = r0 % (SEQ + DEC_SEQ);
    const int L = q0 < SEQ ? SEQ : DEC_SEQ, tb = (q0 < SEQ ? q0 : q0 - SEQ) + w * 8;
    const float* w1 = p.in[I_FW1] + (size_t)l * FE * FH + lane; const float* w2 = p.in[I_FW2] + (size_t)l * FH * FH + lane;
    float wa[FE], wb[FH];
#pragma unroll
    for (int i = 0; i < FE; ++i) wa[i] = w1[i * FH];
#pragma unroll
    for (int i = 0; i < FH; ++i) wb[i] = w2[i * FH];
    const float fq = p.in[I_FFREQ][l * FH + lane], b1 = p.in[I_FB1][l * FH + lane], b2 = p.in[I_FB2][l * FH + lane];
    float* dst = (float*)(p.ws + WS_HID2) + (size_t)l * (SEQ + DEC_SEQ) * FH + (q0 < SEQ ? 0 : (size_t)SEQ * FH) + (size_t)lane * L;
#pragma unroll 1
    for (int r = 0; r < 8; ++r) {
        const int t = tb + r;
        float feat = 0.f;
        if (lane == 0) feat = (float)t / (float)(L - 1);
        else if (lane < FE) {
            const int b = (lane - 1) & 15;
            const float fr = 1e-4f + (float)b * ((15.f - 1e-4f) / 15.f);
            const float ang = (6.283185307179586f / (float)L) * (float)t;
            feat = lane <= 16 ? cosf(fr * ang) : -sinf(fr * ang);
        }
        float a1 = b1;
#pragma unroll
        for (int i = 0; i < FE; ++i) a1 += __shfl(feat, i) * wa[i];
        const float h1 = sinf(fq * a1);
        float a2 = b2;
#pragma unroll
        for (int i = 0; i < FH; ++i) a2 += __shfl(h1, i) * wb[i];
        dst[t] = sinf(fq * a2);
    }
}
DI void p0_cache_item(const Params& p, int item) {
    constexpr int NCHUNK = DEC_BATCH * DEPTH * PAST_LEN * KV_W / 8;
    int e = item * NTHR + TIDX();
    if (e < 2 * NCHUNK) {
        const bool isv = e >= NCHUNK; if (isv) e -= NCHUNK;
        const int c8 = e & 7, j = (e >> 3) % PAST_LEN, kvh = (e >> 3) / PAST_LEN % N_KV, bl = (e >> 3) / PAST_LEN / N_KV;
        const float* src = p.in[isv ? I_CV : I_CK] + ((size_t)(bl * PAST_LEN + j) * N_KV + kvh) * HD + c8 * 8;
        u32x4 o; o.x = pack2(src[0], src[1]); o.y = pack2(src[2], src[3]); o.z = pack2(src[4], src[5]); o.w = pack2(src[6], src[7]);
        *(u32x4*)((bf16*)(p.ws + (isv ? WS_CVTB : WS_CKB)) + (size_t)e * 8) = o;
    }
}

DI const float* x_row_src(const Params& p, int l, int m) {
    if (l == 0) return m < TC ? p.in[I_XP] + (size_t)m * D_MODEL : p.in[I_XS] + (size_t)(m - TC) * D_MODEL;
    return p.out + (size_t)m * D_MODEL;
}
DI void norm_rows2(const Params& p, int l, int m0, int lane) {
    constexpr int NV = (D_MODEL / 4 + 63) / 64;
    f32x4 v[2][NV]; float ss[2] = {0.f, 0.f};
#pragma unroll
    for (int r = 0; r < 2; ++r) {
        const float* xr = x_row_src(p, l, m0 + r);
#pragma unroll
        for (int i = 0; i < NV; ++i) { const int c4 = lane + 64 * i; v[r][i] = c4 < D_MODEL / 4 ? *(const f32x4*)(xr + 4 * c4) : (f32x4){0.f, 0.f, 0.f, 0.f}; }
    }
#pragma unroll
    for (int r = 0; r < 2; ++r)
#pragma unroll
        for (int i = 0; i < NV; ++i) ss[r] += v[r][i].x * v[r][i].x + v[r][i].y * v[r][i].y + v[r][i].z * v[r][i].z + v[r][i].w * v[r][i].w;
#pragma unroll
    for (int o = 1; o < 64; o <<= 1) { ss[0] += __shfl_xor(ss[0], o); ss[1] += __shfl_xor(ss[1], o); }
#pragma unroll
    for (int r = 0; r < 2; ++r) {
        const int m = m0 + r;
        const float rstd = rsqrtf(ss[r] * (1.f / D_MODEL) + 1e-6f);
        if (l < DEPTH) {
            const float* g = p.in[I_NORMG] + (size_t)l * D_MODEL;
            const float* mod = (const float*)(p.ws + WS_MOD) + ((size_t)l * NR + mod_row(m)) * 3 * D_MODEL;
            bf16* xn = (bf16*)(p.ws + WS_XN) + (size_t)m * D_MODEL;
#pragma unroll
            for (int i = 0; i < NV; ++i) {
                const int c4 = lane + 64 * i;
                if (c4 < D_MODEL / 4) {
                    const f32x4 x = v[r][i], gv = *(const f32x4*)(g + 4 * c4), sh = *(const f32x4*)(mod + 4 * c4), sc = *(const f32x4*)(mod + D_MODEL + 4 * c4);
                    u32x2 o; o.x = pack2(x.x * rstd * gv.x * (1.f + sc.x) + sh.x, x.y * rstd * gv.y * (1.f + sc.y) + sh.y);
                    o.y = pack2(x.z * rstd * gv.z * (1.f + sc.z) + sh.z, x.w * rstd * gv.w * (1.f + sc.w) + sh.w);
                    *(u32x2*)(xn + 4 * c4) = o;
                }
            }
        } else {
            const float* g = p.in[I_FINALG];
            float* yo = p.out + (size_t)m * D_MODEL;
#pragma unroll
            for (int i = 0; i < NV; ++i) {
                const int c4 = lane + 64 * i;
                if (c4 < D_MODEL / 4) {
                    const f32x4 x = v[r][i], gv = *(const f32x4*)(g + 4 * c4);
                    f32x4 o; o.x = x.x * rstd * gv.x; o.y = x.y * rstd * gv.y; o.z = x.z * rstd * gv.z; o.w = x.w * rstd * gv.w;
                    *(f32x4*)(yo + 4 * c4) = o;
                }
            }
        }
    }
}
DI void norm_item(const Params& p, int l, int item) {
    norm_rows2(p, l, item * 16 + 2 * (TIDX() >> 6), TIDX() & 63);
}

DI int swz128(int row, int c) { return row * 128 + ((c ^ ((row >> 1) & 7)) << 4); }
constexpr int BM = 256, BK = 64, HALFT = 128, HTB = HALFT * BK * 2, STAGE_BYTES = 8 * HTB;
static_assert(STAGE_BYTES <= LDS_BYTES - 32 && 2 * 8704 * 8 + 128 <= LDS_BYTES - 16, "lds");
DI int lds_byte(int r, int c) { const int st = (r >> 4) * 2 + (c >> 5), rr = r & 15, cc = c & 31, ob = rr * 64 + cc * 2; return st * 1024 + (ob ^ (((ob >> 9) & 1) << 5)); }
DI void stage_rc(int b, int& R, int& C) { const int st = b / 1024, sb = b % 1024, swz = sb ^ (((sb >> 9) & 1) << 5); R = (st >> 1) * 16 + swz / 64; C = (st & 1) * 32 + (swz % 64) / 2; }
DI int perm32(int rho) { const int n = rho >> 4, i = rho & 15; return 8 * (i >> 2) + 4 * n + (i & 3); }
struct Unit { int pm, pn, kind; };
DI void static_order(int L, int nM, int nN, int& pm, int& pn) {
    constexpr int NXCD = 8, WGM = 8;
    const int nwg = nM * nN;
    int wgid = L; { const int q = nwg / NXCD, r = nwg % NXCD, xcd = wgid % NXCD, off = wgid / NXCD; wgid = (xcd < r ? xcd * (q + 1) : r * (q + 1) + (xcd - r) * q) + off; }
    const int nig = WGM * nN, gid = wgid / nig, fm = gid * WGM, gsz = (nM - fm) < WGM ? (nM - fm) : WGM;
    pm = fm + ((wgid % nig) % gsz); pn = (wgid % nig) / gsz;
}
constexpr int NT_TOK = (IN_COLS - 4 * HYENA_W) / 256, NT_TOKA = C_HV / 256, NT_CH = 4 * HYENA_W / 256, NTM = T / 256;
constexpr int NU_TOK = NTM * NT_TOK, NU_CH = NT_CH * NTM, NU_OUT = NTM * (D_MODEL / 256);
struct GemmJob {
    Params p; int mode, l, K;
    DI bool next(int i, Unit& u) const {
        const int L = i * (int)gridDim.x + BIDX();
        if (mode == 0) {
            if (L < NU_TOK) { u.kind = 0; static_order(L, NTM, NT_TOK, u.pm, u.pn); return true; }
            if (L < NU_TOK + NU_CH) { u.kind = 1; static_order(L - NU_TOK, NT_CH, NTM, u.pm, u.pn); return true; }
            return false;
        }
        if (L < NU_OUT) { u.kind = 2; static_order(L, NTM, D_MODEL / 256, u.pm, u.pn); return true; }
        return false;
    }
    DI int tokcol(int pn) const { return pn < NT_TOKA ? pn * 256 : C_SB + (pn - NT_TOKA) * 256; }
    DI void ptrs(const Unit& u, const char*& a, const char*& b) const {
        const size_t rb = (size_t)K * 2;
        const char* xn = (const char*)(p.ws + WS_XN);
        if (u.kind == 0) { a = xn + (size_t)u.pm * 256 * rb; b = (const char*)(p.ws + WS_WINT) + ((size_t)l * IN_COLS + tokcol(u.pn)) * rb; }
        else if (u.kind == 1) { a = (const char*)(p.ws + WS_WINT) + ((size_t)l * IN_COLS + C_HV + u.pm * 256) * rb; b = xn + (size_t)u.pn * 256 * rb; }
        else { a = xn + (size_t)u.pm * 256 * rb; b = (const char*)(p.ws + WS_WOUTT) + ((size_t)l * D_MODEL + u.pn * 256) * rb; }
    }
    DI void epilogue(const f32x4 (&acc)[2][2][4][2], const Unit& u, int wr, int wc, int fr, int fq) const {
        if (u.kind == 0) {
            const bool ctx = u.pm * 256 < TC;
#pragma unroll 1
            for (int bj = 0; bj < 2; ++bj) {
                const int n0 = tokcol(u.pn) + 128 * bj, c0 = n0 + 32 * wc + 8 * fq;
                bf16* dst; int ld; bool sil = false; int special = 0;
                if (n0 < C_K) { dst = (bf16*)(p.ws + WS_Q) + c0; ld = ATTN_W; }
                else if (n0 < C_V) { dst = (bf16*)(p.ws + WS_KB) + (c0 - C_K); ld = KV_W; special = 1; }
                else if (n0 < C_GA) { dst = (bf16*)(p.ws + WS_VB) + (c0 - C_V); ld = KV_W; special = 2; }
                else if (n0 < C_HV) { dst = (bf16*)(p.ws + WS_GA) + (c0 - C_GA); ld = ATTN_W; sil = true; }
                else { dst = (bf16*)(p.ws + WS_SC) + (c0 - C_SB); ld = 4 * CONV_W; sil = n0 >= C_GC; }
#pragma unroll
                for (int ai = 0; ai < 2; ++ai)
#pragma unroll
                    for (int m = 0; m < 4; ++m) {
                        const int row = u.pm * 256 + 64 * wr + fr + OPQ(128 * ai + 16 * m);
                        f32x4 v0 = bj ? acc[ai][1][m][0] : acc[ai][0][m][0], v1 = bj ? acc[ai][1][m][1] : acc[ai][0][m][1];
                        if (sil) { v0.x = silu_f(v0.x); v0.y = silu_f(v0.y); v0.z = silu_f(v0.z); v0.w = silu_f(v0.w); v1.x = silu_f(v1.x); v1.y = silu_f(v1.y); v1.z = silu_f(v1.z); v1.w = silu_f(v1.w); }
                        if (special && ctx) {
                            float* o = p.out + (special == 1 ? OUT_NK : OUT_NV) + ((size_t)((row / SEQ) * DEPTH + l) * SEQ + (row % SEQ)) * KV_W + (c0 - (special == 1 ? C_K : C_V));
                            *(f32x4*)o = v0; *(f32x4*)(o + 4) = v1;
                        }
                        if (special == 1 && !ctx) {
                            const int pos = (row - TC) % DEC_SEQ, a = wc & 1, pp = fq >> 1, f0 = 8 * (fq & 1);
                            const f32x4* rp = (const f32x4*)((const f32x2*)(p.ws + WS_ROPE) + (pos * 2 + a) * 16 + f0);
                            const f32x4 r0 = rp[0], r1 = rp[1], r2 = rp[2], r3 = rp[3];
                            f32x4 o0, o1;
                            o0.x = __shfl_xor(v0.x, 32); o0.y = __shfl_xor(v0.y, 32); o0.z = __shfl_xor(v0.z, 32); o0.w = __shfl_xor(v0.w, 32);
                            o1.x = __shfl_xor(v1.x, 32); o1.y = __shfl_xor(v1.y, 32); o1.z = __shfl_xor(v1.z, 32); o1.w = __shfl_xor(v1.w, 32);
                            const float sg = pp ? 1.f : -1.f;
                            v0.x = v0.x * r0.x + sg * o0.x * r0.y; v0.y = v0.y * r0.z + sg * o0.y * r0.w; v0.z = v0.z * r1.x + sg * o0.z * r1.y; v0.w = v0.w * r1.z + sg * o0.w * r1.w;
                            v1.x = v1.x * r2.x + sg * o1.x * r2.y; v1.y = v1.y * r2.z + sg * o1.y * r2.w; v1.z = v1.z * r3.x + sg * o1.z * r3.y; v1.w = v1.w * r3.z + sg * o1.w * r3.w;
                        }
                        u32x4 w; w.x = pack2(v0.x, v0.y); w.y = pack2(v0.z, v0.w); w.z = pack2(v1.x, v1.y); w.w = pack2(v1.z, v1.w);
                        *(u32x4*)(dst + (size_t)row * ld) = w;
                        CBAR();
                    }
            }
        } else if (u.kind == 1) {
            bf16* HYT = (bf16*)(p.ws + WS_HYT);
#pragma unroll
            for (int ai = 0; ai < 2; ++ai) {
                const bool sil = u.pm * 256 + 128 * ai >= 3 * HYENA_W;
#pragma unroll
                for (int m = 0; m < 4; ++m) {
                    const int ch = u.pm * 256 + 64 * wr + fr + OPQ(128 * ai + 16 * m);
#pragma unroll
                    for (int bj = 0; bj < 2; ++bj) {
                        f32x4 v0 = acc[ai][bj][m][0], v1 = acc[ai][bj][m][1];
                        if (sil) { v0.x = silu_f(v0.x); v0.y = silu_f(v0.y); v0.z = silu_f(v0.z); v0.w = silu_f(v0.w); v1.x = silu_f(v1.x); v1.y = silu_f(v1.y); v1.z = silu_f(v1.z); v1.w = silu_f(v1.w); }
                        u32x4 w; w.x = pack2(v0.x, v0.y); w.y = pack2(v0.z, v0.w); w.z = pack2(v1.x, v1.y); w.w = pack2(v1.z, v1.w);
                        *(u32x4*)(HYT + (size_t)ch * T + u.pn * 256 + 128 * bj + 32 * wc + 8 * fq) = w;
                        CBAR();
                    }
                }
            }
        } else {
            const float* gate = (const float*)(p.ws + WS_MOD) + ((size_t)l * NR + mod_row(u.pm * 256)) * 3 * D_MODEL + 2 * D_MODEL;
#pragma unroll
            for (int bj = 0; bj < 2; ++bj) {
                const int n = u.pn * 256 + 128 * bj + 32 * wc + 8 * fq;
                const f32x4 g0 = *(const f32x4*)(gate + n), g1 = *(const f32x4*)(gate + n + 4);
#pragma unroll
                for (int ai = 0; ai < 2; ++ai)
#pragma unroll
                    for (int m = 0; m < 4; ++m) {
                        const int row = u.pm * 256 + 64 * wr + fr + OPQ(128 * ai + 16 * m);
                        const float* xs = x_row_src(p, l, row) + n;
                        const f32x4 x0 = *(const f32x4*)xs, x1 = *(const f32x4*)(xs + 4);
                        float* o = p.out + (size_t)row * D_MODEL + n;
                        *(f32x4*)o = x0 + g0 * acc[ai][bj][m][0]; *(f32x4*)(o + 4) = x1 + g1 * acc[ai][bj][m][1];
                        CBAR();
                    }
            }
        }
    }
};

#ifdef EMU
typedef unsigned char* ldsptr_t;
#else
typedef LAS unsigned char* ldsptr_t;
#endif
DI void gemm_phase(ldsptr_t lds, const GemmJob& S) {
    const int tid = TIDX(), wid = RFL(tid >> 6), lane = tid & 63, wr = wid >> 2, wc = wid & 3, fr = lane & 15, fq = lane >> 4;
    const int K = S.K, nt = K / BK;
    unsigned voffA[2], voffB[2];
#pragma unroll
    for (int i = 0; i < 2; ++i) { int R, C; stage_rc(tid * 16 + i * 8192, R, C); const int Rb = (R & ~31) + perm32(R & 31);
        voffA[i] = (unsigned)(R * K + C) * 2u; voffB[i] = (unsigned)(Rb * K + C) * 2u; }
    const size_t kstep = (size_t)(BK * 2);
    const size_t hstep = (size_t)HALFT * K * 2;
    const unsigned ldsw = (unsigned)wid * 1024u;
    const int aoff = lds_byte(wr * 64 + fr, fq * 8), boff = lds_byte(wc * 32 + fr, fq * 8);
#define PG8_SA(b, h) (((b) * 2 + (h)) * HTB)
#define PG8_SB(b, h) ((4 + (b) * 2 + (h)) * HTB)
#define PG8_STAGE(bufoff, gbase, voff) do { _Pragma("unroll") for (int _i = 0; _i < 2; ++_i) GLDS16((const char*)(gbase) + (voff)[_i], lds + (bufoff) + ldsw + _i * 8192); } while (0)
#define PG8_LDA(dst, b, h) do { _Pragma("unroll") for (int m = 0; m < 4; ++m) _Pragma("unroll") for (int k = 0; k < 2; ++k) dst[m][k] = *(const LAS bf16x8*)(lds + PG8_SA(b, h) + aoff + m * 2048 + k * 1024); } while (0)
#define PG8_LDB(dst, b, h) do { _Pragma("unroll") for (int n = 0; n < 2; ++n) _Pragma("unroll") for (int k = 0; k < 2; ++k) dst[n][k] = *(const LAS bf16x8*)(lds + PG8_SB(b, h) + boff + n * 2048 + k * 1024); } while (0)
#define PG8_MMA(ai, bj, At, Bt) do { SETPRIO(1); _Pragma("unroll") for (int m = 0; m < 4; ++m) _Pragma("unroll") for (int n = 0; n < 2; ++n) _Pragma("unroll") for (int k = 0; k < 2; ++k) \
        acc[ai][bj][m][n] = MFMA16(Bt[n][k], At[m][k], acc[ai][bj][m][n]); SETPRIO(0); } while (0)
    Unit cur, nxt; int ui = 0;
    if (!S.next(0, cur)) return;
    f32x4 acc[2][2][4][2];
#pragma unroll
    for (int a = 0; a < 2; ++a)
#pragma unroll
        for (int b = 0; b < 2; ++b)
#pragma unroll
            for (int m = 0; m < 4; ++m)
#pragma unroll
                for (int n = 0; n < 2; ++n) acc[a][b][m][n] = (f32x4){0.f, 0.f, 0.f, 0.f};
    bf16x8 At[4][2], B0[2][2], B1[2][2];
    const char* cA; const char* cB; S.ptrs(cur, cA, cB);
    PG8_STAGE(PG8_SB(0, 0), cB, voffB); PG8_STAGE(PG8_SA(0, 0), cA, voffA); PG8_STAGE(PG8_SB(0, 1), cB + hstep, voffB); PG8_STAGE(PG8_SA(0, 1), cA + hstep, voffA);
    if (wr == 1) S_BARRIER();
    WAIT_V(4); S_BARRIER();
    PG8_STAGE(PG8_SB(1, 0), cB + kstep, voffB); PG8_STAGE(PG8_SA(1, 0), cA + kstep, voffA); PG8_STAGE(PG8_SB(1, 1), cB + hstep + kstep, voffB);
    WAIT_V(6); S_BARRIER();
    for (;;) {
        const bool has_next = S.next(ui + 1, nxt);
        const char* nA = cA; const char* nB = cB; if (has_next) S.ptrs(nxt, nA, nB);
        for (int t = 0; t < nt; t += 2) {
            const bool last = (t == nt - 2);
            const char* a1 = cA + (size_t)(t + 1) * kstep;
            const char* a2 = last ? nA : cA + (size_t)(t + 2) * kstep; const char* b2 = last ? nB : cB + (size_t)(t + 2) * kstep;
            const char* a3 = a2 + kstep; const char* b3 = b2 + kstep;
            PG8_LDB(B0, 0, 0); SCHED_BAR(); PG8_LDA(At, 0, 0); PG8_STAGE(PG8_SA(1, 1), a1 + hstep, voffA);
            WAIT_L(8); S_BARRIER(); WAIT_L(0); PG8_MMA(0, 0, At, B0); S_BARRIER(); SCHED_BAR();
            PG8_LDB(B1, 0, 1); PG8_STAGE(PG8_SB(0, 0), b2, voffB);
            S_BARRIER(); WAIT_L(0); PG8_MMA(0, 1, At, B1); S_BARRIER();
            PG8_LDA(At, 0, 1); PG8_STAGE(PG8_SA(0, 0), a2, voffA);
            S_BARRIER(); WAIT_L(0); PG8_MMA(1, 0, At, B0); S_BARRIER(); SCHED_BAR();
            PG8_STAGE(PG8_SB(0, 1), b2 + hstep, voffB);
            WAIT_V(6); S_BARRIER(); PG8_MMA(1, 1, At, B1); S_BARRIER();
            PG8_LDB(B0, 1, 0); SCHED_BAR(); PG8_LDA(At, 1, 0); PG8_STAGE(PG8_SA(0, 1), a2 + hstep, voffA);
            WAIT_L(8); S_BARRIER(); WAIT_L(0); PG8_MMA(0, 0, At, B0); S_BARRIER(); SCHED_BAR();
            PG8_LDB(B1, 1, 1); PG8_STAGE(PG8_SB(1, 0), b3, voffB);
            S_BARRIER(); WAIT_L(0); PG8_MMA(0, 1, At, B1); S_BARRIER();
            PG8_LDA(At, 1, 1); PG8_STAGE(PG8_SA(1, 0), a3, voffA);
            S_BARRIER(); WAIT_L(0); PG8_MMA(1, 0, At, B0); S_BARRIER(); SCHED_BAR();
            PG8_STAGE(PG8_SB(1, 1), b3 + hstep, voffB);
            WAIT_V(6); S_BARRIER(); PG8_MMA(1, 1, At, B1); S_BARRIER();
        }
        S.epilogue(acc, cur, wr, wc, fr, fq);
        if (!has_next) break;
#pragma unroll
        for (int a = 0; a < 2; ++a)
#pragma unroll
            for (int b = 0; b < 2; ++b)
#pragma unroll
                for (int m = 0; m < 4; ++m)
#pragma unroll
                    for (int n = 0; n < 2; ++n) acc[a][b][m][n] = (f32x4){0.f, 0.f, 0.f, 0.f};
        cur = nxt; cA = nA; cB = nB; ++ui;
    }
    WAIT_V(0);
    if (wr == 0) S_BARRIER();
    S_BARRIER();
#undef PG8_SA
#undef PG8_SB
#undef PG8_STAGE
#undef PG8_LDA
#undef PG8_LDB
#undef PG8_MMA
}

DI void unpack8(const u32x4 v, float (&f)[8]) {
    f[0] = __uint_as_float(v.x << 16); f[1] = __uint_as_float(v.x & 0xffff0000u); f[2] = __uint_as_float(v.y << 16); f[3] = __uint_as_float(v.y & 0xffff0000u);
    f[4] = __uint_as_float(v.z << 16); f[5] = __uint_as_float(v.z & 0xffff0000u); f[6] = __uint_as_float(v.w << 16); f[7] = __uint_as_float(v.w & 0xffff0000u);
}
DI int PADX(int i) { return i + (i >> 4); }
constexpr int FB_BANK = 8704;
template <int SIGN> DI void dft4(cpx& a0, cpx& a1, cpx& a2, cpx& a3) {
    const cpx t0 = a0 + a2, t1 = a0 - a2, t2 = a1 + a3, t3 = a1 - a3;
    const cpx t3r = SIGN < 0 ? cpx{t3.y, -t3.x} : cpx{-t3.y, t3.x};
    a0 = t0 + t2; a1 = t1 + t3r; a2 = t0 - t2; a3 = t1 - t3r;
}
template <int SIGN> DI void dft16(cpx (&v)[16]) {
#pragma unroll
    for (int n2 = 0; n2 < 4; ++n2) dft4<SIGN>(v[n2], v[4 + n2], v[8 + n2], v[12 + n2]);
    constexpr float C1 = 0.92387953251128674f, S1 = 0.38268343236508977f, R = 0.70710678118654752f, SG = (float)SIGN;
    v[5] = cmul(v[5], cpx{C1, SG * S1});  v[6] = cmul(v[6], cpx{R, SG * R});     v[7] = cmul(v[7], cpx{S1, SG * C1});
    v[9] = cmul(v[9], cpx{R, SG * R});    v[10] = cmul(v[10], cpx{0.f, SG});     v[11] = cmul(v[11], cpx{-R, SG * R});
    v[13] = cmul(v[13], cpx{S1, SG * C1}); v[14] = cmul(v[14], cpx{-R, SG * R}); v[15] = cmul(v[15], cpx{-C1, -SG * S1});
#pragma unroll
    for (int k1 = 0; k1 < 4; ++k1) dft4<SIGN>(v[4 * k1], v[4 * k1 + 1], v[4 * k1 + 2], v[4 * k1 + 3]);
}
template <int SIGN> DI void fft_pass16x2(cpx* fa, cpx* fb, int j, int Ns, int N16) {
    cpx va[16], vb[16];
#pragma unroll
    for (int r = 0; r < 16; ++r) { const int ix = PADX(j + N16 * r); va[r] = fa[ix]; vb[r] = fb[ix]; }
    const int k = j & (Ns - 1);
    if (Ns > 1) {
        float sn, cs; sincospif((float)(SIGN * 2 * k) / (float)(16 * Ns), &sn, &cs);
        cpx w[16];
        w[1] = cpx{cs, sn}; w[2] = cmul(w[1], w[1]); w[3] = cmul(w[2], w[1]); w[4] = cmul(w[2], w[2]); w[5] = cmul(w[4], w[1]); w[6] = cmul(w[4], w[2]); w[7] = cmul(w[4], w[3]); w[8] = cmul(w[4], w[4]);
#pragma unroll
        for (int r = 9; r < 16; ++r) w[r] = cmul(w[8], w[r - 8]);
#pragma unroll
        for (int r = 1; r < 16; ++r) { va[r] = cmul(va[r], w[r]); vb[r] = cmul(vb[r], w[r]); }
    }
    dft16<SIGN>(va); dft16<SIGN>(vb);
    __syncthreads();
    const int base = (j - k) * 16 + k;
#pragma unroll
    for (int kk = 0; kk < 16; ++kk) { const int ix = PADX(base + kk * Ns); fa[ix] = va[4 * (kk & 3) + (kk >> 2)]; fb[ix] = vb[4 * (kk & 3) + (kk >> 2)]; }
    __syncthreads();
}
template <int SIGN> DI void fft_passes(cpx* fa, cpx* fb, int j, int Ns0, int np16, int N16) {
#pragma unroll 1
    for (int ps = 0, Ns = Ns0; ps < np16; ++ps, Ns <<= 4) fft_pass16x2<SIGN>(fa, fb, j, Ns, N16);
}
DI cpx conv_out(const cpx* fb, int t, int L) {
    const cpx a = fb[PADX(t)], b = fb[PADX(t + L)];
    float sn, cs; sincospif((float)t / (float)L, &sn, &cs);
    const cpx wb = cmul(cpx{cs, sn}, b);
    const float rn = 0.5f / (float)L;
    return (a + wb) * rn;
}
DI float conv3(const bf16* ptr, int t, int L, float w0, float w1, float w2) {
    const float a = t > 0 ? bf2f(ptr[t - 1]) : 0.f, b = bf2f(ptr[t]), c = t < L - 1 ? bf2f(ptr[t + 1]) : 0.f;
    return a * w0 + b * w1 + c * w2;
}
DI void filter_item(const Params& p, int l, int item, char* smem, bool lat) {
    const int np16 = lat ? 3 : 2, N16 = lat ? 512 : 32, N = 16 * N16, L = N / 2;
    const int tid = TIDX(), sub = tid / N16, j = tid % N16;
    const int c = lat ? item : item * 16 + sub;
    cpx* fa = (cpx*)smem + sub * (N + N / 16); cpx* fb = fa + FB_BANK;
    float* red = (float*)(smem + 2 * FB_BANK * 8);
    const float* hid = (const float*)(p.ws + WS_HID2) + ((size_t)l * (SEQ + DEC_SEQ) + (lat ? SEQ : 0)) * FH + j;
    const float* w3 = p.in[I_FW3] + (size_t)l * FH * 4 * HYENA_W + c;
    float f0[8], f1[8], b0[8], b1[8];
#pragma unroll
    for (int i = 0; i < 8; ++i) { f0[i] = 0.f; f1[i] = 0.f; b0[i] = 0.f; b1[i] = 0.f; }
#pragma unroll 8
    for (int q = 0; q < FH; ++q) {
        const float* wq = w3 + (size_t)q * 4 * HYENA_W;
        const float wf0 = wq[0], wf1 = wq[HYENA_W], wb0 = wq[2 * HYENA_W], wb1 = wq[3 * HYENA_W];
#pragma unroll
        for (int i = 0; i < 8; ++i) { const float hv = hid[(size_t)q * L + N16 * i]; f0[i] += hv * wf0; f1[i] += hv * wf1; b0[i] += hv * wb0; b1[i] += hv * wb1; }
    }
    const float min_decay = -4.605170185988091f / 1.5f, max_decay = -4.605170185988091f / 0.3f;
    const float delta = fabsf(min_decay + (max_decay - min_decay) * (float)c / (float)(HYENA_W - 1));
    float as0 = 0.f, as1 = 0.f;
#pragma unroll
    for (int i = 0; i < 8; ++i) {
        const int t = j + N16 * i;
        const float dec = __expf(-((float)t / (float)(L - 1)) * delta);
        const float vf0 = f0[i] * dec, vf1 = f1[i] * dec, vb0 = b0[i] * dec, vb1 = b1[i] * dec;
        fa[PADX(t)] = cpx{vf0, 0.f}; fb[PADX(t)] = cpx{vf1, 0.f};
        if (t == 0) { fa[PADX(L)] = cpx{0.f, 0.f}; fb[PADX(L)] = cpx{0.f, 0.f}; } else { fa[PADX(N - t)] = cpx{vb0, 0.f}; fb[PADX(N - t)] = cpx{vb1, 0.f}; }
        as0 += fabsf(vf0) + (t == 0 ? 0.f : fabsf(vb0)); as1 += fabsf(vf1) + (t == 0 ? 0.f : fabsf(vb1));
    }
#pragma unroll
    for (int s = 1; s < 32; s <<= 1) { as0 += __shfl_xor(as0, s); as1 += __shfl_xor(as1, s); }
    if (lat) {
        as0 += __shfl_xor(as0, 32); as1 += __shfl_xor(as1, 32);
        if ((tid & 63) == 0) { red[tid >> 6] = as0; red[8 + (tid >> 6)] = as1; }
    }
    __syncthreads();
    if (lat) { as0 = 0.f; as1 = 0.f;
#pragma unroll
        for (int q = 0; q < 8; ++q) { as0 += red[q]; as1 += red[8 + q]; } }
    const float rn0 = 1.f / as0, rn1 = 1.f / as1;
    {
        cpx a0[8], a1[8], c0[8], c1[8];
#pragma unroll
        for (int i = 0; i < 8; ++i) { const int t = j + N16 * i; a0[i] = fa[PADX(t)]; c0[i] = fa[PADX(t + L)]; a1[i] = fb[PADX(t)]; c1[i] = fb[PADX(t + L)]; }
        __syncthreads();
#pragma unroll
        for (int i = 0; i < 8; ++i) { const int t = j + N16 * i; fa[PADX(2 * t)] = a0[i] + c0[i]; fa[PADX(2 * t + 1)] = a0[i] - c0[i]; fb[PADX(2 * t)] = a1[i] + c1[i]; fb[PADX(2 * t + 1)] = a1[i] - c1[i]; }
        __syncthreads();
    }
    fft_passes<-1>(fa, fb, j, 2, np16, N16);
    cpx* kf0 = (cpx*)(p.ws + (lat ? WS_KFL : WS_KFC)) + (size_t)c * N; cpx* kf1 = kf0 + (size_t)HYENA_W * N;
#pragma unroll 4
    for (int i = 0; i < 16; ++i) { const int f = j + N16 * i; kf0[f] = fa[PADX(f)] * rn0; kf1[f] = fb[PADX(f)] * rn1; }
    __syncthreads();
}

DI void conv3x8(const bf16* row, int t0, int L, float w0, float w1, float w2, float (&o)[8]) {
    float v[8]; unpack8(*(const u32x4*)(row + t0), v);
    const bf16 pr = row[t0 > 0 ? t0 - 1 : 0], nr = row[t0 + 8 < L ? t0 + 8 : t0];
    const float pv = t0 > 0 ? bf2f(pr) : 0.f, nx = t0 + 8 < L ? bf2f(nr) : 0.f;
    o[0] = pv * w0 + v[0] * w1 + v[1] * w2;
#pragma unroll
    for (int i = 1; i < 7; ++i) o[i] = v[i - 1] * w0 + v[i] * w1 + v[i + 1] * w2;
    o[7] = v[6] * w0 + v[7] * w1 + nx * w2;
}
DI void hyena_item(const Params& p, int l, int item, char* smem, bool lat) {
    const int np16 = lat ? 3 : 2, N16 = lat ? 512 : 32, N = 16 * N16, L = N / 2;
    const int NPAIR = lat ? DEC_BATCH / 2 : BATCH / 2;
    const int tid = TIDX(), sub = tid / N16, j = tid % N16, t0 = 8 * j;
    constexpr int IPC = (DEC_BATCH / 2 + 1) / 2;
    int cA, cB, prA, prB; bool actA, actB;
    if (lat) { cA = cB = item / IPC; prA = 2 * (item % IPC); prB = prA + 1; actA = true; actB = prB < NPAIR; }
    else { cA = 2 * item; cB = cA + 1; prA = prB = sub; actA = actB = sub < NPAIR; }
    const int tokA = (lat ? TC : 0) + (actA ? 2 * prA : 0) * L, tokB = (lat ? TC : 0) + (actB ? 2 * prB : 0) * L;
    cpx* fa = (cpx*)smem + sub * (N + N / 16); cpx* fb = fa + FB_BANK;
    const bf16* HYT = (const bf16*)(p.ws + WS_HYT);
    const float* cw = p.in[I_HYCW] + (size_t)l * 3 * 3 * HYENA_W;
    const cpx* kfbase = (const cpx*)(p.ws + (lat ? WS_KFL : WS_KFC));
    cpx* zsA = (cpx*)(p.ws + WS_ZS) + (size_t)BIDX() * 2 * 4096 + sub * L + t0; cpx* zsB = zsA + 4096;
    bf16* zoutA = (bf16*)(p.ws + WS_ZT) + (size_t)cA * T; bf16* zoutB = (bf16*)(p.ws + WS_ZT) + (size_t)cB * T;
    {
        const bf16* hvA = HYT + (size_t)cA * T + tokA;
        float a0[8], a1[8];
        conv3x8(hvA, t0, L, cw[cA], cw[3 * HYENA_W + cA], cw[6 * HYENA_W + cA], a0); conv3x8(hvA + L, t0, L, cw[cA], cw[3 * HYENA_W + cA], cw[6 * HYENA_W + cA], a1);
#pragma unroll
        for (int i = 0; i < 8; ++i) {
            const cpx ua = actA ? cpx{a0[i], a1[i]} : cpx{0.f, 0.f};
            zsA[i] = ua;
            const int ix = PADX(2 * (t0 + i));
            fa[ix] = ua; fa[ix + 1] = ua;
        }
    }
    SCHED_BAR();
    {
        const bf16* hvB = HYT + (size_t)cB * T + tokB;
        float b0[8], b1[8];
        conv3x8(hvB, t0, L, cw[cB], cw[3 * HYENA_W + cB], cw[6 * HYENA_W + cB], b0); conv3x8(hvB + L, t0, L, cw[cB], cw[3 * HYENA_W + cB], cw[6 * HYENA_W + cB], b1);
#pragma unroll
        for (int i = 0; i < 8; ++i) {
            const cpx ub = actB ? cpx{b0[i], b1[i]} : cpx{0.f, 0.f};
            zsB[i] = ub;
            const int ix = PADX(2 * (t0 + i));
            fb[ix] = ub; fb[ix + 1] = ub;
        }
    }
    __syncthreads();
#pragma unroll 1
    for (int o = 0; o < 2; ++o) {
        fft_passes<-1>(fa, fb, j, 2, np16, N16);
        const int t0o = OPQ(t0), tokAo = OPQ(tokA), tokBo = OPQ(tokB);
        cpx* zsAo = (cpx*)(p.ws + WS_ZS) + (size_t)BIDX() * 2 * 4096 + sub * L + t0o; cpx* zsBo = zsAo + 4096;
        {
            const cpx* kfA = kfbase + (size_t)(o * HYENA_W + cA) * N + j; const cpx* kfB = kfbase + (size_t)(o * HYENA_W + cB) * N + j;
#pragma unroll 8
            for (int i = 0; i < 16; ++i) { const int ix = PADX(j + N16 * i); const cpx ka = kfA[N16 * i], kb = lat ? ka : kfB[N16 * i]; fa[ix] = cmul(fa[ix], ka); fb[ix] = cmul(fb[ix], kb); }
        }
        __syncthreads();
        fft_passes<1>(fa, fb, j, 1, np16, N16);
        const int wo = (1 + o) * HYENA_W;
        float sn, cs; sincospif((float)t0o / (float)L, &sn, &cs); const cpx wbase = cpx{cs, sn};
        sincospif(1.f / (float)L, &sn, &cs); const cpx wstep = cpx{cs, sn};
        const float rn = 0.5f / (float)L;
        cpx za[8], zb[8];
        {
            float x0[8], x1[8];
            conv3x8(HYT + (size_t)(wo + cA) * T + tokAo, t0o, L, cw[wo + cA], cw[3 * HYENA_W + wo + cA], cw[6 * HYENA_W + wo + cA], x0);
            conv3x8(HYT + (size_t)(wo + cA) * T + tokAo + L, t0o, L, cw[wo + cA], cw[3 * HYENA_W + wo + cA], cw[6 * HYENA_W + wo + cA], x1);
            const float dd = p.in[I_HYD][(size_t)l * 2 * HYENA_W + o * HYENA_W + cA];
            cpx w = wbase;
#pragma unroll
            for (int i = 0; i < 8; ++i) {
                const cpx y = (fa[PADX(t0o + i)] + cmul(w, fa[PADX(t0o + i + L)])) * rn; w = cmul(w, wstep);
                const cpx u = zsAo[i];
                za[i] = cpx{x0[i] * (y.x + dd * u.x), x1[i] * (y.y + dd * u.y)};
            }
        }
        SCHED_BAR();
        {
            float x0[8], x1[8];
            conv3x8(HYT + (size_t)(wo + cB) * T + tokBo, t0o, L, cw[wo + cB], cw[3 * HYENA_W + wo + cB], cw[6 * HYENA_W + wo + cB], x0);
            conv3x8(HYT + (size_t)(wo + cB) * T + tokBo + L, t0o, L, cw[wo + cB], cw[3 * HYENA_W + wo + cB], cw[6 * HYENA_W + wo + cB], x1);
            const float dd = p.in[I_HYD][(size_t)l * 2 * HYENA_W + o * HYENA_W + cB];
            cpx w = wbase;
#pragma unroll
            for (int i = 0; i < 8; ++i) {
                const cpx y = (fb[PADX(t0o + i)] + cmul(w, fb[PADX(t0o + i + L)])) * rn; w = cmul(w, wstep);
                const cpx u = zsBo[i];
                zb[i] = cpx{x0[i] * (y.x + dd * u.x), x1[i] * (y.y + dd * u.y)};
            }
        }
        __syncthreads();
        if (o == 0) {
#pragma unroll
            for (int i = 0; i < 8; ++i) {
                const cpx ua = actA ? za[i] : cpx{0.f, 0.f}, ub = actB ? zb[i] : cpx{0.f, 0.f};
                zsAo[i] = ua; zsBo[i] = ub;
                const int ix = PADX(2 * (t0o + i));
                fa[ix] = ua; fa[ix + 1] = ua; fb[ix] = ub; fb[ix + 1] = ub;
            }
            __syncthreads();
        } else {
            const bf16* ghA = HYT + (size_t)(3 * HYENA_W + cA) * T + tokAo + t0o; const bf16* ghB = HYT + (size_t)(3 * HYENA_W + cB) * T + tokBo + t0o;
            float g[8]; u32x4 ov;
            if (actA) {
                unpack8(*(const u32x4*)ghA, g);
                ov.x = pack2(za[0].x * g[0], za[1].x * g[1]); ov.y = pack2(za[2].x * g[2], za[3].x * g[3]); ov.z = pack2(za[4].x * g[4], za[5].x * g[5]); ov.w = pack2(za[6].x * g[6], za[7].x * g[7]);
                *(u32x4*)(zoutA + tokAo + t0o) = ov;
                unpack8(*(const u32x4*)(ghA + L), g);
                ov.x = pack2(za[0].y * g[0], za[1].y * g[1]); ov.y = pack2(za[2].y * g[2], za[3].y * g[3]); ov.z = pack2(za[4].y * g[4], za[5].y * g[5]); ov.w = pack2(za[6].y * g[6], za[7].y * g[7]);
                *(u32x4*)(zoutA + tokAo + L + t0o) = ov;
            }
            if (actB) {
                unpack8(*(const u32x4*)ghB, g);
                ov.x = pack2(zb[0].x * g[0], zb[1].x * g[1]); ov.y = pack2(zb[2].x * g[2], zb[3].x * g[3]); ov.z = pack2(zb[4].x * g[4], zb[5].x * g[5]); ov.w = pack2(zb[6].x * g[6], zb[7].x * g[7]);
                *(u32x4*)(zoutB + tokBo + t0o) = ov;
                unpack8(*(const u32x4*)(ghB + L), g);
                ov.x = pack2(zb[0].y * g[0], zb[1].y * g[1]); ov.y = pack2(zb[2].y * g[2], zb[3].y * g[3]); ov.z = pack2(zb[4].y * g[4], zb[5].y * g[5]); ov.w = pack2(zb[6].y * g[6], zb[7].y * g[7]);
                *(u32x4*)(zoutB + tokBo + L + t0o) = ov;
            }
        }
    }
}

DI void hytr_item(const Params& p, int item, char* smem) {
    const int tid = TIDX(), tok0 = item * 64;
    const bf16* HYT = (const bf16*)(p.ws + WS_ZT); bf16* mixed = (bf16*)(p.ws + WS_XN);
    unsigned* tile = (unsigned*)smem;
    for (int id = tid; id < HYENA_W * 8; id += NTHR) {
        const int ch = id >> 3, ck = id & 7, x = (ch >> 3) & 31;
        const u32x4 v = *(const u32x4*)(HYT + (size_t)ch * T + tok0 + ck * 8);
        unsigned* row = tile + ch * 32;
        row[(4 * ck) ^ x] = v.x; row[(4 * ck + 1) ^ x] = v.y; row[(4 * ck + 2) ^ x] = v.z; row[(4 * ck + 3) ^ x] = v.w;
    }
    __syncthreads();
    for (int id = tid; id < 64 * (HYENA_W / 8); id += NTHR) {
        const int cg = id % (HYENA_W / 8), tok = id / (HYENA_W / 8), x = cg & 31, sh = (tok & 1) * 16;
        unsigned e[8];
#pragma unroll
        for (int k = 0; k < 8; ++k) e[k] = (tile[(8 * cg + k) * 32 + ((tok >> 1) ^ x)] >> sh) & 0xffffu;
        u32x4 o; o.x = e[0] | (e[1] << 16); o.y = e[2] | (e[3] << 16); o.z = e[4] | (e[5] << 16); o.w = e[6] | (e[7] << 16);
        *(u32x4*)(mixed + (size_t)(tok0 + tok) * MIX_W + ATTN_W + 8 * cg) = o;
    }
    __syncthreads();
}

DI void shortconv_item(const Params& p, int l, int item) {
    const bf16* SCb = (const bf16*)(p.ws + WS_SC);
    bf16* mixed = (bf16*)(p.ws + WS_XN);
    const float* cw = p.in[I_SCW] + (size_t)l * 3 * CONV_W;
    constexpr int C8 = CONV_W / 8;
    const u32x4 zero4 = {0u, 0u, 0u, 0u};
#pragma unroll 4
    for (int e = TIDX(); e < 256 * C8; e += NTHR) {
        const int m = item * 256 + e / C8, c = (e % C8) * 8;
        const int L = m < TC ? SEQ : DEC_SEQ, t = m < TC ? m % SEQ : (m - TC) % DEC_SEQ;
        const bf16* row = SCb + (size_t)m * 4 * CONV_W + c;
        float sb[8], g0[8], x0[8], gm[8], xm[8], gn[8], xn[8], gc[8], w0[8], w1[8], w2[8];
        unpack8(*(const u32x4*)row, sb); unpack8(*(const u32x4*)(row + CONV_W), g0); unpack8(*(const u32x4*)(row + 2 * CONV_W), x0); unpack8(*(const u32x4*)(row + 3 * CONV_W), gc);
        const bf16* rowm = t > 0 ? row - 4 * CONV_W : row; const bf16* rown = t < L - 1 ? row + 4 * CONV_W : row;
        u32x4 vgm = *(const u32x4*)(rowm + CONV_W), vxm = *(const u32x4*)(rowm + 2 * CONV_W), vgn = *(const u32x4*)(rown + CONV_W), vxn = *(const u32x4*)(rown + 2 * CONV_W);
        if (t == 0) { vgm = zero4; vxm = zero4; } if (t == L - 1) { vgn = zero4; vxn = zero4; }
        unpack8(vgm, gm); unpack8(vxm, xm); unpack8(vgn, gn); unpack8(vxn, xn);
#pragma unroll
        for (int i = 0; i < 2; ++i) {
            const f32x4 a = *(const f32x4*)(cw + c + 4 * i), b = *(const f32x4*)(cw + CONV_W + c + 4 * i), d = *(const f32x4*)(cw + 2 * CONV_W + c + 4 * i);
            w0[4 * i] = a.x; w0[4 * i + 1] = a.y; w0[4 * i + 2] = a.z; w0[4 * i + 3] = a.w;
            w1[4 * i] = b.x; w1[4 * i + 1] = b.y; w1[4 * i + 2] = b.z; w1[4 * i + 3] = b.w;
            w2[4 * i] = d.x; w2[4 * i + 1] = d.y; w2[4 * i + 2] = d.z; w2[4 * i + 3] = d.w;
        }
        float o[8];
#pragma unroll
        for (int i = 0; i < 8; ++i) o[i] = sb[i] * (gm[i] * xm[i] * w0[i] + g0[i] * x0[i] * w1[i] + gn[i] * xn[i] * w2[i]) * gc[i];
        u32x4 ov; ov.x = pack2(o[0], o[1]); ov.y = pack2(o[2], o[3]); ov.z = pack2(o[4], o[5]); ov.w = pack2(o[6], o[7]);
        *(u32x4*)(mixed + (size_t)m * MIX_W + ATTN_W + HYENA_W + c) = ov;
    }
}

constexpr int AT_NKL = 320;
constexpr int AT_KL = 0, AT_VL = AT_KL + AT_NKL * 128, AT_KC = AT_VL + AT_NKL * 128, AT_VC = AT_KC + 256 * 128, AT_END = AT_VC + 256 * 128;
static_assert(AT_END <= LDS_BYTES - 16, "lds");
DI int swzv(int row, int c) { return row * 128 + ((c ^ (((row >> 1) & 1) << 2)) << 4); }
struct VFrag { u32x2 r[8]; };
#ifdef EMU
DI void v_tr_issue(const char* a0, const char* a1, VFrag& f) {
#pragma unroll
    for (int i = 0; i < 8; ++i) { const bf16x4 v = emu_ds_read_tr16((i < 4 ? a0 : a1) + 1024 * (i & 3)); f.r[i] = __builtin_bit_cast(u32x2, v); }
}
DI void v_tr_wait(VFrag&) {}
DI float fast_exp2(float x) { return exp2f(x); }
DI bool wave_any(bool pred) { return emu_wave_any(pred); }
#else
DI void v_tr_issue(const char* a0, const char* a1, VFrag& f) {
    const unsigned x0 = (unsigned)(size_t)(const LAS char*)a0, x1 = (unsigned)(size_t)(const LAS char*)a1;
    asm volatile("ds_read_b64_tr_b16 %0, %8\n\tds_read_b64_tr_b16 %1, %8 offset:1024\n\tds_read_b64_tr_b16 %2, %8 offset:2048\n\tds_read_b64_tr_b16 %3, %8 offset:3072\n\t"
                 "ds_read_b64_tr_b16 %4, %9\n\tds_read_b64_tr_b16 %5, %9 offset:1024\n\tds_read_b64_tr_b16 %6, %9 offset:2048\n\tds_read_b64_tr_b16 %7, %9 offset:3072"
                 : "=&v"(f.r[0]), "=&v"(f.r[1]), "=&v"(f.r[2]), "=&v"(f.r[3]), "=&v"(f.r[4]), "=&v"(f.r[5]), "=&v"(f.r[6]), "=&v"(f.r[7]) : "v"(x0), "v"(x1) : "memory");
}
DI void v_tr_wait(VFrag& f) {
    asm volatile("s_waitcnt lgkmcnt(0)" : "+v"(f.r[0]), "+v"(f.r[1]), "+v"(f.r[2]), "+v"(f.r[3]), "+v"(f.r[4]), "+v"(f.r[5]), "+v"(f.r[6]), "+v"(f.r[7]) :: "memory");
    __builtin_amdgcn_sched_barrier(0);
}
DI float fast_exp2(float x) { return __builtin_amdgcn_exp2f(x); }
DI bool wave_any(bool pred) { return __builtin_amdgcn_ballot_w64(pred) != 0ull; }
#endif
DI void softmax_pv(f32x16& S, f32x16 (&O)[2], float& m_run, float& l_run, VFrag& vf) {
    float tmax = S[0];
#pragma unroll
    for (int e = 1; e < 16; ++e) tmax = fmaxf(tmax, S[e]);
    tmax = fmaxf(tmax, __shfl_xor(tmax, 32));
    const float mnew = fmaxf(m_run, tmax);
    if (wave_any(mnew > m_run)) {
        const float alpha = fast_exp2(m_run - mnew);
        l_run *= alpha;
#pragma unroll
        for (int e = 0; e < 16; ++e) { O[0][e] *= alpha; O[1][e] *= alpha; }
    }
    m_run = mnew;
    float ps = 0.f; unsigned pk[8];
#pragma unroll
    for (int e = 0; e < 8; ++e) { const float p0 = fast_exp2(S[2 * e] - mnew), p1 = fast_exp2(S[2 * e + 1] - mnew); ps += p0 + p1; pk[e] = pack2(p0, p1); }
    l_run += ps;
    u32x4 q0; q0.x = pk[0]; q0.y = pk[1]; q0.z = pk[2]; q0.w = pk[3];
    u32x4 q1; q1.x = pk[4]; q1.y = pk[5]; q1.z = pk[6]; q1.w = pk[7];
    const bf16x8 pb0 = __builtin_bit_cast(bf16x8, q0), pb1 = __builtin_bit_cast(bf16x8, q1);
    v_tr_wait(vf);
    u32x4 f;
    f.x = vf.r[0].x; f.y = vf.r[0].y; f.z = vf.r[1].x; f.w = vf.r[1].y; O[0] = MFMA32(__builtin_bit_cast(bf16x8, f), pb0, O[0]);
    f.x = vf.r[2].x; f.y = vf.r[2].y; f.z = vf.r[3].x; f.w = vf.r[3].y; O[0] = MFMA32(__builtin_bit_cast(bf16x8, f), pb1, O[0]);
    f.x = vf.r[4].x; f.y = vf.r[4].y; f.z = vf.r[5].x; f.w = vf.r[5].y; O[1] = MFMA32(__builtin_bit_cast(bf16x8, f), pb0, O[1]);
    f.x = vf.r[6].x; f.y = vf.r[6].y; f.z = vf.r[7].x; f.w = vf.r[7].y; O[1] = MFMA32(__builtin_bit_cast(bf16x8, f), pb1, O[1]);
}
DI void attn_item(const Params& p, int l, int item, char* smem, bool LAT) {
    const int tid = TIDX(), lane = tid & 63, w = tid >> 6, r = lane & 31, h = lane >> 5;
    const int SL = LAT ? DEC_SEQ : SEQ, NQB = SL / 64;
    const int b = item / (N_KV * NQB), kvh = (item / NQB) % N_KV, q0 = (item % NQB) * 64;
    const int tokbase = (LAT ? TC : 0) + b * SL;
    const bf16* Qb = (const bf16*)(p.ws + WS_Q); const bf16* Kb = (const bf16*)(p.ws + WS_KB); const bf16* Vb = (const bf16*)(p.ws + WS_VB);
    const bf16* GAb = (const bf16*)(p.ws + WS_GA); bf16* mixed = (bf16*)(p.ws + WS_XN);
    char* KL = smem + AT_KL; char* VL = smem + AT_VL; char* KC = smem + AT_KC; char* VC = smem + AT_VC;
    const u32x4 zero4 = {0u, 0u, 0u, 0u};
    PRB_BEGIN(1)
    {
        const bf16* ksrc; const bf16* vsrc; size_t stride;
        if (LAT) { const size_t o = (size_t)((b * DEPTH + l) * N_KV + kvh) * PAST_LEN * HD; ksrc = (const bf16*)(p.ws + WS_CKB) + o; vsrc = (const bf16*)(p.ws + WS_CVTB) + o; stride = HD; }
        else { ksrc = Kb + (size_t)tokbase * KV_W + kvh * HD; vsrc = Vb + (size_t)tokbase * KV_W + kvh * HD; stride = KV_W; }
        u32x4 ck[4], cv[4], lk[5], lv[5];
#pragma unroll
        for (int i = 0; i < 4; ++i) { const int id = tid + NTHR * i, row = id >> 3, c = id & 7; ck[i] = *(const u32x4*)(ksrc + (size_t)row * stride + c * 8); cv[i] = *(const u32x4*)(vsrc + (size_t)row * stride + c * 8); }
        if (LAT) {
#pragma unroll
            for (int i = 0; i < 5; ++i) {
                const int id = tid + NTHR * i, row = id >> 3, c = id & 7, kp = q0 - 128 + row;
                const bool inr = kp >= 0 && kp < SL;
                const size_t o = (size_t)(tokbase + (inr ? kp : 0)) * KV_W + kvh * HD + c * 8;
                lk[i] = *(const u32x4*)(Kb + o); lv[i] = *(const u32x4*)(Vb + o);
                if (!inr) { lk[i] = zero4; lv[i] = zero4; }
            }
#pragma unroll
            for (int i = 0; i < 5; ++i) { const int id = tid + NTHR * i, row = id >> 3, c = id & 7; *(u32x4*)(KL + swz128(row, c)) = lk[i]; *(u32x4*)(VL + swzv(row, c)) = lv[i]; }
        }
#pragma unroll
        for (int i = 0; i < 4; ++i) { const int id = tid + NTHR * i, row = id >> 3, c = id & 7; *(u32x4*)(KC + swz128(row, c)) = ck[i]; *(u32x4*)(VC + swzv(row, c)) = cv[i]; }
    }
    __syncthreads();
    PRB_END(1, smem)
    PRB_BEGIN(2)
    {
        const int g = w >> 1, qt = w & 1, head = kvh * 4 + g;
        const int qpos = q0 + 32 * qt + r;
        const size_t qtok = (size_t)tokbase + qpos;
        bf16x8 qraw[4], qrot[4];
#pragma unroll
        for (int s = 0; s < 4; ++s) { qraw[s] = *(const bf16x8*)(Qb + qtok * ATTN_W + head * HD + 16 * s + 8 * h); qrot[s] = qraw[s]; }
        if (LAT) {
            const f32x2* rope = (const f32x2*)(p.ws + WS_ROPE);
#pragma unroll
            for (int a = 0; a < 2; ++a)
#pragma unroll
                for (int jj = 0; jj < 8; ++jj) {
                    const f32x2 cs = rope[(qpos * 2 + a) * 16 + 8 * h + jj];
                    const float xa = bf2f((bf16)qraw[2 * a][jj]), xb = bf2f((bf16)qraw[2 * a + 1][jj]);
                    qrot[2 * a][jj] = (short)f2bf(xa * cs.x - xb * cs.y);
                    qrot[2 * a + 1][jj] = (short)f2bf(xb * cs.x + xa * cs.y);
                }
        }
        const int qq = (lane & 15) >> 2, pp = lane & 3, g16 = (lane >> 4) & 1, vrow = 4 * h + qq;
        const int voff0 = swzv(vrow, 2 * g16 + (pp >> 1)) + (pp & 1) * 8, voff1 = swzv(vrow, 4 + 2 * g16 + (pp >> 1)) + (pp & 1) * 8;
        const float c1 = 0.125f * 1.4426950408889634f;
        float m_run = p.in[I_SINK][l * N_HEADS + head] * 1.4426950408889634f, l_run = h == 0 ? 1.f : 0.f;
        f32x16 O[2];
#pragma unroll
        for (int e = 0; e < 16; ++e) { O[0][e] = 0.f; O[1][e] = 0.f; }
        if (LAT) {
            for (int jt = qt; jt < qt + 9; ++jt) {
                VFrag vf; v_tr_issue(VL + 4096 * jt + voff0, VL + 4096 * jt + voff1, vf);
                f32x16 S;
#pragma unroll
                for (int e = 0; e < 16; ++e) S[e] = 0.f;
                const int krow = 32 * jt + r;
#pragma unroll
                for (int s = 0; s < 4; ++s) S = MFMA32(*(const bf16x8*)(KL + swz128(krow, 2 * s + h)), qrot[s], S);
#pragma unroll
                for (int e = 0; e < 16; ++e) {
                    const int kp = q0 - 128 + 32 * jt + (e & 3) + 8 * (e >> 2) + 4 * h, dd = kp - qpos;
                    const bool ok = dd <= 128 && dd >= -128 && kp >= 0 && kp < SL;
                    S[e] = ok ? S[e] * c1 : -1e30f;
                }
                softmax_pv(S, O, m_run, l_run, vf);
            }
        }
        for (int jt = 0; jt < 8; ++jt) {
            VFrag vf; v_tr_issue(VC + 4096 * jt + voff0, VC + 4096 * jt + voff1, vf);
            f32x16 S;
#pragma unroll
            for (int e = 0; e < 16; ++e) S[e] = 0.f;
            const int krow = 32 * jt + r;
#pragma unroll
            for (int s = 0; s < 4; ++s) S = MFMA32(*(const bf16x8*)(KC + swz128(krow, 2 * s + h)), qraw[s], S);
#pragma unroll
            for (int e = 0; e < 16; ++e) S[e] *= c1;
            softmax_pv(S, O, m_run, l_run, vf);
        }
        const float inv = 1.f / (l_run + __shfl_xor(l_run, 32));
#pragma unroll
        for (int dt = 0; dt < 2; ++dt)
#pragma unroll
            for (int rg = 0; rg < 4; ++rg) {
                const int d0 = dt * 32 + 8 * rg + 4 * h;
                const u32x2 gv = *(const u32x2*)(GAb + qtok * ATTN_W + head * HD + d0);
                const float g0 = bf2f((bf16)(gv.x & 0xffffu)), g1 = bf2f((bf16)(gv.x >> 16)), g2 = bf2f((bf16)(gv.y & 0xffffu)), g3 = bf2f((bf16)(gv.y >> 16));
                u32x2 o; o.x = pack2(O[dt][4 * rg] * inv * g0, O[dt][4 * rg + 1] * inv * g1); o.y = pack2(O[dt][4 * rg + 2] * inv * g2, O[dt][4 * rg + 3] * inv * g3);
                *(u32x2*)(mixed + qtok * MIX_W + head * HD + d0) = o;
            }
    }
    PRB_END(2, smem)
    __syncthreads();
}

DI void phase_p0(const Params& p_, char* smem) {
    constexpr int I_T1 = DEPTH * (D_MODEL / 64) * (IN_COLS / 64), I_T2 = DEPTH * (MIX_W / 64) * (D_MODEL / 64);
    constexpr int I_MOD = DEPTH * (3 * D_MODEL / 64), I_ROPE = DEC_SEQ * 32 / NTHR, I_HID = DEPTH * (SEQ + DEC_SEQ) / 64;
    constexpr int I_CACHE = (2 * DEC_BATCH * DEPTH * PAST_LEN * KV_W / 8 + NTHR - 1) / NTHR;
    constexpr int TOTAL = I_T1 + I_T2 + I_MOD + I_ROPE + I_HID + I_CACHE;
    for (int it = BIDX(); it < TOTAL; it += gridDim.x) {
        const Params p = launder(p_);
        int q = it;
        if (q < I_T1 + I_T2) {
            const bool w1 = q < I_T1; if (!w1) q -= I_T1;
            const int per = w1 ? (D_MODEL / 64) * (IN_COLS / 64) : (MIX_W / 64) * (D_MODEL / 64), l = q / per;
            if (w1) p0_transpose_item(p.in[I_WIN] + (size_t)l * D_MODEL * IN_COLS, D_MODEL, IN_COLS, (bf16*)(p.ws + WS_WINT) + (size_t)l * IN_COLS * D_MODEL, q % per, smem);
            else p0_transpose_item(p.in[I_WOUT] + (size_t)l * MIX_W * D_MODEL, MIX_W, D_MODEL, (bf16*)(p.ws + WS_WOUTT) + (size_t)l * D_MODEL * MIX_W, q % per, smem);
            continue; }
        q -= I_T1 + I_T2;
        if (q < I_MOD) { p0_mod_item(p, q, smem); continue; }
        q -= I_MOD;
        if (q < I_ROPE) { p0_rope_item(p, q); continue; }
        q -= I_ROPE;
        if (q < I_HID) { p0_hid2_item(p, q); continue; }
        q -= I_HID;
        p0_cache_item(p, q);
    }
}
DI void phase_mix(const Params& p_, int l, int qid, char* smem, int mask) {
    constexpr int I_HL = HYENA_W * ((DEC_BATCH / 2 + 1) / 2), I_AL = DEC_BATCH * N_KV * (DEC_SEQ / 64), I_AC = BATCH * N_KV * (SEQ / 64);
    constexpr int I_HC = HYENA_W / 2, I_SC = T / 256;
    static_assert(BATCH / 2 <= 16, "ctx hyena: one bank holds 16 batch pairs");
    for (;;) {
        const Params p = launder(p_);
        int q = wq_next(p, qid, smem);
        if (q >= I_HC + I_HL + I_AL + I_AC + I_SC) break;
        if (q < I_HC + I_HL) { const bool lat = q >= I_HC; if (mask & (lat ? 1 : 2)) hyena_item(p, l, lat ? q - I_HC : q, smem, lat); continue; }
        q -= I_HC + I_HL;
        if (q < I_AL + I_AC) { const bool lat = q < I_AL; if (mask & (lat ? 4 : 8)) attn_item(p, l, lat ? q : q - I_AL, smem, lat); continue; }
        q -= I_AL + I_AC;
        if (mask & 16) shortconv_item(p, l, q);
    }
}
constexpr int I_FILT = HYENA_W + HYENA_W / 16, I_FILT_A = I_FILT / 2;
DI void phase_filters(const Params& p_, int l, int qid, char* smem, int first, int count) {
    constexpr int I_FL = HYENA_W, I_FC = HYENA_W / 16;
    for (;;) {
        const Params p = launder(p_);
        int q = wq_next(p, qid, smem);
        if (q >= count) break;
        q += first;
        const bool lat = q >= I_FC;
        filter_item(p, l, lat ? q - I_FC : q, smem, lat);
    }
}
DI void phase_norm(const Params& p, int l) {
    for (int it = BIDX(); it < T / 16; it += gridDim.x) norm_item(p, l, it);
}
DI void phase_hytr(const Params& p, char* smem) {
    for (int it = BIDX(); it < T / 64; it += gridDim.x) hytr_item(p, it, smem);
}

#ifndef PH_STOP
#define PH_STOP 1000
#endif
#ifndef DUP
#define DUP -1
#endif
#ifndef DMASK
#define DMASK 31
#endif
#ifndef PROBE_SEL
#define PROBE_SEL 0
#endif
#ifndef PROBE_SCALE
#define PROBE_SCALE 10.f
#endif
#ifndef PROBE_WORK
#define PROBE_WORK 0
#endif
__global__ void __launch_bounds__(NTHR, 2) fwd_kernel(Params p_) {
#ifdef EMU
    char* smem = emu_smem();
#else
    extern __shared__ __attribute__((aligned(16))) char smem[];
    volatile LAS unsigned* xst = (volatile LAS unsigned*)(smem + LDS_BYTES - 16);
    if (TIDX() == 0) { xst[0] = 0u; xst[1] = 0u; }
    __syncthreads();
    const XcdBarrier xbar = xcd_barrier_post((unsigned*)(p_.ws + WS_BAR), xst);
#endif
    constexpr int NPH = 2 + 5 * DEPTH;
#if PROBE_SEL
    unsigned long long tacc = 0ull, tprev = __builtin_amdgcn_s_memrealtime();
#if defined(PROBE_SEC_ON)
    if (TIDX() == 0) *(volatile unsigned long long*)(smem + LDS_BYTES - 48) = 0ull;
    __syncthreads();
#endif
#endif
#pragma unroll 1
    for (int ph = 0; ph < NPH && ph < PH_STOP; ++ph) {
#pragma unroll 1
        for (int rep = 0; rep < (ph == DUP ? 2 : 1); ++rep) {
            const Params p = launder(p_);
            const int l = ph >= 2 ? (ph - 2) / 5 : 0, k = ph >= 2 ? (ph - 2) % 5 : -1;
            const int qid = ph + 32 * rep;
            if (ph == 0) phase_p0(p, smem);
            else if (ph == 1) { phase_norm(p, 0); phase_filters(p, 0, qid, smem, 0, I_FILT_A); }
            else if (k == 1) phase_mix(p, l, qid, smem, rep ? DMASK : 31);
            else if (k == 0 || k == 3) {
                if (!(rep && k == 0 && (DMASK & 32))) {
                    GemmJob job; job.p = p; job.mode = k == 0 ? 0 : 1; job.l = l; job.K = k == 0 ? D_MODEL : MIX_W;
                    gemm_phase((ldsptr_t)smem, job);
                }
                if (k == 0) phase_filters(p, l, qid, smem, I_FILT_A, I_FILT - I_FILT_A);
                else if (l + 1 < DEPTH) phase_filters(p, l + 1, qid, smem, 0, I_FILT_A);
            } else if (k == 2) phase_hytr(p, smem);
            else phase_norm(p, l + 1);
        }
#if PROBE_SEL
        {
            const int kk = ph == 0 ? 0 : (ph == 1 ? 1 : 2 + (ph - 2) % 5);
            unsigned long long tnow = __builtin_amdgcn_s_memrealtime();
            if (PROBE_WORK && ((PROBE_SEL >> kk) & 1)) tacc += tnow - tprev;
            GRID_SYNC();
            tnow = __builtin_amdgcn_s_memrealtime();
            if (!PROBE_WORK && ((PROBE_SEL >> kk) & 1)) tacc += tnow - tprev;
            tprev = tnow;
        }
#else
        if (ph + 1 < NPH) GRID_SYNC();
#endif
    }
#if PROBE_SEL
#if defined(PROBE_SEC_ON)
    if (BIDX() == 0 && TIDX() == 0) p_.out[OUT_YS + 777] = (float)*(volatile unsigned long long*)(smem + LDS_BYTES - 48) / (100.f * PROBE_SCALE);
#else
    if (BIDX() == 0 && TIDX() == 0) p_.out[OUT_YS + 777] = (float)tacc / (100.f * PROBE_SCALE);
#endif
#endif
}

#ifndef EMU
extern "C" void kernel_launch(void* const* d_in, const int* in_sizes, int n_in, void* d_out, int out_size, void* d_ws, size_t ws_size, hipStream_t stream) {
    static int grid = 0;
    if (grid == 0) {
        if (n_in != 22 || (size_t)out_size != OUT_TOTAL || ws_size < WS_END) { fprintf(stderr, "kernel_launch: unexpected sizes n_in %d out %d ws %zu (need %zu)\n", n_in, out_size, ws_size, (size_t)WS_END); grid = -1; return; }
        int dev = 0, cus = 0, per_cu = 0;
        hipGetDevice(&dev); hipDeviceGetAttribute(&cus, hipDeviceAttributeMultiprocessorCount, dev);
        if (hipFuncSetAttribute((const void*)fwd_kernel, hipFuncAttributeMaxDynamicSharedMemorySize, LDS_BYTES) != hipSuccess) { fprintf(stderr, "hipFuncSetAttribute failed\n"); grid = -1; return; }
        hipOccupancyMaxActiveBlocksPerMultiprocessor(&per_cu, (const void*)fwd_kernel, NTHR, LDS_BYTES);
        if (per_cu < 1) { fprintf(stderr, "occupancy query says %d\n", per_cu); grid = -1; return; }
        grid = cus;
    }
    if (grid < 0) return;
    Params p{};
    for (int i = 0; i < 22; ++i) p.in[i] = (const float*)d_in[i];
    p.out = (float*)d_out; p.ws = (unsigned char*)d_ws;
    if (hipMemsetAsync((char*)d_ws + WS_BAR, 0, 65536, stream) != hipSuccess) { fprintf(stderr, "memset failed\n"); return; }
    hipLaunchKernelGGL(fwd_kernel, dim3(grid), dim3(NTHR), LDS_BYTES, stream, p);
    const hipError_t e = hipPeekAtLastError();
    if (e != hipSuccess) fprintf(stderr, "launch failed: %s (grid %d)\n", hipGetErrorString(e), grid);
}
#endif
```

```cpp
#ifdef EMU
#include "emu.h"
#define GRID_SYNC() emu_grid_sync()
#define MFMA32(a, b, c) emu_mfma32((a), (b), (c))
#define MFMA16(a, b, c) emu_mfma16((a), (b), (c))
#define LAS
#define GLDS16(g, l) emu_glds16((const void*)(g), (void*)(l))
#define S_BARRIER() __syncthreads()
#define WAIT_V(n)
#define WAIT_L(n)
#define SCHED_BAR()
#define SETPRIO(x)
#define RFL(x) (x)
#define CBAR()
#define OPQ(x) (x)
#define TIDX() ((int)threadIdx.x)
#define BIDX() ((int)blockIdx.x)
#else
#include <hip/hip_runtime.h>
#include <cstdio>
#include <cstdint>
typedef short bf16x8 __attribute__((ext_vector_type(8)));
typedef float f32x16 __attribute__((ext_vector_type(16)));
typedef float f32x4 __attribute__((ext_vector_type(4)));
#define GRID_SYNC() xcd_barrier(xbar)
#define MFMA32(a, b, c) __builtin_amdgcn_mfma_f32_32x32x16_bf16((a), (b), (c), 0, 0, 0)
#define MFMA16(a, b, c) __builtin_amdgcn_mfma_f32_16x16x32_bf16((a), (b), (c), 0, 0, 0)
#define LAS __attribute__((address_space(3)))
#define GLDS16(g, l) __builtin_amdgcn_global_load_lds((const unsigned*)(g), (LAS unsigned*)(l), 16, 0, 0)
#define S_BARRIER() __builtin_amdgcn_s_barrier()
#define WAIT_V(n) asm volatile("s_waitcnt vmcnt(" #n ")" ::: "memory")
#define WAIT_L(n) asm volatile("s_waitcnt lgkmcnt(" #n ")" ::: "memory")
#define SCHED_BAR() __builtin_amdgcn_sched_barrier(0)
#define SETPRIO(x) __builtin_amdgcn_s_setprio(x)
#define RFL(x) __builtin_amdgcn_readfirstlane(x)
#define CBAR() asm volatile("" ::: "memory")
__device__ __forceinline__ int opq_(int x) { asm volatile("" : "+v"(x)); return x; }
#define OPQ(x) opq_(x)
__device__ __forceinline__ int tidx_() { int t = threadIdx.x; asm volatile("" : "+v"(t)); return t; }
__device__ __forceinline__ int bidx_() { int t = blockIdx.x; asm volatile("" : "+s"(t)); return t; }
#define TIDX() tidx_()
#define BIDX() bidx_()
#endif
typedef unsigned u32x4 __attribute__((ext_vector_type(4)));
typedef unsigned u32x2 __attribute__((ext_vector_type(2)));
typedef float f32x2 __attribute__((ext_vector_type(2)));
typedef unsigned short bf16;
#define DI __device__ __forceinline__
#if defined(PROBE_SEC_ON) && !defined(EMU)
#define PRB_BEGIN(id) unsigned long long _prb_t0_##id = 0; if (PROBE_SEC_ON == (id)) { __syncthreads(); _prb_t0_##id = __builtin_amdgcn_s_memrealtime(); }
#define PRB_END(id, smem) if (PROBE_SEC_ON == (id)) { __syncthreads(); if (BIDX() == 0 && TIDX() == 0) *(volatile unsigned long long*)((smem) + LDS_BYTES - 48) += __builtin_amdgcn_s_memrealtime() - _prb_t0_##id; }
#define PRB_BEGIN_NS(id) unsigned long long _prb_t0_##id = 0; if (PROBE_SEC_ON == (id)) { _prb_t0_##id = __builtin_amdgcn_s_memrealtime(); }
#define PRB_END_NS(id, smem) if (PROBE_SEC_ON == (id)) { if (BIDX() == 0 && TIDX() == 0) *(volatile unsigned long long*)((smem) + LDS_BYTES - 48) += __builtin_amdgcn_s_memrealtime() - _prb_t0_##id; }
#else
#define PRB_BEGIN(id)
#define PRB_END(id, smem)
#define PRB_BEGIN_NS(id)
#define PRB_END_NS(id, smem)
#endif

#ifdef CFG_SMALL
constexpr int D_MODEL = 256, BATCH = 2, SEQ = 256, DEPTH = 2, DEC_BATCH = 4, DEC_SEQ = 4096, PAST_LEN = 256, HYENA_W = 128, CONV_W = 128;
#else
constexpr int D_MODEL = 1024, BATCH = 32, SEQ = 256, DEPTH = 4, DEC_BATCH = 8, DEC_SEQ = 4096, PAST_LEN = 256, HYENA_W = 256, CONV_W = 256;
#endif
constexpr int GRID_W = 64, N_HEADS = 8, N_KV = 2, HD = 64, ATTN_W = 512, KV_W = 128;
constexpr int MIX_W = ATTN_W + HYENA_W + CONV_W;
constexpr int C_Q = 0, C_K = ATTN_W, C_V = C_K + KV_W, C_GA = C_V + KV_W, C_HV = C_GA + ATTN_W, C_GH = C_HV + 3 * HYENA_W,
              C_SB = C_GH + HYENA_W, C_GC = C_SB + 3 * CONV_W, IN_COLS = C_GC + CONV_W;
constexpr int TC = BATCH * SEQ, TL = DEC_BATCH * DEC_SEQ, T = TC + TL;
constexpr int NR = 1 + DEC_BATCH;
constexpr int FH = 64, FE = 33;
constexpr int NTHR = 512;
static_assert(T % 256 == 0 && TC % 256 == 0 && C_HV % 256 == 0 && C_SB % 256 == 0 && IN_COLS % 256 == 0 && D_MODEL % 256 == 0 && MIX_W % 128 == 0 && (4 * HYENA_W) % 256 == 0, "tiling");
static_assert(SEQ == 256 && DEC_SEQ == 4096 && PAST_LEN == 256, "fft sizes");

constexpr size_t al256(size_t x) { return (x + 255) & ~(size_t)255; }
constexpr size_t WS_BAR = 0;
constexpr size_t WS_WINT = 65536;
constexpr size_t WS_WOUTT = WS_WINT + al256((size_t)DEPTH * IN_COLS * D_MODEL * 2);
constexpr size_t WS_MOD = WS_WOUTT + al256((size_t)DEPTH * D_MODEL * MIX_W * 2);
constexpr size_t WS_ROPE = WS_MOD + al256((size_t)DEPTH * NR * 3 * D_MODEL * 4);
constexpr size_t WS_HID2 = WS_ROPE + al256((size_t)DEC_SEQ * 32 * 8);
constexpr size_t WS_CKB = WS_HID2 + al256((size_t)DEPTH * (SEQ + DEC_SEQ) * FH * 4);
constexpr size_t WS_CVTB = WS_CKB + al256((size_t)DEC_BATCH * DEPTH * PAST_LEN * KV_W * 2);
constexpr size_t WS_KFL = WS_CVTB + al256((size_t)DEC_BATCH * DEPTH * PAST_LEN * KV_W * 2);
constexpr size_t KFL_BYTES = al256((size_t)2 * HYENA_W * 8192 * 8), KFC_BYTES = al256((size_t)2 * HYENA_W * 512 * 8);
constexpr size_t WS_KFC = WS_KFL + 2 * KFL_BYTES;
constexpr size_t WS_ZS = WS_KFC + 2 * KFC_BYTES;
constexpr size_t WS_XN = WS_ZS + (size_t)256 * 2 * 4096 * 8;
constexpr size_t WS_Q = WS_XN + al256((size_t)T * (D_MODEL > MIX_W ? D_MODEL : MIX_W) * 2);
constexpr size_t WS_KB = WS_Q + al256((size_t)T * ATTN_W * 2);
constexpr size_t WS_VB = WS_KB + al256((size_t)T * KV_W * 2);
constexpr size_t WS_GA = WS_VB + al256((size_t)T * KV_W * 2);
constexpr size_t WS_HYT = WS_GA + al256((size_t)T * ATTN_W * 2);
constexpr size_t WS_SC = WS_HYT + al256((size_t)4 * HYENA_W * T * 2);
constexpr size_t WS_END0 = WS_SC + al256((size_t)T * 4 * CONV_W * 2);
#ifndef DUP
#define DUP -1
#endif
constexpr size_t WS_ZT = DUP >= 0 ? WS_END0 : WS_HYT;
constexpr size_t WS_END = WS_END0 + (DUP >= 0 ? al256((size_t)HYENA_W * T * 2) : 0);

constexpr size_t OUT_YS = (size_t)TC * D_MODEL, OUT_NK = (size_t)T * D_MODEL, OUT_NV = OUT_NK + (size_t)BATCH * DEPTH * SEQ * KV_W,
                 OUT_TOTAL = OUT_NV + (size_t)BATCH * DEPTH * SEQ * KV_W;

constexpr int LDS_BYTES = 149504;

struct Params {
    const float* in[22];
    float* out;
    unsigned char* ws;
};
enum { I_XP = 0, I_XS, I_CK, I_CV, I_C, I_CCTX, I_NORMG, I_MODW, I_MODB, I_WIN, I_SINK, I_HYCW, I_FW1, I_FB1, I_FW2, I_FB2, I_FW3, I_FFREQ, I_HYD, I_SCW, I_WOUT, I_FINALG };

DI bf16 f2bf(float f) { unsigned u = __float_as_uint(f); u += 0x7fffu + ((u >> 16) & 1u); return (bf16)(u >> 16); }
DI float bf2f(bf16 h) { return __uint_as_float(((unsigned)h) << 16); }
#ifdef EMU
DI unsigned pack2(float a, float b) { return (unsigned)f2bf(a) | ((unsigned)f2bf(b) << 16); }
DI float silu_f(float x) { return x / (1.f + __expf(-x)); }
#else
DI unsigned pack2(float a, float b) { unsigned r; asm("v_cvt_pk_bf16_f32 %0, %1, %2" : "=v"(r) : "v"(a), "v"(b)); return r; }
DI float silu_f(float x) { return x * __builtin_amdgcn_rcpf(1.f + __builtin_amdgcn_exp2f(x * -1.4426950408889634f)); }
#endif
typedef float cpx __attribute__((ext_vector_type(2)));
DI cpx cmul(cpx a, cpx b) { cpx r = b * a.x; r += cpx{-b.y, b.x} * a.y; return r; }
#ifdef EMU
DI Params launder(const Params& p) { return p; }
#else
DI Params launder(const Params& p) { Params q = p; int z = 0; asm volatile("" : "+s"(z)); q.ws = p.ws + z; q.out = p.out + z; return q; }
#endif
DI int mod_row(int m) { return m < TC ? 0 : 1 + (m - TC) / DEC_SEQ; }


#ifndef EMU
#define XB_TMO      128
#define XB_XCNT(j)  (256  + 64 * (j))
#define XB_XSUB(j)  (1280 + 64 * (j))
#define XB_XGEN(j)  (2304 + 64 * (j))
#define XB_TOP      3328
#define XB_TOPGEN   3392
#define XCD_BAR_WORDS 3456
#define XB_SPIN_CAP (1u << 22)
DI unsigned xb_ld(unsigned* p) { return __hip_atomic_load(p, __ATOMIC_RELAXED, __HIP_MEMORY_SCOPE_AGENT); }
DI unsigned xb_add(unsigned* p, unsigned v) { return __hip_atomic_fetch_add(p, v, __ATOMIC_RELAXED, __HIP_MEMORY_SCOPE_AGENT); }
DI unsigned xb_xcc_id() { return (unsigned)__builtin_amdgcn_s_getreg((3 << 11) | 20) & 0xFu; }
#define XB_SPIN(cond, bar) do { unsigned _sp = 0; while (cond) { __builtin_amdgcn_s_sleep(1); \
    if ((++_sp & 255u) == 0u) { if (xb_ld(&(bar)[XB_TMO])) break; if (_sp > XB_SPIN_CAP) { atomicAdd(&(bar)[XB_TMO], 1u); break; } } } } while (0)
struct XcdBarrier { unsigned* bar; unsigned x; volatile LAS unsigned* st; };
DI XcdBarrier xcd_barrier_post(unsigned* bar, volatile LAS unsigned* st) {
    XcdBarrier b; b.bar = bar; b.x = xb_xcc_id(); b.st = st;
    if (TIDX() == 0) (void)xb_add(&bar[XB_XCNT(b.x)], 1u);
    return b;
}
DI void xcd_barrier_complete(unsigned* bar, unsigned x, unsigned& nloc, unsigned& nx) {
    const unsigned G = gridDim.x * gridDim.y * gridDim.z;
    unsigned sum, cnt, mine, sp = 0u;
    for (;;) {
        sum = 0u; cnt = 0u; mine = 0u;
#pragma unroll
        for (unsigned j = 0; j < 16; ++j) { const unsigned c = xb_ld(&bar[XB_XCNT(j)]); sum += c; cnt += (c > 0u) ? 1u : 0u; mine = (j == x) ? c : mine; }
        if (sum == G) break;
        __builtin_amdgcn_s_sleep(1);
        if ((++sp & 255u) == 0u) { if (xb_ld(&bar[XB_TMO])) break; if (sp > XB_SPIN_CAP) { atomicAdd(&bar[XB_TMO], 1u); break; } }
    }
    nloc = mine > 0u ? mine : 1u; nx = cnt > 0u ? cnt : 1u;
}
DI void xcd_barrier(const XcdBarrier& b) {
    asm volatile("s_waitcnt vmcnt(0)" ::: "memory");
    __syncthreads();
    if (TIDX() == 0) {
        unsigned* bar = b.bar;
        __builtin_amdgcn_s_waitcnt(0);
        unsigned nloc = b.st[0], nx = b.st[1];
        if (nloc == 0u) { xcd_barrier_complete(bar, b.x, nloc, nx); b.st[0] = nloc; b.st[1] = nx; }
        const unsigned old = xb_add(&bar[XB_XSUB(b.x)], 1u);
        const unsigned gen = old / nloc;
        if (old + 1u == (gen + 1u) * nloc) {
            __builtin_amdgcn_fence(__ATOMIC_RELEASE, "agent");
            asm volatile("s_waitcnt vmcnt(0)" ::: "memory");
            const unsigned og = xb_add(&bar[XB_TOP], 1u);
            const unsigned tg = og / nx;
            if (og + 1u == (tg + 1u) * nx) xb_add(&bar[XB_TOPGEN], 1u);
            else XB_SPIN(xb_ld(&bar[XB_TOPGEN]) == tg, bar);
            __builtin_amdgcn_fence(__ATOMIC_ACQUIRE, "agent");
            xb_add(&bar[XB_XGEN(b.x)], 1u);
            asm volatile("s_waitcnt vmcnt(0)" ::: "memory");
        } else {
            XB_SPIN(xb_ld(&bar[XB_XGEN(b.x)]) == gen, bar);
            __builtin_amdgcn_fence(__ATOMIC_ACQUIRE, "agent");
            asm volatile("s_waitcnt vmcnt(0)" ::: "memory");
        }
    }
    __syncthreads();
}
#endif

constexpr size_t WS_WQ = WS_BAR + 16384;
#ifdef EMU
DI int wq_fetch(unsigned* c) { const unsigned v = *c; *c = v + 1; return (int)v; }
#else
DI int wq_fetch(unsigned* c) { return (int)__hip_atomic_fetch_add(c, 1u, __ATOMIC_RELAXED, __HIP_MEMORY_SCOPE_AGENT); }
#endif
DI int wq_next(const Params& p, int qid, char* smem) {
    volatile int* slot = (volatile int*)(smem + LDS_BYTES - 32);
    __syncthreads();
    if (TIDX() == 0) *slot = wq_fetch((unsigned*)(p.ws + WS_WQ) + qid * 64);
    __syncthreads();
    return *slot;
}

DI void p0_transpose_item(const float* W, int K, int N, bf16* WT, int item, char* smem) {
    float* scr = (float*)smem;
    const int tid = TIDX(), nblk = N / 64, k0 = (item / nblk) * 64, n0 = (item % nblk) * 64;
#pragma unroll
    for (int i = 0; i < 8; ++i) { const int kk = (tid >> 6) + 8 * i, nn = tid & 63; scr[kk * 65 + nn] = W[(size_t)(k0 + kk) * N + n0 + nn]; }
    __syncthreads();
    const int n = tid >> 3, c = tid & 7;
    const float* s = scr + (8 * c) * 65 + n;
    u32x4 o; o.x = pack2(s[0], s[65]); o.y = pack2(s[2 * 65], s[3 * 65]); o.z = pack2(s[4 * 65], s[5 * 65]); o.w = pack2(s[6 * 65], s[7 * 65]);
    *(u32x4*)(WT + (size_t)(n0 + n) * K + k0 + 8 * c) = o;
    __syncthreads();
}
DI void p0_mod_item(const Params& p, int item, char* smem) {
    constexpr int NCH = 3 * D_MODEL / 64, KG = D_MODEL / 8;
    float* tab = (float*)smem;
    float* red = tab + NR * D_MODEL;
    const int tid = TIDX(), l = item / NCH, col = (item % NCH) * 64 + (tid & 63), kg = tid >> 6;
    for (int e = tid; e < NR * D_MODEL; e += NTHR) { const int r = e / D_MODEL, k = e % D_MODEL; const float cv = r == 0 ? p.in[I_CCTX][k] : p.in[I_C][(size_t)(r - 1) * D_MODEL + k]; tab[e] = silu_f(cv); }
    __syncthreads();
    float acc[NR];
#pragma unroll
    for (int r = 0; r < NR; ++r) acc[r] = 0.f;
    const float* w = p.in[I_MODW] + (size_t)l * D_MODEL * 3 * D_MODEL + (size_t)(kg * KG) * 3 * D_MODEL + col;
#pragma unroll 16
    for (int k = 0; k < KG; ++k) { const float wv = w[(size_t)k * 3 * D_MODEL];
#pragma unroll
        for (int r = 0; r < NR; ++r) acc[r] += tab[r * D_MODEL + kg * KG + k] * wv; }
#pragma unroll
    for (int r = 0; r < NR; ++r) red[(kg * NR + r) * 64 + (tid & 63)] = acc[r];
    __syncthreads();
    for (int e = tid; e < NR * 64; e += NTHR) {
        const int r = e >> 6, c = e & 63, cc = (item % NCH) * 64 + c;
        float s = p.in[I_MODB][(size_t)l * 3 * D_MODEL + cc];
#pragma unroll
        for (int g = 0; g < 8; ++g) s += red[(g * NR + r) * 64 + c];
        ((float*)(p.ws + WS_MOD))[((size_t)l * NR + r) * 3 * D_MODEL + cc] = s;
    }
    __syncthreads();
}
DI void p0_rope_item(const Params& p, int item) {
    const int e = item * NTHR + TIDX();
    if (e < DEC_SEQ * 32) {
        const int t = e >> 5, a = (e >> 4) & 1, f = e & 15;
        const float pos = (float)(a ? (t % GRID_W) : (t / GRID_W));
        const float inv = exp2f(-(float)f * (13.287712379549449f / 16.f));
        const float ang = pos * inv;
        f32x2 v; v.x = cosf(ang); v.y = sinf(ang);
        ((f32x2*)(p.ws + WS_ROPE))[e] = v;
    }
}
DI void p0_hid2_item(const Params& p, int item) {
    const int lane = TIDX() & 63, w = TIDX() >> 6;
    const int r0 = item * 64, l = r0 / (SEQ + DEC_SEQ), q0 = r0 % (SEQ + DEC_SEQ);
    const int L = q0 < SEQ ? SEQ : DEC_SEQ, tb = (q0 < SEQ ? q0 : q0 - SEQ) + w * 8;
    const float* w1 = p.in[I_FW1] + (size_t)l * FE * FH + lane; const float* w2 = p.in[I_FW2] + (size_t)l * FH * FH + lane;
    float wa[FE], wb[FH];
#pragma unroll
    for (int i = 0; i < FE; ++i) wa[i] = w1[i * FH];
#pragma unroll
    for (int i = 0; i < FH; ++i) wb[i] = w2[i * FH];
    const float fq = p.in[I_FFREQ][l * FH + lane], b1 = p.in[I_FB1][l * FH + lane], b2 = p.in[I_FB2][l * FH + lane];
    float* dst = (float*)(p.ws + WS_HID2) + (size_t)l * (SEQ + DEC_SEQ) * FH + (q0 < SEQ ? 0 : (size_t)SEQ * FH) + (size_t)lane * L;
#pragma unroll 1
    for (int r = 0; r < 8; ++r) {
        const int t = tb + r;
        float feat = 0.f;
        if (lane == 0) feat = (float)t / (float)(L - 1);
        else if (lane < FE) {
            const int b = (lane - 1) & 15;
            const float fr = 1e-4f + (float)b * ((15.f - 1e-4f) / 15.f);
            const float ang = (6.283185307179586f / (float)L) * (float)t;
            feat = lane <= 16 ? cosf(fr * ang) : -sinf(fr * ang);
        }
        float a1 = b1;
#pragma unroll
        for (int i = 0; i < FE; ++i) a1 += __shfl(feat, i) * wa[i];
        const float h1 = sinf(fq * a1);
        float a2 = b2;
#pragma unroll
        for (int i = 0; i < FH; ++i) a2 += __shfl(h1, i) * wb[i];
        dst[t] = sinf(fq * a2);
    }
}
DI void p0_cache_item(const Params& p, int item) {
    constexpr int NCHUNK = DEC_BATCH * DEPTH * PAST_LEN * KV_W / 8;
    int e = item * NTHR + TIDX();
    if (e < 2 * NCHUNK) {
        const bool isv = e >= NCHUNK; if (isv) e -= NCHUNK;
        const int c8 = e & 7, j = (e >> 3) % PAST_LEN, kvh = (e >> 3) / PAST_LEN % N_KV, bl = (e >> 3) / PAST_LEN / N_KV;
        const float* src = p.in[isv ? I_CV : I_CK] + ((size_t)(bl * PAST_LEN + j) * N_KV + kvh) * HD + c8 * 8;
        u32x4 o; o.x = pack2(src[0], src[1]); o.y = pack2(src[2], src[3]); o.z = pack2(src[4], src[5]); o.w = pack2(src[6], src[7]);
        *(u32x4*)((bf16*)(p.ws + (isv ? WS_CVTB : WS_CKB)) + (size_t)e * 8) = o;
    }
}

DI const float* x_row_src(const Params& p, int l, int m) {
    if (l == 0) return m < TC ? p.in[I_XP] + (size_t)m * D_MODEL : p.in[I_XS] + (size_t)(m - TC) * D_MODEL;
    return p.out + (size_t)m * D_MODEL;
}
DI void norm_rows2(const Params& p, int l, int m0, int lane) {
    constexpr int NV = (D_MODEL / 4 + 63) / 64;
    f32x4 v[2][NV]; float ss[2] = {0.f, 0.f};
#pragma unroll
    for (int r = 0; r < 2; ++r) {
        const float* xr = x_row_src(p, l, m0 + r);
#pragma unroll
        for (int i = 0; i < NV; ++i) { const int c4 = lane + 64 * i; v[r][i] = c4 < D_MODEL / 4 ? *(const f32x4*)(xr + 4 * c4) : (f32x4){0.f, 0.f, 0.f, 0.f}; }
    }
#pragma unroll
    for (int r = 0; r < 2; ++r)
#pragma unroll
        for (int i = 0; i < NV; ++i) ss[r] += v[r][i].x * v[r][i].x + v[r][i].y * v[r][i].y + v[r][i].z * v[r][i].z + v[r][i].w * v[r][i].w;
#pragma unroll
    for (int o = 1; o < 64; o <<= 1) { ss[0] += __shfl_xor(ss[0], o); ss[1] += __shfl_xor(ss[1], o); }
#pragma unroll
    for (int r = 0; r < 2; ++r) {
        const int m = m0 + r;
        const float rstd = rsqrtf(ss[r] * (1.f / D_MODEL) + 1e-6f);
        if (l < DEPTH) {
            const float* g = p.in[I_NORMG] + (size_t)l * D_MODEL;
            const float* mod = (const float*)(p.ws + WS_MOD) + ((size_t)l * NR + mod_row(m)) * 3 * D_MODEL;
            bf16* xn = (bf16*)(p.ws + WS_XN) + (size_t)m * D_MODEL;
#pragma unroll
            for (int i = 0; i < NV; ++i) {
                const int c4 = lane + 64 * i;
                if (c4 < D_MODEL / 4) {
                    const f32x4 x = v[r][i], gv = *(const f32x4*)(g + 4 * c4), sh = *(const f32x4*)(mod + 4 * c4), sc = *(const f32x4*)(mod + D_MODEL + 4 * c4);
                    u32x2 o; o.x = pack2(x.x * rstd * gv.x * (1.f + sc.x) + sh.x, x.y * rstd * gv.y * (1.f + sc.y) + sh.y);
                    o.y = pack2(x.z * rstd * gv.z * (1.f + sc.z) + sh.z, x.w * rstd * gv.w * (1.f + sc.w) + sh.w);
                    *(u32x2*)(xn + 4 * c4) = o;
                }
            }
        } else {
            const float* g = p.in[I_FINALG];
            float* yo = p.out + (size_t)m * D_MODEL;
#pragma unroll
            for (int i = 0; i < NV; ++i) {
                const int c4 = lane + 64 * i;
                if (c4 < D_MODEL / 4) {
                    const f32x4 x = v[r][i], gv = *(const f32x4*)(g + 4 * c4);
                    f32x4 o; o.x = x.x * rstd * gv.x; o.y = x.y * rstd * gv.y; o.z = x.z * rstd * gv.z; o.w = x.w * rstd * gv.w;
                    *(f32x4*)(yo + 4 * c4) = o;
                }
            }
        }
    }
}
DI void norm_item(const Params& p, int l, int item) {
    norm_rows2(p, l, item * 16 + 2 * (TIDX() >> 6), TIDX() & 63);
}

DI int swz128(int row, int c) { return row * 128 + ((c ^ ((row >> 1) & 7)) << 4); }
constexpr int BM = 256, BK = 64, HALFT = 128, HTB = HALFT * BK * 2, STAGE_BYTES = 8 * HTB;
static_assert(STAGE_BYTES <= LDS_BYTES - 32 && 2 * 8704 * 8 + 128 <= LDS_BYTES - 16, "lds");
DI int lds_byte(int r, int c) { const int st = (r >> 4) * 2 + (c >> 5), rr = r & 15, cc = c & 31, ob = rr * 64 + cc * 2; return st * 1024 + (ob ^ (((ob >> 9) & 1) << 5)); }
DI void stage_rc(int b, int& R, int& C) { const int st = b / 1024, sb = b % 1024, swz = sb ^ (((sb >> 9) & 1) << 5); R = (st >> 1) * 16 + swz / 64; C = (st & 1) * 32 + (swz % 64) / 2; }
DI int perm32(int rho) { const int n = rho >> 4, i = rho & 15; return 8 * (i >> 2) + 4 * n + (i & 3); }
struct Unit { int pm, pn, kind; };
DI void static_order(int L, int nM, int nN, int& pm, int& pn) {
    constexpr int NXCD = 8, WGM = 8;
    const int nwg = nM * nN;
    int wgid = L; { const int q = nwg / NXCD, r = nwg % NXCD, xcd = wgid % NXCD, off = wgid / NXCD; wgid = (xcd < r ? xcd * (q + 1) : r * (q + 1) + (xcd - r) * q) + off; }
    const int nig = WGM * nN, gid = wgid / nig, fm = gid * WGM, gsz = (nM - fm) < WGM ? (nM - fm) : WGM;
    pm = fm + ((wgid % nig) % gsz); pn = (wgid % nig) / gsz;
}
constexpr int NT_TOK = (IN_COLS - 4 * HYENA_W) / 256, NT_TOKA = C_HV / 256, NT_CH = 4 * HYENA_W / 256, NTM = T / 256;
constexpr int NU_TOK = NTM * NT_TOK, NU_CH = NT_CH * NTM, NU_OUT = NTM * (D_MODEL / 256);
struct GemmJob {
    Params p; int mode, l, K;
    DI bool next(int i, Unit& u) const {
        const int L = i * (int)gridDim.x + BIDX();
        if (mode == 0) {
            if (L < NU_TOK) { u.kind = 0; static_order(L, NTM, NT_TOK, u.pm, u.pn); return true; }
            if (L < NU_TOK + NU_CH) { u.kind = 1; static_order(L - NU_TOK, NT_CH, NTM, u.pm, u.pn); return true; }
            return false;
        }
        if (L < NU_OUT) { u.kind = 2; static_order(L, NTM, D_MODEL / 256, u.pm, u.pn); return true; }
        return false;
    }
    DI int tokcol(int pn) const { return pn < NT_TOKA ? pn * 256 : C_SB + (pn - NT_TOKA) * 256; }
    DI void ptrs(const Unit& u, const char*& a, const char*& b) const {
        const size_t rb = (size_t)K * 2;
        const char* xn = (const char*)(p.ws + WS_XN);
        if (u.kind == 0) { a = xn + (size_t)u.pm * 256 * rb; b = (const char*)(p.ws + WS_WINT) + ((size_t)l * IN_COLS + tokcol(u.pn)) * rb; }
        else if (u.kind == 1) { a = (const char*)(p.ws + WS_WINT) + ((size_t)l * IN_COLS + C_HV + u.pm * 256) * rb; b = xn + (size_t)u.pn * 256 * rb; }
        else { a = xn + (size_t)u.pm * 256 * rb; b = (const char*)(p.ws + WS_WOUTT) + ((size_t)l * D_MODEL + u.pn * 256) * rb; }
    }
    DI void epilogue(const f32x4 (&acc)[2][2][4][2], const Unit& u, int wr, int wc, int fr, int fq) const {
        if (u.kind == 0) {
            const bool ctx = u.pm * 256 < TC;
#pragma unroll 1
            for (int bj = 0; bj < 2; ++bj) {
                const int n0 = tokcol(u.pn) + 128 * bj, c0 = n0 + 32 * wc + 8 * fq;
                bf16* dst; int ld; bool sil = false; int special = 0;
                if (n0 < C_K) { dst = (bf16*)(p.ws + WS_Q) + c0; ld = ATTN_W; }
                else if (n0 < C_V) { dst = (bf16*)(p.ws + WS_KB) + (c0 - C_K); ld = KV_W; special = 1; }
                else if (n0 < C_GA) { dst = (bf16*)(p.ws + WS_VB) + (c0 - C_V); ld = KV_W; special = 2; }
                else if (n0 < C_HV) { dst = (bf16*)(p.ws + WS_GA) + (c0 - C_GA); ld = ATTN_W; sil = true; }
                else { dst = (bf16*)(p.ws + WS_SC) + (c0 - C_SB); ld = 4 * CONV_W; sil = n0 >= C_GC; }
#pragma unroll
                for (int ai = 0; ai < 2; ++ai)
#pragma unroll
                    for (int m = 0; m < 4; ++m) {
                        const int row = u.pm * 256 + 64 * wr + fr + OPQ(128 * ai + 16 * m);
                        f32x4 v0 = bj ? acc[ai][1][m][0] : acc[ai][0][m][0], v1 = bj ? acc[ai][1][m][1] : acc[ai][0][m][1];
                        if (sil) { v0.x = silu_f(v0.x); v0.y = silu_f(v0.y); v0.z = silu_f(v0.z); v0.w = silu_f(v0.w); v1.x = silu_f(v1.x); v1.y = silu_f(v1.y); v1.z = silu_f(v1.z); v1.w = silu_f(v1.w); }
                        if (special && ctx) {
                            float* o = p.out + (special == 1 ? OUT_NK : OUT_NV) + ((size_t)((row / SEQ) * DEPTH + l) * SEQ + (row % SEQ)) * KV_W + (c0 - (special == 1 ? C_K : C_V));
                            *(f32x4*)o = v0; *(f32x4*)(o + 4) = v1;
                        }
                        if (special == 1 && !ctx) {
                            const int pos = (row - TC) % DEC_SEQ, a = wc & 1, pp = fq >> 1, f0 = 8 * (fq & 1);
                            const f32x4* rp = (const f32x4*)((const f32x2*)(p.ws + WS_ROPE) + (pos * 2 + a) * 16 + f0);
                            const f32x4 r0 = rp[0], r1 = rp[1], r2 = rp[2], r3 = rp[3];
                            f32x4 o0, o1;
                            o0.x = __shfl_xor(v0.x, 32); o0.y = __shfl_xor(v0.y, 32); o0.z = __shfl_xor(v0.z, 32); o0.w = __shfl_xor(v0.w, 32);
                            o1.x = __shfl_xor(v1.x, 32); o1.y = __shfl_xor(v1.y, 32); o1.z = __shfl_xor(v1.z, 32); o1.w = __shfl_xor(v1.w, 32);
                            const float sg = pp ? 1.f : -1.f;
                            v0.x = v0.x * r0.x + sg * o0.x * r0.y; v0.y = v0.y * r0.z + sg * o0.y * r0.w; v0.z = v0.z * r1.x + sg * o0.z * r1.y; v0.w = v0.w * r1.z + sg * o0.w * r1.w;
                            v1.x = v1.x * r2.x + sg * o1.x * r2.y; v1.y = v1.y * r2.z + sg * o1.y * r2.w; v1.z = v1.z * r3.x + sg * o1.z * r3.y; v1.w = v1.w * r3.z + sg * o1.w * r3.w;
                        }
                        u32x4 w; w.x = pack2(v0.x, v0.y); w.y = pack2(v0.z, v0.w); w.z = pack2(v1.x, v1.y); w.w = pack2(v1.z, v1.w);
                        *(u32x4*)(dst + (size_t)row * ld) = w;
                        CBAR();
                    }
            }
        } else if (u.kind == 1) {
            bf16* HYT = (bf16*)(p.ws + WS_HYT);
#pragma unroll
            for (int ai = 0; ai < 2; ++ai) {
                const bool sil = u.pm * 256 + 128 * ai >= 3 * HYENA_W;
#pragma unroll
                for (int m = 0; m < 4; ++m) {
                    const int ch = u.pm * 256 + 64 * wr + fr + OPQ(128 * ai + 16 * m);
#pragma unroll
                    for (int bj = 0; bj < 2; ++bj) {
                        f32x4 v0 = acc[ai][bj][m][0], v1 = acc[ai][bj][m][1];
                        if (sil) { v0.x = silu_f(v0.x); v0.y = silu_f(v0.y); v0.z = silu_f(v0.z); v0.w = silu_f(v0.w); v1.x = silu_f(v1.x); v1.y = silu_f(v1.y); v1.z = silu_f(v1.z); v1.w = silu_f(v1.w); }
                        u32x4 w; w.x = pack2(v0.x, v0.y); w.y = pack2(v0.z, v0.w); w.z = pack2(v1.x, v1.y); w.w = pack2(v1.z, v1.w);
                        *(u32x4*)(HYT + (size_t)ch * T + u.pn * 256 + 128 * bj + 32 * wc + 8 * fq) = w;
                        CBAR();
                    }
                }
            }
        } else {
            const float* gate = (const float*)(p.ws + WS_MOD) + ((size_t)l * NR + mod_row(u.pm * 256)) * 3 * D_MODEL + 2 * D_MODEL;
#pragma unroll
            for (int bj = 0; bj < 2; ++bj) {
                const int n = u.pn * 256 + 128 * bj + 32 * wc + 8 * fq;
                const f32x4 g0 = *(const f32x4*)(gate + n), g1 = *(const f32x4*)(gate + n + 4);
#pragma unroll
                for (int ai = 0; ai < 2; ++ai)
#pragma unroll
                    for (int m = 0; m < 4; ++m) {
                        const int row = u.pm * 256 + 64 * wr + fr + OPQ(128 * ai + 16 * m);
                        const float* xs = x_row_src(p, l, row) + n;
                        const f32x4 x0 = *(const f32x4*)xs, x1 = *(const f32x4*)(xs + 4);
                        float* o = p.out + (size_t)row * D_MODEL + n;
                        *(f32x4*)o = x0 + g0 * acc[ai][bj][m][0]; *(f32x4*)(o + 4) = x1 + g1 * acc[ai][bj][m][1];
                        CBAR();
                    }
            }
        }
    }
};

#ifdef EMU
typedef unsigned char* ldsptr_t;
#else
typedef LAS unsigned char* ldsptr_t;
#endif
DI void gemm_phase(ldsptr_t lds, const GemmJob& S) {
    const int tid = TIDX(), wid = RFL(tid >> 6), lane = tid & 63, wr = wid >> 2, wc = wid & 3, fr = lane & 15, fq = lane >> 4;
    const int K = S.K, nt = K / BK;
    unsigned voffA[2], voffB[2];
#pragma unroll
    for (int i = 0; i < 2; ++i) { int R, C; stage_rc(tid * 16 + i * 8192, R, C); const int Rb = (R & ~31) + perm32(R & 31);
        voffA[i] = (unsigned)(R * K + C) * 2u; voffB[i] = (unsigned)(Rb * K + C) * 2u; }
    const size_t kstep = (size_t)(BK * 2);
    const size_t hstep = (size_t)HALFT * K * 2;
    const unsigned ldsw = (unsigned)wid * 1024u;
    const int aoff = lds_byte(wr * 64 + fr, fq * 8), boff = lds_byte(wc * 32 + fr, fq * 8);
#define PG8_SA(b, h) (((b) * 2 + (h)) * HTB)
#define PG8_SB(b, h) ((4 + (b) * 2 + (h)) * HTB)
#define PG8_STAGE(bufoff, gbase, voff) do { _Pragma("unroll") for (int _i = 0; _i < 2; ++_i) GLDS16((const char*)(gbase) + (voff)[_i], lds + (bufoff) + ldsw + _i * 8192); } while (0)
#define PG8_LDA(dst, b, h) do { _Pragma("unroll") for (int m = 0; m < 4; ++m) _Pragma("unroll") for (int k = 0; k < 2; ++k) dst[m][k] = *(const LAS bf16x8*)(lds + PG8_SA(b, h) + aoff + m * 2048 + k * 1024); } while (0)
#define PG8_LDB(dst, b, h) do { _Pragma("unroll") for (int n = 0; n < 2; ++n) _Pragma("unroll") for (int k = 0; k < 2; ++k) dst[n][k] = *(const LAS bf16x8*)(lds + PG8_SB(b, h) + boff + n * 2048 + k * 1024); } while (0)
#define PG8_MMA(ai, bj, At, Bt) do { SETPRIO(1); _Pragma("unroll") for (int m = 0; m < 4; ++m) _Pragma("unroll") for (int n = 0; n < 2; ++n) _Pragma("unroll") for (int k = 0; k < 2; ++k) \
        acc[ai][bj][m][n] = MFMA16(Bt[n][k], At[m][k], acc[ai][bj][m][n]); SETPRIO(0); } while (0)
    Unit cur, nxt; int ui = 0;
    if (!S.next(0, cur)) return;
    f32x4 acc[2][2][4][2];
#pragma unroll
    for (int a = 0; a < 2; ++a)
#pragma unroll
        for (int b = 0; b < 2; ++b)
#pragma unroll
            for (int m = 0; m < 4; ++m)
#pragma unroll
                for (int n = 0; n < 2; ++n) acc[a][b][m][n] = (f32x4){0.f, 0.f, 0.f, 0.f};
    bf16x8 At[4][2], B0[2][2], B1[2][2];
    const char* cA; const char* cB; S.ptrs(cur, cA, cB);
    PG8_STAGE(PG8_SB(0, 0), cB, voffB); PG8_STAGE(PG8_SA(0, 0), cA, voffA); PG8_STAGE(PG8_SB(0, 1), cB + hstep, voffB); PG8_STAGE(PG8_SA(0, 1), cA + hstep, voffA);
    if (wr == 1) S_BARRIER();
    WAIT_V(4); S_BARRIER();
    PG8_STAGE(PG8_SB(1, 0), cB + kstep, voffB); PG8_STAGE(PG8_SA(1, 0), cA + kstep, voffA); PG8_STAGE(PG8_SB(1, 1), cB + hstep + kstep, voffB);
    WAIT_V(6); S_BARRIER();
    for (;;) {
        const bool has_next = S.next(ui + 1, nxt);
        const char* nA = cA; const char* nB = cB; if (has_next) S.ptrs(nxt, nA, nB);
        PRB_BEGIN_NS(3) PRB_BEGIN_NS(5)
        for (int t = 0; t < nt; t += 2) {
            const bool last = (t == nt - 2);
            const char* a1 = cA + (size_t)(t + 1) * kstep;
            const char* a2 = last ? nA : cA + (size_t)(t + 2) * kstep; const char* b2 = last ? nB : cB + (size_t)(t + 2) * kstep;
            const char* a3 = a2 + kstep; const char* b3 = b2 + kstep;
            PG8_LDB(B0, 0, 0); SCHED_BAR(); PG8_LDA(At, 0, 0); PG8_STAGE(PG8_SA(1, 1), a1 + hstep, voffA);
            WAIT_L(8); S_BARRIER(); WAIT_L(0); PG8_MMA(0, 0, At, B0); S_BARRIER(); SCHED_BAR();
            PG8_LDB(B1, 0, 1); PG8_STAGE(PG8_SB(0, 0), b2, voffB);
            S_BARRIER(); WAIT_L(0); PG8_MMA(0, 1, At, B1); S_BARRIER();
            PG8_LDA(At, 0, 1); PG8_STAGE(PG8_SA(0, 0), a2, voffA);
            S_BARRIER(); WAIT_L(0); PG8_MMA(1, 0, At, B0); S_BARRIER(); SCHED_BAR();
            PG8_STAGE(PG8_SB(0, 1), b2 + hstep, voffB);
            WAIT_V(6); S_BARRIER(); PG8_MMA(1, 1, At, B1); S_BARRIER();
            PG8_LDB(B0, 1, 0); SCHED_BAR(); PG8_LDA(At, 1, 0); PG8_STAGE(PG8_SA(0, 1), a2 + hstep, voffA);
            WAIT_L(8); S_BARRIER(); WAIT_L(0); PG8_MMA(0, 0, At, B0); S_BARRIER(); SCHED_BAR();
            PG8_LDB(B1, 1, 1); PG8_STAGE(PG8_SB(1, 0), b3, voffB);
            S_BARRIER(); WAIT_L(0); PG8_MMA(0, 1, At, B1); S_BARRIER();
            PG8_LDA(At, 1, 1); PG8_STAGE(PG8_SA(1, 0), a3, voffA);
            S_BARRIER(); WAIT_L(0); PG8_MMA(1, 0, At, B0); S_BARRIER(); SCHED_BAR();
            PG8_STAGE(PG8_SB(1, 1), b3 + hstep, voffB);
            WAIT_V(6); S_BARRIER(); PG8_MMA(1, 1, At, B1); S_BARRIER();
        }
        if (S.mode == 0) { PRB_END_NS(3, (char*)lds) } else { PRB_END_NS(5, (char*)lds) }
        PRB_BEGIN_NS(4) PRB_BEGIN_NS(6)
        S.epilogue(acc, cur, wr, wc, fr, fq);
        if (S.mode == 0) { PRB_END_NS(4, (char*)lds) } else { PRB_END_NS(6, (char*)lds) }
        if (!has_next) break;
#pragma unroll
        for (int a = 0; a < 2; ++a)
#pragma unroll
            for (int b = 0; b < 2; ++b)
#pragma unroll
                for (int m = 0; m < 4; ++m)
#pragma unroll
                    for (int n = 0; n < 2; ++n) acc[a][b][m][n] = (f32x4){0.f, 0.f, 0.f, 0.f};
        cur = nxt; cA = nA; cB = nB; ++ui;
    }
    WAIT_V(0);
    if (wr == 0) S_BARRIER();
    S_BARRIER();
#undef PG8_SA
#undef PG8_SB
#undef PG8_STAGE
#undef PG8_LDA
#undef PG8_LDB
#undef PG8_MMA
}

DI void unpack8(const u32x4 v, float (&f)[8]) {
    f[0] = __uint_as_float(v.x << 16); f[1] = __uint_as_float(v.x & 0xffff0000u); f[2] = __uint_as_float(v.y << 16); f[3] = __uint_as_float(v.y & 0xffff0000u);
    f[4] = __uint_as_float(v.z << 16); f[5] = __uint_as_float(v.z & 0xffff0000u); f[6] = __uint_as_float(v.w << 16); f[7] = __uint_as_float(v.w & 0xffff0000u);
}
DI int PADX(int i) { return i + (i >> 4); }
constexpr int FB_BANK = 8704;
template <int SIGN> DI void dft4(cpx& a0, cpx& a1, cpx& a2, cpx& a3) {
    const cpx t0 = a0 + a2, t1 = a0 - a2, t2 = a1 + a3, t3 = a1 - a3;
    const cpx t3r = SIGN < 0 ? cpx{t3.y, -t3.x} : cpx{-t3.y, t3.x};
    a0 = t0 + t2; a1 = t1 + t3r; a2 = t0 - t2; a3 = t1 - t3r;
}
template <int SIGN> DI void dft16(cpx (&v)[16]) {
#pragma unroll
    for (int n2 = 0; n2 < 4; ++n2) dft4<SIGN>(v[n2], v[4 + n2], v[8 + n2], v[12 + n2]);
    constexpr float C1 = 0.92387953251128674f, S1 = 0.38268343236508977f, R = 0.70710678118654752f, SG = (float)SIGN;
    v[5] = cmul(v[5], cpx{C1, SG * S1});  v[6] = cmul(v[6], cpx{R, SG * R});     v[7] = cmul(v[7], cpx{S1, SG * C1});
    v[9] = cmul(v[9], cpx{R, SG * R});    v[10] = cmul(v[10], cpx{0.f, SG});     v[11] = cmul(v[11], cpx{-R, SG * R});
    v[13] = cmul(v[13], cpx{S1, SG * C1}); v[14] = cmul(v[14], cpx{-R, SG * R}); v[15] = cmul(v[15], cpx{-C1, -SG * S1});
#pragma unroll
    for (int k1 = 0; k1 < 4; ++k1) dft4<SIGN>(v[4 * k1], v[4 * k1 + 1], v[4 * k1 + 2], v[4 * k1 + 3]);
}
template <int SIGN> DI void fft_pass16x2(cpx* fa, cpx* fb, int j, int Ns, int N16) {
    cpx va[16], vb[16];
#pragma unroll
    for (int r = 0; r < 16; ++r) { const int ix = PADX(j + N16 * r); va[r] = fa[ix]; vb[r] = fb[ix]; }
    const int k = j & (Ns - 1);
    if (Ns > 1) {
        float sn, cs; sincospif((float)(SIGN * 2 * k) / (float)(16 * Ns), &sn, &cs);
        cpx w[16];
        w[1] = cpx{cs, sn}; w[2] = cmul(w[1], w[1]); w[3] = cmul(w[2], w[1]); w[4] = cmul(w[2], w[2]); w[5] = cmul(w[4], w[1]); w[6] = cmul(w[4], w[2]); w[7] = cmul(w[4], w[3]); w[8] = cmul(w[4], w[4]);
#pragma unroll
        for (int r = 9; r < 16; ++r) w[r] = cmul(w[8], w[r - 8]);
#pragma unroll
        for (int r = 1; r < 16; ++r) { va[r] = cmul(va[r], w[r]); vb[r] = cmul(vb[r], w[r]); }
    }
    dft16<SIGN>(va); dft16<SIGN>(vb);
    __syncthreads();
    const int base = (j - k) * 16 + k;
#pragma unroll
    for (int kk = 0; kk < 16; ++kk) { const int ix = PADX(base + kk * Ns); fa[ix] = va[4 * (kk & 3) + (kk >> 2)]; fb[ix] = vb[4 * (kk & 3) + (kk >> 2)]; }
    __syncthreads();
}
template <int SIGN> DI void fft_passes(cpx* fa, cpx* fb, int j, int Ns0, int np16, int N16) {
#pragma unroll 1
    for (int ps = 0, Ns = Ns0; ps < np16; ++ps, Ns <<= 4) fft_pass16x2<SIGN>(fa, fb, j, Ns, N16);
}
DI cpx conv_out(const cpx* fb, int t, int L) {
    const cpx a = fb[PADX(t)], b = fb[PADX(t + L)];
    float sn, cs; sincospif((float)t / (float)L, &sn, &cs);
    const cpx wb = cmul(cpx{cs, sn}, b);
    const float rn = 0.5f / (float)L;
    return (a + wb) * rn;
}
DI float conv3(const bf16* ptr, int t, int L, float w0, float w1, float w2) {
    const float a = t > 0 ? bf2f(ptr[t - 1]) : 0.f, b = bf2f(ptr[t]), c = t < L - 1 ? bf2f(ptr[t + 1]) : 0.f;
    return a * w0 + b * w1 + c * w2;
}
DI void filter_item(const Params& p, int l, int item, char* smem, bool lat) {
    const int np16 = lat ? 3 : 2, N16 = lat ? 512 : 32, N = 16 * N16, L = N / 2;
    const int tid = TIDX(), sub = tid / N16, j = tid % N16;
    const int c = lat ? item : item * 16 + sub;
    cpx* fa = (cpx*)smem + sub * (N + N / 16); cpx* fb = fa + FB_BANK;
    float* red = (float*)(smem + 2 * FB_BANK * 8);
    const float* hid = (const float*)(p.ws + WS_HID2) + ((size_t)l * (SEQ + DEC_SEQ) + (lat ? SEQ : 0)) * FH + j;
    const float* w3 = p.in[I_FW3] + (size_t)l * FH * 4 * HYENA_W + c;
    float f0[8], f1[8], b0[8], b1[8];
#pragma unroll
    for (int i = 0; i < 8; ++i) { f0[i] = 0.f; f1[i] = 0.f; b0[i] = 0.f; b1[i] = 0.f; }
#pragma unroll 8
    for (int q = 0; q < FH; ++q) {
        const float* wq = w3 + (size_t)q * 4 * HYENA_W;
        const float wf0 = wq[0], wf1 = wq[HYENA_W], wb0 = wq[2 * HYENA_W], wb1 = wq[3 * HYENA_W];
#pragma unroll
        for (int i = 0; i < 8; ++i) { const float hv = hid[(size_t)q * L + N16 * i]; f0[i] += hv * wf0; f1[i] += hv * wf1; b0[i] += hv * wb0; b1[i] += hv * wb1; }
    }
    const float min_decay = -4.605170185988091f / 1.5f, max_decay = -4.605170185988091f / 0.3f;
    const float delta = fabsf(min_decay + (max_decay - min_decay) * (float)c / (float)(HYENA_W - 1));
    float as0 = 0.f, as1 = 0.f;
#pragma unroll
    for (int i = 0; i < 8; ++i) {
        const int t = j + N16 * i;
        const float dec = __expf(-((float)t / (float)(L - 1)) * delta);
        const float vf0 = f0[i] * dec, vf1 = f1[i] * dec, vb0 = b0[i] * dec, vb1 = b1[i] * dec;
        fa[PADX(t)] = cpx{vf0, 0.f}; fb[PADX(t)] = cpx{vf1, 0.f};
        if (t == 0) { fa[PADX(L)] = cpx{0.f, 0.f}; fb[PADX(L)] = cpx{0.f, 0.f}; } else { fa[PADX(N - t)] = cpx{vb0, 0.f}; fb[PADX(N - t)] = cpx{vb1, 0.f}; }
        as0 += fabsf(vf0) + (t == 0 ? 0.f : fabsf(vb0)); as1 += fabsf(vf1) + (t == 0 ? 0.f : fabsf(vb1));
    }
#pragma unroll
    for (int s = 1; s < 32; s <<= 1) { as0 += __shfl_xor(as0, s); as1 += __shfl_xor(as1, s); }
    if (lat) {
        as0 += __shfl_xor(as0, 32); as1 += __shfl_xor(as1, 32);
        if ((tid & 63) == 0) { red[tid >> 6] = as0; red[8 + (tid >> 6)] = as1; }
    }
    __syncthreads();
    if (lat) { as0 = 0.f; as1 = 0.f;
#pragma unroll
        for (int q = 0; q < 8; ++q) { as0 += red[q]; as1 += red[8 + q]; } }
    const float rn0 = 1.f / as0, rn1 = 1.f / as1;
    {
        cpx a0[8], a1[8], c0[8], c1[8];
#pragma unroll
        for (int i = 0; i < 8; ++i) { const int t = j + N16 * i; a0[i] = fa[PADX(t)]; c0[i] = fa[PADX(t + L)]; a1[i] = fb[PADX(t)]; c1[i] = fb[PADX(t + L)]; }
        __syncthreads();
#pragma unroll
        for (int i = 0; i < 8; ++i) { const int t = j + N16 * i; fa[PADX(2 * t)] = a0[i] + c0[i]; fa[PADX(2 * t + 1)] = a0[i] - c0[i]; fb[PADX(2 * t)] = a1[i] + c1[i]; fb[PADX(2 * t + 1)] = a1[i] - c1[i]; }
        __syncthreads();
    }
    fft_passes<-1>(fa, fb, j, 2, np16, N16);
    cpx* kf0 = (cpx*)(p.ws + (lat ? WS_KFL + (l & 1) * KFL_BYTES : WS_KFC + (l & 1) * KFC_BYTES)) + (size_t)c * N; cpx* kf1 = kf0 + (size_t)HYENA_W * N;
#pragma unroll 4
    for (int i = 0; i < 16; ++i) { const int f = j + N16 * i; kf0[f] = fa[PADX(f)] * rn0; kf1[f] = fb[PADX(f)] * rn1; }
    __syncthreads();
}

DI void conv3x8(const bf16* row, int t0, int L, float w0, float w1, float w2, float (&o)[8]) {
    float v[8]; unpack8(*(const u32x4*)(row + t0), v);
    const bf16 pr = row[t0 > 0 ? t0 - 1 : 0], nr = row[t0 + 8 < L ? t0 + 8 : t0];
    const float pv = t0 > 0 ? bf2f(pr) : 0.f, nx = t0 + 8 < L ? bf2f(nr) : 0.f;
    o[0] = pv * w0 + v[0] * w1 + v[1] * w2;
#pragma unroll
    for (int i = 1; i < 7; ++i) o[i] = v[i - 1] * w0 + v[i] * w1 + v[i + 1] * w2;
    o[7] = v[6] * w0 + v[7] * w1 + nx * w2;
}
DI void hyena_item(const Params& p, int l, int item, char* smem, bool lat) {
    const int np16 = lat ? 3 : 2, N16 = lat ? 512 : 32, N = 16 * N16, L = N / 2;
    const int NPAIR = lat ? DEC_BATCH / 2 : BATCH / 2;
    const int tid = TIDX(), sub = tid / N16, j = tid % N16, t0 = 8 * j;
    constexpr int IPC = (DEC_BATCH / 2 + 1) / 2;
    int cA, cB, prA, prB; bool actA, actB;
    if (lat) { cA = cB = item / IPC; prA = 2 * (item % IPC); prB = prA + 1; actA = true; actB = prB < NPAIR; }
    else { cA = 2 * item; cB = cA + 1; prA = prB = sub; actA = actB = sub < NPAIR; }
    const int tokA = (lat ? TC : 0) + (actA ? 2 * prA : 0) * L, tokB = (lat ? TC : 0) + (actB ? 2 * prB : 0) * L;
    cpx* fa = (cpx*)smem + sub * (N + N / 16); cpx* fb = fa + FB_BANK;
    const bf16* HYT = (const bf16*)(p.ws + WS_HYT);
    const float* cw = p.in[I_HYCW] + (size_t)l * 3 * 3 * HYENA_W;
    const cpx* kfbase = (const cpx*)(p.ws + (lat ? WS_KFL + (l & 1) * KFL_BYTES : WS_KFC + (l & 1) * KFC_BYTES));
    cpx* zsA = (cpx*)(p.ws + WS_ZS) + (size_t)BIDX() * 2 * 4096 + sub * L + t0; cpx* zsB = zsA + 4096;
    bf16* zoutA = (bf16*)(p.ws + WS_ZT) + (size_t)cA * T; bf16* zoutB = (bf16*)(p.ws + WS_ZT) + (size_t)cB * T;
    {
        const bf16* hvA = HYT + (size_t)cA * T + tokA;
        float a0[8], a1[8];
        conv3x8(hvA, t0, L, cw[cA], cw[3 * HYENA_W + cA], cw[6 * HYENA_W + cA], a0); conv3x8(hvA + L, t0, L, cw[cA], cw[3 * HYENA_W + cA], cw[6 * HYENA_W + cA], a1);
#pragma unroll
        for (int i = 0; i < 8; ++i) {
            const cpx ua = actA ? cpx{a0[i], a1[i]} : cpx{0.f, 0.f};
            zsA[i] = ua;
            const int ix = PADX(2 * (t0 + i));
            fa[ix] = ua; fa[ix + 1] = ua;
        }
    }
    SCHED_BAR();
    {
        const bf16* hvB = HYT + (size_t)cB * T + tokB;
        float b0[8], b1[8];
        conv3x8(hvB, t0, L, cw[cB], cw[3 * HYENA_W + cB], cw[6 * HYENA_W + cB], b0); conv3x8(hvB + L, t0, L, cw[cB], cw[3 * HYENA_W + cB], cw[6 * HYENA_W + cB], b1);
#pragma unroll
        for (int i = 0; i < 8; ++i) {
            const cpx ub = actB ? cpx{b0[i], b1[i]} : cpx{0.f, 0.f};
            zsB[i] = ub;
            const int ix = PADX(2 * (t0 + i));
            fb[ix] = ub; fb[ix + 1] = ub;
        }
    }
    __syncthreads();
#pragma unroll 1
    for (int o = 0; o < 2; ++o) {
        fft_passes<-1>(fa, fb, j, 2, np16, N16);
        const int t0o = OPQ(t0), tokAo = OPQ(tokA), tokBo = OPQ(tokB);
        cpx* zsAo = (cpx*)(p.ws + WS_ZS) + (size_t)BIDX() * 2 * 4096 + sub * L + t0o; cpx* zsBo = zsAo + 4096;
        {
            const cpx* kfA = kfbase + (size_t)(o * HYENA_W + cA) * N + j; const cpx* kfB = kfbase + (size_t)(o * HYENA_W + cB) * N + j;
#pragma unroll 8
            for (int i = 0; i < 16; ++i) { const int ix = PADX(j + N16 * i); const cpx ka = kfA[N16 * i], kb = lat ? ka : kfB[N16 * i]; fa[ix] = cmul(fa[ix], ka); fb[ix] = cmul(fb[ix], kb); }
        }
        __syncthreads();
        fft_passes<1>(fa, fb, j, 1, np16, N16);
        const int wo = (1 + o) * HYENA_W;
        float sn, cs; sincospif((float)t0o / (float)L, &sn, &cs); const cpx wbase = cpx{cs, sn};
        sincospif(1.f / (float)L, &sn, &cs); const cpx wstep = cpx{cs, sn};
        const float rn = 0.5f / (float)L;
        cpx za[8], zb[8];
        {
            float x0[8], x1[8];
            conv3x8(HYT + (size_t)(wo + cA) * T + tokAo, t0o, L, cw[wo + cA], cw[3 * HYENA_W + wo + cA], cw[6 * HYENA_W + wo + cA], x0);
            conv3x8(HYT + (size_t)(wo + cA) * T + tokAo + L, t0o, L, cw[wo + cA], cw[3 * HYENA_W + wo + cA], cw[6 * HYENA_W + wo + cA], x1);
            const float dd = p.in[I_HYD][(size_t)l * 2 * HYENA_W + o * HYENA_W + cA];
            cpx w = wbase;
#pragma unroll
            for (int i = 0; i < 8; ++i) {
                const cpx y = (fa[PADX(t0o + i)] + cmul(w, fa[PADX(t0o + i + L)])) * rn; w = cmul(w, wstep);
                const cpx u = zsAo[i];
                za[i] = cpx{x0[i] * (y.x + dd * u.x), x1[i] * (y.y + dd * u.y)};
            }
        }
        SCHED_BAR();
        {
            float x0[8], x1[8];
            conv3x8(HYT + (size_t)(wo + cB) * T + tokBo, t0o, L, cw[wo + cB], cw[3 * HYENA_W + wo + cB], cw[6 * HYENA_W + wo + cB], x0);
            conv3x8(HYT + (size_t)(wo + cB) * T + tokBo + L, t0o, L, cw[wo + cB], cw[3 * HYENA_W + wo + cB], cw[6 * HYENA_W + wo + cB], x1);
            const float dd = p.in[I_HYD][(size_t)l * 2 * HYENA_W + o * HYENA_W + cB];
            cpx w = wbase;
#pragma unroll
            for (int i = 0; i < 8; ++i) {
                const cpx y = (fb[PADX(t0o + i)] + cmul(w, fb[PADX(t0o + i + L)])) * rn; w = cmul(w, wstep);
                const cpx u = zsBo[i];
                zb[i] = cpx{x0[i] * (y.x + dd * u.x), x1[i] * (y.y + dd * u.y)};
            }
        }
        __syncthreads();
        if (o == 0) {
#pragma unroll
            for (int i = 0; i < 8; ++i) {
                const cpx ua = actA ? za[i] : cpx{0.f, 0.f}, ub = actB ? zb[i] : cpx{0.f, 0.f};
                zsAo[i] = ua; zsBo[i] = ub;
                const int ix = PADX(2 * (t0o + i));
                fa[ix] = ua; fa[ix + 1] = ua; fb[ix] = ub; fb[ix + 1] = ub;
            }
            __syncthreads();
        } else {
            const bf16* ghA = HYT + (size_t)(3 * HYENA_W + cA) * T + tokAo + t0o; const bf16* ghB = HYT + (size_t)(3 * HYENA_W + cB) * T + tokBo + t0o;
            float g[8]; u32x4 ov;
            if (actA) {
                unpack8(*(const u32x4*)ghA, g);
                ov.x = pack2(za[0].x * g[0], za[1].x * g[1]); ov.y = pack2(za[2].x * g[2], za[3].x * g[3]); ov.z = pack2(za[4].x * g[4], za[5].x * g[5]); ov.w = pack2(za[6].x * g[6], za[7].x * g[7]);
                *(u32x4*)(zoutA + tokAo + t0o) = ov;
                unpack8(*(const u32x4*)(ghA + L), g);
                ov.x = pack2(za[0].y * g[0], za[1].y * g[1]); ov.y = pack2(za[2].y * g[2], za[3].y * g[3]); ov.z = pack2(za[4].y * g[4], za[5].y * g[5]); ov.w = pack2(za[6].y * g[6], za[7].y * g[7]);
                *(u32x4*)(zoutA + tokAo + L + t0o) = ov;
            }
            if (actB) {
                unpack8(*(const u32x4*)ghB, g);
                ov.x = pack2(zb[0].x * g[0], zb[1].x * g[1]); ov.y = pack2(zb[2].x * g[2], zb[3].x * g[3]); ov.z = pack2(zb[4].x * g[4], zb[5].x * g[5]); ov.w = pack2(zb[6].x * g[6], zb[7].x * g[7]);
                *(u32x4*)(zoutB + tokBo + t0o) = ov;
                unpack8(*(const u32x4*)(ghB + L), g);
                ov.x = pack2(zb[0].y * g[0], zb[1].y * g[1]); ov.y = pack2(zb[2].y * g[2], zb[3].y * g[3]); ov.z = pack2(zb[4].y * g[4], zb[5].y * g[5]); ov.w = pack2(zb[6].y * g[6], zb[7].y * g[7]);
                *(u32x4*)(zoutB + tokBo + L + t0o) = ov;
            }
        }
    }
}

DI void hytr_item(const Params& p, int item, char* smem) {
    const int tid = TIDX(), tok0 = item * 64;
    const bf16* HYT = (const bf16*)(p.ws + WS_ZT); bf16* mixed = (bf16*)(p.ws + WS_XN);
    unsigned* tile = (unsigned*)smem;
    for (int id = tid; id < HYENA_W * 8; id += NTHR) {
        const int ch = id >> 3, ck = id & 7, x = (ch >> 3) & 31;
        const u32x4 v = *(const u32x4*)(HYT + (size_t)ch * T + tok0 + ck * 8);
        unsigned* row = tile + ch * 32;
        row[(4 * ck) ^ x] = v.x; row[(4 * ck + 1) ^ x] = v.y; row[(4 * ck + 2) ^ x] = v.z; row[(4 * ck + 3) ^ x] = v.w;
    }
    __syncthreads();
    for (int id = tid; id < 64 * (HYENA_W / 8); id += NTHR) {
        const int cg = id % (HYENA_W / 8), tok = id / (HYENA_W / 8), x = cg & 31, sh = (tok & 1) * 16;
        unsigned e[8];
#pragma unroll
        for (int k = 0; k < 8; ++k) e[k] = (tile[(8 * cg + k) * 32 + ((tok >> 1) ^ x)] >> sh) & 0xffffu;
        u32x4 o; o.x = e[0] | (e[1] << 16); o.y = e[2] | (e[3] << 16); o.z = e[4] | (e[5] << 16); o.w = e[6] | (e[7] << 16);
        *(u32x4*)(mixed + (size_t)(tok0 + tok) * MIX_W + ATTN_W + 8 * cg) = o;
    }
    __syncthreads();
}

DI void shortconv_item(const Params& p, int l, int item) {
    const bf16* SCb = (const bf16*)(p.ws + WS_SC);
    bf16* mixed = (bf16*)(p.ws + WS_XN);
    const float* cw = p.in[I_SCW] + (size_t)l * 3 * CONV_W;
    constexpr int C8 = CONV_W / 8;
    const u32x4 zero4 = {0u, 0u, 0u, 0u};
#pragma unroll 4
    for (int e = TIDX(); e < 256 * C8; e += NTHR) {
        const int m = item * 256 + e / C8, c = (e % C8) * 8;
        const int L = m < TC ? SEQ : DEC_SEQ, t = m < TC ? m % SEQ : (m - TC) % DEC_SEQ;
        const bf16* row = SCb + (size_t)m * 4 * CONV_W + c;
        float sb[8], g0[8], x0[8], gm[8], xm[8], gn[8], xn[8], gc[8], w0[8], w1[8], w2[8];
        unpack8(*(const u32x4*)row, sb); unpack8(*(const u32x4*)(row + CONV_W), g0); unpack8(*(const u32x4*)(row + 2 * CONV_W), x0); unpack8(*(const u32x4*)(row + 3 * CONV_W), gc);
        const bf16* rowm = t > 0 ? row - 4 * CONV_W : row; const bf16* rown = t < L - 1 ? row + 4 * CONV_W : row;
        u32x4 vgm = *(const u32x4*)(rowm + CONV_W), vxm = *(const u32x4*)(rowm + 2 * CONV_W), vgn = *(const u32x4*)(rown + CONV_W), vxn = *(const u32x4*)(rown + 2 * CONV_W);
        if (t == 0) { vgm = zero4; vxm = zero4; } if (t == L - 1) { vgn = zero4; vxn = zero4; }
        unpack8(vgm, gm); unpack8(vxm, xm); unpack8(vgn, gn); unpack8(vxn, xn);
#pragma unroll
        for (int i = 0; i < 2; ++i) {
            const f32x4 a = *(const f32x4*)(cw + c + 4 * i), b = *(const f32x4*)(cw + CONV_W + c + 4 * i), d = *(const f32x4*)(cw + 2 * CONV_W + c + 4 * i);
            w0[4 * i] = a.x; w0[4 * i + 1] = a.y; w0[4 * i + 2] = a.z; w0[4 * i + 3] = a.w;
            w1[4 * i] = b.x; w1[4 * i + 1] = b.y; w1[4 * i + 2] = b.z; w1[4 * i + 3] = b.w;
            w2[4 * i] = d.x; w2[4 * i + 1] = d.y; w2[4 * i + 2] = d.z; w2[4 * i + 3] = d.w;
        }
        float o[8];
#pragma unroll
        for (int i = 0; i < 8; ++i) o[i] = sb[i] * (gm[i] * xm[i] * w0[i] + g0[i] * x0[i] * w1[i] + gn[i] * xn[i] * w2[i]) * gc[i];
        u32x4 ov; ov.x = pack2(o[0], o[1]); ov.y = pack2(o[2], o[3]); ov.z = pack2(o[4], o[5]); ov.w = pack2(o[6], o[7]);
        *(u32x4*)(mixed + (size_t)m * MIX_W + ATTN_W + HYENA_W + c) = ov;
    }
}

constexpr int AT_NKL = 320;
constexpr int AT_KL = 0, AT_VL = AT_KL + AT_NKL * 128, AT_KC = AT_VL + AT_NKL * 128, AT_VC = AT_KC + 256 * 128, AT_END = AT_VC + 256 * 128;
static_assert(AT_END <= LDS_BYTES - 16, "lds");
DI int swzv(int row, int c) { return row * 128 + ((c ^ (((row >> 1) & 1) << 2)) << 4); }
struct VFrag { u32x2 r[8]; };
#ifdef EMU
DI void v_tr_issue(const char* a0, const char* a1, VFrag& f) {
#pragma unroll
    for (int i = 0; i < 8; ++i) { const bf16x4 v = emu_ds_read_tr16((i < 4 ? a0 : a1) + 1024 * (i & 3)); f.r[i] = __builtin_bit_cast(u32x2, v); }
}
DI void v_tr_wait(VFrag&) {}
DI float fast_exp2(float x) { return exp2f(x); }
DI bool wave_any(bool pred) { return emu_wave_any(pred); }
#else
DI void v_tr_issue(const char* a0, const char* a1, VFrag& f) {
    const unsigned x0 = (unsigned)(size_t)(const LAS char*)a0, x1 = (unsigned)(size_t)(const LAS char*)a1;
    asm volatile("ds_read_b64_tr_b16 %0, %8\n\tds_read_b64_tr_b16 %1, %8 offset:1024\n\tds_read_b64_tr_b16 %2, %8 offset:2048\n\tds_read_b64_tr_b16 %3, %8 offset:3072\n\t"
                 "ds_read_b64_tr_b16 %4, %9\n\tds_read_b64_tr_b16 %5, %9 offset:1024\n\tds_read_b64_tr_b16 %6, %9 offset:2048\n\tds_read_b64_tr_b16 %7, %9 offset:3072"
                 : "=&v"(f.r[0]), "=&v"(f.r[1]), "=&v"(f.r[2]), "=&v"(f.r[3]), "=&v"(f.r[4]), "=&v"(f.r[5]), "=&v"(f.r[6]), "=&v"(f.r[7]) : "v"(x0), "v"(x1) : "memory");
}
DI void v_tr_wait(VFrag& f) {
    asm volatile("s_waitcnt lgkmcnt(0)" : "+v"(f.r[0]), "+v"(f.r[1]), "+v"(f.r[2]), "+v"(f.r[3]), "+v"(f.r[4]), "+v"(f.r[5]), "+v"(f.r[6]), "+v"(f.r[7]) :: "memory");
    __builtin_amdgcn_sched_barrier(0);
}
DI float fast_exp2(float x) { return __builtin_amdgcn_exp2f(x); }
DI bool wave_any(bool pred) { return __builtin_amdgcn_ballot_w64(pred) != 0ull; }
#endif
DI void softmax_pv(f32x16& S, f32x16 (&O)[2], float& m_run, float& l_run, VFrag& vf, float c1) {
    float tmax = S[0];
#pragma unroll
    for (int e = 1; e < 16; ++e) tmax = fmaxf(tmax, S[e]);
    tmax *= c1;
    if (wave_any(tmax > m_run + 8.f)) {
        tmax = fmaxf(tmax, __shfl_xor(tmax, 32));
        const float mnew = fmaxf(m_run, tmax), alpha = fast_exp2(m_run - mnew);
        m_run = mnew; l_run *= alpha;
#pragma unroll
        for (int e = 0; e < 16; ++e) { O[0][e] *= alpha; O[1][e] *= alpha; }
    }
    float ps = 0.f; unsigned pk[8];
#pragma unroll
    for (int e = 0; e < 8; ++e) { const float p0 = fast_exp2(S[2 * e] * c1 - m_run), p1 = fast_exp2(S[2 * e + 1] * c1 - m_run); ps += p0 + p1; pk[e] = pack2(p0, p1); }
    l_run += ps;
    u32x4 q0; q0.x = pk[0]; q0.y = pk[1]; q0.z = pk[2]; q0.w = pk[3];
    u32x4 q1; q1.x = pk[4]; q1.y = pk[5]; q1.z = pk[6]; q1.w = pk[7];
    const bf16x8 pb0 = __builtin_bit_cast(bf16x8, q0), pb1 = __builtin_bit_cast(bf16x8, q1);
    v_tr_wait(vf);
    u32x4 f;
    f.x = vf.r[0].x; f.y = vf.r[0].y; f.z = vf.r[1].x; f.w = vf.r[1].y; O[0] = MFMA32(__builtin_bit_cast(bf16x8, f), pb0, O[0]);
    f.x = vf.r[2].x; f.y = vf.r[2].y; f.z = vf.r[3].x; f.w = vf.r[3].y; O[0] = MFMA32(__builtin_bit_cast(bf16x8, f), pb1, O[0]);
    f.x = vf.r[4].x; f.y = vf.r[4].y; f.z = vf.r[5].x; f.w = vf.r[5].y; O[1] = MFMA32(__builtin_bit_cast(bf16x8, f), pb0, O[1]);
    f.x = vf.r[6].x; f.y = vf.r[6].y; f.z = vf.r[7].x; f.w = vf.r[7].y; O[1] = MFMA32(__builtin_bit_cast(bf16x8, f), pb1, O[1]);
}
DI void attn_item(const Params& p, int l, int item, char* smem, bool LAT) {
    const int tid = TIDX(), lane = tid & 63, w = tid >> 6, r = lane & 31, h = lane >> 5;
    const int SL = LAT ? DEC_SEQ : SEQ, NQB = SL / 64;
    const int b = item / (N_KV * NQB), kvh = (item / NQB) % N_KV, q0 = (item % NQB) * 64;
    const int tokbase = (LAT ? TC : 0) + b * SL;
    const bf16* Qb = (const bf16*)(p.ws + WS_Q); const bf16* Kb = (const bf16*)(p.ws + WS_KB); const bf16* Vb = (const bf16*)(p.ws + WS_VB);
    const bf16* GAb = (const bf16*)(p.ws + WS_GA); bf16* mixed = (bf16*)(p.ws + WS_XN);
    char* KL = smem + AT_KL; char* VL = smem + AT_VL; char* KC = smem + AT_KC; char* VC = smem + AT_VC;
    const u32x4 zero4 = {0u, 0u, 0u, 0u};
    PRB_BEGIN(1)
    {
        const bf16* ksrc; const bf16* vsrc; size_t stride;
        if (LAT) { const size_t o = (size_t)((b * DEPTH + l) * N_KV + kvh) * PAST_LEN * HD; ksrc = (const bf16*)(p.ws + WS_CKB) + o; vsrc = (const bf16*)(p.ws + WS_CVTB) + o; stride = HD; }
        else { ksrc = Kb + (size_t)tokbase * KV_W + kvh * HD; vsrc = Vb + (size_t)tokbase * KV_W + kvh * HD; stride = KV_W; }
        u32x4 ck[4], cv[4], lk[5], lv[5];
#pragma unroll
        for (int i = 0; i < 4; ++i) { const int id = tid + NTHR * i, row = id >> 3, c = id & 7; ck[i] = *(const u32x4*)(ksrc + (size_t)row * stride + c * 8); cv[i] = *(const u32x4*)(vsrc + (size_t)row * stride + c * 8); }
        if (LAT) {
#pragma unroll
            for (int i = 0; i < 5; ++i) {
                const int id = tid + NTHR * i, row = id >> 3, c = id & 7, kp = q0 - 128 + row;
                const bool inr = kp >= 0 && kp < SL;
                const size_t o = (size_t)(tokbase + (inr ? kp : 0)) * KV_W + kvh * HD + c * 8;
                lk[i] = *(const u32x4*)(Kb + o); lv[i] = *(const u32x4*)(Vb + o);
                if (!inr) { lk[i] = zero4; lv[i] = zero4; }
            }
#pragma unroll
            for (int i = 0; i < 5; ++i) { const int id = tid + NTHR * i, row = id >> 3, c = id & 7; *(u32x4*)(KL + swz128(row, c)) = lk[i]; *(u32x4*)(VL + swzv(row, c)) = lv[i]; }
        }
#pragma unroll
        for (int i = 0; i < 4; ++i) { const int id = tid + NTHR * i, row = id >> 3, c = id & 7; *(u32x4*)(KC + swz128(row, c)) = ck[i]; *(u32x4*)(VC + swzv(row, c)) = cv[i]; }
    }
    __syncthreads();
    PRB_END(1, smem)
    PRB_BEGIN(2)
    {
        const int g = w >> 1, qt = w & 1, head = kvh * 4 + g;
        const int qpos = q0 + 32 * qt + r;
        const size_t qtok = (size_t)tokbase + qpos;
        bf16x8 qraw[4], qrot[4];
#pragma unroll
        for (int s = 0; s < 4; ++s) { qraw[s] = *(const bf16x8*)(Qb + qtok * ATTN_W + head * HD + 16 * s + 8 * h); qrot[s] = qraw[s]; }
        if (LAT) {
            const f32x2* rope = (const f32x2*)(p.ws + WS_ROPE);
#pragma unroll
            for (int a = 0; a < 2; ++a)
#pragma unroll
                for (int jj = 0; jj < 8; ++jj) {
                    const f32x2 cs = rope[(qpos * 2 + a) * 16 + 8 * h + jj];
                    const float xa = bf2f((bf16)qraw[2 * a][jj]), xb = bf2f((bf16)qraw[2 * a + 1][jj]);
                    qrot[2 * a][jj] = (short)f2bf(xa * cs.x - xb * cs.y);
                    qrot[2 * a + 1][jj] = (short)f2bf(xb * cs.x + xa * cs.y);
                }
        }
        const int qq = (lane & 15) >> 2, pp = lane & 3, g16 = (lane >> 4) & 1, vrow = 4 * h + qq;
        const int voff0 = swzv(vrow, 2 * g16 + (pp >> 1)) + (pp & 1) * 8, voff1 = swzv(vrow, 4 + 2 * g16 + (pp >> 1)) + (pp & 1) * 8;
        const float c1 = 0.125f * 1.4426950408889634f;
        float m_run = p.in[I_SINK][l * N_HEADS + head] * 1.4426950408889634f, l_run = h == 0 ? 1.f : 0.f;
        f32x16 O[2];
#pragma unroll
        for (int e = 0; e < 16; ++e) { O[0][e] = 0.f; O[1][e] = 0.f; }
        if (LAT) {
            for (int jt = qt; jt < qt + 9; ++jt) {
                VFrag vf; v_tr_issue(VL + 4096 * jt + voff0, VL + 4096 * jt + voff1, vf);
                f32x16 S;
#pragma unroll
                for (int e = 0; e < 16; ++e) S[e] = 0.f;
                const int krow = 32 * jt + r;
#pragma unroll
                for (int s = 0; s < 4; ++s) S = MFMA32(*(const bf16x8*)(KL + swz128(krow, 2 * s + h)), qrot[s], S);
                const int kt0 = q0 - 128 + 32 * jt, qt0 = q0 + 32 * qt;
                if (kt0 + 31 - qt0 > 128 || qt0 + 31 - kt0 > 128 || kt0 < 0 || kt0 + 31 >= SL) {
#pragma unroll
                    for (int e = 0; e < 16; ++e) {
                        const int kp = kt0 + (e & 3) + 8 * (e >> 2) + 4 * h, dd = kp - qpos;
                        const bool ok = dd <= 128 && dd >= -128 && kp >= 0 && kp < SL;
                        S[e] = ok ? S[e] : -1e30f;
                    }
                }
                softmax_pv(S, O, m_run, l_run, vf, c1);
            }
        }
        for (int jt = 0; jt < 8; ++jt) {
            VFrag vf; v_tr_issue(VC + 4096 * jt + voff0, VC + 4096 * jt + voff1, vf);
            f32x16 S;
#pragma unroll
            for (int e = 0; e < 16; ++e) S[e] = 0.f;
            const int krow = 32 * jt + r;
#pragma unroll
            for (int s = 0; s < 4; ++s) S = MFMA32(*(const bf16x8*)(KC + swz128(krow, 2 * s + h)), qraw[s], S);
            softmax_pv(S, O, m_run, l_run, vf, c1);
        }
        const float inv = 1.f / (l_run + __shfl_xor(l_run, 32));
#pragma unroll
        for (int dt = 0; dt < 2; ++dt)
#pragma unroll
            for (int rg = 0; rg < 4; ++rg) {
                const int d0 = dt * 32 + 8 * rg + 4 * h;
                const u32x2 gv = *(const u32x2*)(GAb + qtok * ATTN_W + head * HD + d0);
                const float g0 = bf2f((bf16)(gv.x & 0xffffu)), g1 = bf2f((bf16)(gv.x >> 16)), g2 = bf2f((bf16)(gv.y & 0xffffu)), g3 = bf2f((bf16)(gv.y >> 16));
                u32x2 o; o.x = pack2(O[dt][4 * rg] * inv * g0, O[dt][4 * rg + 1] * inv * g1); o.y = pack2(O[dt][4 * rg + 2] * inv * g2, O[dt][4 * rg + 3] * inv * g3);
                *(u32x2*)(mixed + qtok * MIX_W + head * HD + d0) = o;
            }
    }
    PRB_END(2, smem)
    __syncthreads();
}

DI void phase_p0(const Params& p_, char* smem) {
    constexpr int I_T1 = DEPTH * (D_MODEL / 64) * (IN_COLS / 64), I_T2 = DEPTH * (MIX_W / 64) * (D_MODEL / 64);
    constexpr int I_MOD = DEPTH * (3 * D_MODEL / 64), I_ROPE = DEC_SEQ * 32 / NTHR, I_HID = DEPTH * (SEQ + DEC_SEQ) / 64;
    constexpr int I_CACHE = (2 * DEC_BATCH * DEPTH * PAST_LEN * KV_W / 8 + NTHR - 1) / NTHR;
    constexpr int TOTAL = I_T1 + I_T2 + I_MOD + I_ROPE + I_HID + I_CACHE;
    for (int it = BIDX(); it < TOTAL; it += gridDim.x) {
        const Params p = launder(p_);
        int q = it;
        if (q < I_T1 + I_T2) {
            const bool w1 = q < I_T1; if (!w1) q -= I_T1;
            const int per = w1 ? (D_MODEL / 64) * (IN_COLS / 64) : (MIX_W / 64) * (D_MODEL / 64), l = q / per;
            if (w1) p0_transpose_item(p.in[I_WIN] + (size_t)l * D_MODEL * IN_COLS, D_MODEL, IN_COLS, (bf16*)(p.ws + WS_WINT) + (size_t)l * IN_COLS * D_MODEL, q % per, smem);
            else p0_transpose_item(p.in[I_WOUT] + (size_t)l * MIX_W * D_MODEL, MIX_W, D_MODEL, (bf16*)(p.ws + WS_WOUTT) + (size_t)l * D_MODEL * MIX_W, q % per, smem);
            continue; }
        q -= I_T1 + I_T2;
        if (q < I_MOD) { p0_mod_item(p, q, smem); continue; }
        q -= I_MOD;
        if (q < I_ROPE) { p0_rope_item(p, q); continue; }
        q -= I_ROPE;
        if (q < I_HID) { p0_hid2_item(p, q); continue; }
        q -= I_HID;
        p0_cache_item(p, q);
    }
}
DI void phase_mix(const Params& p_, int l, int fl, int qid, char* smem, int mask) {
    constexpr int I_HL = HYENA_W * ((DEC_BATCH / 2 + 1) / 2), I_AL = DEC_BATCH * N_KV * (DEC_SEQ / 64), I_AC = BATCH * N_KV * (SEQ / 64);
    constexpr int I_HC = HYENA_W / 2, I_SC = T / 256, I_FL = HYENA_W, I_FC = HYENA_W / 16;
    static_assert(BATCH / 2 <= 16, "ctx hyena: one bank holds 16 batch pairs");
    const int nf = fl >= 0 ? I_FL + I_FC : 0;
    for (;;) {
        const Params p = launder(p_);
        int q = wq_next(p, qid, smem);
        if (q >= I_HC + I_HL + nf + I_AL + I_AC + I_SC) break;
        if (q < I_HC + I_HL) { const bool lat = q >= I_HC; if (mask & (lat ? 1 : 2)) hyena_item(p, l, lat ? q - I_HC : q, smem, lat); continue; }
        q -= I_HC + I_HL;
        if (q < nf) { const bool lat = q < I_FL; filter_item(p, fl, lat ? q : q - I_FL, smem, lat); continue; }
        q -= nf;
        if (q < I_AL + I_AC) { const bool lat = q < I_AL; if (mask & (lat ? 4 : 8)) attn_item(p, l, lat ? q : q - I_AL, smem, lat); continue; }
        q -= I_AL + I_AC;
        if (mask & 16) shortconv_item(p, l, q);
    }
}
constexpr int I_FILT = HYENA_W + HYENA_W / 16, I_FILT_A = I_FILT / 2;
DI void phase_filters(const Params& p_, int l, int qid, char* smem, int first, int count) {
    constexpr int I_FL = HYENA_W, I_FC = HYENA_W / 16;
    for (;;) {
        const Params p = launder(p_);
        int q = wq_next(p, qid, smem);
        if (q >= count) break;
        q += first;
        const bool lat = q >= I_FC;
        filter_item(p, l, lat ? q - I_FC : q, smem, lat);
    }
}
DI void phase_norm(const Params& p, int l) {
    for (int it = BIDX(); it < T / 16; it += gridDim.x) norm_item(p, l, it);
}
DI void phase_hytr(const Params& p, char* smem) {
    for (int it = BIDX(); it < T / 64; it += gridDim.x) hytr_item(p, it, smem);
}

#ifndef PH_STOP
#define PH_STOP 1000
#endif
#ifndef DUP
#define DUP -1
#endif
#ifndef DMASK
#define DMASK 31
#endif
#ifndef PROBE_SEL
#define PROBE_SEL 0
#endif
#ifndef PROBE_SCALE
#define PROBE_SCALE 10.f
#endif
#ifndef PROBE_WORK
#define PROBE_WORK 0
#endif
__global__ void __launch_bounds__(NTHR, 2) fwd_kernel(Params p_) {
#ifdef EMU
    char* smem = emu_smem();
#else
    extern __shared__ __attribute__((aligned(16))) char smem[];
    volatile LAS unsigned* xst = (volatile LAS unsigned*)(smem + LDS_BYTES - 16);
    if (TIDX() == 0) { xst[0] = 0u; xst[1] = 0u; }
    __syncthreads();
    const XcdBarrier xbar = xcd_barrier_post((unsigned*)(p_.ws + WS_BAR), xst);
#endif
    constexpr int NPH = 2 + 5 * DEPTH;
#if PROBE_SEL
    unsigned long long tacc = 0ull, tprev = __builtin_amdgcn_s_memrealtime();
#if defined(PROBE_SEC_ON)
    if (TIDX() == 0) *(volatile unsigned long long*)(smem + LDS_BYTES - 48) = 0ull;
    __syncthreads();
#endif
#endif
#pragma unroll 1
    for (int ph = 0; ph < NPH && ph < PH_STOP; ++ph) {
#pragma unroll 1
        for (int rep = 0; rep < (ph == DUP ? 2 : 1); ++rep) {
            const Params p = launder(p_);
            const int l = ph >= 2 ? (ph - 2) / 5 : 0, k = ph >= 2 ? (ph - 2) % 5 : -1;
            const int qid = ph + 32 * rep;
            if (ph == 0) phase_p0(p, smem);
            else if (ph == 1) { phase_norm(p, 0); phase_filters(p, 0, qid, smem, 0, I_FILT); }
            else if (k == 1) phase_mix(p, l, (rep || l + 1 >= DEPTH) ? -1 : l + 1, qid, smem, rep ? DMASK : 31);
            else if (k == 0 || k == 3) {
                GemmJob job; job.p = p; job.mode = k == 0 ? 0 : 1; job.l = l; job.K = k == 0 ? D_MODEL : MIX_W;
                gemm_phase((ldsptr_t)smem, job);
            } else if (k == 2) phase_hytr(p, smem);
            else phase_norm(p, l + 1);
        }
#if PROBE_SEL
        {
            const int kk = ph == 0 ? 0 : (ph == 1 ? 1 : 2 + (ph - 2) % 5);
            unsigned long long tnow = __builtin_amdgcn_s_memrealtime();
            if (PROBE_WORK && ((PROBE_SEL >> kk) & 1)) tacc += tnow - tprev;
            GRID_SYNC();
            tnow = __builtin_amdgcn_s_memrealtime();
            if (!PROBE_WORK && ((PROBE_SEL >> kk) & 1)) tacc += tnow - tprev;
            tprev = tnow;
        }
#else
        if (ph + 1 < NPH) GRID_SYNC();
#endif
    }
#if PROBE_SEL
#if defined(PROBE_SEC_ON)
    if (BIDX() == 0 && TIDX() == 0) p_.out[OUT_YS + 777] = (float)*(volatile unsigned long long*)(smem + LDS_BYTES - 48) / (100.f * PROBE_SCALE);
#elif PROBE_WORK >= 2
    {
        unsigned* slot = (unsigned*)(p_.ws + WS_WQ) + 63 * 64;
        if (TIDX() == 0) { if (PROBE_WORK == 2) atomicMax(slot, (unsigned)tacc); else atomicMin(slot + 1, ~(unsigned)tacc == 0u ? 0u : (unsigned)tacc + 0u); }
        GRID_SYNC();
        if (BIDX() == 0 && TIDX() == 0) p_.out[OUT_YS + 777] = (float)__hip_atomic_load(slot + (PROBE_WORK == 2 ? 0 : 1), __ATOMIC_RELAXED, __HIP_MEMORY_SCOPE_AGENT) / (100.f * PROBE_SCALE);
    }
#else
    if (BIDX() == 0 && TIDX() == 0) p_.out[OUT_YS + 777] = (float)tacc / (100.f * PROBE_SCALE);
#endif
#endif
}

#ifndef EMU
extern "C" void kernel_launch(void* const* d_in, const int* in_sizes, int n_in, void* d_out, int out_size, void* d_ws, size_t ws_size, hipStream_t stream) {
    static int grid = 0;
    if (grid == 0) {
        if (n_in != 22 || (size_t)out_size != OUT_TOTAL || ws_size < WS_END) { fprintf(stderr, "kernel_launch: unexpected sizes n_in %d out %d ws %zu (need %zu)\n", n_in, out_size, ws_size, (size_t)WS_END); grid = -1; return; }
        int dev = 0, cus = 0, per_cu = 0;
        hipGetDevice(&dev); hipDeviceGetAttribute(&cus, hipDeviceAttributeMultiprocessorCount, dev);
        if (hipFuncSetAttribute((const void*)fwd_kernel, hipFuncAttributeMaxDynamicSharedMemorySize, LDS_BYTES) != hipSuccess) { fprintf(stderr, "hipFuncSetAttribute failed\n"); grid = -1; return; }
        hipOccupancyMaxActiveBlocksPerMultiprocessor(&per_cu, (const void*)fwd_kernel, NTHR, LDS_BYTES);
        if (per_cu < 1) { fprintf(stderr, "occupancy query says %d\n", per_cu); grid = -1; return; }
        grid = cus;
    }
    if (grid < 0) return;
    Params p{};
    for (int i = 0; i < 22; ++i) p.in[i] = (const float*)d_in[i];
    p.out = (float*)d_out; p.ws = (unsigned char*)d_ws;
    if (hipMemsetAsync((char*)d_ws + WS_BAR, 0, 65536, stream) != hipSuccess) { fprintf(stderr, "memset failed\n"); return; }
    hipLaunchKernelGGL(fwd_kernel, dim3(grid), dim3(NTHR), LDS_BYTES, stream, p);
    const hipError_t e = hipPeekAtLastError();
    if (e != hipSuccess) fprintf(stderr, "launch failed: %s (grid %d)\n", hipGetErrorString(e), grid);
}
#endif
```

```cpp
#ifdef EMU
#include "emu.h"
#define GRID_SYNC() emu_grid_sync()
#define MFMA32(a, b, c) emu_mfma32((a), (b), (c))
#define MFMA16(a, b, c) emu_mfma16((a), (b), (c))
#define LAS
#define GLDS16(g, l) emu_glds16((const void*)(g), (void*)(l))
#define S_BARRIER() __syncthreads()
#define WAIT_V(n)
#define WAIT_L(n)
#define SCHED_BAR()
#define SETPRIO(x)
#define RFL(x) (x)
#define CBAR()
#define OPQ(x) (x)
#define TIDX() ((int)threadIdx.x)
#define BIDX() ((int)blockIdx.x)
#else
#include <hip/hip_runtime.h>
#include <cstdio>
#include <cstdint>
typedef short bf16x8 __attribute__((ext_vector_type(8)));
typedef float f32x16 __attribute__((ext_vector_type(16)));
typedef float f32x4 __attribute__((ext_vector_type(4)));
#define GRID_SYNC() xcd_barrier(xbar)
#define MFMA32(a, b, c) __builtin_amdgcn_mfma_f32_32x32x16_bf16((a), (b), (c), 0, 0, 0)
#define MFMA16(a, b, c) __builtin_amdgcn_mfma_f32_16x16x32_bf16((a), (b), (c), 0, 0, 0)
#define LAS __attribute__((address_space(3)))
#define GLDS16(g, l) __builtin_amdgcn_global_load_lds((const unsigned*)(g), (LAS unsigned*)(l), 16, 0, 0)
#define S_BARRIER() __builtin_amdgcn_s_barrier()
#define WAIT_V(n) asm volatile("s_waitcnt vmcnt(" #n ")" ::: "memory")
#define WAIT_L(n) asm volatile("s_waitcnt lgkmcnt(" #n ")" ::: "memory")
#define SCHED_BAR() __builtin_amdgcn_sched_barrier(0)
#define SETPRIO(x) __builtin_amdgcn_s_setprio(x)
#define RFL(x) __builtin_amdgcn_readfirstlane(x)
#define CBAR() asm volatile("" ::: "memory")
__device__ __forceinline__ int opq_(int x) { asm volatile("" : "+v"(x)); return x; }
#define OPQ(x) opq_(x)
__device__ __forceinline__ int tidx_() { int t = threadIdx.x; asm volatile("" : "+v"(t)); return t; }
__device__ __forceinline__ int bidx_() { int t = blockIdx.x; asm volatile("" : "+s"(t)); return t; }
#define TIDX() tidx_()
#define BIDX() bidx_()
#endif
typedef unsigned u32x4 __attribute__((ext_vector_type(4)));
typedef unsigned u32x2 __attribute__((ext_vector_type(2)));
typedef float f32x2 __attribute__((ext_vector_type(2)));
typedef unsigned short bf16;
#define DI __device__ __forceinline__
#if defined(PROBE_SEC_ON) && !defined(EMU)
#define PRB_BEGIN(id) unsigned long long _prb_t0_##id = 0; if (PROBE_SEC_ON == (id)) { __syncthreads(); _prb_t0_##id = __builtin_amdgcn_s_memrealtime(); }
#define PRB_END(id, smem) if (PROBE_SEC_ON == (id)) { __syncthreads(); if (BIDX() == 0 && TIDX() == 0) *(volatile unsigned long long*)((smem) + LDS_BYTES - 48) += __builtin_amdgcn_s_memrealtime() - _prb_t0_##id; }
#define PRB_BEGIN_NS(id) unsigned long long _prb_t0_##id = 0; if (PROBE_SEC_ON == (id)) { _prb_t0_##id = __builtin_amdgcn_s_memrealtime(); }
#define PRB_END_NS(id, smem) if (PROBE_SEC_ON == (id)) { if (BIDX() == 0 && TIDX() == 0) *(volatile unsigned long long*)((smem) + LDS_BYTES - 48) += __builtin_amdgcn_s_memrealtime() - _prb_t0_##id; }
#else
#define PRB_BEGIN(id)
#define PRB_END(id, smem)
#define PRB_BEGIN_NS(id)
#define PRB_END_NS(id, smem)
#endif

#ifdef CFG_SMALL
constexpr int D_MODEL = 256, BATCH = 2, SEQ = 256, DEPTH = 2, DEC_BATCH = 4, DEC_SEQ = 4096, PAST_LEN = 256, HYENA_W = 128, CONV_W = 128;
#else
constexpr int D_MODEL = 1024, BATCH = 32, SEQ = 256, DEPTH = 4, DEC_BATCH = 8, DEC_SEQ = 4096, PAST_LEN = 256, HYENA_W = 256, CONV_W = 256;
#endif
constexpr int GRID_W = 64, N_HEADS = 8, N_KV = 2, HD = 64, ATTN_W = 512, KV_W = 128;
constexpr int MIX_W = ATTN_W + HYENA_W + CONV_W;
constexpr int C_Q = 0, C_K = ATTN_W, C_V = C_K + KV_W, C_GA = C_V + KV_W, C_HV = C_GA + ATTN_W, C_GH = C_HV + 3 * HYENA_W,
              C_SB = C_GH + HYENA_W, C_GC = C_SB + 3 * CONV_W, IN_COLS = C_GC + CONV_W;
constexpr int TC = BATCH * SEQ, TL = DEC_BATCH * DEC_SEQ, T = TC + TL;
constexpr int NR = 1 + DEC_BATCH;
constexpr int FH = 64, FE = 33;
constexpr int NTHR = 512;
static_assert(T % 256 == 0 && TC % 256 == 0 && C_HV % 256 == 0 && C_SB % 256 == 0 && IN_COLS % 256 == 0 && D_MODEL % 256 == 0 && MIX_W % 128 == 0 && (4 * HYENA_W) % 256 == 0, "tiling");
static_assert(SEQ == 256 && DEC_SEQ == 4096 && PAST_LEN == 256, "fft sizes");

constexpr size_t al256(size_t x) { return (x + 255) & ~(size_t)255; }
constexpr size_t WS_BAR = 0;
constexpr size_t WS_WINT = 65536;
constexpr size_t WS_WOUTT = WS_WINT + al256((size_t)DEPTH * IN_COLS * D_MODEL * 2);
constexpr size_t WS_MOD = WS_WOUTT + al256((size_t)DEPTH * D_MODEL * MIX_W * 2);
constexpr size_t WS_ROPE = WS_MOD + al256((size_t)DEPTH * NR * 3 * D_MODEL * 4);
constexpr size_t WS_HID2 = WS_ROPE + al256((size_t)DEC_SEQ * 32 * 8);
constexpr size_t WS_CKB = WS_HID2 + al256((size_t)DEPTH * (SEQ + DEC_SEQ) * FH * 4);
constexpr size_t WS_CVTB = WS_CKB + al256((size_t)DEC_BATCH * DEPTH * PAST_LEN * KV_W * 2);
constexpr size_t WS_KFL = WS_CVTB + al256((size_t)DEC_BATCH * DEPTH * PAST_LEN * KV_W * 2);
constexpr size_t KFL_BYTES = al256((size_t)2 * HYENA_W * 8192 * 8), KFC_BYTES = al256((size_t)2 * HYENA_W * 512 * 8);
constexpr size_t WS_KFC = WS_KFL + 2 * KFL_BYTES;
constexpr size_t WS_ZS = WS_KFC + 2 * KFC_BYTES;
constexpr size_t WS_XN = WS_ZS + (size_t)256 * 2 * 4096 * 8;
constexpr size_t WS_Q = WS_XN + al256((size_t)T * (D_MODEL > MIX_W ? D_MODEL : MIX_W) * 2);
constexpr size_t WS_KB = WS_Q + al256((size_t)T * ATTN_W * 2);
constexpr size_t WS_VB = WS_KB + al256((size_t)T * KV_W * 2);
constexpr size_t WS_GA = WS_VB + al256((size_t)T * KV_W * 2);
constexpr size_t WS_HYT = WS_GA + al256((size_t)T * ATTN_W * 2);
constexpr size_t WS_SC = WS_HYT + al256((size_t)4 * HYENA_W * T * 2);
constexpr size_t WS_END0 = WS_SC + al256((size_t)T * 4 * CONV_W * 2);
#ifndef DUP
#define DUP -1
#endif
constexpr size_t WS_ZT = DUP >= 0 ? WS_END0 : WS_HYT;
constexpr size_t WS_END = WS_END0 + (DUP >= 0 ? al256((size_t)HYENA_W * T * 2) : 0);

constexpr size_t OUT_YS = (size_t)TC * D_MODEL, OUT_NK = (size_t)T * D_MODEL, OUT_NV = OUT_NK + (size_t)BATCH * DEPTH * SEQ * KV_W,
                 OUT_TOTAL = OUT_NV + (size_t)BATCH * DEPTH * SEQ * KV_W;

constexpr int LDS_BYTES = 149504;

struct Params {
    const float* in[22];
    float* out;
    unsigned char* ws;
};
enum { I_XP = 0, I_XS, I_CK, I_CV, I_C, I_CCTX, I_NORMG, I_MODW, I_MODB, I_WIN, I_SINK, I_HYCW, I_FW1, I_FB1, I_FW2, I_FB2, I_FW3, I_FFREQ, I_HYD, I_SCW, I_WOUT, I_FINALG };

DI bf16 f2bf(float f) { unsigned u = __float_as_uint(f); u += 0x7fffu + ((u >> 16) & 1u); return (bf16)(u >> 16); }
DI float bf2f(bf16 h) { return __uint_as_float(((unsigned)h) << 16); }
#ifdef EMU
DI unsigned pack2(float a, float b) { return (unsigned)f2bf(a) | ((unsigned)f2bf(b) << 16); }
DI float silu_f(float x) { return x / (1.f + __expf(-x)); }
#else
DI unsigned pack2(float a, float b) { unsigned r; asm("v_cvt_pk_bf16_f32 %0, %1, %2" : "=v"(r) : "v"(a), "v"(b)); return r; }
DI float silu_f(float x) { return x * __builtin_amdgcn_rcpf(1.f + __builtin_amdgcn_exp2f(x * -1.4426950408889634f)); }
#endif
typedef float cpx __attribute__((ext_vector_type(2)));
DI cpx cmul(cpx a, cpx b) { cpx r = b * a.x; r += cpx{-b.y, b.x} * a.y; return r; }
#ifdef EMU
DI Params launder(const Params& p) { return p; }
#else
DI Params launder(const Params& p) { Params q = p; int z = 0; asm volatile("" : "+s"(z)); q.ws = p.ws + z; q.out = p.out + z; return q; }
#endif
DI int mod_row(int m) { return m < TC ? 0 : 1 + (m - TC) / DEC_SEQ; }


#ifndef EMU
#define XB_TMO      128
#define XB_XCNT(j)  (256  + 64 * (j))
#define XB_XSUB(j)  (1280 + 64 * (j))
#define XB_XGEN(j)  (2304 + 64 * (j))
#define XB_TOP      3328
#define XB_TOPGEN   3392
#define XCD_BAR_WORDS 3456
#define XB_SPIN_CAP (1u << 22)
DI unsigned xb_ld(unsigned* p) { return __hip_atomic_load(p, __ATOMIC_RELAXED, __HIP_MEMORY_SCOPE_AGENT); }
DI unsigned xb_add(unsigned* p, unsigned v) { return __hip_atomic_fetch_add(p, v, __ATOMIC_RELAXED, __HIP_MEMORY_SCOPE_AGENT); }
DI unsigned xb_xcc_id() { return (unsigned)__builtin_amdgcn_s_getreg((3 << 11) | 20) & 0xFu; }
#define XB_SPIN(cond, bar) do { unsigned _sp = 0; while (cond) { __builtin_amdgcn_s_sleep(1); \
    if ((++_sp & 255u) == 0u) { if (xb_ld(&(bar)[XB_TMO])) break; if (_sp > XB_SPIN_CAP) { atomicAdd(&(bar)[XB_TMO], 1u); break; } } } } while (0)
struct XcdBarrier { unsigned* bar; unsigned x; volatile LAS unsigned* st; };
DI XcdBarrier xcd_barrier_post(unsigned* bar, volatile LAS unsigned* st) {
    XcdBarrier b; b.bar = bar; b.x = xb_xcc_id(); b.st = st;
    if (TIDX() == 0) (void)xb_add(&bar[XB_XCNT(b.x)], 1u);
    return b;
}
DI void xcd_barrier_complete(unsigned* bar, unsigned x, unsigned& nloc, unsigned& nx) {
    const unsigned G = gridDim.x * gridDim.y * gridDim.z;
    unsigned sum, cnt, mine, sp = 0u;
    for (;;) {
        sum = 0u; cnt = 0u; mine = 0u;
#pragma unroll
        for (unsigned j = 0; j < 16; ++j) { const unsigned c = xb_ld(&bar[XB_XCNT(j)]); sum += c; cnt += (c > 0u) ? 1u : 0u; mine = (j == x) ? c : mine; }
        if (sum == G) break;
        __builtin_amdgcn_s_sleep(1);
        if ((++sp & 255u) == 0u) { if (xb_ld(&bar[XB_TMO])) break; if (sp > XB_SPIN_CAP) { atomicAdd(&bar[XB_TMO], 1u); break; } }
    }
    nloc = mine > 0u ? mine : 1u; nx = cnt > 0u ? cnt : 1u;
}
DI void xcd_barrier(const XcdBarrier& b) {
    asm volatile("s_waitcnt vmcnt(0)" ::: "memory");
    __syncthreads();
    if (TIDX() == 0) {
        unsigned* bar = b.bar;
        __builtin_amdgcn_s_waitcnt(0);
        unsigned nloc = b.st[0], nx = b.st[1];
        if (nloc == 0u) { xcd_barrier_complete(bar, b.x, nloc, nx); b.st[0] = nloc; b.st[1] = nx; }
        const unsigned old = xb_add(&bar[XB_XSUB(b.x)], 1u);
        const unsigned gen = old / nloc;
        if (old + 1u == (gen + 1u) * nloc) {
            __builtin_amdgcn_fence(__ATOMIC_RELEASE, "agent");
            asm volatile("s_waitcnt vmcnt(0)" ::: "memory");
            const unsigned og = xb_add(&bar[XB_TOP], 1u);
            const unsigned tg = og / nx;
            if (og + 1u == (tg + 1u) * nx) xb_add(&bar[XB_TOPGEN], 1u);
            else XB_SPIN(xb_ld(&bar[XB_TOPGEN]) == tg, bar);
            __builtin_amdgcn_fence(__ATOMIC_ACQUIRE, "agent");
            xb_add(&bar[XB_XGEN(b.x)], 1u);
            asm volatile("s_waitcnt vmcnt(0)" ::: "memory");
        } else {
            XB_SPIN(xb_ld(&bar[XB_XGEN(b.x)]) == gen, bar);
            __builtin_amdgcn_fence(__ATOMIC_ACQUIRE, "agent");
            asm volatile("s_waitcnt vmcnt(0)" ::: "memory");
        }
    }
    __syncthreads();
}
#endif

constexpr size_t WS_WQ = WS_BAR + 16384;
#ifdef EMU
DI int wq_fetch(unsigned* c) { const unsigned v = *c; *c = v + 1; return (int)v; }
#else
DI int wq_fetch(unsigned* c) { return (int)__hip_atomic_fetch_add(c, 1u, __ATOMIC_RELAXED, __HIP_MEMORY_SCOPE_AGENT); }
#endif
DI int wq_next(const Params& p, int qid, char* smem) {
    volatile int* slot = (volatile int*)(smem + LDS_BYTES - 32);
    __syncthreads();
    if (TIDX() == 0) *slot = wq_fetch((unsigned*)(p.ws + WS_WQ) + qid * 64);
    __syncthreads();
    return *slot;
}

DI void p0_transpose_item(const float* W, int K, int N, bf16* WT, int item, char* smem) {
    float* scr = (float*)smem;
    const int tid = TIDX(), nblk = N / 64, k0 = (item / nblk) * 64, n0 = (item % nblk) * 64;
#pragma unroll
    for (int i = 0; i < 8; ++i) { const int kk = (tid >> 6) + 8 * i, nn = tid & 63; scr[kk * 65 + nn] = W[(size_t)(k0 + kk) * N + n0 + nn]; }
    __syncthreads();
    const int n = tid >> 3, c = tid & 7;
    const float* s = scr + (8 * c) * 65 + n;
    u32x4 o; o.x = pack2(s[0], s[65]); o.y = pack2(s[2 * 65], s[3 * 65]); o.z = pack2(s[4 * 65], s[5 * 65]); o.w = pack2(s[6 * 65], s[7 * 65]);
    *(u32x4*)(WT + (size_t)(n0 + n) * K + k0 + 8 * c) = o;
    __syncthreads();
}
DI void p0_mod_item(const Params& p, int item, char* smem) {
    constexpr int NCH = 3 * D_MODEL / 64, KG = D_MODEL / 8;
    float* tab = (float*)smem;
    float* red = tab + NR * D_MODEL;
    const int tid = TIDX(), l = item / NCH, col = (item % NCH) * 64 + (tid & 63), kg = tid >> 6;
    for (int e = tid; e < NR * D_MODEL; e += NTHR) { const int r = e / D_MODEL, k = e % D_MODEL; const float cv = r == 0 ? p.in[I_CCTX][k] : p.in[I_C][(size_t)(r - 1) * D_MODEL + k]; tab[e] = silu_f(cv); }
    __syncthreads();
    float acc[NR];
#pragma unroll
    for (int r = 0; r < NR; ++r) acc[r] = 0.f;
    const float* w = p.in[I_MODW] + (size_t)l * D_MODEL * 3 * D_MODEL + (size_t)(kg * KG) * 3 * D_MODEL + col;
#pragma unroll 16
    for (int k = 0; k < KG; ++k) { const float wv = w[(size_t)k * 3 * D_MODEL];
#pragma unroll
        for (int r = 0; r < NR; ++r) acc[r] += tab[r * D_MODEL + kg * KG + k] * wv; }
#pragma unroll
    for (int r = 0; r < NR; ++r) red[(kg * NR + r) * 64 + (tid & 63)] = acc[r];
    __syncthreads();
    for (int e = tid; e < NR * 64; e += NTHR) {
        const int r = e >> 6, c = e & 63, cc = (item % NCH) * 64 + c;
        float s = p.in[I_MODB][(size_t)l * 3 * D_MODEL + cc];
#pragma unroll
        for (int g = 0; g < 8; ++g) s += red[(g * NR + r) * 64 + c];
        ((float*)(p.ws + WS_MOD))[((size_t)l * NR + r) * 3 * D_MODEL + cc] = s;
    }
    __syncthreads();
}
DI void p0_rope_item(const Params& p, int item) {
    const int e = item * NTHR + TIDX();
    if (e < DEC_SEQ * 32) {
        const int t = e >> 5, a = (e >> 4) & 1, f = e & 15;
        const float pos = (float)(a ? (t % GRID_W) : (t / GRID_W));
        const float inv = exp2f(-(float)f * (13.287712379549449f / 16.f));
        const float ang = pos * inv;
        f32x2 v; v.x = cosf(ang); v.y = sinf(ang);
        ((f32x2*)(p.ws + WS_ROPE))[e] = v;
    }
}
DI void p0_hid2_item(const Params& p, int item) {
    const int lane = TIDX() & 63, w = TIDX() >> 6;
    const int r0 = item * 64, l = r0 / (SEQ + DEC_SEQ), q0 = r0 % (SEQ + DEC_SEQ);
    const int L = q0 < SEQ ? SEQ : DEC_SEQ, tb = (q0 < SEQ ? q0 : q0 - SEQ) + w * 8;
    const float* w1 = p.in[I_FW1] + (size_t)l * FE * FH + lane; const float* w2 = p.in[I_FW2] + (size_t)l * FH * FH + lane;
    float wa[FE], wb[FH];
#pragma unroll
    for (int i = 0; i < FE; ++i) wa[i] = w1[i * FH];
#pragma unroll
    for (int i = 0; i < FH; ++i) wb[i] = w2[i * FH];
    const float fq = p.in[I_FFREQ][l * FH + lane], b1 = p.in[I_FB1][l * FH + lane], b2 = p.in[I_FB2][l * FH + lane];
    float* dst = (float*)(p.ws + WS_HID2) + (size_t)l * (SEQ + DEC_SEQ) * FH + (q0 < SEQ ? 0 : (size_t)SEQ * FH) + (size_t)lane * L;
#pragma unroll 1
    for (int r = 0; r < 8; ++r) {
        const int t = tb + r;
        float feat = 0.f;
        if (lane == 0) feat = (float)t / (float)(L - 1);
        else if (lane < FE) {
            const int b = (lane - 1) & 15;
            const float fr = 1e-4f + (float)b * ((15.f - 1e-4f) / 15.f);
            const float ang = (6.283185307179586f / (float)L) * (float)t;
            feat = lane <= 16 ? cosf(fr * ang) : -sinf(fr * ang);
        }
        float a1 = b1;
#pragma unroll
        for (int i = 0; i < FE; ++i) a1 += __shfl(feat, i) * wa[i];
        const float h1 = sinf(fq * a1);
        float a2 = b2;
#pragma unroll
        for (int i = 0; i < FH; ++i) a2 += __shfl(h1, i) * wb[i];
        dst[t] = sinf(fq * a2);
    }
}
DI void p0_cache_item(const Params& p, int item) {
    constexpr int NCHUNK = DEC_BATCH * DEPTH * PAST_LEN * KV_W / 8;
    int e = item * NTHR + TIDX();
    if (e < 2 * NCHUNK) {
        const bool isv = e >= NCHUNK; if (isv) e -= NCHUNK;
        const int c8 = e & 7, j = (e >> 3) % PAST_LEN, kvh = (e >> 3) / PAST_LEN % N_KV, bl = (e >> 3) / PAST_LEN / N_KV;
        const float* src = p.in[isv ? I_CV : I_CK] + ((size_t)(bl * PAST_LEN + j) * N_KV + kvh) * HD + c8 * 8;
        u32x4 o; o.x = pack2(src[0], src[1]); o.y = pack2(src[2], src[3]); o.z = pack2(src[4], src[5]); o.w = pack2(src[6], src[7]);
        *(u32x4*)((bf16*)(p.ws + (isv ? WS_CVTB : WS_CKB)) + (size_t)e * 8) = o;
    }
}

DI const float* x_row_src(const Params& p, int l, int m) {
    if (l == 0) return m < TC ? p.in[I_XP] + (size_t)m * D_MODEL : p.in[I_XS] + (size_t)(m - TC) * D_MODEL;
    return p.out + (size_t)m * D_MODEL;
}
DI void norm_rows2(const Params& p, int l, int m0, int lane) {
    constexpr int NV = (D_MODEL / 4 + 63) / 64;
    f32x4 v[2][NV]; float ss[2] = {0.f, 0.f};
#pragma unroll
    for (int r = 0; r < 2; ++r) {
        const float* xr = x_row_src(p, l, m0 + r);
#pragma unroll
        for (int i = 0; i < NV; ++i) { const int c4 = lane + 64 * i; v[r][i] = c4 < D_MODEL / 4 ? *(const f32x4*)(xr + 4 * c4) : (f32x4){0.f, 0.f, 0.f, 0.f}; }
    }
#pragma unroll
    for (int r = 0; r < 2; ++r)
#pragma unroll
        for (int i = 0; i < NV; ++i) ss[r] += v[r][i].x * v[r][i].x + v[r][i].y * v[r][i].y + v[r][i].z * v[r][i].z + v[r][i].w * v[r][i].w;
#pragma unroll
    for (int o = 1; o < 64; o <<= 1) { ss[0] += __shfl_xor(ss[0], o); ss[1] += __shfl_xor(ss[1], o); }
#pragma unroll
    for (int r = 0; r < 2; ++r) {
        const int m = m0 + r;
        const float rstd = rsqrtf(ss[r] * (1.f / D_MODEL) + 1e-6f);
        if (l < DEPTH) {
            const float* g = p.in[I_NORMG] + (size_t)l * D_MODEL;
            const float* mod = (const float*)(p.ws + WS_MOD) + ((size_t)l * NR + mod_row(m)) * 3 * D_MODEL;
            bf16* xn = (bf16*)(p.ws + WS_XN) + (size_t)m * D_MODEL;
#pragma unroll
            for (int i = 0; i < NV; ++i) {
                const int c4 = lane + 64 * i;
                if (c4 < D_MODEL / 4) {
                    const f32x4 x = v[r][i], gv = *(const f32x4*)(g + 4 * c4), sh = *(const f32x4*)(mod + 4 * c4), sc = *(const f32x4*)(mod + D_MODEL + 4 * c4);
                    u32x2 o; o.x = pack2(x.x * rstd * gv.x * (1.f + sc.x) + sh.x, x.y * rstd * gv.y * (1.f + sc.y) + sh.y);
                    o.y = pack2(x.z * rstd * gv.z * (1.f + sc.z) + sh.z, x.w * rstd * gv.w * (1.f + sc.w) + sh.w);
                    *(u32x2*)(xn + 4 * c4) = o;
                }
            }
        } else {
            const float* g = p.in[I_FINALG];
            float* yo = p.out + (size_t)m * D_MODEL;
#pragma unroll
            for (int i = 0; i < NV; ++i) {
                const int c4 = lane + 64 * i;
                if (c4 < D_MODEL / 4) {
                    const f32x4 x = v[r][i], gv = *(const f32x4*)(g + 4 * c4);
                    f32x4 o; o.x = x.x * rstd * gv.x; o.y = x.y * rstd * gv.y; o.z = x.z * rstd * gv.z; o.w = x.w * rstd * gv.w;
                    *(f32x4*)(yo + 4 * c4) = o;
                }
            }
        }
    }
}
DI void norm_item(const Params& p, int l, int item) {
    norm_rows2(p, l, item * 16 + 2 * (TIDX() >> 6), TIDX() & 63);
}

DI int swz128(int row, int c) { return row * 128 + ((c ^ ((row >> 1) & 7)) << 4); }
constexpr int BM = 256, BK = 64, HALFT = 128, HTB = HALFT * BK * 2, STAGE_BYTES = 8 * HTB;
static_assert(STAGE_BYTES <= LDS_BYTES - 32 && 2 * 8704 * 8 + 128 <= LDS_BYTES - 16, "lds");
DI int lds_byte(int r, int c) { const int st = (r >> 4) * 2 + (c >> 5), rr = r & 15, cc = c & 31, ob = rr * 64 + cc * 2; return st * 1024 + (ob ^ (((ob >> 9) & 1) << 5)); }
DI void stage_rc(int b, int& R, int& C) { const int st = b / 1024, sb = b % 1024, swz = sb ^ (((sb >> 9) & 1) << 5); R = (st >> 1) * 16 + swz / 64; C = (st & 1) * 32 + (swz % 64) / 2; }
DI int perm32(int rho) { const int n = rho >> 4, i = rho & 15; return 8 * (i >> 2) + 4 * n + (i & 3); }
struct Unit { int pm, pn, kind; };
DI void static_order(int L, int nM, int nN, int& pm, int& pn) {
    constexpr int NXCD = 8, WGM = 8;
    const int nwg = nM * nN;
    int wgid = L; { const int q = nwg / NXCD, r = nwg % NXCD, xcd = wgid % NXCD, off = wgid / NXCD; wgid = (xcd < r ? xcd * (q + 1) : r * (q + 1) + (xcd - r) * q) + off; }
    const int nig = WGM * nN, gid = wgid / nig, fm = gid * WGM, gsz = (nM - fm) < WGM ? (nM - fm) : WGM;
    pm = fm + ((wgid % nig) % gsz); pn = (wgid % nig) / gsz;
}
constexpr int NT_TOK = (IN_COLS - 4 * HYENA_W) / 256, NT_TOKA = C_HV / 256, NT_CH = 4 * HYENA_W / 256, NTM = T / 256;
constexpr int NU_TOK = NTM * NT_TOK, NU_CH = NT_CH * NTM, NU_OUT = NTM * (D_MODEL / 256);
struct GemmJob {
    Params p; int mode, l, K;
    DI bool next(int i, Unit& u) const {
        const int L = i * (int)gridDim.x + BIDX();
        if (mode == 0) {
            if (L < NU_TOK) { u.kind = 0; static_order(L, NTM, NT_TOK, u.pm, u.pn); return true; }
            if (L < NU_TOK + NU_CH) { u.kind = 1; static_order(L - NU_TOK, NT_CH, NTM, u.pm, u.pn); return true; }
            return false;
        }
        if (L < NU_OUT) { u.kind = 2; static_order(L, NTM, D_MODEL / 256, u.pm, u.pn); return true; }
        return false;
    }
    DI int tokcol(int pn) const { return pn < NT_TOKA ? pn * 256 : C_SB + (pn - NT_TOKA) * 256; }
    DI void ptrs(const Unit& u, const char*& a, const char*& b) const {
        const size_t rb = (size_t)K * 2;
        const char* xn = (const char*)(p.ws + WS_XN);
        if (u.kind == 0) { a = xn + (size_t)u.pm * 256 * rb; b = (const char*)(p.ws + WS_WINT) + ((size_t)l * IN_COLS + tokcol(u.pn)) * rb; }
        else if (u.kind == 1) { a = (const char*)(p.ws + WS_WINT) + ((size_t)l * IN_COLS + C_HV + u.pm * 256) * rb; b = xn + (size_t)u.pn * 256 * rb; }
        else { a = xn + (size_t)u.pm * 256 * rb; b = (const char*)(p.ws + WS_WOUTT) + ((size_t)l * D_MODEL + u.pn * 256) * rb; }
    }
    DI void epilogue(const f32x4 (&acc)[2][2][4][2], const Unit& u, int wr, int wc, int fr, int fq) const {
        if (u.kind == 0) {
            const bool ctx = u.pm * 256 < TC;
#pragma unroll 1
            for (int bj = 0; bj < 2; ++bj) {
                const int n0 = tokcol(u.pn) + 128 * bj, c0 = n0 + 32 * wc + 8 * fq;
                bf16* dst; int ld; bool sil = false; int special = 0;
                if (n0 < C_K) { dst = (bf16*)(p.ws + WS_Q) + c0; ld = ATTN_W; }
                else if (n0 < C_V) { dst = (bf16*)(p.ws + WS_KB) + (c0 - C_K); ld = KV_W; special = 1; }
                else if (n0 < C_GA) { dst = (bf16*)(p.ws + WS_VB) + (c0 - C_V); ld = KV_W; special = 2; }
                else if (n0 < C_HV) { dst = (bf16*)(p.ws + WS_GA) + (c0 - C_GA); ld = ATTN_W; sil = true; }
                else { dst = (bf16*)(p.ws + WS_SC) + (c0 - C_SB); ld = 4 * CONV_W; sil = n0 >= C_GC; }
#pragma unroll
                for (int ai = 0; ai < 2; ++ai)
#pragma unroll
                    for (int m = 0; m < 4; ++m) {
                        const int row = u.pm * 256 + 64 * wr + fr + OPQ(128 * ai + 16 * m);
                        f32x4 v0 = bj ? acc[ai][1][m][0] : acc[ai][0][m][0], v1 = bj ? acc[ai][1][m][1] : acc[ai][0][m][1];
                        if (sil) { v0.x = silu_f(v0.x); v0.y = silu_f(v0.y); v0.z = silu_f(v0.z); v0.w = silu_f(v0.w); v1.x = silu_f(v1.x); v1.y = silu_f(v1.y); v1.z = silu_f(v1.z); v1.w = silu_f(v1.w); }
                        if (special && ctx) {
                            float* o = p.out + (special == 1 ? OUT_NK : OUT_NV) + ((size_t)((row / SEQ) * DEPTH + l) * SEQ + (row % SEQ)) * KV_W + (c0 - (special == 1 ? C_K : C_V));
                            *(f32x4*)o = v0; *(f32x4*)(o + 4) = v1;
                        }
                        if (special == 1 && !ctx) {
                            const int pos = (row - TC) % DEC_SEQ, a = wc & 1, pp = fq >> 1, f0 = 8 * (fq & 1);
                            const f32x4* rp = (const f32x4*)((const f32x2*)(p.ws + WS_ROPE) + (pos * 2 + a) * 16 + f0);
                            const f32x4 r0 = rp[0], r1 = rp[1], r2 = rp[2], r3 = rp[3];
                            f32x4 o0, o1;
                            o0.x = __shfl_xor(v0.x, 32); o0.y = __shfl_xor(v0.y, 32); o0.z = __shfl_xor(v0.z, 32); o0.w = __shfl_xor(v0.w, 32);
                            o1.x = __shfl_xor(v1.x, 32); o1.y = __shfl_xor(v1.y, 32); o1.z = __shfl_xor(v1.z, 32); o1.w = __shfl_xor(v1.w, 32);
                            const float sg = pp ? 1.f : -1.f;
                            v0.x = v0.x * r0.x + sg * o0.x * r0.y; v0.y = v0.y * r0.z + sg * o0.y * r0.w; v0.z = v0.z * r1.x + sg * o0.z * r1.y; v0.w = v0.w * r1.z + sg * o0.w * r1.w;
                            v1.x = v1.x * r2.x + sg * o1.x * r2.y; v1.y = v1.y * r2.z + sg * o1.y * r2.w; v1.z = v1.z * r3.x + sg * o1.z * r3.y; v1.w = v1.w * r3.z + sg * o1.w * r3.w;
                        }
                        u32x4 w; w.x = pack2(v0.x, v0.y); w.y = pack2(v0.z, v0.w); w.z = pack2(v1.x, v1.y); w.w = pack2(v1.z, v1.w);
                        *(u32x4*)(dst + (size_t)row * ld) = w;
                        CBAR();
                    }
            }
        } else if (u.kind == 1) {
            bf16* HYT = (bf16*)(p.ws + WS_HYT);
#pragma unroll
            for (int ai = 0; ai < 2; ++ai) {
                const bool sil = u.pm * 256 + 128 * ai >= 3 * HYENA_W;
#pragma unroll
                for (int m = 0; m < 4; ++m) {
                    const int ch = u.pm * 256 + 64 * wr + fr + OPQ(128 * ai + 16 * m);
#pragma unroll
                    for (int bj = 0; bj < 2; ++bj) {
                        f32x4 v0 = acc[ai][bj][m][0], v1 = acc[ai][bj][m][1];
                        if (sil) { v0.x = silu_f(v0.x); v0.y = silu_f(v0.y); v0.z = silu_f(v0.z); v0.w = silu_f(v0.w); v1.x = silu_f(v1.x); v1.y = silu_f(v1.y); v1.z = silu_f(v1.z); v1.w = silu_f(v1.w); }
                        u32x4 w; w.x = pack2(v0.x, v0.y); w.y = pack2(v0.z, v0.w); w.z = pack2(v1.x, v1.y); w.w = pack2(v1.z, v1.w);
                        *(u32x4*)(HYT + (size_t)ch * T + u.pn * 256 + 128 * bj + 32 * wc + 8 * fq) = w;
                        CBAR();
                    }
                }
            }
        } else {
            const float* gate = (const float*)(p.ws + WS_MOD) + ((size_t)l * NR + mod_row(u.pm * 256)) * 3 * D_MODEL + 2 * D_MODEL;
#pragma unroll
            for (int bj = 0; bj < 2; ++bj) {
                const int n = u.pn * 256 + 128 * bj + 32 * wc + 8 * fq;
                const f32x4 g0 = *(const f32x4*)(gate + n), g1 = *(const f32x4*)(gate + n + 4);
#pragma unroll
                for (int ai = 0; ai < 2; ++ai)
#pragma unroll
                    for (int m = 0; m < 4; ++m) {
                        const int row = u.pm * 256 + 64 * wr + fr + OPQ(128 * ai + 16 * m);
                        const float* xs = x_row_src(p, l, row) + n;
                        const f32x4 x0 = *(const f32x4*)xs, x1 = *(const f32x4*)(xs + 4);
                        float* o = p.out + (size_t)row * D_MODEL + n;
                        *(f32x4*)o = x0 + g0 * acc[ai][bj][m][0]; *(f32x4*)(o + 4) = x1 + g1 * acc[ai][bj][m][1];
                        CBAR();
                    }
            }
        }
    }
};

#ifdef EMU
typedef unsigned char* ldsptr_t;
#else
typedef LAS unsigned char* ldsptr_t;
#endif
DI void gemm_phase(ldsptr_t lds, const GemmJob& S) {
    const int tid = TIDX(), wid = RFL(tid >> 6), lane = tid & 63, wr = wid >> 2, wc = wid & 3, fr = lane & 15, fq = lane >> 4;
    const int K = S.K, nt = K / BK;
    unsigned voffA[2], voffB[2];
#pragma unroll
    for (int i = 0; i < 2; ++i) { int R, C; stage_rc(tid * 16 + i * 8192, R, C); const int Rb = (R & ~31) + perm32(R & 31);
        voffA[i] = (unsigned)(R * K + C) * 2u; voffB[i] = (unsigned)(Rb * K + C) * 2u; }
    const size_t kstep = (size_t)(BK * 2);
    const size_t hstep = (size_t)HALFT * K * 2;
    const unsigned ldsw = (unsigned)wid * 1024u;
    const int aoff = lds_byte(wr * 64 + fr, fq * 8), boff = lds_byte(wc * 32 + fr, fq * 8);
#define PG8_SA(b, h) (((b) * 2 + (h)) * HTB)
#define PG8_SB(b, h) ((4 + (b) * 2 + (h)) * HTB)
#define PG8_STAGE(bufoff, gbase, voff) do { _Pragma("unroll") for (int _i = 0; _i < 2; ++_i) GLDS16((const char*)(gbase) + (voff)[_i], lds + (bufoff) + ldsw + _i * 8192); } while (0)
#define PG8_LDA(dst, b, h) do { _Pragma("unroll") for (int m = 0; m < 4; ++m) _Pragma("unroll") for (int k = 0; k < 2; ++k) dst[m][k] = *(const LAS bf16x8*)(lds + PG8_SA(b, h) + aoff + m * 2048 + k * 1024); } while (0)
#define PG8_LDB(dst, b, h) do { _Pragma("unroll") for (int n = 0; n < 2; ++n) _Pragma("unroll") for (int k = 0; k < 2; ++k) dst[n][k] = *(const LAS bf16x8*)(lds + PG8_SB(b, h) + boff + n * 2048 + k * 1024); } while (0)
#define PG8_MMA(ai, bj, At, Bt) do { SETPRIO(1); _Pragma("unroll") for (int m = 0; m < 4; ++m) _Pragma("unroll") for (int n = 0; n < 2; ++n) _Pragma("unroll") for (int k = 0; k < 2; ++k) \
        acc[ai][bj][m][n] = MFMA16(Bt[n][k], At[m][k], acc[ai][bj][m][n]); SETPRIO(0); } while (0)
    Unit cur, nxt; int ui = 0;
    if (!S.next(0, cur)) return;
    f32x4 acc[2][2][4][2];
#pragma unroll
    for (int a = 0; a < 2; ++a)
#pragma unroll
        for (int b = 0; b < 2; ++b)
#pragma unroll
            for (int m = 0; m < 4; ++m)
#pragma unroll
                for (int n = 0; n < 2; ++n) acc[a][b][m][n] = (f32x4){0.f, 0.f, 0.f, 0.f};
    bf16x8 At[4][2], B0[2][2], B1[2][2];
    const char* cA; const char* cB; S.ptrs(cur, cA, cB);
    PG8_STAGE(PG8_SB(0, 0), cB, voffB); PG8_STAGE(PG8_SA(0, 0), cA, voffA); PG8_STAGE(PG8_SB(0, 1), cB + hstep, voffB); PG8_STAGE(PG8_SA(0, 1), cA + hstep, voffA);
    if (wr == 1) S_BARRIER();
    WAIT_V(4); S_BARRIER();
    PG8_STAGE(PG8_SB(1, 0), cB + kstep, voffB); PG8_STAGE(PG8_SA(1, 0), cA + kstep, voffA); PG8_STAGE(PG8_SB(1, 1), cB + hstep + kstep, voffB);
    WAIT_V(6); S_BARRIER();
    for (;;) {
        const bool has_next = S.next(ui + 1, nxt);
        const char* nA = cA; const char* nB = cB; if (has_next) S.ptrs(nxt, nA, nB);
        PRB_BEGIN_NS(3) PRB_BEGIN_NS(5)
        for (int t = 0; t < nt; t += 2) {
            const bool last = (t == nt - 2);
            const char* a1 = cA + (size_t)(t + 1) * kstep;
            const char* a2 = last ? nA : cA + (size_t)(t + 2) * kstep; const char* b2 = last ? nB : cB + (size_t)(t + 2) * kstep;
            const char* a3 = a2 + kstep; const char* b3 = b2 + kstep;
            PG8_LDB(B0, 0, 0); SCHED_BAR(); PG8_LDA(At, 0, 0); PG8_STAGE(PG8_SA(1, 1), a1 + hstep, voffA);
            WAIT_L(8); S_BARRIER(); WAIT_L(0); PG8_MMA(0, 0, At, B0); S_BARRIER(); SCHED_BAR();
            PG8_LDB(B1, 0, 1); PG8_STAGE(PG8_SB(0, 0), b2, voffB);
            S_BARRIER(); WAIT_L(0); PG8_MMA(0, 1, At, B1); S_BARRIER();
            PG8_LDA(At, 0, 1); PG8_STAGE(PG8_SA(0, 0), a2, voffA);
            S_BARRIER(); WAIT_L(0); PG8_MMA(1, 0, At, B0); S_BARRIER(); SCHED_BAR();
            PG8_STAGE(PG8_SB(0, 1), b2 + hstep, voffB);
            WAIT_V(6); S_BARRIER(); PG8_MMA(1, 1, At, B1); S_BARRIER();
            PG8_LDB(B0, 1, 0); SCHED_BAR(); PG8_LDA(At, 1, 0); PG8_STAGE(PG8_SA(0, 1), a2 + hstep, voffA);
            WAIT_L(8); S_BARRIER(); WAIT_L(0); PG8_MMA(0, 0, At, B0); S_BARRIER(); SCHED_BAR();
            PG8_LDB(B1, 1, 1); PG8_STAGE(PG8_SB(1, 0), b3, voffB);
            S_BARRIER(); WAIT_L(0); PG8_MMA(0, 1, At, B1); S_BARRIER();
            PG8_LDA(At, 1, 1); PG8_STAGE(PG8_SA(1, 0), a3, voffA);
            S_BARRIER(); WAIT_L(0); PG8_MMA(1, 0, At, B0); S_BARRIER(); SCHED_BAR();
            PG8_STAGE(PG8_SB(1, 1), b3 + hstep, voffB);
            WAIT_V(6); S_BARRIER(); PG8_MMA(1, 1, At, B1); S_BARRIER();
        }
        if (S.mode == 0) { PRB_END_NS(3, (char*)lds) } else { PRB_END_NS(5, (char*)lds) }
        PRB_BEGIN_NS(4) PRB_BEGIN_NS(6)
        S.epilogue(acc, cur, wr, wc, fr, fq);
        if (S.mode == 0) { PRB_END_NS(4, (char*)lds) } else { PRB_END_NS(6, (char*)lds) }
        if (!has_next) break;
#pragma unroll
        for (int a = 0; a < 2; ++a)
#pragma unroll
            for (int b = 0; b < 2; ++b)
#pragma unroll
                for (int m = 0; m < 4; ++m)
#pragma unroll
                    for (int n = 0; n < 2; ++n) acc[a][b][m][n] = (f32x4){0.f, 0.f, 0.f, 0.f};
        cur = nxt; cA = nA; cB = nB; ++ui;
    }
    WAIT_V(0);
    if (wr == 0) S_BARRIER();
    S_BARRIER();
#undef PG8_SA
#undef PG8_SB
#undef PG8_STAGE
#undef PG8_LDA
#undef PG8_LDB
#undef PG8_MMA
}

DI void unpack8(const u32x4 v, float (&f)[8]) {
    f[0] = __uint_as_float(v.x << 16); f[1] = __uint_as_float(v.x & 0xffff0000u); f[2] = __uint_as_float(v.y << 16); f[3] = __uint_as_float(v.y & 0xffff0000u);
    f[4] = __uint_as_float(v.z << 16); f[5] = __uint_as_float(v.z & 0xffff0000u); f[6] = __uint_as_float(v.w << 16); f[7] = __uint_as_float(v.w & 0xffff0000u);
}
DI int PADX(int i) { return i + (i >> 4); }
constexpr int FB_BANK = 8704;
template <int SIGN> DI void dft4(cpx& a0, cpx& a1, cpx& a2, cpx& a3) {
    const cpx t0 = a0 + a2, t1 = a0 - a2, t2 = a1 + a3, t3 = a1 - a3;
    const cpx t3r = SIGN < 0 ? cpx{t3.y, -t3.x} : cpx{-t3.y, t3.x};
    a0 = t0 + t2; a1 = t1 + t3r; a2 = t0 - t2; a3 = t1 - t3r;
}
template <int SIGN> DI void dft16(cpx (&v)[16]) {
#pragma unroll
    for (int n2 = 0; n2 < 4; ++n2) dft4<SIGN>(v[n2], v[4 + n2], v[8 + n2], v[12 + n2]);
    constexpr float C1 = 0.92387953251128674f, S1 = 0.38268343236508977f, R = 0.70710678118654752f, SG = (float)SIGN;
    v[5] = cmul(v[5], cpx{C1, SG * S1});  v[6] = cmul(v[6], cpx{R, SG * R});     v[7] = cmul(v[7], cpx{S1, SG * C1});
    v[9] = cmul(v[9], cpx{R, SG * R});    v[10] = cmul(v[10], cpx{0.f, SG});     v[11] = cmul(v[11], cpx{-R, SG * R});
    v[13] = cmul(v[13], cpx{S1, SG * C1}); v[14] = cmul(v[14], cpx{-R, SG * R}); v[15] = cmul(v[15], cpx{-C1, -SG * S1});
#pragma unroll
    for (int k1 = 0; k1 < 4; ++k1) dft4<SIGN>(v[4 * k1], v[4 * k1 + 1], v[4 * k1 + 2], v[4 * k1 + 3]);
}
template <int SIGN> DI void fft_pass16x2(cpx* fa, cpx* fb, int j, int Ns, int N16) {
    cpx va[16], vb[16];
#pragma unroll
    for (int r = 0; r < 16; ++r) { const int ix = PADX(j + N16 * r); va[r] = fa[ix]; vb[r] = fb[ix]; }
    const int k = j & (Ns - 1);
    if (Ns > 1) {
        float sn, cs; sincospif((float)(SIGN * 2 * k) / (float)(16 * Ns), &sn, &cs);
        cpx w[16];
        w[1] = cpx{cs, sn}; w[2] = cmul(w[1], w[1]); w[3] = cmul(w[2], w[1]); w[4] = cmul(w[2], w[2]); w[5] = cmul(w[4], w[1]); w[6] = cmul(w[4], w[2]); w[7] = cmul(w[4], w[3]); w[8] = cmul(w[4], w[4]);
#pragma unroll
        for (int r = 9; r < 16; ++r) w[r] = cmul(w[8], w[r - 8]);
#pragma unroll
        for (int r = 1; r < 16; ++r) { va[r] = cmul(va[r], w[r]); vb[r] = cmul(vb[r], w[r]); }
    }
    dft16<SIGN>(va); dft16<SIGN>(vb);
    __syncthreads();
    const int base = (j - k) * 16 + k;
#pragma unroll
    for (int kk = 0; kk < 16; ++kk) { const int ix = PADX(base + kk * Ns); fa[ix] = va[4 * (kk & 3) + (kk >> 2)]; fb[ix] = vb[4 * (kk & 3) + (kk >> 2)]; }
    __syncthreads();
}
template <int SIGN> DI void fft_passes(cpx* fa, cpx* fb, int j, int Ns0, int np16, int N16) {
#pragma unroll 1
    for (int ps = 0, Ns = Ns0; ps < np16; ++ps, Ns <<= 4) fft_pass16x2<SIGN>(fa, fb, j, Ns, N16);
}
DI cpx conv_out(const cpx* fb, int t, int L) {
    const cpx a = fb[PADX(t)], b = fb[PADX(t + L)];
    float sn, cs; sincospif((float)t / (float)L, &sn, &cs);
    const cpx wb = cmul(cpx{cs, sn}, b);
    const float rn = 0.5f / (float)L;
    return (a + wb) * rn;
}
DI float conv3(const bf16* ptr, int t, int L, float w0, float w1, float w2) {
    const float a = t > 0 ? bf2f(ptr[t - 1]) : 0.f, b = bf2f(ptr[t]), c = t < L - 1 ? bf2f(ptr[t + 1]) : 0.f;
    return a * w0 + b * w1 + c * w2;
}
DI void filter_item(const Params& p, int l, int item, char* smem, bool lat) {
    const int np16 = lat ? 3 : 2, N16 = lat ? 512 : 32, N = 16 * N16, L = N / 2;
    const int tid = TIDX(), sub = tid / N16, j = tid % N16;
    const int c = lat ? item : item * 16 + sub;
    cpx* fa = (cpx*)smem + sub * (N + N / 16); cpx* fb = fa + FB_BANK;
    float* red = (float*)(smem + 2 * FB_BANK * 8);
    const float* hid = (const float*)(p.ws + WS_HID2) + ((size_t)l * (SEQ + DEC_SEQ) + (lat ? SEQ : 0)) * FH + 8 * j;
    const float* w3 = p.in[I_FW3] + (size_t)l * FH * 4 * HYENA_W + c;
    float f0[8], f1[8], b0[8], b1[8];
#pragma unroll
    for (int i = 0; i < 8; ++i) { f0[i] = 0.f; f1[i] = 0.f; b0[i] = 0.f; b1[i] = 0.f; }
#pragma unroll 8
    for (int q = 0; q < FH; ++q) {
        const float* wq = w3 + (size_t)q * 4 * HYENA_W;
        const float wf0 = wq[0], wf1 = wq[HYENA_W], wb0 = wq[2 * HYENA_W], wb1 = wq[3 * HYENA_W];
        const f32x4 h0 = *(const f32x4*)(hid + (size_t)q * L), h1 = *(const f32x4*)(hid + (size_t)q * L + 4);
        const float hv[8] = {h0.x, h0.y, h0.z, h0.w, h1.x, h1.y, h1.z, h1.w};
#pragma unroll
        for (int i = 0; i < 8; ++i) { f0[i] += hv[i] * wf0; f1[i] += hv[i] * wf1; b0[i] += hv[i] * wb0; b1[i] += hv[i] * wb1; }
    }
    const float min_decay = -4.605170185988091f / 1.5f, max_decay = -4.605170185988091f / 0.3f;
    const float delta = fabsf(min_decay + (max_decay - min_decay) * (float)c / (float)(HYENA_W - 1));
    float as0 = 0.f, as1 = 0.f;
#pragma unroll
    for (int i = 0; i < 8; ++i) {
        const int t = 8 * j + i;
        const float dec = __expf(-((float)t / (float)(L - 1)) * delta);
        const float vf0 = f0[i] * dec, vf1 = f1[i] * dec, vb0 = b0[i] * dec, vb1 = b1[i] * dec;
        fa[PADX(t)] = cpx{vf0, 0.f}; fb[PADX(t)] = cpx{vf1, 0.f};
        if (t == 0) { fa[PADX(L)] = cpx{0.f, 0.f}; fb[PADX(L)] = cpx{0.f, 0.f}; } else { fa[PADX(N - t)] = cpx{vb0, 0.f}; fb[PADX(N - t)] = cpx{vb1, 0.f}; }
        as0 += fabsf(vf0) + (t == 0 ? 0.f : fabsf(vb0)); as1 += fabsf(vf1) + (t == 0 ? 0.f : fabsf(vb1));
    }
#pragma unroll
    for (int s = 1; s < 32; s <<= 1) { as0 += __shfl_xor(as0, s); as1 += __shfl_xor(as1, s); }
    if (lat) {
        as0 += __shfl_xor(as0, 32); as1 += __shfl_xor(as1, 32);
        if ((tid & 63) == 0) { red[tid >> 6] = as0; red[8 + (tid >> 6)] = as1; }
    }
    __syncthreads();
    if (lat) { as0 = 0.f; as1 = 0.f;
#pragma unroll
        for (int q = 0; q < 8; ++q) { as0 += red[q]; as1 += red[8 + q]; } }
    const float rn0 = 1.f / as0, rn1 = 1.f / as1;
    {
        cpx a0[8], a1[8], c0[8], c1[8];
#pragma unroll
        for (int i = 0; i < 8; ++i) { const int t = j + N16 * i; a0[i] = fa[PADX(t)]; c0[i] = fa[PADX(t + L)]; a1[i] = fb[PADX(t)]; c1[i] = fb[PADX(t + L)]; }
        __syncthreads();
#pragma unroll
        for (int i = 0; i < 8; ++i) { const int t = j + N16 * i; fa[PADX(2 * t)] = a0[i] + c0[i]; fa[PADX(2 * t + 1)] = a0[i] - c0[i]; fb[PADX(2 * t)] = a1[i] + c1[i]; fb[PADX(2 * t + 1)] = a1[i] - c1[i]; }
        __syncthreads();
    }
    fft_passes<-1>(fa, fb, j, 2, np16, N16);
    cpx* kf0 = (cpx*)(p.ws + (lat ? WS_KFL + (l & 1) * KFL_BYTES : WS_KFC + (l & 1) * KFC_BYTES)) + (size_t)c * N; cpx* kf1 = kf0 + (size_t)HYENA_W * N;
#pragma unroll 4
    for (int i = 0; i < 16; ++i) { const int f = j + N16 * i; kf0[f] = fa[PADX(f)] * rn0; kf1[f] = fb[PADX(f)] * rn1; }
    __syncthreads();
}

DI void conv3x8(const bf16* row, int t0, int L, float w0, float w1, float w2, float (&o)[8]) {
    float v[8]; unpack8(*(const u32x4*)(row + t0), v);
    const bf16 pr = row[t0 > 0 ? t0 - 1 : 0], nr = row[t0 + 8 < L ? t0 + 8 : t0];
    const float pv = t0 > 0 ? bf2f(pr) : 0.f, nx = t0 + 8 < L ? bf2f(nr) : 0.f;
    o[0] = pv * w0 + v[0] * w1 + v[1] * w2;
#pragma unroll
    for (int i = 1; i < 7; ++i) o[i] = v[i - 1] * w0 + v[i] * w1 + v[i + 1] * w2;
    o[7] = v[6] * w0 + v[7] * w1 + nx * w2;
}
DI void hyena_item(const Params& p, int l, int item, char* smem, bool lat) {
    const int np16 = lat ? 3 : 2, N16 = lat ? 512 : 32, N = 16 * N16, L = N / 2;
    const int NPAIR = lat ? DEC_BATCH / 2 : BATCH / 2;
    const int tid = TIDX(), sub = tid / N16, j = tid % N16, t0 = 8 * j;
    constexpr int IPC = (DEC_BATCH / 2 + 1) / 2;
    int cA, cB, prA, prB; bool actA, actB;
    if (lat) { cA = cB = item / IPC; prA = 2 * (item % IPC); prB = prA + 1; actA = true; actB = prB < NPAIR; }
    else { cA = 2 * item; cB = cA + 1; prA = prB = sub; actA = actB = sub < NPAIR; }
    const int tokA = (lat ? TC : 0) + (actA ? 2 * prA : 0) * L, tokB = (lat ? TC : 0) + (actB ? 2 * prB : 0) * L;
    cpx* fa = (cpx*)smem + sub * (N + N / 16); cpx* fb = fa + FB_BANK;
    const bf16* HYT = (const bf16*)(p.ws + WS_HYT);
    const float* cw = p.in[I_HYCW] + (size_t)l * 3 * 3 * HYENA_W;
    const cpx* kfbase = (const cpx*)(p.ws + (lat ? WS_KFL + (l & 1) * KFL_BYTES : WS_KFC + (l & 1) * KFC_BYTES));
    cpx* zsA = (cpx*)(p.ws + WS_ZS) + (size_t)BIDX() * 2 * 4096 + sub * L + t0; cpx* zsB = zsA + 4096;
    bf16* zoutA = (bf16*)(p.ws + WS_ZT) + (size_t)cA * T; bf16* zoutB = (bf16*)(p.ws + WS_ZT) + (size_t)cB * T;
    {
        const bf16* hvA = HYT + (size_t)cA * T + tokA;
        float a0[8], a1[8];
        conv3x8(hvA, t0, L, cw[cA], cw[3 * HYENA_W + cA], cw[6 * HYENA_W + cA], a0); conv3x8(hvA + L, t0, L, cw[cA], cw[3 * HYENA_W + cA], cw[6 * HYENA_W + cA], a1);
#pragma unroll
        for (int i = 0; i < 8; ++i) {
            const cpx ua = actA ? cpx{a0[i], a1[i]} : cpx{0.f, 0.f};
            zsA[i] = ua;
            const int ix = PADX(2 * (t0 + i));
            fa[ix] = ua; fa[ix + 1] = ua;
        }
    }
    SCHED_BAR();
    {
        const bf16* hvB = HYT + (size_t)cB * T + tokB;
        float b0[8], b1[8];
        conv3x8(hvB, t0, L, cw[cB], cw[3 * HYENA_W + cB], cw[6 * HYENA_W + cB], b0); conv3x8(hvB + L, t0, L, cw[cB], cw[3 * HYENA_W + cB], cw[6 * HYENA_W + cB], b1);
#pragma unroll
        for (int i = 0; i < 8; ++i) {
            const cpx ub = actB ? cpx{b0[i], b1[i]} : cpx{0.f, 0.f};
            zsB[i] = ub;
            const int ix = PADX(2 * (t0 + i));
            fb[ix] = ub; fb[ix + 1] = ub;
        }
    }
    __syncthreads();
#pragma unroll 1
    for (int o = 0; o < 2; ++o) {
        fft_passes<-1>(fa, fb, j, 2, np16, N16);
        const int t0o = OPQ(t0), tokAo = OPQ(tokA), tokBo = OPQ(tokB);
        cpx* zsAo = (cpx*)(p.ws + WS_ZS) + (size_t)BIDX() * 2 * 4096 + sub * L + t0o; cpx* zsBo = zsAo + 4096;
        {
            const cpx* kfA = kfbase + (size_t)(o * HYENA_W + cA) * N + j; const cpx* kfB = kfbase + (size_t)(o * HYENA_W + cB) * N + j;
#pragma unroll 8
            for (int i = 0; i < 16; ++i) { const int ix = PADX(j + N16 * i); const cpx ka = kfA[N16 * i], kb = lat ? ka : kfB[N16 * i]; fa[ix] = cmul(fa[ix], ka); fb[ix] = cmul(fb[ix], kb); }
        }
        __syncthreads();
        fft_passes<1>(fa, fb, j, 1, np16, N16);
        const int wo = (1 + o) * HYENA_W;
        float sn, cs; sincospif((float)t0o / (float)L, &sn, &cs); const cpx wbase = cpx{cs, sn};
        sincospif(1.f / (float)L, &sn, &cs); const cpx wstep = cpx{cs, sn};
        const float rn = 0.5f / (float)L;
        cpx za[8], zb[8];
        {
            float x0[8], x1[8];
            conv3x8(HYT + (size_t)(wo + cA) * T + tokAo, t0o, L, cw[wo + cA], cw[3 * HYENA_W + wo + cA], cw[6 * HYENA_W + wo + cA], x0);
            conv3x8(HYT + (size_t)(wo + cA) * T + tokAo + L, t0o, L, cw[wo + cA], cw[3 * HYENA_W + wo + cA], cw[6 * HYENA_W + wo + cA], x1);
            const float dd = p.in[I_HYD][(size_t)l * 2 * HYENA_W + o * HYENA_W + cA];
            cpx w = wbase;
#pragma unroll
            for (int i = 0; i < 8; ++i) {
                const cpx y = (fa[PADX(t0o + i)] + cmul(w, fa[PADX(t0o + i + L)])) * rn; w = cmul(w, wstep);
                const cpx u = zsAo[i];
                za[i] = cpx{x0[i] * (y.x + dd * u.x), x1[i] * (y.y + dd * u.y)};
            }
        }
        SCHED_BAR();
        {
            float x0[8], x1[8];
            conv3x8(HYT + (size_t)(wo + cB) * T + tokBo, t0o, L, cw[wo + cB], cw[3 * HYENA_W + wo + cB], cw[6 * HYENA_W + wo + cB], x0);
            conv3x8(HYT + (size_t)(wo + cB) * T + tokBo + L, t0o, L, cw[wo + cB], cw[3 * HYENA_W + wo + cB], cw[6 * HYENA_W + wo + cB], x1);
            const float dd = p.in[I_HYD][(size_t)l * 2 * HYENA_W + o * HYENA_W + cB];
            cpx w = wbase;
#pragma unroll
            for (int i = 0; i < 8; ++i) {
                const cpx y = (fb[PADX(t0o + i)] + cmul(w, fb[PADX(t0o + i + L)])) * rn; w = cmul(w, wstep);
                const cpx u = zsBo[i];
                zb[i] = cpx{x0[i] * (y.x + dd * u.x), x1[i] * (y.y + dd * u.y)};
            }
        }
        __syncthreads();
        if (o == 0) {
#pragma unroll
            for (int i = 0; i < 8; ++i) {
                const cpx ua = actA ? za[i] : cpx{0.f, 0.f}, ub = actB ? zb[i] : cpx{0.f, 0.f};
                zsAo[i] = ua; zsBo[i] = ub;
                const int ix = PADX(2 * (t0o + i));
                fa[ix] = ua; fa[ix + 1] = ua; fb[ix] = ub; fb[ix + 1] = ub;
            }
            __syncthreads();
        } else {
            const bf16* ghA = HYT + (size_t)(3 * HYENA_W + cA) * T + tokAo + t0o; const bf16* ghB = HYT + (size_t)(3 * HYENA_W + cB) * T + tokBo + t0o;
            float g[8]; u32x4 ov;
            if (actA) {
                unpack8(*(const u32x4*)ghA, g);
                ov.x = pack2(za[0].x * g[0], za[1].x * g[1]); ov.y = pack2(za[2].x * g[2], za[3].x * g[3]); ov.z = pack2(za[4].x * g[4], za[5].x * g[5]); ov.w = pack2(za[6].x * g[6], za[7].x * g[7]);
                *(u32x4*)(zoutA + tokAo + t0o) = ov;
                unpack8(*(const u32x4*)(ghA + L), g);
                ov.x = pack2(za[0].y * g[0], za[1].y * g[1]); ov.y = pack2(za[2].y * g[2], za[3].y * g[3]); ov.z = pack2(za[4].y * g[4], za[5].y * g[5]); ov.w = pack2(za[6].y * g[6], za[7].y * g[7]);
                *(u32x4*)(zoutA + tokAo + L + t0o) = ov;
            }
            if (actB) {
                unpack8(*(const u32x4*)ghB, g);
                ov.x = pack2(zb[0].x * g[0], zb[1].x * g[1]); ov.y = pack2(zb[2].x * g[2], zb[3].x * g[3]); ov.z = pack2(zb[4].x * g[4], zb[5].x * g[5]); ov.w = pack2(zb[6].x * g[6], zb[7].x * g[7]);
                *(u32x4*)(zoutB + tokBo + t0o) = ov;
                unpack8(*(const u32x4*)(ghB + L), g);
                ov.x = pack2(zb[0].y * g[0], zb[1].y * g[1]); ov.y = pack2(zb[2].y * g[2], zb[3].y * g[3]); ov.z = pack2(zb[4].y * g[4], zb[5].y * g[5]); ov.w = pack2(zb[6].y * g[6], zb[7].y * g[7]);
                *(u32x4*)(zoutB + tokBo + L + t0o) = ov;
            }
        }
    }
}

DI void hytr_item(const Params& p, int item, char* smem) {
    const int tid = TIDX(), tok0 = item * 64;
    const bf16* HYT = (const bf16*)(p.ws + WS_ZT); bf16* mixed = (bf16*)(p.ws + WS_XN);
    unsigned* tile = (unsigned*)smem;
    for (int id = tid; id < HYENA_W * 8; id += NTHR) {
        const int ch = id >> 3, ck = id & 7, x = (ch >> 3) & 31;
        const u32x4 v = *(const u32x4*)(HYT + (size_t)ch * T + tok0 + ck * 8);
        unsigned* row = tile + ch * 32;
        row[(4 * ck) ^ x] = v.x; row[(4 * ck + 1) ^ x] = v.y; row[(4 * ck + 2) ^ x] = v.z; row[(4 * ck + 3) ^ x] = v.w;
    }
    __syncthreads();
    for (int id = tid; id < 64 * (HYENA_W / 8); id += NTHR) {
        const int cg = id % (HYENA_W / 8), tok = id / (HYENA_W / 8), x = cg & 31, sh = (tok & 1) * 16;
        unsigned e[8];
#pragma unroll
        for (int k = 0; k < 8; ++k) e[k] = (tile[(8 * cg + k) * 32 + ((tok >> 1) ^ x)] >> sh) & 0xffffu;
        u32x4 o; o.x = e[0] | (e[1] << 16); o.y = e[2] | (e[3] << 16); o.z = e[4] | (e[5] << 16); o.w = e[6] | (e[7] << 16);
        *(u32x4*)(mixed + (size_t)(tok0 + tok) * MIX_W + ATTN_W + 8 * cg) = o;
    }
    __syncthreads();
}

DI void shortconv_item(const Params& p, int l, int item) {
    const bf16* SCb = (const bf16*)(p.ws + WS_SC);
    bf16* mixed = (bf16*)(p.ws + WS_XN);
    const float* cw = p.in[I_SCW] + (size_t)l * 3 * CONV_W;
    constexpr int C8 = CONV_W / 8;
    const u32x4 zero4 = {0u, 0u, 0u, 0u};
#pragma unroll 4
    for (int e = TIDX(); e < 256 * C8; e += NTHR) {
        const int m = item * 256 + e / C8, c = (e % C8) * 8;
        const int L = m < TC ? SEQ : DEC_SEQ, t = m < TC ? m % SEQ : (m - TC) % DEC_SEQ;
        const bf16* row = SCb + (size_t)m * 4 * CONV_W + c;
        float sb[8], g0[8], x0[8], gm[8], xm[8], gn[8], xn[8], gc[8], w0[8], w1[8], w2[8];
        unpack8(*(const u32x4*)row, sb); unpack8(*(const u32x4*)(row + CONV_W), g0); unpack8(*(const u32x4*)(row + 2 * CONV_W), x0); unpack8(*(const u32x4*)(row + 3 * CONV_W), gc);
        const bf16* rowm = t > 0 ? row - 4 * CONV_W : row; const bf16* rown = t < L - 1 ? row + 4 * CONV_W : row;
        u32x4 vgm = *(const u32x4*)(rowm + CONV_W), vxm = *(const u32x4*)(rowm + 2 * CONV_W), vgn = *(const u32x4*)(rown + CONV_W), vxn = *(const u32x4*)(rown + 2 * CONV_W);
        if (t == 0) { vgm = zero4; vxm = zero4; } if (t == L - 1) { vgn = zero4; vxn = zero4; }
        unpack8(vgm, gm); unpack8(vxm, xm); unpack8(vgn, gn); unpack8(vxn, xn);
#pragma unroll
        for (int i = 0; i < 2; ++i) {
            const f32x4 a = *(const f32x4*)(cw + c + 4 * i), b = *(const f32x4*)(cw + CONV_W + c + 4 * i), d = *(const f32x4*)(cw + 2 * CONV_W + c + 4 * i);
            w0[4 * i] = a.x; w0[4 * i + 1] = a.y; w0[4 * i + 2] = a.z; w0[4 * i + 3] = a.w;
            w1[4 * i] = b.x; w1[4 * i + 1] = b.y; w1[4 * i + 2] = b.z; w1[4 * i + 3] = b.w;
            w2[4 * i] = d.x; w2[4 * i + 1] = d.y; w2[4 * i + 2] = d.z; w2[4 * i + 3] = d.w;
        }
        float o[8];
#pragma unroll
        for (int i = 0; i < 8; ++i) o[i] = sb[i] * (gm[i] * xm[i] * w0[i] + g0[i] * x0[i] * w1[i] + gn[i] * xn[i] * w2[i]) * gc[i];
        u32x4 ov; ov.x = pack2(o[0], o[1]); ov.y = pack2(o[2], o[3]); ov.z = pack2(o[4], o[5]); ov.w = pack2(o[6], o[7]);
        *(u32x4*)(mixed + (size_t)m * MIX_W + ATTN_W + HYENA_W + c) = ov;
    }
}

constexpr int AT_NKL = 320;
constexpr int AT_KL = 0, AT_VL = AT_KL + AT_NKL * 128, AT_KC = AT_VL + AT_NKL * 128, AT_VC = AT_KC + 256 * 128, AT_END = AT_VC + 256 * 128;
static_assert(AT_END <= LDS_BYTES - 16, "lds");
DI int swzv(int row, int c) { return row * 128 + ((c ^ (((row >> 1) & 1) << 2)) << 4); }
struct VFrag { u32x2 r[8]; };
#ifdef EMU
DI void v_tr_issue(const char* a0, const char* a1, VFrag& f) {
#pragma unroll
    for (int i = 0; i < 8; ++i) { const bf16x4 v = emu_ds_read_tr16((i < 4 ? a0 : a1) + 1024 * (i & 3)); f.r[i] = __builtin_bit_cast(u32x2, v); }
}
DI void v_tr_wait(VFrag&) {}
DI float fast_exp2(float x) { return exp2f(x); }
DI bool wave_any(bool pred) { return emu_wave_any(pred); }
#else
DI void v_tr_issue(const char* a0, const char* a1, VFrag& f) {
    const unsigned x0 = (unsigned)(size_t)(const LAS char*)a0, x1 = (unsigned)(size_t)(const LAS char*)a1;
    asm volatile("ds_read_b64_tr_b16 %0, %8\n\tds_read_b64_tr_b16 %1, %8 offset:1024\n\tds_read_b64_tr_b16 %2, %8 offset:2048\n\tds_read_b64_tr_b16 %3, %8 offset:3072\n\t"
                 "ds_read_b64_tr_b16 %4, %9\n\tds_read_b64_tr_b16 %5, %9 offset:1024\n\tds_read_b64_tr_b16 %6, %9 offset:2048\n\tds_read_b64_tr_b16 %7, %9 offset:3072"
                 : "=&v"(f.r[0]), "=&v"(f.r[1]), "=&v"(f.r[2]), "=&v"(f.r[3]), "=&v"(f.r[4]), "=&v"(f.r[5]), "=&v"(f.r[6]), "=&v"(f.r[7]) : "v"(x0), "v"(x1) : "memory");
}
DI void v_tr_wait(VFrag& f) {
    asm volatile("s_waitcnt lgkmcnt(0)" : "+v"(f.r[0]), "+v"(f.r[1]), "+v"(f.r[2]), "+v"(f.r[3]), "+v"(f.r[4]), "+v"(f.r[5]), "+v"(f.r[6]), "+v"(f.r[7]) :: "memory");
    __builtin_amdgcn_sched_barrier(0);
}
DI float fast_exp2(float x) { return __builtin_amdgcn_exp2f(x); }
DI bool wave_any(bool pred) { return __builtin_amdgcn_ballot_w64(pred) != 0ull; }
#endif
DI void softmax_pv(f32x16& S, f32x16 (&O)[2], float& m_run, float& l_run, VFrag& vf, float c1) {
    float tmax = S[0];
#pragma unroll
    for (int e = 1; e < 16; ++e) tmax = fmaxf(tmax, S[e]);
    tmax *= c1;
    if (wave_any(tmax > m_run + 8.f)) {
        tmax = fmaxf(tmax, __shfl_xor(tmax, 32));
        const float mnew = fmaxf(m_run, tmax), alpha = fast_exp2(m_run - mnew);
        m_run = mnew; l_run *= alpha;
#pragma unroll
        for (int e = 0; e < 16; ++e) { O[0][e] *= alpha; O[1][e] *= alpha; }
    }
    float ps = 0.f; unsigned pk[8];
#pragma unroll
    for (int e = 0; e < 8; ++e) { const float p0 = fast_exp2(S[2 * e] * c1 - m_run), p1 = fast_exp2(S[2 * e + 1] * c1 - m_run); ps += p0 + p1; pk[e] = pack2(p0, p1); }
    l_run += ps;
    u32x4 q0; q0.x = pk[0]; q0.y = pk[1]; q0.z = pk[2]; q0.w = pk[3];
    u32x4 q1; q1.x = pk[4]; q1.y = pk[5]; q1.z = pk[6]; q1.w = pk[7];
    const bf16x8 pb0 = __builtin_bit_cast(bf16x8, q0), pb1 = __builtin_bit_cast(bf16x8, q1);
    v_tr_wait(vf);
    u32x4 f;
    f.x = vf.r[0].x; f.y = vf.r[0].y; f.z = vf.r[1].x; f.w = vf.r[1].y; O[0] = MFMA32(__builtin_bit_cast(bf16x8, f), pb0, O[0]);
    f.x = vf.r[2].x; f.y = vf.r[2].y; f.z = vf.r[3].x; f.w = vf.r[3].y; O[0] = MFMA32(__builtin_bit_cast(bf16x8, f), pb1, O[0]);
    f.x = vf.r[4].x; f.y = vf.r[4].y; f.z = vf.r[5].x; f.w = vf.r[5].y; O[1] = MFMA32(__builtin_bit_cast(bf16x8, f), pb0, O[1]);
    f.x = vf.r[6].x; f.y = vf.r[6].y; f.z = vf.r[7].x; f.w = vf.r[7].y; O[1] = MFMA32(__builtin_bit_cast(bf16x8, f), pb1, O[1]);
}
DI void attn_item(const Params& p, int l, int item, char* smem, bool LAT) {
    const int tid = TIDX(), lane = tid & 63, w = tid >> 6, r = lane & 31, h = lane >> 5;
    const int SL = LAT ? DEC_SEQ : SEQ, NQB = SL / 64;
    const int b = item / (N_KV * NQB), kvh = (item / NQB) % N_KV, q0 = (item % NQB) * 64;
    const int tokbase = (LAT ? TC : 0) + b * SL;
    const bf16* Qb = (const bf16*)(p.ws + WS_Q); const bf16* Kb = (const bf16*)(p.ws + WS_KB); const bf16* Vb = (const bf16*)(p.ws + WS_VB);
    const bf16* GAb = (const bf16*)(p.ws + WS_GA); bf16* mixed = (bf16*)(p.ws + WS_XN);
    char* KL = smem + AT_KL; char* VL = smem + AT_VL; char* KC = smem + AT_KC; char* VC = smem + AT_VC;
    const u32x4 zero4 = {0u, 0u, 0u, 0u};
    PRB_BEGIN(1)
    {
        const bf16* ksrc; const bf16* vsrc; size_t stride;
        if (LAT) { const size_t o = (size_t)((b * DEPTH + l) * N_KV + kvh) * PAST_LEN * HD; ksrc = (const bf16*)(p.ws + WS_CKB) + o; vsrc = (const bf16*)(p.ws + WS_CVTB) + o; stride = HD; }
        else { ksrc = Kb + (size_t)tokbase * KV_W + kvh * HD; vsrc = Vb + (size_t)tokbase * KV_W + kvh * HD; stride = KV_W; }
        u32x4 ck[4], cv[4], lk[5], lv[5];
#pragma unroll
        for (int i = 0; i < 4; ++i) { const int id = tid + NTHR * i, row = id >> 3, c = id & 7; ck[i] = *(const u32x4*)(ksrc + (size_t)row * stride + c * 8); cv[i] = *(const u32x4*)(vsrc + (size_t)row * stride + c * 8); }
        if (LAT) {
#pragma unroll
            for (int i = 0; i < 5; ++i) {
                const int id = tid + NTHR * i, row = id >> 3, c = id & 7, kp = q0 - 128 + row;
                const bool inr = kp >= 0 && kp < SL;
                const size_t o = (size_t)(tokbase + (inr ? kp : 0)) * KV_W + kvh * HD + c * 8;
                lk[i] = *(const u32x4*)(Kb + o); lv[i] = *(const u32x4*)(Vb + o);
                if (!inr) { lk[i] = zero4; lv[i] = zero4; }
            }
#pragma unroll
            for (int i = 0; i < 5; ++i) { const int id = tid + NTHR * i, row = id >> 3, c = id & 7; *(u32x4*)(KL + swz128(row, c)) = lk[i]; *(u32x4*)(VL + swzv(row, c)) = lv[i]; }
        }
#pragma unroll
        for (int i = 0; i < 4; ++i) { const int id = tid + NTHR * i, row = id >> 3, c = id & 7; *(u32x4*)(KC + swz128(row, c)) = ck[i]; *(u32x4*)(VC + swzv(row, c)) = cv[i]; }
    }
    __syncthreads();
    PRB_END(1, smem)
    PRB_BEGIN(2)
    {
        const int g = w >> 1, qt = w & 1, head = kvh * 4 + g;
        const int qpos = q0 + 32 * qt + r;
        const size_t qtok = (size_t)tokbase + qpos;
        bf16x8 qraw[4], qrot[4];
#pragma unroll
        for (int s = 0; s < 4; ++s) { qraw[s] = *(const bf16x8*)(Qb + qtok * ATTN_W + head * HD + 16 * s + 8 * h); qrot[s] = qraw[s]; }
        if (LAT) {
            const f32x2* rope = (const f32x2*)(p.ws + WS_ROPE);
#pragma unroll
            for (int a = 0; a < 2; ++a)
#pragma unroll
                for (int jj = 0; jj < 8; ++jj) {
                    const f32x2 cs = rope[(qpos * 2 + a) * 16 + 8 * h + jj];
                    const float xa = bf2f((bf16)qraw[2 * a][jj]), xb = bf2f((bf16)qraw[2 * a + 1][jj]);
                    qrot[2 * a][jj] = (short)f2bf(xa * cs.x - xb * cs.y);
                    qrot[2 * a + 1][jj] = (short)f2bf(xb * cs.x + xa * cs.y);
                }
        }
        const int qq = (lane & 15) >> 2, pp = lane & 3, g16 = (lane >> 4) & 1, vrow = 4 * h + qq;
        const int voff0 = swzv(vrow, 2 * g16 + (pp >> 1)) + (pp & 1) * 8, voff1 = swzv(vrow, 4 + 2 * g16 + (pp >> 1)) + (pp & 1) * 8;
        const float c1 = 0.125f * 1.4426950408889634f;
        float m_run = p.in[I_SINK][l * N_HEADS + head] * 1.4426950408889634f, l_run = h == 0 ? 1.f : 0.f;
        f32x16 O[2];
#pragma unroll
        for (int e = 0; e < 16; ++e) { O[0][e] = 0.f; O[1][e] = 0.f; }
        if (LAT) {
            for (int jt = qt; jt < qt + 9; ++jt) {
                VFrag vf; v_tr_issue(VL + 4096 * jt + voff0, VL + 4096 * jt + voff1, vf);
                f32x16 S;
#pragma unroll
                for (int e = 0; e < 16; ++e) S[e] = 0.f;
                const int krow = 32 * jt + r;
#pragma unroll
                for (int s = 0; s < 4; ++s) S = MFMA32(*(const bf16x8*)(KL + swz128(krow, 2 * s + h)), qrot[s], S);
                const int kt0 = q0 - 128 + 32 * jt, qt0 = q0 + 32 * qt;
                if (kt0 + 31 - qt0 > 128 || qt0 + 31 - kt0 > 128 || kt0 < 0 || kt0 + 31 >= SL) {
#pragma unroll
                    for (int e = 0; e < 16; ++e) {
                        const int kp = kt0 + (e & 3) + 8 * (e >> 2) + 4 * h, dd = kp - qpos;
                        const bool ok = dd <= 128 && dd >= -128 && kp >= 0 && kp < SL;
                        S[e] = ok ? S[e] : -1e30f;
                    }
                }
                softmax_pv(S, O, m_run, l_run, vf, c1);
            }
        }
        for (int jt = 0; jt < 8; ++jt) {
            VFrag vf; v_tr_issue(VC + 4096 * jt + voff0, VC + 4096 * jt + voff1, vf);
            f32x16 S;
#pragma unroll
            for (int e = 0; e < 16; ++e) S[e] = 0.f;
            const int krow = 32 * jt + r;
#pragma unroll
            for (int s = 0; s < 4; ++s) S = MFMA32(*(const bf16x8*)(KC + swz128(krow, 2 * s + h)), qraw[s], S);
            softmax_pv(S, O, m_run, l_run, vf, c1);
        }
        const float inv = 1.f / (l_run + __shfl_xor(l_run, 32));
#pragma unroll
        for (int dt = 0; dt < 2; ++dt)
#pragma unroll
            for (int rg = 0; rg < 4; ++rg) {
                const int d0 = dt * 32 + 8 * rg + 4 * h;
                const u32x2 gv = *(const u32x2*)(GAb + qtok * ATTN_W + head * HD + d0);
                const float g0 = bf2f((bf16)(gv.x & 0xffffu)), g1 = bf2f((bf16)(gv.x >> 16)), g2 = bf2f((bf16)(gv.y & 0xffffu)), g3 = bf2f((bf16)(gv.y >> 16));
                u32x2 o; o.x = pack2(O[dt][4 * rg] * inv * g0, O[dt][4 * rg + 1] * inv * g1); o.y = pack2(O[dt][4 * rg + 2] * inv * g2, O[dt][4 * rg + 3] * inv * g3);
                *(u32x2*)(mixed + qtok * MIX_W + head * HD + d0) = o;
            }
    }
    PRB_END(2, smem)
    __syncthreads();
}

DI void phase_p0(const Params& p_, char* smem) {
    constexpr int I_T1 = DEPTH * (D_MODEL / 64) * (IN_COLS / 64), I_T2 = DEPTH * (MIX_W / 64) * (D_MODEL / 64);
    constexpr int I_MOD = DEPTH * (3 * D_MODEL / 64), I_ROPE = DEC_SEQ * 32 / NTHR, I_HID = DEPTH * (SEQ + DEC_SEQ) / 64;
    constexpr int I_CACHE = (2 * DEC_BATCH * DEPTH * PAST_LEN * KV_W / 8 + NTHR - 1) / NTHR;
    constexpr int TOTAL = I_T1 + I_T2 + I_MOD + I_ROPE + I_HID + I_CACHE;
    for (int it = BIDX(); it < TOTAL; it += gridDim.x) {
        const Params p = launder(p_);
        int q = it;
        if (q < I_T1 + I_T2) {
            const bool w1 = q < I_T1; if (!w1) q -= I_T1;
            const int per = w1 ? (D_MODEL / 64) * (IN_COLS / 64) : (MIX_W / 64) * (D_MODEL / 64), l = q / per;
            if (w1) p0_transpose_item(p.in[I_WIN] + (size_t)l * D_MODEL * IN_COLS, D_MODEL, IN_COLS, (bf16*)(p.ws + WS_WINT) + (size_t)l * IN_COLS * D_MODEL, q % per, smem);
            else p0_transpose_item(p.in[I_WOUT] + (size_t)l * MIX_W * D_MODEL, MIX_W, D_MODEL, (bf16*)(p.ws + WS_WOUTT) + (size_t)l * D_MODEL * MIX_W, q % per, smem);
            continue; }
        q -= I_T1 + I_T2;
        if (q < I_MOD) { p0_mod_item(p, q, smem); continue; }
        q -= I_MOD;
        if (q < I_ROPE) { p0_rope_item(p, q); continue; }
        q -= I_ROPE;
        if (q < I_HID) { p0_hid2_item(p, q); continue; }
        q -= I_HID;
        p0_cache_item(p, q);
    }
}
DI void phase_mix(const Params& p_, int l, int fl, int qid, char* smem, int mask) {
    constexpr int I_HL = HYENA_W * ((DEC_BATCH / 2 + 1) / 2), I_AL = DEC_BATCH * N_KV * (DEC_SEQ / 64), I_AC = BATCH * N_KV * (SEQ / 64);
    constexpr int I_HC = HYENA_W / 2, I_SC = T / 256, I_FL = HYENA_W, I_FC = HYENA_W / 16;
    static_assert(BATCH / 2 <= 16, "ctx hyena: one bank holds 16 batch pairs");
    const int nf = fl >= 0 ? I_FL + I_FC : 0;
    for (;;) {
        const Params p = launder(p_);
        int q = wq_next(p, qid, smem);
        if (q >= I_HC + I_HL + nf + I_AL + I_AC + I_SC) break;
        if (q < I_HC + I_HL) { const bool lat = q >= I_HC; if (mask & (lat ? 1 : 2)) hyena_item(p, l, lat ? q - I_HC : q, smem, lat); continue; }
        q -= I_HC + I_HL;
        if (q < nf) { const bool lat = q < I_FL; filter_item(p, fl, lat ? q : q - I_FL, smem, lat); continue; }
        q -= nf;
        if (q < I_AL + I_AC) { const bool lat = q < I_AL; if (mask & (lat ? 4 : 8)) attn_item(p, l, lat ? q : q - I_AL, smem, lat); continue; }
        q -= I_AL + I_AC;
        if (mask & 16) shortconv_item(p, l, q);
    }
}
constexpr int I_FILT = HYENA_W + HYENA_W / 16, I_FILT_A = I_FILT / 2;
DI void phase_filters(const Params& p_, int l, int qid, char* smem, int first, int count) {
    constexpr int I_FL = HYENA_W, I_FC = HYENA_W / 16;
    for (;;) {
        const Params p = launder(p_);
        int q = wq_next(p, qid, smem);
        if (q >= count) break;
        q += first;
        const bool lat = q >= I_FC;
        filter_item(p, l, lat ? q - I_FC : q, smem, lat);
    }
}
DI void phase_norm(const Params& p, int l) {
    for (int it = BIDX(); it < T / 16; it += gridDim.x) norm_item(p, l, it);
}
DI void phase_hytr(const Params& p, char* smem) {
    for (int it = BIDX(); it < T / 64; it += gridDim.x) hytr_item(p, it, smem);
}

#ifndef PH_STOP
#define PH_STOP 1000
#endif
#ifndef DUP
#define DUP -1
#endif
#ifndef DMASK
#define DMASK 31
#endif
#ifndef PROBE_SEL
#define PROBE_SEL 0
#endif
#ifndef PROBE_SCALE
#define PROBE_SCALE 10.f
#endif
#ifndef PROBE_WORK
#define PROBE_WORK 0
#endif
__global__ void __launch_bounds__(NTHR, 2) fwd_kernel(Params p_) {
#ifdef EMU
    char* smem = emu_smem();
#else
    extern __shared__ __attribute__((aligned(16))) char smem[];
    volatile LAS unsigned* xst = (volatile LAS unsigned*)(smem + LDS_BYTES - 16);
    if (TIDX() == 0) { xst[0] = 0u; xst[1] = 0u; }
    __syncthreads();
    const XcdBarrier xbar = xcd_barrier_post((unsigned*)(p_.ws + WS_BAR), xst);
#endif
    constexpr int NPH = 2 + 5 * DEPTH;
#if PROBE_SEL
    unsigned long long tacc = 0ull, tprev = __builtin_amdgcn_s_memrealtime();
#if defined(PROBE_SEC_ON)
    if (TIDX() == 0) *(volatile unsigned long long*)(smem + LDS_BYTES - 48) = 0ull;
    __syncthreads();
#endif
#endif
#pragma unroll 1
    for (int ph = 0; ph < NPH && ph < PH_STOP; ++ph) {
#pragma unroll 1
        for (int rep = 0; rep < (ph == DUP ? 2 : 1); ++rep) {
            const Params p = launder(p_);
            const int l = ph >= 2 ? (ph - 2) / 5 : 0, k = ph >= 2 ? (ph - 2) % 5 : -1;
            const int qid = ph + 32 * rep;
            if (ph == 0) phase_p0(p, smem);
            else if (ph == 1) { phase_norm(p, 0); phase_filters(p, 0, qid, smem, 0, I_FILT); }
            else if (k == 1) phase_mix(p, l, (rep || l + 1 >= DEPTH) ? -1 : l + 1, qid, smem, rep ? DMASK : 31);
            else if (k == 0 || k == 3) {
                GemmJob job; job.p = p; job.mode = k == 0 ? 0 : 1; job.l = l; job.K = k == 0 ? D_MODEL : MIX_W;
                gemm_phase((ldsptr_t)smem, job);
            } else if (k == 2) phase_hytr(p, smem);
            else phase_norm(p, l + 1);
        }
#if PROBE_SEL
        {
            const int kk = ph == 0 ? 0 : (ph == 1 ? 1 : 2 + (ph - 2) % 5);
            unsigned long long tnow = __builtin_amdgcn_s_memrealtime();
            if (PROBE_WORK && ((PROBE_SEL >> kk) & 1)) tacc += tnow - tprev;
            GRID_SYNC();
            tnow = __builtin_amdgcn_s_memrealtime();
            if (!PROBE_WORK && ((PROBE_SEL >> kk) & 1)) tacc += tnow - tprev;
            tprev = tnow;
        }
#else
        if (ph + 1 < NPH) GRID_SYNC();
#endif
    }
#if PROBE_SEL
#if defined(PROBE_SEC_ON)
    if (BIDX() == 0 && TIDX() == 0) p_.out[OUT_YS + 777] = (float)*(volatile unsigned long long*)(smem + LDS_BYTES - 48) / (100.f * PROBE_SCALE);
#elif PROBE_WORK >= 2
    {
        unsigned* slot = (unsigned*)(p_.ws + WS_WQ) + 63 * 64;
        if (TIDX() == 0) { if (PROBE_WORK == 2) atomicMax(slot, (unsigned)tacc); else atomicMin(slot + 1, ~(unsigned)tacc == 0u ? 0u : (unsigned)tacc + 0u); }
        GRID_SYNC();
        if (BIDX() == 0 && TIDX() == 0) p_.out[OUT_YS + 777] = (float)__hip_atomic_load(slot + (PROBE_WORK == 2 ? 0 : 1), __ATOMIC_RELAXED, __HIP_MEMORY_SCOPE_AGENT) / (100.f * PROBE_SCALE);
    }
#else
    if (BIDX() == 0 && TIDX() == 0) p_.out[OUT_YS + 777] = (float)tacc / (100.f * PROBE_SCALE);
#endif
#endif
}

#ifndef EMU
extern "C" void kernel_launch(void* const* d_in, const int* in_sizes, int n_in, void* d_out, int out_size, void* d_ws, size_t ws_size, hipStream_t stream) {
    static int grid = 0;
    if (grid == 0) {
        if (n_in != 22 || (size_t)out_size != OUT_TOTAL || ws_size < WS_END) { fprintf(stderr, "kernel_launch: unexpected sizes n_in %d out %d ws %zu (need %zu)\n", n_in, out_size, ws_size, (size_t)WS_END); grid = -1; return; }
        int dev = 0, cus = 0, per_cu = 0;
        hipGetDevice(&dev); hipDeviceGetAttribute(&cus, hipDeviceAttributeMultiprocessorCount, dev);
        if (hipFuncSetAttribute((const void*)fwd_kernel, hipFuncAttributeMaxDynamicSharedMemorySize, LDS_BYTES) != hipSuccess) { fprintf(stderr, "hipFuncSetAttribute failed\n"); grid = -1; return; }
        hipOccupancyMaxActiveBlocksPerMultiprocessor(&per_cu, (const void*)fwd_kernel, NTHR, LDS_BYTES);
        if (per_cu < 1) { fprintf(stderr, "occupancy query says %d\n", per_cu); grid = -1; return; }
        grid = cus;
    }
    if (grid < 0) return;
    Params p{};
    for (int i = 0; i < 22; ++i) p.in[i] = (const float*)d_in[i];
    p.out = (float*)d_out; p.ws = (unsigned char*)d_ws;
    if (hipMemsetAsync((char*)d_ws + WS_BAR, 0, 65536, stream) != hipSuccess) { fprintf(stderr, "memset failed\n"); return; }
    hipLaunchKernelGGL(fwd_kernel, dim3(grid), dim3(NTHR), LDS_BYTES, stream, p);
    const hipError_t e = hipPeekAtLastError();
    if (e != hipSuccess) fprintf(stderr, "launch failed: %s (grid %d)\n", hipGetErrorString(e), grid);
}
#endif
```

```cpp
#ifdef EMU
#include "emu.h"
#define GRID_SYNC() emu_grid_sync()
#define MFMA32(a, b, c) emu_mfma32((a), (b), (c))
#define MFMA16(a, b, c) emu_mfma16((a), (b), (c))
#define LAS
#define GLDS16(g, l) emu_glds16((const void*)(g), (void*)(l))
#define S_BARRIER() __syncthreads()
#define WAIT_V(n)
#define WAIT_L(n)
#define SCHED_BAR()
#define SETPRIO(x)
#define RFL(x) (x)
#define CBAR()
#define OPQ(x) (x)
#define TIDX() ((int)threadIdx.x)
#define BIDX() ((int)blockIdx.x)
#else
#include <hip/hip_runtime.h>
#include <cstdio>
#include <cstdint>
typedef short bf16x8 __attribute__((ext_vector_type(8)));
typedef float f32x16 __attribute__((ext_vector_type(16)));
typedef float f32x4 __attribute__((ext_vector_type(4)));
#define GRID_SYNC() xcd_barrier(xbar)
#define MFMA32(a, b, c) __builtin_amdgcn_mfma_f32_32x32x16_bf16((a), (b), (c), 0, 0, 0)
#define MFMA16(a, b, c) __builtin_amdgcn_mfma_f32_16x16x32_bf16((a), (b), (c), 0, 0, 0)
#define LAS __attribute__((address_space(3)))
#define GLDS16(g, l) __builtin_amdgcn_global_load_lds((const unsigned*)(g), (LAS unsigned*)(l), 16, 0, 0)
#define S_BARRIER() __builtin_amdgcn_s_barrier()
#define WAIT_V(n) asm volatile("s_waitcnt vmcnt(" #n ")" ::: "memory")
#define WAIT_L(n) asm volatile("s_waitcnt lgkmcnt(" #n ")" ::: "memory")
#define SCHED_BAR() __builtin_amdgcn_sched_barrier(0)
#define SETPRIO(x) __builtin_amdgcn_s_setprio(x)
#define RFL(x) __builtin_amdgcn_readfirstlane(x)
#define CBAR() asm volatile("" ::: "memory")
__device__ __forceinline__ int opq_(int x) { asm volatile("" : "+v"(x)); return x; }
#define OPQ(x) opq_(x)
__device__ __forceinline__ int tidx_() { int t = threadIdx.x; asm volatile("" : "+v"(t)); return t; }
__device__ __forceinline__ int bidx_() { int t = blockIdx.x; asm volatile("" : "+s"(t)); return t; }
#define TIDX() tidx_()
#define BIDX() bidx_()
#endif
typedef unsigned u32x4 __attribute__((ext_vector_type(4)));
typedef unsigned u32x2 __attribute__((ext_vector_type(2)));
typedef float f32x2 __attribute__((ext_vector_type(2)));
typedef unsigned short bf16;
#define DI __device__ __forceinline__
#if defined(PROBE_SEC_ON) && !defined(EMU)
#define PRB_BEGIN(id) unsigned long long _prb_t0_##id = 0; if (PROBE_SEC_ON == (id)) { __syncthreads(); _prb_t0_##id = __builtin_amdgcn_s_memrealtime(); }
#define PRB_END(id, smem) if (PROBE_SEC_ON == (id)) { __syncthreads(); if (BIDX() == 0 && TIDX() == 0) *(volatile unsigned long long*)((smem) + LDS_BYTES - 48) += __builtin_amdgcn_s_memrealtime() - _prb_t0_##id; }
#define PRB_BEGIN_NS(id) unsigned long long _prb_t0_##id = 0; if (PROBE_SEC_ON == (id)) { _prb_t0_##id = __builtin_amdgcn_s_memrealtime(); }
#define PRB_END_NS(id, smem) if (PROBE_SEC_ON == (id)) { if (BIDX() == 0 && TIDX() == 0) *(volatile unsigned long long*)((smem) + LDS_BYTES - 48) += __builtin_amdgcn_s_memrealtime() - _prb_t0_##id; }
#else
#define PRB_BEGIN(id)
#define PRB_END(id, smem)
#define PRB_BEGIN_NS(id)
#define PRB_END_NS(id, smem)
#endif

#ifdef CFG_SMALL
constexpr int D_MODEL = 256, BATCH = 2, SEQ = 256, DEPTH = 2, DEC_BATCH = 4, DEC_SEQ = 4096, PAST_LEN = 256, HYENA_W = 128, CONV_W = 128;
#else
constexpr int D_MODEL = 1024, BATCH = 32, SEQ = 256, DEPTH = 4, DEC_BATCH = 8, DEC_SEQ = 4096, PAST_LEN = 256, HYENA_W = 256, CONV_W = 256;
#endif
constexpr int GRID_W = 64, N_HEADS = 8, N_KV = 2, HD = 64, ATTN_W = 512, KV_W = 128;
constexpr int MIX_W = ATTN_W + HYENA_W + CONV_W;
constexpr int C_Q = 0, C_K = ATTN_W, C_V = C_K + KV_W, C_GA = C_V + KV_W, C_HV = C_GA + ATTN_W, C_GH = C_HV + 3 * HYENA_W,
              C_SB = C_GH + HYENA_W, C_GC = C_SB + 3 * CONV_W, IN_COLS = C_GC + CONV_W;
constexpr int TC = BATCH * SEQ, TL = DEC_BATCH * DEC_SEQ, T = TC + TL;
constexpr int NR = 1 + DEC_BATCH;
constexpr int FH = 64, FE = 33;
constexpr int NTHR = 512;
static_assert(T % 256 == 0 && TC % 256 == 0 && C_HV % 256 == 0 && C_SB % 256 == 0 && IN_COLS % 256 == 0 && D_MODEL % 256 == 0 && MIX_W % 128 == 0 && (4 * HYENA_W) % 256 == 0, "tiling");
static_assert(SEQ == 256 && DEC_SEQ == 4096 && PAST_LEN == 256, "fft sizes");

constexpr size_t al256(size_t x) { return (x + 255) & ~(size_t)255; }
constexpr size_t WS_BAR = 0;
constexpr size_t WS_WINT = 65536;
constexpr size_t WS_WOUTT = WS_WINT + al256((size_t)DEPTH * IN_COLS * D_MODEL * 2);
constexpr size_t WS_MOD = WS_WOUTT + al256((size_t)DEPTH * D_MODEL * MIX_W * 2);
constexpr size_t WS_ROPE = WS_MOD + al256((size_t)DEPTH * NR * 3 * D_MODEL * 4);
constexpr size_t WS_HID2 = WS_ROPE + al256((size_t)DEC_SEQ * 32 * 8);
constexpr size_t WS_CKB = WS_HID2 + al256((size_t)DEPTH * (SEQ + DEC_SEQ) * FH * 4);
constexpr size_t WS_CVTB = WS_CKB + al256((size_t)DEC_BATCH * DEPTH * PAST_LEN * KV_W * 2);
constexpr size_t WS_KFL = WS_CVTB + al256((size_t)DEC_BATCH * DEPTH * PAST_LEN * KV_W * 2);
constexpr size_t KFL_BYTES = al256((size_t)2 * HYENA_W * 8192 * 8), KFC_BYTES = al256((size_t)2 * HYENA_W * 512 * 8);
constexpr size_t WS_KFC = WS_KFL + 2 * KFL_BYTES;
constexpr size_t WS_ZS = WS_KFC + 2 * KFC_BYTES;
constexpr size_t WS_XN = WS_ZS + (size_t)256 * 2 * 4096 * 8;
constexpr size_t WS_Q = WS_XN + al256((size_t)T * (D_MODEL > MIX_W ? D_MODEL : MIX_W) * 2);
constexpr size_t WS_KB = WS_Q + al256((size_t)T * ATTN_W * 2);
constexpr size_t WS_VB = WS_KB + al256((size_t)T * KV_W * 2);
constexpr size_t WS_GA = WS_VB + al256((size_t)T * KV_W * 2);
constexpr size_t WS_HYT = WS_GA + al256((size_t)T * ATTN_W * 2);
constexpr size_t WS_SC = WS_HYT + al256((size_t)4 * HYENA_W * T * 2);
constexpr size_t WS_END0 = WS_SC + al256((size_t)T * 4 * CONV_W * 2);
#ifndef DUP
#define DUP -1
#endif
constexpr size_t WS_ZT = DUP >= 0 ? WS_END0 : WS_HYT;
constexpr size_t WS_END = WS_END0 + (DUP >= 0 ? al256((size_t)HYENA_W * T * 2) : 0);

constexpr size_t OUT_YS = (size_t)TC * D_MODEL, OUT_NK = (size_t)T * D_MODEL, OUT_NV = OUT_NK + (size_t)BATCH * DEPTH * SEQ * KV_W,
                 OUT_TOTAL = OUT_NV + (size_t)BATCH * DEPTH * SEQ * KV_W;

constexpr int LDS_BYTES = 149504;

struct Params {
    const float* in[22];
    float* out;
    unsigned char* ws;
};
enum { I_XP = 0, I_XS, I_CK, I_CV, I_C, I_CCTX, I_NORMG, I_MODW, I_MODB, I_WIN, I_SINK, I_HYCW, I_FW1, I_FB1, I_FW2, I_FB2, I_FW3, I_FFREQ, I_HYD, I_SCW, I_WOUT, I_FINALG };

DI bf16 f2bf(float f) { unsigned u = __float_as_uint(f); u += 0x7fffu + ((u >> 16) & 1u); return (bf16)(u >> 16); }
DI float bf2f(bf16 h) { return __uint_as_float(((unsigned)h) << 16); }
#ifdef EMU
DI unsigned pack2(float a, float b) { return (unsigned)f2bf(a) | ((unsigned)f2bf(b) << 16); }
DI float silu_f(float x) { return x / (1.f + __expf(-x)); }
#else
DI unsigned pack2(float a, float b) { unsigned r; asm("v_cvt_pk_bf16_f32 %0, %1, %2" : "=v"(r) : "v"(a), "v"(b)); return r; }
DI float silu_f(float x) { return x * __builtin_amdgcn_rcpf(1.f + __builtin_amdgcn_exp2f(x * -1.4426950408889634f)); }
#endif
typedef float cpx __attribute__((ext_vector_type(2)));
DI cpx cmul(cpx a, cpx b) { cpx r = b * a.x; r += cpx{-b.y, b.x} * a.y; return r; }
#ifdef EMU
DI Params launder(const Params& p) { return p; }
#else
DI Params launder(const Params& p) { Params q = p; int z = 0; asm volatile("" : "+s"(z)); q.ws = p.ws + z; q.out = p.out + z; return q; }
#endif
DI int mod_row(int m) { return m < TC ? 0 : 1 + (m - TC) / DEC_SEQ; }


#ifndef EMU
#define XB_TMO      128
#define XB_XCNT(j)  (256  + 64 * (j))
#define XB_XSUB(j)  (1280 + 64 * (j))
#define XB_XGEN(j)  (2304 + 64 * (j))
#define XB_TOP      3328
#define XB_TOPGEN   3392
#define XCD_BAR_WORDS 3456
#define XB_SPIN_CAP (1u << 22)
DI unsigned xb_ld(unsigned* p) { return __hip_atomic_load(p, __ATOMIC_RELAXED, __HIP_MEMORY_SCOPE_AGENT); }
DI unsigned xb_add(unsigned* p, unsigned v) { return __hip_atomic_fetch_add(p, v, __ATOMIC_RELAXED, __HIP_MEMORY_SCOPE_AGENT); }
DI unsigned xb_xcc_id() { return (unsigned)__builtin_amdgcn_s_getreg((3 << 11) | 20) & 0xFu; }
#define XB_SPIN(cond, bar) do { unsigned _sp = 0; while (cond) { __builtin_amdgcn_s_sleep(1); \
    if ((++_sp & 255u) == 0u) { if (xb_ld(&(bar)[XB_TMO])) break; if (_sp > XB_SPIN_CAP) { atomicAdd(&(bar)[XB_TMO], 1u); break; } } } } while (0)
struct XcdBarrier { unsigned* bar; unsigned x; volatile LAS unsigned* st; };
DI XcdBarrier xcd_barrier_post(unsigned* bar, volatile LAS unsigned* st) {
    XcdBarrier b; b.bar = bar; b.x = xb_xcc_id(); b.st = st;
    if (TIDX() == 0) (void)xb_add(&bar[XB_XCNT(b.x)], 1u);
    return b;
}
DI void xcd_barrier_complete(unsigned* bar, unsigned x, unsigned& nloc, unsigned& nx) {
    const unsigned G = gridDim.x * gridDim.y * gridDim.z;
    unsigned sum, cnt, mine, sp = 0u;
    for (;;) {
        sum = 0u; cnt = 0u; mine = 0u;
#pragma unroll
        for (unsigned j = 0; j < 16; ++j) { const unsigned c = xb_ld(&bar[XB_XCNT(j)]); sum += c; cnt += (c > 0u) ? 1u : 0u; mine = (j == x) ? c : mine; }
        if (sum == G) break;
        __builtin_amdgcn_s_sleep(1);
        if ((++sp & 255u) == 0u) { if (xb_ld(&bar[XB_TMO])) break; if (sp > XB_SPIN_CAP) { atomicAdd(&bar[XB_TMO], 1u); break; } }
    }
    nloc = mine > 0u ? mine : 1u; nx = cnt > 0u ? cnt : 1u;
}
DI void xcd_barrier(const XcdBarrier& b) {
    asm volatile("s_waitcnt vmcnt(0)" ::: "memory");
    __syncthreads();
    if (TIDX() == 0) {
        unsigned* bar = b.bar;
        __builtin_amdgcn_s_waitcnt(0);
        unsigned nloc = b.st[0], nx = b.st[1];
        if (nloc == 0u) { xcd_barrier_complete(bar, b.x, nloc, nx); b.st[0] = nloc; b.st[1] = nx; }
        const unsigned old = xb_add(&bar[XB_XSUB(b.x)], 1u);
        const unsigned gen = old / nloc;
        if (old + 1u == (gen + 1u) * nloc) {
            __builtin_amdgcn_fence(__ATOMIC_RELEASE, "agent");
            asm volatile("s_waitcnt vmcnt(0)" ::: "memory");
            const unsigned og = xb_add(&bar[XB_TOP], 1u);
            const unsigned tg = og / nx;
            if (og + 1u == (tg + 1u) * nx) xb_add(&bar[XB_TOPGEN], 1u);
            else XB_SPIN(xb_ld(&bar[XB_TOPGEN]) == tg, bar);
            __builtin_amdgcn_fence(__ATOMIC_ACQUIRE, "agent");
            xb_add(&bar[XB_XGEN(b.x)], 1u);
            asm volatile("s_waitcnt vmcnt(0)" ::: "memory");
        } else {
            XB_SPIN(xb_ld(&bar[XB_XGEN(b.x)]) == gen, bar);
            __builtin_amdgcn_fence(__ATOMIC_ACQUIRE, "agent");
            asm volatile("s_waitcnt vmcnt(0)" ::: "memory");
        }
    }
    __syncthreads();
}
#endif

constexpr size_t WS_WQ = WS_BAR + 16384;
#ifdef EMU
DI int wq_fetch(unsigned* c) { const unsigned v = *c; *c = v + 1; return (int)v; }
#else
DI int wq_fetch(unsigned* c) { return (int)__hip_atomic_fetch_add(c, 1u, __ATOMIC_RELAXED, __HIP_MEMORY_SCOPE_AGENT); }
#endif
DI int wq_next(const Params& p, int qid, char* smem) {
    volatile int* slot = (volatile int*)(smem + LDS_BYTES - 32);
    __syncthreads();
    if (TIDX() == 0) *slot = wq_fetch((unsigned*)(p.ws + WS_WQ) + qid * 64);
    __syncthreads();
    return RFL(*slot);
}

DI void p0_transpose_item(const float* W, int K, int N, bf16* WT, int item, char* smem) {
    float* scr = (float*)smem;
    const int tid = TIDX(), nblk = N / 64, k0 = (item / nblk) * 64, n0 = (item % nblk) * 64;
#pragma unroll
    for (int i = 0; i < 8; ++i) { const int kk = (tid >> 6) + 8 * i, nn = tid & 63; scr[kk * 65 + nn] = W[(size_t)(k0 + kk) * N + n0 + nn]; }
    __syncthreads();
    const int n = tid >> 3, c = tid & 7;
    const float* s = scr + (8 * c) * 65 + n;
    u32x4 o; o.x = pack2(s[0], s[65]); o.y = pack2(s[2 * 65], s[3 * 65]); o.z = pack2(s[4 * 65], s[5 * 65]); o.w = pack2(s[6 * 65], s[7 * 65]);
    *(u32x4*)(WT + (size_t)(n0 + n) * K + k0 + 8 * c) = o;
    __syncthreads();
}
DI void p0_mod_item(const Params& p, int item, char* smem) {
    constexpr int NCH = 3 * D_MODEL / 64, KG = D_MODEL / 8;
    float* tab = (float*)smem;
    float* red = tab + NR * D_MODEL;
    const int tid = TIDX(), l = item / NCH, col = (item % NCH) * 64 + (tid & 63), kg = tid >> 6;
    for (int e = tid; e < NR * D_MODEL; e += NTHR) { const int r = e / D_MODEL, k = e % D_MODEL; const float cv = r == 0 ? p.in[I_CCTX][k] : p.in[I_C][(size_t)(r - 1) * D_MODEL + k]; tab[e] = silu_f(cv); }
    __syncthreads();
    float acc[NR];
#pragma unroll
    for (int r = 0; r < NR; ++r) acc[r] = 0.f;
    const float* w = p.in[I_MODW] + (size_t)l * D_MODEL * 3 * D_MODEL + (size_t)(kg * KG) * 3 * D_MODEL + col;
#pragma unroll 16
    for (int k = 0; k < KG; ++k) { const float wv = w[(size_t)k * 3 * D_MODEL];
#pragma unroll
        for (int r = 0; r < NR; ++r) acc[r] += tab[r * D_MODEL + kg * KG + k] * wv; }
#pragma unroll
    for (int r = 0; r < NR; ++r) red[(kg * NR + r) * 64 + (tid & 63)] = acc[r];
    __syncthreads();
    for (int e = tid; e < NR * 64; e += NTHR) {
        const int r = e >> 6, c = e & 63, cc = (item % NCH) * 64 + c;
        float s = p.in[I_MODB][(size_t)l * 3 * D_MODEL + cc];
#pragma unroll
        for (int g = 0; g < 8; ++g) s += red[(g * NR + r) * 64 + c];
        ((float*)(p.ws + WS_MOD))[((size_t)l * NR + r) * 3 * D_MODEL + cc] = s;
    }
    __syncthreads();
}
DI void p0_rope_item(const Params& p, int item) {
    const int e = item * NTHR + TIDX();
    if (e < DEC_SEQ * 32) {
        const int t = e >> 5, a = (e >> 4) & 1, f = e & 15;
        const float pos = (float)(a ? (t % GRID_W) : (t / GRID_W));
        const float inv = exp2f(-(float)f * (13.287712379549449f / 16.f));
        const float ang = pos * inv;
        f32x2 v; v.x = cosf(ang); v.y = sinf(ang);
        ((f32x2*)(p.ws + WS_ROPE))[e] = v;
    }
}
DI void p0_hid2_item(const Params& p, int item) {
    const int lane = TIDX() & 63, w = TIDX() >> 6;
    const int r0 = item * 64, l = r0 / (SEQ + DEC_SEQ), q0 = r0 % (SEQ + DEC_SEQ);
    const int L = q0 < SEQ ? SEQ : DEC_SEQ, tb = (q0 < SEQ ? q0 : q0 - SEQ) + w * 8;
    const float* w1 = p.in[I_FW1] + (size_t)l * FE * FH + lane; const float* w2 = p.in[I_FW2] + (size_t)l * FH * FH + lane;
    float wa[FE], wb[FH];
#pragma unroll
    for (int i = 0; i < FE; ++i) wa[i] = w1[i * FH];
#pragma unroll
    for (int i = 0; i < FH; ++i) wb[i] = w2[i * FH];
    const float fq = p.in[I_FFREQ][l * FH + lane], b1 = p.in[I_FB1][l * FH + lane], b2 = p.in[I_FB2][l * FH + lane];
    float* dst = (float*)(p.ws + WS_HID2) + (size_t)l * (SEQ + DEC_SEQ) * FH + (q0 < SEQ ? 0 : (size_t)SEQ * FH) + (size_t)lane * L;
#pragma unroll 1
    for (int r = 0; r < 8; ++r) {
        const int t = tb + r;
        float feat = 0.f;
        if (lane == 0) feat = (float)t / (float)(L - 1);
        else if (lane < FE) {
            const int b = (lane - 1) & 15;
            const float fr = 1e-4f + (float)b * ((15.f - 1e-4f) / 15.f);
            const float ang = (6.283185307179586f / (float)L) * (float)t;
            feat = lane <= 16 ? cosf(fr * ang) : -sinf(fr * ang);
        }
        float a1 = b1;
#pragma unroll
        for (int i = 0; i < FE; ++i) a1 += __shfl(feat, i) * wa[i];
        const float h1 = sinf(fq * a1);
        float a2 = b2;
#pragma unroll
        for (int i = 0; i < FH; ++i) a2 += __shfl(h1, i) * wb[i];
        dst[t] = sinf(fq * a2);
    }
}
DI void p0_cache_item(const Params& p, int item) {
    constexpr int NCHUNK = DEC_BATCH * DEPTH * PAST_LEN * KV_W / 8;
    int e = item * NTHR + TIDX();
    if (e < 2 * NCHUNK) {
        const bool isv = e >= NCHUNK; if (isv) e -= NCHUNK;
        const int c8 = e & 7, j = (e >> 3) % PAST_LEN, kvh = (e >> 3) / PAST_LEN % N_KV, bl = (e >> 3) / PAST_LEN / N_KV;
        const float* src = p.in[isv ? I_CV : I_CK] + ((size_t)(bl * PAST_LEN + j) * N_KV + kvh) * HD + c8 * 8;
        u32x4 o; o.x = pack2(src[0], src[1]); o.y = pack2(src[2], src[3]); o.z = pack2(src[4], src[5]); o.w = pack2(src[6], src[7]);
        *(u32x4*)((bf16*)(p.ws + (isv ? WS_CVTB : WS_CKB)) + (size_t)e * 8) = o;
    }
}

DI const float* x_row_src(const Params& p, int l, int m) {
    if (l == 0) return m < TC ? p.in[I_XP] + (size_t)m * D_MODEL : p.in[I_XS] + (size_t)(m - TC) * D_MODEL;
    return p.out + (size_t)m * D_MODEL;
}
DI void norm_rows2(const Params& p, int l, int m0, int lane) {
    constexpr int NV = (D_MODEL / 4 + 63) / 64;
    f32x4 v[2][NV]; float ss[2] = {0.f, 0.f};
#pragma unroll
    for (int r = 0; r < 2; ++r) {
        const float* xr = x_row_src(p, l, m0 + r);
#pragma unroll
        for (int i = 0; i < NV; ++i) { const int c4 = lane + 64 * i; v[r][i] = c4 < D_MODEL / 4 ? *(const f32x4*)(xr + 4 * c4) : (f32x4){0.f, 0.f, 0.f, 0.f}; }
    }
#pragma unroll
    for (int r = 0; r < 2; ++r)
#pragma unroll
        for (int i = 0; i < NV; ++i) ss[r] += v[r][i].x * v[r][i].x + v[r][i].y * v[r][i].y + v[r][i].z * v[r][i].z + v[r][i].w * v[r][i].w;
#pragma unroll
    for (int o = 1; o < 64; o <<= 1) { ss[0] += __shfl_xor(ss[0], o); ss[1] += __shfl_xor(ss[1], o); }
#pragma unroll
    for (int r = 0; r < 2; ++r) {
        const int m = m0 + r;
        const float rstd = rsqrtf(ss[r] * (1.f / D_MODEL) + 1e-6f);
        if (l < DEPTH) {
            const float* g = p.in[I_NORMG] + (size_t)l * D_MODEL;
            const float* mod = (const float*)(p.ws + WS_MOD) + ((size_t)l * NR + mod_row(m)) * 3 * D_MODEL;
            bf16* xn = (bf16*)(p.ws + WS_XN) + (size_t)m * D_MODEL;
#pragma unroll
            for (int i = 0; i < NV; ++i) {
                const int c4 = lane + 64 * i;
                if (c4 < D_MODEL / 4) {
                    const f32x4 x = v[r][i], gv = *(const f32x4*)(g + 4 * c4), sh = *(const f32x4*)(mod + 4 * c4), sc = *(const f32x4*)(mod + D_MODEL + 4 * c4);
                    u32x2 o; o.x = pack2(x.x * rstd * gv.x * (1.f + sc.x) + sh.x, x.y * rstd * gv.y * (1.f + sc.y) + sh.y);
                    o.y = pack2(x.z * rstd * gv.z * (1.f + sc.z) + sh.z, x.w * rstd * gv.w * (1.f + sc.w) + sh.w);
                    *(u32x2*)(xn + 4 * c4) = o;
                }
            }
        } else {
            const float* g = p.in[I_FINALG];
            float* yo = p.out + (size_t)m * D_MODEL;
#pragma unroll
            for (int i = 0; i < NV; ++i) {
                const int c4 = lane + 64 * i;
                if (c4 < D_MODEL / 4) {
                    const f32x4 x = v[r][i], gv = *(const f32x4*)(g + 4 * c4);
                    f32x4 o; o.x = x.x * rstd * gv.x; o.y = x.y * rstd * gv.y; o.z = x.z * rstd * gv.z; o.w = x.w * rstd * gv.w;
                    *(f32x4*)(yo + 4 * c4) = o;
                }
            }
        }
    }
}
DI void norm_item(const Params& p, int l, int item) {
    norm_rows2(p, l, item * 16 + 2 * (TIDX() >> 6), TIDX() & 63);
}

DI int swz128(int row, int c) { return row * 128 + ((c ^ ((row >> 1) & 7)) << 4); }
constexpr int BM = 256, BK = 64, HALFT = 128, HTB = HALFT * BK * 2, STAGE_BYTES = 8 * HTB;
static_assert(STAGE_BYTES <= LDS_BYTES - 32 && 2 * 8704 * 8 + 128 <= LDS_BYTES - 16, "lds");
DI int lds_byte(int r, int c) { const int st = (r >> 4) * 2 + (c >> 5), rr = r & 15, cc = c & 31, ob = rr * 64 + cc * 2; return st * 1024 + (ob ^ (((ob >> 9) & 1) << 5)); }
DI void stage_rc(int b, int& R, int& C) { const int st = b / 1024, sb = b % 1024, swz = sb ^ (((sb >> 9) & 1) << 5); R = (st >> 1) * 16 + swz / 64; C = (st & 1) * 32 + (swz % 64) / 2; }
DI int perm32(int rho) { const int n = rho >> 4, i = rho & 15; return 8 * (i >> 2) + 4 * n + (i & 3); }
struct Unit { int pm, pn, kind; };
DI void static_order(int L, int nM, int nN, int& pm, int& pn) {
    constexpr int NXCD = 8, WGM = 8;
    const int nwg = nM * nN;
    int wgid = L; { const int q = nwg / NXCD, r = nwg % NXCD, xcd = wgid % NXCD, off = wgid / NXCD; wgid = (xcd < r ? xcd * (q + 1) : r * (q + 1) + (xcd - r) * q) + off; }
    const int nig = WGM * nN, gid = wgid / nig, fm = gid * WGM, gsz = (nM - fm) < WGM ? (nM - fm) : WGM;
    pm = fm + ((wgid % nig) % gsz); pn = (wgid % nig) / gsz;
}
constexpr int NT_TOK = (IN_COLS - 4 * HYENA_W) / 256, NT_TOKA = C_HV / 256, NT_CH = 4 * HYENA_W / 256, NTM = T / 256;
constexpr int NU_TOK = NTM * NT_TOK, NU_CH = NT_CH * NTM, NU_OUT = NTM * (D_MODEL / 256);
struct GemmJob {
    Params p; int mode, l, K;
    DI bool next(int i, Unit& u) const {
        const int L = i * (int)gridDim.x + BIDX();
        if (mode == 0) {
            if (L < NU_TOK) { u.kind = 0; static_order(L, NTM, NT_TOK, u.pm, u.pn); return true; }
            if (L < NU_TOK + NU_CH) { u.kind = 1; static_order(L - NU_TOK, NT_CH, NTM, u.pm, u.pn); return true; }
            return false;
        }
        if (L < NU_OUT) { u.kind = 2; static_order(L, NTM, D_MODEL / 256, u.pm, u.pn); return true; }
        return false;
    }
    DI int tokcol(int pn) const { return pn < NT_TOKA ? pn * 256 : C_SB + (pn - NT_TOKA) * 256; }
    DI void ptrs(const Unit& u, const char*& a, const char*& b) const {
        const size_t rb = (size_t)K * 2;
        const char* xn = (const char*)(p.ws + WS_XN);
        if (u.kind == 0) { a = xn + (size_t)u.pm * 256 * rb; b = (const char*)(p.ws + WS_WINT) + ((size_t)l * IN_COLS + tokcol(u.pn)) * rb; }
        else if (u.kind == 1) { a = (const char*)(p.ws + WS_WINT) + ((size_t)l * IN_COLS + C_HV + u.pm * 256) * rb; b = xn + (size_t)u.pn * 256 * rb; }
        else { a = xn + (size_t)u.pm * 256 * rb; b = (const char*)(p.ws + WS_WOUTT) + ((size_t)l * D_MODEL + u.pn * 256) * rb; }
    }
    DI void epilogue(const f32x4 (&acc)[2][2][4][2], const Unit& u, int wr, int wc, int fr, int fq) const {
        if (u.kind == 0) {
            const bool ctx = u.pm * 256 < TC;
#pragma unroll 1
            for (int bj = 0; bj < 2; ++bj) {
                const int n0 = tokcol(u.pn) + 128 * bj, c0 = n0 + 32 * wc + 8 * fq;
                bf16* dst; int ld; bool sil = false; int special = 0;
                if (n0 < C_K) { dst = (bf16*)(p.ws + WS_Q) + c0; ld = ATTN_W; }
                else if (n0 < C_V) { dst = (bf16*)(p.ws + WS_KB) + (c0 - C_K); ld = KV_W; special = 1; }
                else if (n0 < C_GA) { dst = (bf16*)(p.ws + WS_VB) + (c0 - C_V); ld = KV_W; special = 2; }
                else if (n0 < C_HV) { dst = (bf16*)(p.ws + WS_GA) + (c0 - C_GA); ld = ATTN_W; sil = true; }
                else { dst = (bf16*)(p.ws + WS_SC) + (c0 - C_SB); ld = 4 * CONV_W; sil = n0 >= C_GC; }
#pragma unroll
                for (int ai = 0; ai < 2; ++ai)
#pragma unroll
                    for (int m = 0; m < 4; ++m) {
                        const int row = u.pm * 256 + 64 * wr + fr + OPQ(128 * ai + 16 * m);
                        f32x4 v0 = bj ? acc[ai][1][m][0] : acc[ai][0][m][0], v1 = bj ? acc[ai][1][m][1] : acc[ai][0][m][1];
                        if (sil) { v0.x = silu_f(v0.x); v0.y = silu_f(v0.y); v0.z = silu_f(v0.z); v0.w = silu_f(v0.w); v1.x = silu_f(v1.x); v1.y = silu_f(v1.y); v1.z = silu_f(v1.z); v1.w = silu_f(v1.w); }
                        if (special && ctx) {
                            float* o = p.out + (special == 1 ? OUT_NK : OUT_NV) + ((size_t)((row / SEQ) * DEPTH + l) * SEQ + (row % SEQ)) * KV_W + (c0 - (special == 1 ? C_K : C_V));
                            *(f32x4*)o = v0; *(f32x4*)(o + 4) = v1;
                        }
                        if (special == 1 && !ctx) {
                            const int pos = (row - TC) % DEC_SEQ, a = wc & 1, pp = fq >> 1, f0 = 8 * (fq & 1);
                            const f32x4* rp = (const f32x4*)((const f32x2*)(p.ws + WS_ROPE) + (pos * 2 + a) * 16 + f0);
                            const f32x4 r0 = rp[0], r1 = rp[1], r2 = rp[2], r3 = rp[3];
                            f32x4 o0, o1;
                            o0.x = __shfl_xor(v0.x, 32); o0.y = __shfl_xor(v0.y, 32); o0.z = __shfl_xor(v0.z, 32); o0.w = __shfl_xor(v0.w, 32);
                            o1.x = __shfl_xor(v1.x, 32); o1.y = __shfl_xor(v1.y, 32); o1.z = __shfl_xor(v1.z, 32); o1.w = __shfl_xor(v1.w, 32);
                            const float sg = pp ? 1.f : -1.f;
                            v0.x = v0.x * r0.x + sg * o0.x * r0.y; v0.y = v0.y * r0.z + sg * o0.y * r0.w; v0.z = v0.z * r1.x + sg * o0.z * r1.y; v0.w = v0.w * r1.z + sg * o0.w * r1.w;
                            v1.x = v1.x * r2.x + sg * o1.x * r2.y; v1.y = v1.y * r2.z + sg * o1.y * r2.w; v1.z = v1.z * r3.x + sg * o1.z * r3.y; v1.w = v1.w * r3.z + sg * o1.w * r3.w;
                        }
                        u32x4 w; w.x = pack2(v0.x, v0.y); w.y = pack2(v0.z, v0.w); w.z = pack2(v1.x, v1.y); w.w = pack2(v1.z, v1.w);
                        *(u32x4*)(dst + (size_t)row * ld) = w;
                        CBAR();
                    }
            }
        } else if (u.kind == 1) {
            bf16* HYT = (bf16*)(p.ws + WS_HYT);
#pragma unroll
            for (int ai = 0; ai < 2; ++ai) {
                const bool sil = u.pm * 256 + 128 * ai >= 3 * HYENA_W;
#pragma unroll
                for (int m = 0; m < 4; ++m) {
                    const int ch = u.pm * 256 + 64 * wr + fr + OPQ(128 * ai + 16 * m);
#pragma unroll
                    for (int bj = 0; bj < 2; ++bj) {
                        f32x4 v0 = acc[ai][bj][m][0], v1 = acc[ai][bj][m][1];
                        if (sil) { v0.x = silu_f(v0.x); v0.y = silu_f(v0.y); v0.z = silu_f(v0.z); v0.w = silu_f(v0.w); v1.x = silu_f(v1.x); v1.y = silu_f(v1.y); v1.z = silu_f(v1.z); v1.w = silu_f(v1.w); }
                        u32x4 w; w.x = pack2(v0.x, v0.y); w.y = pack2(v0.z, v0.w); w.z = pack2(v1.x, v1.y); w.w = pack2(v1.z, v1.w);
                        *(u32x4*)(HYT + (size_t)ch * T + u.pn * 256 + 128 * bj + 32 * wc + 8 * fq) = w;
                        CBAR();
                    }
                }
            }
        } else {
            const float* gate = (const float*)(p.ws + WS_MOD) + ((size_t)l * NR + mod_row(u.pm * 256)) * 3 * D_MODEL + 2 * D_MODEL;
#pragma unroll 1
            for (int h2 = 0; h2 < 4; ++h2) {
                const int bj = h2 >> 1, ai = h2 & 1;
                const int n = u.pn * 256 + 128 * OPQ(bj) + 32 * wc + 8 * fq;
                const f32x4 g0 = *(const f32x4*)(gate + n), g1 = *(const f32x4*)(gate + n + 4);
                f32x4 x0[4], x1[4];
#pragma unroll
                for (int m = 0; m < 4; ++m) {
                    const float* xs = x_row_src(p, l, u.pm * 256 + 64 * wr + fr + 128 * ai + 16 * m) + n;
                    x0[m] = *(const f32x4*)xs; x1[m] = *(const f32x4*)(xs + 4);
                }
#pragma unroll
                for (int m = 0; m < 4; ++m) {
                    float* o = p.out + (size_t)(u.pm * 256 + 64 * wr + fr + 128 * ai + 16 * m) * D_MODEL + n;
                    const f32x4 a0 = h2 == 0 ? acc[0][0][m][0] : (h2 == 1 ? acc[1][0][m][0] : (h2 == 2 ? acc[0][1][m][0] : acc[1][1][m][0]));
                    const f32x4 a1 = h2 == 0 ? acc[0][0][m][1] : (h2 == 1 ? acc[1][0][m][1] : (h2 == 2 ? acc[0][1][m][1] : acc[1][1][m][1]));
                    *(f32x4*)o = x0[m] + g0 * a0; *(f32x4*)(o + 4) = x1[m] + g1 * a1;
                }
            }
        }
    }
};

#ifdef EMU
typedef unsigned char* ldsptr_t;
#else
typedef LAS unsigned char* ldsptr_t;
#endif
DI void gemm_phase(ldsptr_t lds, const GemmJob& S) {
    const int tid = TIDX(), wid = RFL(tid >> 6), lane = tid & 63, wr = wid >> 2, wc = wid & 3, fr = lane & 15, fq = lane >> 4;
    const int K = S.K, nt = K / BK;
    unsigned voffA[2], voffB[2];
#pragma unroll
    for (int i = 0; i < 2; ++i) { int R, C; stage_rc(tid * 16 + i * 8192, R, C); const int Rb = (R & ~31) + perm32(R & 31);
        voffA[i] = (unsigned)(R * K + C) * 2u; voffB[i] = (unsigned)(Rb * K + C) * 2u; }
    const size_t kstep = (size_t)(BK * 2);
    const size_t hstep = (size_t)HALFT * K * 2;
    const unsigned ldsw = (unsigned)wid * 1024u;
    const int aoff = lds_byte(wr * 64 + fr, fq * 8), boff = lds_byte(wc * 32 + fr, fq * 8);
#define PG8_SA(b, h) (((b) * 2 + (h)) * HTB)
#define PG8_SB(b, h) ((4 + (b) * 2 + (h)) * HTB)
#define PG8_STAGE(bufoff, gbase, voff) do { _Pragma("unroll") for (int _i = 0; _i < 2; ++_i) GLDS16((const char*)(gbase) + (voff)[_i], lds + (bufoff) + ldsw + _i * 8192); } while (0)
#define PG8_LDA(dst, b, h) do { _Pragma("unroll") for (int m = 0; m < 4; ++m) _Pragma("unroll") for (int k = 0; k < 2; ++k) dst[m][k] = *(const LAS bf16x8*)(lds + PG8_SA(b, h) + aoff + m * 2048 + k * 1024); } while (0)
#define PG8_LDB(dst, b, h) do { _Pragma("unroll") for (int n = 0; n < 2; ++n) _Pragma("unroll") for (int k = 0; k < 2; ++k) dst[n][k] = *(const LAS bf16x8*)(lds + PG8_SB(b, h) + boff + n * 2048 + k * 1024); } while (0)
#define PG8_MMA(ai, bj, At, Bt) do { SETPRIO(1); _Pragma("unroll") for (int m = 0; m < 4; ++m) _Pragma("unroll") for (int n = 0; n < 2; ++n) _Pragma("unroll") for (int k = 0; k < 2; ++k) \
        acc[ai][bj][m][n] = MFMA16(Bt[n][k], At[m][k], acc[ai][bj][m][n]); SETPRIO(0); } while (0)
    Unit cur, nxt; int ui = 0;
    if (!S.next(0, cur)) return;
    f32x4 acc[2][2][4][2];
#pragma unroll
    for (int a = 0; a < 2; ++a)
#pragma unroll
        for (int b = 0; b < 2; ++b)
#pragma unroll
            for (int m = 0; m < 4; ++m)
#pragma unroll
                for (int n = 0; n < 2; ++n) acc[a][b][m][n] = (f32x4){0.f, 0.f, 0.f, 0.f};
    bf16x8 At[4][2], B0[2][2], B1[2][2];
    const char* cA; const char* cB; S.ptrs(cur, cA, cB);
    PG8_STAGE(PG8_SB(0, 0), cB, voffB); PG8_STAGE(PG8_SA(0, 0), cA, voffA); PG8_STAGE(PG8_SB(0, 1), cB + hstep, voffB); PG8_STAGE(PG8_SA(0, 1), cA + hstep, voffA);
    if (wr == 1) S_BARRIER();
    WAIT_V(4); S_BARRIER();
    PG8_STAGE(PG8_SB(1, 0), cB + kstep, voffB); PG8_STAGE(PG8_SA(1, 0), cA + kstep, voffA); PG8_STAGE(PG8_SB(1, 1), cB + hstep + kstep, voffB);
    WAIT_V(6); S_BARRIER();
    for (;;) {
        const bool has_next = S.next(ui + 1, nxt);
        const char* nA = cA; const char* nB = cB; if (has_next) S.ptrs(nxt, nA, nB);
        PRB_BEGIN_NS(3) PRB_BEGIN_NS(5)
        for (int t = 0; t < nt; t += 2) {
            const bool last = (t == nt - 2);
            const char* a1 = cA + (size_t)(t + 1) * kstep;
            const char* a2 = last ? nA : cA + (size_t)(t + 2) * kstep; const char* b2 = last ? nB : cB + (size_t)(t + 2) * kstep;
            const char* a3 = a2 + kstep; const char* b3 = b2 + kstep;
            PG8_LDB(B0, 0, 0); SCHED_BAR(); PG8_LDA(At, 0, 0); PG8_STAGE(PG8_SA(1, 1), a1 + hstep, voffA);
            WAIT_L(8); S_BARRIER(); WAIT_L(0); PG8_MMA(0, 0, At, B0); S_BARRIER(); SCHED_BAR();
            PG8_LDB(B1, 0, 1); PG8_STAGE(PG8_SB(0, 0), b2, voffB);
            S_BARRIER(); WAIT_L(0); PG8_MMA(0, 1, At, B1); S_BARRIER();
            PG8_LDA(At, 0, 1); PG8_STAGE(PG8_SA(0, 0), a2, voffA);
            S_BARRIER(); WAIT_L(0); PG8_MMA(1, 0, At, B0); S_BARRIER(); SCHED_BAR();
            PG8_STAGE(PG8_SB(0, 1), b2 + hstep, voffB);
            WAIT_V(6); S_BARRIER(); PG8_MMA(1, 1, At, B1); S_BARRIER();
            PG8_LDB(B0, 1, 0); SCHED_BAR(); PG8_LDA(At, 1, 0); PG8_STAGE(PG8_SA(0, 1), a2 + hstep, voffA);
            WAIT_L(8); S_BARRIER(); WAIT_L(0); PG8_MMA(0, 0, At, B0); S_BARRIER(); SCHED_BAR();
            PG8_LDB(B1, 1, 1); PG8_STAGE(PG8_SB(1, 0), b3, voffB);
            S_BARRIER(); WAIT_L(0); PG8_MMA(0, 1, At, B1); S_BARRIER();
            PG8_LDA(At, 1, 1); PG8_STAGE(PG8_SA(1, 0), a3, voffA);
            S_BARRIER(); WAIT_L(0); PG8_MMA(1, 0, At, B0); S_BARRIER(); SCHED_BAR();
            PG8_STAGE(PG8_SB(1, 1), b3 + hstep, voffB);
            WAIT_V(6); S_BARRIER(); PG8_MMA(1, 1, At, B1); S_BARRIER();
        }
        if (S.mode == 0) { PRB_END_NS(3, (char*)lds) } else { PRB_END_NS(5, (char*)lds) }
        PRB_BEGIN_NS(4) PRB_BEGIN_NS(6)
        S.epilogue(acc, cur, wr, wc, fr, fq);
        if (S.mode == 0) { PRB_END_NS(4, (char*)lds) } else { PRB_END_NS(6, (char*)lds) }
        if (!has_next) break;
#pragma unroll
        for (int a = 0; a < 2; ++a)
#pragma unroll
            for (int b = 0; b < 2; ++b)
#pragma unroll
                for (int m = 0; m < 4; ++m)
#pragma unroll
                    for (int n = 0; n < 2; ++n) acc[a][b][m][n] = (f32x4){0.f, 0.f, 0.f, 0.f};
        cur = nxt; cA = nA; cB = nB; ++ui;
    }
    WAIT_V(0);
    if (wr == 0) S_BARRIER();
    S_BARRIER();
#undef PG8_SA
#undef PG8_SB
#undef PG8_STAGE
#undef PG8_LDA
#undef PG8_LDB
#undef PG8_MMA
}

DI void unpack8(const u32x4 v, float (&f)[8]) {
    f[0] = __uint_as_float(v.x << 16); f[1] = __uint_as_float(v.x & 0xffff0000u); f[2] = __uint_as_float(v.y << 16); f[3] = __uint_as_float(v.y & 0xffff0000u);
    f[4] = __uint_as_float(v.z << 16); f[5] = __uint_as_float(v.z & 0xffff0000u); f[6] = __uint_as_float(v.w << 16); f[7] = __uint_as_float(v.w & 0xffff0000u);
}
DI int PADX(int i) { return i + (i >> 4); }
constexpr int FB_BANK = 8704;
template <int SIGN> DI void dft4(cpx& a0, cpx& a1, cpx& a2, cpx& a3) {
    const cpx t0 = a0 + a2, t1 = a0 - a2, t2 = a1 + a3, t3 = a1 - a3;
    const cpx t3r = SIGN < 0 ? cpx{t3.y, -t3.x} : cpx{-t3.y, t3.x};
    a0 = t0 + t2; a1 = t1 + t3r; a2 = t0 - t2; a3 = t1 - t3r;
}
template <int SIGN> DI void dft16(cpx (&v)[16]) {
#pragma unroll
    for (int n2 = 0; n2 < 4; ++n2) dft4<SIGN>(v[n2], v[4 + n2], v[8 + n2], v[12 + n2]);
    constexpr float C1 = 0.92387953251128674f, S1 = 0.38268343236508977f, R = 0.70710678118654752f, SG = (float)SIGN;
    v[5] = cmul(v[5], cpx{C1, SG * S1});  v[6] = cmul(v[6], cpx{R, SG * R});     v[7] = cmul(v[7], cpx{S1, SG * C1});
    v[9] = cmul(v[9], cpx{R, SG * R});    v[10] = cmul(v[10], cpx{0.f, SG});     v[11] = cmul(v[11], cpx{-R, SG * R});
    v[13] = cmul(v[13], cpx{S1, SG * C1}); v[14] = cmul(v[14], cpx{-R, SG * R}); v[15] = cmul(v[15], cpx{-C1, -SG * S1});
#pragma unroll
    for (int k1 = 0; k1 < 4; ++k1) dft4<SIGN>(v[4 * k1], v[4 * k1 + 1], v[4 * k1 + 2], v[4 * k1 + 3]);
}
template <int SIGN> DI void fft_pass16x2(cpx* fa, cpx* fb, int j, int Ns, int N16) {
    cpx va[16], vb[16];
#pragma unroll
    for (int r = 0; r < 16; ++r) { const int ix = PADX(j + N16 * r); va[r] = fa[ix]; vb[r] = fb[ix]; }
    const int k = j & (Ns - 1);
    if (Ns > 1) {
        float sn, cs; sincospif((float)(SIGN * 2 * k) / (float)(16 * Ns), &sn, &cs);
        cpx w[16];
        w[1] = cpx{cs, sn}; w[2] = cmul(w[1], w[1]); w[3] = cmul(w[2], w[1]); w[4] = cmul(w[2], w[2]); w[5] = cmul(w[4], w[1]); w[6] = cmul(w[4], w[2]); w[7] = cmul(w[4], w[3]); w[8] = cmul(w[4], w[4]);
#pragma unroll
        for (int r = 9; r < 16; ++r) w[r] = cmul(w[8], w[r - 8]);
#pragma unroll
        for (int r = 1; r < 16; ++r) { va[r] = cmul(va[r], w[r]); vb[r] = cmul(vb[r], w[r]); }
    }
    dft16<SIGN>(va); dft16<SIGN>(vb);
    __syncthreads();
    const int base = (j - k) * 16 + k;
#pragma unroll
    for (int kk = 0; kk < 16; ++kk) { const int ix = PADX(base + kk * Ns); fa[ix] = va[4 * (kk & 3) + (kk >> 2)]; fb[ix] = vb[4 * (kk & 3) + (kk >> 2)]; }
    __syncthreads();
}
template <int SIGN> DI void fft_passes(cpx* fa, cpx* fb, int j, int Ns0, int np16, int N16) {
#pragma unroll 1
    for (int ps = 0, Ns = Ns0; ps < np16; ++ps, Ns <<= 4) fft_pass16x2<SIGN>(fa, fb, j, Ns, N16);
}
DI cpx conv_out(const cpx* fb, int t, int L) {
    const cpx a = fb[PADX(t)], b = fb[PADX(t + L)];
    float sn, cs; sincospif((float)t / (float)L, &sn, &cs);
    const cpx wb = cmul(cpx{cs, sn}, b);
    const float rn = 0.5f / (float)L;
    return (a + wb) * rn;
}
DI float conv3(const bf16* ptr, int t, int L, float w0, float w1, float w2) {
    const float a = t > 0 ? bf2f(ptr[t - 1]) : 0.f, b = bf2f(ptr[t]), c = t < L - 1 ? bf2f(ptr[t + 1]) : 0.f;
    return a * w0 + b * w1 + c * w2;
}
DI void filter_item(const Params& p, int l, int item, char* smem, bool lat) {
    const int np16 = lat ? 3 : 2, N16 = lat ? 512 : 32, N = 16 * N16, L = N / 2;
    const int tid = TIDX(), sub = tid / N16, j = tid % N16;
    const int c = lat ? item : item * 16 + sub;
    cpx* fa = (cpx*)smem + sub * (N + N / 16); cpx* fb = fa + FB_BANK;
    float* red = (float*)(smem + 2 * FB_BANK * 8);
    const float* hid = (const float*)(p.ws + WS_HID2) + ((size_t)l * (SEQ + DEC_SEQ) + (lat ? SEQ : 0)) * FH + 8 * j;
    const float* w3 = p.in[I_FW3] + (size_t)l * FH * 4 * HYENA_W + c;
    float f0[8], f1[8], b0[8], b1[8];
#pragma unroll
    for (int i = 0; i < 8; ++i) { f0[i] = 0.f; f1[i] = 0.f; b0[i] = 0.f; b1[i] = 0.f; }
#pragma unroll 8
    for (int q = 0; q < FH; ++q) {
        const float* wq = w3 + (size_t)q * 4 * HYENA_W;
        const float wf0 = wq[0], wf1 = wq[HYENA_W], wb0 = wq[2 * HYENA_W], wb1 = wq[3 * HYENA_W];
        const f32x4 h0 = *(const f32x4*)(hid + (size_t)q * L), h1 = *(const f32x4*)(hid + (size_t)q * L + 4);
        const float hv[8] = {h0.x, h0.y, h0.z, h0.w, h1.x, h1.y, h1.z, h1.w};
#pragma unroll
        for (int i = 0; i < 8; ++i) { f0[i] += hv[i] * wf0; f1[i] += hv[i] * wf1; b0[i] += hv[i] * wb0; b1[i] += hv[i] * wb1; }
    }
    const float min_decay = -4.605170185988091f / 1.5f, max_decay = -4.605170185988091f / 0.3f;
    const float delta = fabsf(min_decay + (max_decay - min_decay) * (float)c / (float)(HYENA_W - 1));
    float as0 = 0.f, as1 = 0.f;
#pragma unroll
    for (int i = 0; i < 8; ++i) {
        const int t = 8 * j + i;
        const float dec = __expf(-((float)t / (float)(L - 1)) * delta);
        const float vf0 = f0[i] * dec, vf1 = f1[i] * dec, vb0 = b0[i] * dec, vb1 = b1[i] * dec;
        fa[PADX(t)] = cpx{vf0, 0.f}; fb[PADX(t)] = cpx{vf1, 0.f};
        if (t == 0) { fa[PADX(L)] = cpx{0.f, 0.f}; fb[PADX(L)] = cpx{0.f, 0.f}; } else { fa[PADX(N - t)] = cpx{vb0, 0.f}; fb[PADX(N - t)] = cpx{vb1, 0.f}; }
        as0 += fabsf(vf0) + (t == 0 ? 0.f : fabsf(vb0)); as1 += fabsf(vf1) + (t == 0 ? 0.f : fabsf(vb1));
    }
#pragma unroll
    for (int s = 1; s < 32; s <<= 1) { as0 += __shfl_xor(as0, s); as1 += __shfl_xor(as1, s); }
    if (lat) {
        as0 += __shfl_xor(as0, 32); as1 += __shfl_xor(as1, 32);
        if ((tid & 63) == 0) { red[tid >> 6] = as0; red[8 + (tid >> 6)] = as1; }
    }
    __syncthreads();
    if (lat) { as0 = 0.f; as1 = 0.f;
#pragma unroll
        for (int q = 0; q < 8; ++q) { as0 += red[q]; as1 += red[8 + q]; } }
    const float rn0 = 1.f / as0, rn1 = 1.f / as1;
    {
        cpx a0[8], a1[8], c0[8], c1[8];
#pragma unroll
        for (int i = 0; i < 8; ++i) { const int t = j + N16 * i; a0[i] = fa[PADX(t)]; c0[i] = fa[PADX(t + L)]; a1[i] = fb[PADX(t)]; c1[i] = fb[PADX(t + L)]; }
        __syncthreads();
#pragma unroll
        for (int i = 0; i < 8; ++i) { const int t = j + N16 * i; fa[PADX(2 * t)] = a0[i] + c0[i]; fa[PADX(2 * t + 1)] = a0[i] - c0[i]; fb[PADX(2 * t)] = a1[i] + c1[i]; fb[PADX(2 * t + 1)] = a1[i] - c1[i]; }
        __syncthreads();
    }
    fft_passes<-1>(fa, fb, j, 2, np16, N16);
    cpx* kf0 = (cpx*)(p.ws + (lat ? WS_KFL + (l & 1) * KFL_BYTES : WS_KFC + (l & 1) * KFC_BYTES)) + (size_t)c * N; cpx* kf1 = kf0 + (size_t)HYENA_W * N;
#pragma unroll 4
    for (int i = 0; i < 16; ++i) { const int f = j + N16 * i; kf0[f] = fa[PADX(f)] * rn0; kf1[f] = fb[PADX(f)] * rn1; }
    __syncthreads();
}

DI void conv3x8(const bf16* row, int t0, int L, float w0, float w1, float w2, float (&o)[8]) {
    float v[8]; unpack8(*(const u32x4*)(row + t0), v);
    const bf16 pr = row[t0 > 0 ? t0 - 1 : 0], nr = row[t0 + 8 < L ? t0 + 8 : t0];
    const float pv = t0 > 0 ? bf2f(pr) : 0.f, nx = t0 + 8 < L ? bf2f(nr) : 0.f;
    o[0] = pv * w0 + v[0] * w1 + v[1] * w2;
#pragma unroll
    for (int i = 1; i < 7; ++i) o[i] = v[i - 1] * w0 + v[i] * w1 + v[i + 1] * w2;
    o[7] = v[6] * w0 + v[7] * w1 + nx * w2;
}
DI void hyena_item(const Params& p, int l, int item, char* smem, bool lat) {
    const int np16 = lat ? 3 : 2, N16 = lat ? 512 : 32, N = 16 * N16, L = N / 2;
    const int NPAIR = lat ? DEC_BATCH / 2 : BATCH / 2;
    const int tid = TIDX(), sub = tid / N16, j = tid % N16, t0 = 8 * j;
    constexpr int IPC = (DEC_BATCH / 2 + 1) / 2;
    int cA, cB, prA, prB; bool actA, actB;
    if (lat) { cA = cB = item / IPC; prA = 2 * (item % IPC); prB = prA + 1; actA = true; actB = prB < NPAIR; }
    else { cA = 2 * item; cB = cA + 1; prA = prB = sub; actA = actB = sub < NPAIR; }
    const int tokA = (lat ? TC : 0) + (actA ? 2 * prA : 0) * L, tokB = (lat ? TC : 0) + (actB ? 2 * prB : 0) * L;
    cpx* fa = (cpx*)smem + sub * (N + N / 16); cpx* fb = fa + FB_BANK;
    const bf16* HYT = (const bf16*)(p.ws + WS_HYT);
    const float* cw = p.in[I_HYCW] + (size_t)l * 3 * 3 * HYENA_W;
    const cpx* kfbase = (const cpx*)(p.ws + (lat ? WS_KFL + (l & 1) * KFL_BYTES : WS_KFC + (l & 1) * KFC_BYTES));
    cpx* zsA = (cpx*)(p.ws + WS_ZS) + (size_t)BIDX() * 2 * 4096 + sub * L + t0; cpx* zsB = zsA + 4096;
    bf16* zoutA = (bf16*)(p.ws + WS_ZT) + (size_t)cA * T; bf16* zoutB = (bf16*)(p.ws + WS_ZT) + (size_t)cB * T;
    {
        const bf16* hvA = HYT + (size_t)cA * T + tokA;
        float a0[8], a1[8];
        conv3x8(hvA, t0, L, cw[cA], cw[3 * HYENA_W + cA], cw[6 * HYENA_W + cA], a0); conv3x8(hvA + L, t0, L, cw[cA], cw[3 * HYENA_W + cA], cw[6 * HYENA_W + cA], a1);
#pragma unroll
        for (int i = 0; i < 8; ++i) {
            const cpx ua = actA ? cpx{a0[i], a1[i]} : cpx{0.f, 0.f};
            zsA[i] = ua;
            const int ix = PADX(2 * (t0 + i));
            fa[ix] = ua; fa[ix + 1] = ua;
        }
    }
    SCHED_BAR();
    {
        const bf16* hvB = HYT + (size_t)cB * T + tokB;
        float b0[8], b1[8];
        conv3x8(hvB, t0, L, cw[cB], cw[3 * HYENA_W + cB], cw[6 * HYENA_W + cB], b0); conv3x8(hvB + L, t0, L, cw[cB], cw[3 * HYENA_W + cB], cw[6 * HYENA_W + cB], b1);
#pragma unroll
        for (int i = 0; i < 8; ++i) {
            const cpx ub = actB ? cpx{b0[i], b1[i]} : cpx{0.f, 0.f};
            zsB[i] = ub;
            const int ix = PADX(2 * (t0 + i));
            fb[ix] = ub; fb[ix + 1] = ub;
        }
    }
    __syncthreads();
#pragma unroll 1
    for (int o = 0; o < 2; ++o) {
        cpx ka[16];
        {
            const cpx* kfA = kfbase + (size_t)(o * HYENA_W + cA) * N + j;
#pragma unroll
            for (int i = 0; i < 16; ++i) ka[i] = kfA[N16 * i];
        }
        fft_passes<-1>(fa, fb, j, 2, np16, N16);
        const int t0o = OPQ(t0), tokAo = OPQ(tokA), tokBo = OPQ(tokB);
        cpx* zsAo = (cpx*)(p.ws + WS_ZS) + (size_t)BIDX() * 2 * 4096 + sub * L + t0o; cpx* zsBo = zsAo + 4096;
        const int ix0 = PADX(j), ixs = N16 + (N16 >> 4);
        if (lat) {
#pragma unroll
            for (int i = 0; i < 16; ++i) { const int ix = ix0 + OPQ(ixs * i); fa[ix] = cmul(fa[ix], ka[i]); fb[ix] = cmul(fb[ix], ka[i]); }
        } else {
            const cpx* kfB = kfbase + (size_t)(o * HYENA_W + cB) * N + j;
#pragma unroll
            for (int i = 0; i < 16; ++i) { const int ix = ix0 + OPQ(ixs * i); fa[ix] = cmul(fa[ix], ka[i]); ka[i] = kfB[OPQ(N16 * i)]; }
#pragma unroll
            for (int i = 0; i < 16; ++i) { const int ix = ix0 + OPQ(ixs * i); fb[ix] = cmul(fb[ix], ka[i]); }
        }
        __syncthreads();
        fft_passes<1>(fa, fb, j, 1, np16, N16);
        const int wo = (1 + o) * HYENA_W;
        float sn, cs; sincospif((float)t0o / (float)L, &sn, &cs); const cpx wbase = cpx{cs, sn};
        sincospif(1.f / (float)L, &sn, &cs); const cpx wstep = cpx{cs, sn};
        const float rn = 0.5f / (float)L;
        cpx za[8], zb[8];
        {
            float x0[8], x1[8];
            conv3x8(HYT + (size_t)(wo + cA) * T + tokAo, t0o, L, cw[wo + cA], cw[3 * HYENA_W + wo + cA], cw[6 * HYENA_W + wo + cA], x0);
            conv3x8(HYT + (size_t)(wo + cA) * T + tokAo + L, t0o, L, cw[wo + cA], cw[3 * HYENA_W + wo + cA], cw[6 * HYENA_W + wo + cA], x1);
            const float dd = p.in[I_HYD][(size_t)l * 2 * HYENA_W + o * HYENA_W + cA];
            cpx w = wbase;
#pragma unroll
            for (int i = 0; i < 8; ++i) {
                const cpx y = (fa[PADX(t0o + i)] + cmul(w, fa[PADX(t0o + i + L)])) * rn; w = cmul(w, wstep);
                const cpx u = zsAo[i];
                za[i] = cpx{x0[i] * (y.x + dd * u.x), x1[i] * (y.y + dd * u.y)};
            }
        }
        SCHED_BAR();
        {
            float x0[8], x1[8];
            conv3x8(HYT + (size_t)(wo + cB) * T + tokBo, t0o, L, cw[wo + cB], cw[3 * HYENA_W + wo + cB], cw[6 * HYENA_W + wo + cB], x0);
            conv3x8(HYT + (size_t)(wo + cB) * T + tokBo + L, t0o, L, cw[wo + cB], cw[3 * HYENA_W + wo + cB], cw[6 * HYENA_W + wo + cB], x1);
            const float dd = p.in[I_HYD][(size_t)l * 2 * HYENA_W + o * HYENA_W + cB];
            cpx w = wbase;
#pragma unroll
            for (int i = 0; i < 8; ++i) {
                const cpx y = (fb[PADX(t0o + i)] + cmul(w, fb[PADX(t0o + i + L)])) * rn; w = cmul(w, wstep);
                const cpx u = zsBo[i];
                zb[i] = cpx{x0[i] * (y.x + dd * u.x), x1[i] * (y.y + dd * u.y)};
            }
        }
        __syncthreads();
        if (o == 0) {
#pragma unroll
            for (int i = 0; i < 8; ++i) {
                const cpx ua = actA ? za[i] : cpx{0.f, 0.f}, ub = actB ? zb[i] : cpx{0.f, 0.f};
                zsAo[i] = ua; zsBo[i] = ub;
                const int ix = PADX(2 * (t0o + i));
                fa[ix] = ua; fa[ix + 1] = ua; fb[ix] = ub; fb[ix + 1] = ub;
            }
            __syncthreads();
        } else {
            const bf16* ghA = HYT + (size_t)(3 * HYENA_W + cA) * T + tokAo + t0o; const bf16* ghB = HYT + (size_t)(3 * HYENA_W + cB) * T + tokBo + t0o;
            float g[8]; u32x4 ov;
            if (actA) {
                unpack8(*(const u32x4*)ghA, g);
                ov.x = pack2(za[0].x * g[0], za[1].x * g[1]); ov.y = pack2(za[2].x * g[2], za[3].x * g[3]); ov.z = pack2(za[4].x * g[4], za[5].x * g[5]); ov.w = pack2(za[6].x * g[6], za[7].x * g[7]);
                *(u32x4*)(zoutA + tokAo + t0o) = ov;
                unpack8(*(const u32x4*)(ghA + L), g);
                ov.x = pack2(za[0].y * g[0], za[1].y * g[1]); ov.y = pack2(za[2].y * g[2], za[3].y * g[3]); ov.z = pack2(za[4].y * g[4], za[5].y * g[5]); ov.w = pack2(za[6].y * g[6], za[7].y * g[7]);
                *(u32x4*)(zoutA + tokAo + L + t0o) = ov;
            }
            if (actB) {
                unpack8(*(const u32x4*)ghB, g);
                ov.x = pack2(zb[0].x * g[0], zb[1].x * g[1]); ov.y = pack2(zb[2].x * g[2], zb[3].x * g[3]); ov.z = pack2(zb[4].x * g[4], zb[5].x * g[5]); ov.w = pack2(zb[6].x * g[6], zb[7].x * g[7]);
                *(u32x4*)(zoutB + tokBo + t0o) = ov;
                unpack8(*(const u32x4*)(ghB + L), g);
                ov.x = pack2(zb[0].y * g[0], zb[1].y * g[1]); ov.y = pack2(zb[2].y * g[2], zb[3].y * g[3]); ov.z = pack2(zb[4].y * g[4], zb[5].y * g[5]); ov.w = pack2(zb[6].y * g[6], zb[7].y * g[7]);
                *(u32x4*)(zoutB + tokBo + L + t0o) = ov;
            }
        }
    }
}

DI void hytr_item(const Params& p, int item, char* smem) {
    const int tid = TIDX(), tok0 = item * 64;
    const bf16* HYT = (const bf16*)(p.ws + WS_ZT); bf16* mixed = (bf16*)(p.ws + WS_XN);
    unsigned* tile = (unsigned*)smem;
    constexpr int NLD = HYENA_W * 8 / NTHR;
    u32x4 v[NLD];
#pragma unroll
    for (int i = 0; i < NLD; ++i) { const int id = tid + NTHR * i; v[i] = *(const u32x4*)(HYT + (size_t)(id >> 3) * T + tok0 + (id & 7) * 8); }
#pragma unroll
    for (int i = 0; i < NLD; ++i) {
        const int id = tid + NTHR * i, ch = id >> 3, ck = id & 7, x = (ch >> 3) & 31;
        unsigned* row = tile + ch * 32;
        row[(4 * ck) ^ x] = v[i].x; row[(4 * ck + 1) ^ x] = v[i].y; row[(4 * ck + 2) ^ x] = v[i].z; row[(4 * ck + 3) ^ x] = v[i].w;
    }
    __syncthreads();
    for (int id = tid; id < 64 * (HYENA_W / 8); id += NTHR) {
        const int cg = id % (HYENA_W / 8), tok = id / (HYENA_W / 8), x = cg & 31, sh = (tok & 1) * 16;
        unsigned e[8];
#pragma unroll
        for (int k = 0; k < 8; ++k) e[k] = (tile[(8 * cg + k) * 32 + ((tok >> 1) ^ x)] >> sh) & 0xffffu;
        u32x4 o; o.x = e[0] | (e[1] << 16); o.y = e[2] | (e[3] << 16); o.z = e[4] | (e[5] << 16); o.w = e[6] | (e[7] << 16);
        *(u32x4*)(mixed + (size_t)(tok0 + tok) * MIX_W + ATTN_W + 8 * cg) = o;
    }
    __syncthreads();
}

DI void shortconv_item(const Params& p, int l, int item) {
    const bf16* SCb = (const bf16*)(p.ws + WS_SC);
    bf16* mixed = (bf16*)(p.ws + WS_XN);
    const float* cw = p.in[I_SCW] + (size_t)l * 3 * CONV_W;
    constexpr int C8 = CONV_W / 8;
    const u32x4 zero4 = {0u, 0u, 0u, 0u};
#pragma unroll 4
    for (int e = TIDX(); e < 256 * C8; e += NTHR) {
        const int m = item * 256 + e / C8, c = (e % C8) * 8;
        const int L = m < TC ? SEQ : DEC_SEQ, t = m < TC ? m % SEQ : (m - TC) % DEC_SEQ;
        const bf16* row = SCb + (size_t)m * 4 * CONV_W + c;
        float sb[8], g0[8], x0[8], gm[8], xm[8], gn[8], xn[8], gc[8], w0[8], w1[8], w2[8];
        unpack8(*(const u32x4*)row, sb); unpack8(*(const u32x4*)(row + CONV_W), g0); unpack8(*(const u32x4*)(row + 2 * CONV_W), x0); unpack8(*(const u32x4*)(row + 3 * CONV_W), gc);
        const bf16* rowm = t > 0 ? row - 4 * CONV_W : row; const bf16* rown = t < L - 1 ? row + 4 * CONV_W : row;
        u32x4 vgm = *(const u32x4*)(rowm + CONV_W), vxm = *(const u32x4*)(rowm + 2 * CONV_W), vgn = *(const u32x4*)(rown + CONV_W), vxn = *(const u32x4*)(rown + 2 * CONV_W);
        if (t == 0) { vgm = zero4; vxm = zero4; } if (t == L - 1) { vgn = zero4; vxn = zero4; }
        unpack8(vgm, gm); unpack8(vxm, xm); unpack8(vgn, gn); unpack8(vxn, xn);
#pragma unroll
        for (int i = 0; i < 2; ++i) {
            const f32x4 a = *(const f32x4*)(cw + c + 4 * i), b = *(const f32x4*)(cw + CONV_W + c + 4 * i), d = *(const f32x4*)(cw + 2 * CONV_W + c + 4 * i);
            w0[4 * i] = a.x; w0[4 * i + 1] = a.y; w0[4 * i + 2] = a.z; w0[4 * i + 3] = a.w;
            w1[4 * i] = b.x; w1[4 * i + 1] = b.y; w1[4 * i + 2] = b.z; w1[4 * i + 3] = b.w;
            w2[4 * i] = d.x; w2[4 * i + 1] = d.y; w2[4 * i + 2] = d.z; w2[4 * i + 3] = d.w;
        }
        float o[8];
#pragma unroll
        for (int i = 0; i < 8; ++i) o[i] = sb[i] * (gm[i] * xm[i] * w0[i] + g0[i] * x0[i] * w1[i] + gn[i] * xn[i] * w2[i]) * gc[i];
        u32x4 ov; ov.x = pack2(o[0], o[1]); ov.y = pack2(o[2], o[3]); ov.z = pack2(o[4], o[5]); ov.w = pack2(o[6], o[7]);
        *(u32x4*)(mixed + (size_t)m * MIX_W + ATTN_W + HYENA_W + c) = ov;
    }
}

constexpr int AT_NKL = 320;
constexpr int AT_KL = 0, AT_VL = AT_KL + AT_NKL * 128, AT_KC = AT_VL + AT_NKL * 128, AT_VC = AT_KC + 256 * 128, AT_END = AT_VC + 256 * 128;
static_assert(AT_END <= LDS_BYTES - 16, "lds");
DI int swzv(int row, int c) { return row * 128 + ((c ^ (((row >> 1) & 1) << 2)) << 4); }
struct VFrag { u32x2 r[8]; };
#ifdef EMU
DI void v_tr_issue(const char* a0, const char* a1, VFrag& f) {
#pragma unroll
    for (int i = 0; i < 8; ++i) { const bf16x4 v = emu_ds_read_tr16((i < 4 ? a0 : a1) + 1024 * (i & 3)); f.r[i] = __builtin_bit_cast(u32x2, v); }
}
DI void v_tr_wait(VFrag&) {}
DI float fast_exp2(float x) { return exp2f(x); }
DI bool wave_any(bool pred) { return emu_wave_any(pred); }
#else
DI void v_tr_issue(const char* a0, const char* a1, VFrag& f) {
    const unsigned x0 = (unsigned)(size_t)(const LAS char*)a0, x1 = (unsigned)(size_t)(const LAS char*)a1;
    asm volatile("ds_read_b64_tr_b16 %0, %8\n\tds_read_b64_tr_b16 %1, %8 offset:1024\n\tds_read_b64_tr_b16 %2, %8 offset:2048\n\tds_read_b64_tr_b16 %3, %8 offset:3072\n\t"
                 "ds_read_b64_tr_b16 %4, %9\n\tds_read_b64_tr_b16 %5, %9 offset:1024\n\tds_read_b64_tr_b16 %6, %9 offset:2048\n\tds_read_b64_tr_b16 %7, %9 offset:3072"
                 : "=&v"(f.r[0]), "=&v"(f.r[1]), "=&v"(f.r[2]), "=&v"(f.r[3]), "=&v"(f.r[4]), "=&v"(f.r[5]), "=&v"(f.r[6]), "=&v"(f.r[7]) : "v"(x0), "v"(x1) : "memory");
}
DI void v_tr_wait(VFrag& f) {
    asm volatile("s_waitcnt lgkmcnt(0)" : "+v"(f.r[0]), "+v"(f.r[1]), "+v"(f.r[2]), "+v"(f.r[3]), "+v"(f.r[4]), "+v"(f.r[5]), "+v"(f.r[6]), "+v"(f.r[7]) :: "memory");
    __builtin_amdgcn_sched_barrier(0);
}
DI float fast_exp2(float x) { return __builtin_amdgcn_exp2f(x); }
DI bool wave_any(bool pred) { return __builtin_amdgcn_ballot_w64(pred) != 0ull; }
#endif
DI void softmax_pv(f32x16& S, f32x16 (&O)[2], float& m_run, float& l_run, VFrag& vf, float c1) {
    float tmax = S[0];
#pragma unroll
    for (int e = 1; e < 16; ++e) tmax = fmaxf(tmax, S[e]);
    tmax *= c1;
    if (wave_any(tmax > m_run + 8.f)) {
        tmax = fmaxf(tmax, __shfl_xor(tmax, 32));
        const float mnew = fmaxf(m_run, tmax), alpha = fast_exp2(m_run - mnew);
        m_run = mnew; l_run *= alpha;
#pragma unroll
        for (int e = 0; e < 16; ++e) { O[0][e] *= alpha; O[1][e] *= alpha; }
    }
    float ps = 0.f; unsigned pk[8];
#pragma unroll
    for (int e = 0; e < 8; ++e) { const float p0 = fast_exp2(S[2 * e] * c1 - m_run), p1 = fast_exp2(S[2 * e + 1] * c1 - m_run); ps += p0 + p1; pk[e] = pack2(p0, p1); }
    l_run += ps;
    u32x4 q0; q0.x = pk[0]; q0.y = pk[1]; q0.z = pk[2]; q0.w = pk[3];
    u32x4 q1; q1.x = pk[4]; q1.y = pk[5]; q1.z = pk[6]; q1.w = pk[7];
    const bf16x8 pb0 = __builtin_bit_cast(bf16x8, q0), pb1 = __builtin_bit_cast(bf16x8, q1);
    v_tr_wait(vf);
    u32x4 f;
    f.x = vf.r[0].x; f.y = vf.r[0].y; f.z = vf.r[1].x; f.w = vf.r[1].y; O[0] = MFMA32(__builtin_bit_cast(bf16x8, f), pb0, O[0]);
    f.x = vf.r[2].x; f.y = vf.r[2].y; f.z = vf.r[3].x; f.w = vf.r[3].y; O[0] = MFMA32(__builtin_bit_cast(bf16x8, f), pb1, O[0]);
    f.x = vf.r[4].x; f.y = vf.r[4].y; f.z = vf.r[5].x; f.w = vf.r[5].y; O[1] = MFMA32(__builtin_bit_cast(bf16x8, f), pb0, O[1]);
    f.x = vf.r[6].x; f.y = vf.r[6].y; f.z = vf.r[7].x; f.w = vf.r[7].y; O[1] = MFMA32(__builtin_bit_cast(bf16x8, f), pb1, O[1]);
}
DI void attn_item(const Params& p, int l, int item, char* smem, bool LAT) {
    const int tid = TIDX(), lane = tid & 63, w = tid >> 6, r = lane & 31, h = lane >> 5;
    const int SL = LAT ? DEC_SEQ : SEQ, NQB = SL / 64;
    const int b = item / (N_KV * NQB), kvh = (item / NQB) % N_KV, q0 = (item % NQB) * 64;
    const int tokbase = (LAT ? TC : 0) + b * SL;
    const bf16* Qb = (const bf16*)(p.ws + WS_Q); const bf16* Kb = (const bf16*)(p.ws + WS_KB); const bf16* Vb = (const bf16*)(p.ws + WS_VB);
    const bf16* GAb = (const bf16*)(p.ws + WS_GA); bf16* mixed = (bf16*)(p.ws + WS_XN);
    char* KL = smem + AT_KL; char* VL = smem + AT_VL; char* KC = smem + AT_KC; char* VC = smem + AT_VC;
    const u32x4 zero4 = {0u, 0u, 0u, 0u};
    PRB_BEGIN(1)
    {
        const bf16* ksrc; const bf16* vsrc; size_t stride;
        if (LAT) { const size_t o = (size_t)((b * DEPTH + l) * N_KV + kvh) * PAST_LEN * HD; ksrc = (const bf16*)(p.ws + WS_CKB) + o; vsrc = (const bf16*)(p.ws + WS_CVTB) + o; stride = HD; }
        else { ksrc = Kb + (size_t)tokbase * KV_W + kvh * HD; vsrc = Vb + (size_t)tokbase * KV_W + kvh * HD; stride = KV_W; }
        u32x4 ck[4], cv[4], lk[5], lv[5];
#pragma unroll
        for (int i = 0; i < 4; ++i) { const int id = tid + NTHR * i, row = id >> 3, c = id & 7; ck[i] = *(const u32x4*)(ksrc + (size_t)row * stride + c * 8); cv[i] = *(const u32x4*)(vsrc + (size_t)row * stride + c * 8); }
        if (LAT) {
#pragma unroll
            for (int i = 0; i < 5; ++i) {
                const int id = tid + NTHR * i, row = id >> 3, c = id & 7, kp = q0 - 128 + row;
                const bool inr = kp >= 0 && kp < SL;
                const size_t o = (size_t)(tokbase + (inr ? kp : 0)) * KV_W + kvh * HD + c * 8;
                lk[i] = *(const u32x4*)(Kb + o); lv[i] = *(const u32x4*)(Vb + o);
                if (!inr) { lk[i] = zero4; lv[i] = zero4; }
            }
#pragma unroll
            for (int i = 0; i < 5; ++i) { const int id = tid + NTHR * i, row = id >> 3, c = id & 7; *(u32x4*)(KL + swz128(row, c)) = lk[i]; *(u32x4*)(VL + swzv(row, c)) = lv[i]; }
        }
#pragma unroll
        for (int i = 0; i < 4; ++i) { const int id = tid + NTHR * i, row = id >> 3, c = id & 7; *(u32x4*)(KC + swz128(row, c)) = ck[i]; *(u32x4*)(VC + swzv(row, c)) = cv[i]; }
    }
    __syncthreads();
    PRB_END(1, smem)
    PRB_BEGIN(2)
    {
        const int g = w >> 1, qt = w & 1, head = kvh * 4 + g;
        const int qpos = q0 + 32 * qt + r;
        const size_t qtok = (size_t)tokbase + qpos;
        bf16x8 qraw[4], qrot[4];
#pragma unroll
        for (int s = 0; s < 4; ++s) { qraw[s] = *(const bf16x8*)(Qb + qtok * ATTN_W + head * HD + 16 * s + 8 * h); qrot[s] = qraw[s]; }
        if (LAT) {
            const f32x2* rope = (const f32x2*)(p.ws + WS_ROPE);
#pragma unroll
            for (int a = 0; a < 2; ++a)
#pragma unroll
                for (int jj = 0; jj < 8; ++jj) {
                    const f32x2 cs = rope[(qpos * 2 + a) * 16 + 8 * h + jj];
                    const float xa = bf2f((bf16)qraw[2 * a][jj]), xb = bf2f((bf16)qraw[2 * a + 1][jj]);
                    qrot[2 * a][jj] = (short)f2bf(xa * cs.x - xb * cs.y);
                    qrot[2 * a + 1][jj] = (short)f2bf(xb * cs.x + xa * cs.y);
                }
        }
        const int qq = (lane & 15) >> 2, pp = lane & 3, g16 = (lane >> 4) & 1, vrow = 4 * h + qq;
        const int voff0 = swzv(vrow, 2 * g16 + (pp >> 1)) + (pp & 1) * 8, voff1 = swzv(vrow, 4 + 2 * g16 + (pp >> 1)) + (pp & 1) * 8;
        const float c1 = 0.125f * 1.4426950408889634f;
        float m_run = p.in[I_SINK][l * N_HEADS + head] * 1.4426950408889634f, l_run = h == 0 ? 1.f : 0.f;
        f32x16 O[2];
#pragma unroll
        for (int e = 0; e < 16; ++e) { O[0][e] = 0.f; O[1][e] = 0.f; }
        if (LAT) {
            for (int jt = qt; jt < qt + 9; ++jt) {
                VFrag vf; v_tr_issue(VL + 4096 * jt + voff0, VL + 4096 * jt + voff1, vf);
                f32x16 S;
#pragma unroll
                for (int e = 0; e < 16; ++e) S[e] = 0.f;
                const int krow = 32 * jt + r;
#pragma unroll
                for (int s = 0; s < 4; ++s) S = MFMA32(*(const bf16x8*)(KL + swz128(krow, 2 * s + h)), qrot[s], S);
                const int kt0 = q0 - 128 + 32 * jt, qt0 = q0 + 32 * qt;
                if (kt0 + 31 - qt0 > 128 || qt0 + 31 - kt0 > 128 || kt0 < 0 || kt0 + 31 >= SL) {
#pragma unroll
                    for (int e = 0; e < 16; ++e) {
                        const int kp = kt0 + (e & 3) + 8 * (e >> 2) + 4 * h, dd = kp - qpos;
                        const bool ok = dd <= 128 && dd >= -128 && kp >= 0 && kp < SL;
                        S[e] = ok ? S[e] : -1e30f;
                    }
                }
                softmax_pv(S, O, m_run, l_run, vf, c1);
            }
        }
        for (int jt = 0; jt < 8; ++jt) {
            VFrag vf; v_tr_issue(VC + 4096 * jt + voff0, VC + 4096 * jt + voff1, vf);
            f32x16 S;
#pragma unroll
            for (int e = 0; e < 16; ++e) S[e] = 0.f;
            const int krow = 32 * jt + r;
#pragma unroll
            for (int s = 0; s < 4; ++s) S = MFMA32(*(const bf16x8*)(KC + swz128(krow, 2 * s + h)), qraw[s], S);
            softmax_pv(S, O, m_run, l_run, vf, c1);
        }
        const float inv = 1.f / (l_run + __shfl_xor(l_run, 32));
#pragma unroll
        for (int dt = 0; dt < 2; ++dt)
#pragma unroll
            for (int rg = 0; rg < 4; ++rg) {
                const int d0 = dt * 32 + 8 * rg + 4 * h;
                const u32x2 gv = *(const u32x2*)(GAb + qtok * ATTN_W + head * HD + d0);
                const float g0 = bf2f((bf16)(gv.x & 0xffffu)), g1 = bf2f((bf16)(gv.x >> 16)), g2 = bf2f((bf16)(gv.y & 0xffffu)), g3 = bf2f((bf16)(gv.y >> 16));
                u32x2 o; o.x = pack2(O[dt][4 * rg] * inv * g0, O[dt][4 * rg + 1] * inv * g1); o.y = pack2(O[dt][4 * rg + 2] * inv * g2, O[dt][4 * rg + 3] * inv * g3);
                *(u32x2*)(mixed + qtok * MIX_W + head * HD + d0) = o;
            }
    }
    PRB_END(2, smem)
    __syncthreads();
}

DI void phase_p0(const Params& p_, char* smem) {
    constexpr int I_T1 = DEPTH * (D_MODEL / 64) * (IN_COLS / 64), I_T2 = DEPTH * (MIX_W / 64) * (D_MODEL / 64);
    constexpr int I_MOD = DEPTH * (3 * D_MODEL / 64), I_ROPE = DEC_SEQ * 32 / NTHR, I_HID = DEPTH * (SEQ + DEC_SEQ) / 64;
    constexpr int I_CACHE = (2 * DEC_BATCH * DEPTH * PAST_LEN * KV_W / 8 + NTHR - 1) / NTHR;
    constexpr int TOTAL = I_T1 + I_T2 + I_MOD + I_ROPE + I_HID + I_CACHE;
    for (int it = BIDX(); it < TOTAL; it += gridDim.x) {
        const Params p = launder(p_);
        int q = it;
        if (q < I_T1 + I_T2) {
            const bool w1 = q < I_T1; if (!w1) q -= I_T1;
            const int per = w1 ? (D_MODEL / 64) * (IN_COLS / 64) : (MIX_W / 64) * (D_MODEL / 64), l = q / per;
            if (w1) p0_transpose_item(p.in[I_WIN] + (size_t)l * D_MODEL * IN_COLS, D_MODEL, IN_COLS, (bf16*)(p.ws + WS_WINT) + (size_t)l * IN_COLS * D_MODEL, q % per, smem);
            else p0_transpose_item(p.in[I_WOUT] + (size_t)l * MIX_W * D_MODEL, MIX_W, D_MODEL, (bf16*)(p.ws + WS_WOUTT) + (size_t)l * D_MODEL * MIX_W, q % per, smem);
            continue; }
        q -= I_T1 + I_T2;
        if (q < I_MOD) { p0_mod_item(p, q, smem); continue; }
        q -= I_MOD;
        if (q < I_ROPE) { p0_rope_item(p, q); continue; }
        q -= I_ROPE;
        if (q < I_HID) { p0_hid2_item(p, q); continue; }
        q -= I_HID;
        p0_cache_item(p, q);
    }
}
DI void phase_mix(const Params& p_, int l, int fl, int qid, char* smem, int mask) {
    constexpr int I_HL = HYENA_W * ((DEC_BATCH / 2 + 1) / 2), I_AL = DEC_BATCH * N_KV * (DEC_SEQ / 64), I_AC = BATCH * N_KV * (SEQ / 64);
    constexpr int I_HC = HYENA_W / 2, I_SC = T / 256, I_FL = HYENA_W, I_FC = HYENA_W / 16;
    static_assert(BATCH / 2 <= 16, "ctx hyena: one bank holds 16 batch pairs");
    const int nf = fl >= 0 ? I_FL + I_FC : 0;
    for (;;) {
        const Params p = launder(p_);
        int q = wq_next(p, qid, smem);
        if (q >= I_HC + I_HL + nf + I_AL + I_AC + I_SC) break;
        if (q < I_HC + I_HL) { const bool lat = q >= I_HC; if (mask & (lat ? 1 : 2)) hyena_item(p, l, lat ? q - I_HC : q, smem, lat); continue; }
        q -= I_HC + I_HL;
        if (q < nf) { const bool lat = q < I_FL; filter_item(p, fl, lat ? q : q - I_FL, smem, lat); continue; }
        q -= nf;
        if (q < I_AL + I_AC) { const bool lat = q < I_AL; if (mask & (lat ? 4 : 8)) attn_item(p, l, lat ? q : q - I_AL, smem, lat); continue; }
        q -= I_AL + I_AC;
        if (mask & 16) shortconv_item(p, l, q);
    }
}
constexpr int I_FILT = HYENA_W + HYENA_W / 16, I_FILT_A = I_FILT / 2;
DI void phase_filters(const Params& p_, int l, int qid, char* smem, int first, int count) {
    constexpr int I_FL = HYENA_W, I_FC = HYENA_W / 16;
    for (;;) {
        const Params p = launder(p_);
        int q = wq_next(p, qid, smem);
        if (q >= count) break;
        q += first;
        const bool lat = q >= I_FC;
        filter_item(p, l, lat ? q - I_FC : q, smem, lat);
    }
}
DI void phase_p1(const Params& p_, int qid, char* smem) {
    constexpr int I_NB = T / 64;
    for (;;) {
        const Params p = launder(p_);
        int q = wq_next(p, qid, smem);
        if (q >= I_FILT + I_NB) break;
        if (q < I_FILT) { const bool lat = q >= HYENA_W / 16; filter_item(p, 0, lat ? q - HYENA_W / 16 : q, smem, lat); continue; }
        q -= I_FILT;
#pragma unroll 1
        for (int i = 0; i < 4; ++i) norm_item(p, 0, q * 4 + i);
    }
}
DI void phase_norm(const Params& p, int l) {
    for (int it = BIDX(); it < T / 16; it += gridDim.x) norm_item(p, l, it);
}
DI void phase_hytr(const Params& p, char* smem) {
    for (int it = BIDX(); it < T / 64; it += gridDim.x) hytr_item(p, it, smem);
}

#ifndef PH_STOP
#define PH_STOP 1000
#endif
#ifndef DUP
#define DUP -1
#endif
#ifndef DMASK
#define DMASK 31
#endif
#ifndef PROBE_SEL
#define PROBE_SEL 0
#endif
#ifndef PROBE_SCALE
#define PROBE_SCALE 10.f
#endif
#ifndef PROBE_WORK
#define PROBE_WORK 0
#endif
__global__ void __launch_bounds__(NTHR, 2) fwd_kernel(Params p_) {
#ifdef EMU
    char* smem = emu_smem();
#else
    extern __shared__ __attribute__((aligned(16))) char smem[];
    volatile LAS unsigned* xst = (volatile LAS unsigned*)(smem + LDS_BYTES - 16);
    if (TIDX() == 0) { xst[0] = 0u; xst[1] = 0u; }
    __syncthreads();
    const XcdBarrier xbar = xcd_barrier_post((unsigned*)(p_.ws + WS_BAR), xst);
#endif
    constexpr int NPH = 2 + 5 * DEPTH;
#if PROBE_SEL
    unsigned long long tacc = 0ull, tprev = __builtin_amdgcn_s_memrealtime();
#if defined(PROBE_SEC_ON)
    if (TIDX() == 0) *(volatile unsigned long long*)(smem + LDS_BYTES - 48) = 0ull;
    __syncthreads();
#endif
#endif
#pragma unroll 1
    for (int ph = 0; ph < NPH && ph < PH_STOP; ++ph) {
#pragma unroll 1
        for (int rep = 0; rep < (ph == DUP ? 2 : 1); ++rep) {
            const Params p = launder(p_);
            const int l = ph >= 2 ? (ph - 2) / 5 : 0, k = ph >= 2 ? (ph - 2) % 5 : -1;
            const int qid = ph + 32 * rep;
            if (ph == 0) phase_p0(p, smem);
            else if (ph == 1) phase_p1(p, qid, smem);
            else if (k == 1) phase_mix(p, l, (rep || l + 1 >= DEPTH) ? -1 : l + 1, qid, smem, rep ? DMASK : 31);
            else if (k == 0 || k == 3) {
                GemmJob job; job.p = p; job.mode = k == 0 ? 0 : 1; job.l = l; job.K = k == 0 ? D_MODEL : MIX_W;
                gemm_phase((ldsptr_t)smem, job);
            } else if (k == 2) phase_hytr(p, smem);
            else phase_norm(p, l + 1);
        }
#if PROBE_SEL
        {
            const int kk = ph == 0 ? 0 : (ph == 1 ? 1 : 2 + (ph - 2) % 5);
            unsigned long long tnow = __builtin_amdgcn_s_memrealtime();
            if (PROBE_WORK && ((PROBE_SEL >> kk) & 1)) tacc += tnow - tprev;
            GRID_SYNC();
            tnow = __builtin_amdgcn_s_memrealtime();
            if (!PROBE_WORK && ((PROBE_SEL >> kk) & 1)) tacc += tnow - tprev;
            tprev = tnow;
        }
#else
        if (ph + 1 < NPH) GRID_SYNC();
#endif
    }
#if PROBE_SEL
#if defined(PROBE_SEC_ON)
    if (BIDX() == 0 && TIDX() == 0) p_.out[OUT_YS + 777] = (float)*(volatile unsigned long long*)(smem + LDS_BYTES - 48) / (100.f * PROBE_SCALE);
#elif PROBE_WORK >= 2
    {
        unsigned* slot = (unsigned*)(p_.ws + WS_WQ) + 63 * 64;
        if (TIDX() == 0) { if (PROBE_WORK == 2) atomicMax(slot, (unsigned)tacc); else atomicMin(slot + 1, ~(unsigned)tacc == 0u ? 0u : (unsigned)tacc + 0u); }
        GRID_SYNC();
        if (BIDX() == 0 && TIDX() == 0) p_.out[OUT_YS + 777] = (float)__hip_atomic_load(slot + (PROBE_WORK == 2 ? 0 : 1), __ATOMIC_RELAXED, __HIP_MEMORY_SCOPE_AGENT) / (100.f * PROBE_SCALE);
    }
#else
    if (BIDX() == 0 && TIDX() == 0) p_.out[OUT_YS + 777] = (float)tacc / (100.f * PROBE_SCALE);
#endif
#endif
}

#ifndef EMU
extern "C" void kernel_launch(void* const* d_in, const int* in_sizes, int n_in, void* d_out, int out_size, void* d_ws, size_t ws_size, hipStream_t stream) {
    static int grid = 0;
    if (grid == 0) {
        if (n_in != 22 || (size_t)out_size != OUT_TOTAL || ws_size < WS_END) { fprintf(stderr, "kernel_launch: unexpected sizes n_in %d out %d ws %zu (need %zu)\n", n_in, out_size, ws_size, (size_t)WS_END); grid = -1; return; }
        int dev = 0, cus = 0, per_cu = 0;
        hipGetDevice(&dev); hipDeviceGetAttribute(&cus, hipDeviceAttributeMultiprocessorCount, dev);
        if (hipFuncSetAttribute((const void*)fwd_kernel, hipFuncAttributeMaxDynamicSharedMemorySize, LDS_BYTES) != hipSuccess) { fprintf(stderr, "hipFuncSetAttribute failed\n"); grid = -1; return; }
        hipOccupancyMaxActiveBlocksPerMultiprocessor(&per_cu, (const void*)fwd_kernel, NTHR, LDS_BYTES);
        if (per_cu < 1) { fprintf(stderr, "occupancy query says %d\n", per_cu); grid = -1; return; }
        grid = cus;
    }
    if (grid < 0) return;
    Params p{};
    for (int i = 0; i < 22; ++i) p.in[i] = (const float*)d_in[i];
    p.out = (float*)d_out; p.ws = (unsigned char*)d_ws;
    if (hipMemsetAsync((char*)d_ws + WS_BAR, 0, 65536, stream) != hipSuccess) { fprintf(stderr, "memset failed\n"); return; }
    hipLaunchKernelGGL(fwd_kernel, dim3(grid), dim3(NTHR), LDS_BYTES, stream, p);
    const hipError_t e = hipPeekAtLastError();
    if (e != hipSuccess) fprintf(stderr, "launch failed: %s (grid %d)\n", hipGetErrorString(e), grid);
}
#endif
```
